# Optimizing an MI355X kernel written in HIP

```python
import math
import jax, jax.numpy as jnp
from jax import lax
import numpy as np

D_MODEL = 1024
BATCH = 32
SEQ = 256
DEPTH = 2
DEC_BATCH = 2
DEC_SEQ = 2048
PAST_LEN = 512

GRID_W = 64
EPS = 1e-6
H_A = 8
DK = 64
DV = 64
W_A = H_A * DV
QKV_W = 2 * H_A * DK + H_A * DV
CONV_K = 3
CHUNK = 64
W_B = 512
HY_ORDER = 2
HY_EMB = 33
HY_HID = 64
HY_DECAY_TARGET = 1e-2
HY_FAST_PCT = 0.3
HY_SLOW_PCT = 1.5
G_C = 8
DC = 64
W_C = G_C * DC
N_BRANCH = 3
D_FF = ((8 * D_MODEL + 3 * 256 - 1) // (3 * 256)) * 256
OFF_Z = QKV_W
OFF_B = OFF_Z + W_A
OFF_A = OFF_B + 2 * H_A
OFF_HY = OFF_A + 2 * H_A
OFF_FN = OFF_HY + (HY_ORDER + 1) * W_B
OFF_GATE = OFF_FN + W_C
D_IN = OFF_GATE + N_BRANCH * D_MODEL

kernel_name = "hybrid_deltanet_hyena_fnet_diffusion_step"


def rmsnorm(x, g):
    xf = x.astype(jnp.float32)
    y = xf * lax.rsqrt(jnp.mean(xf * xf, axis=-1, keepdims=True) + EPS)
    return (y * g.astype(jnp.float32)).astype(x.dtype)


def l2norm(t):
    return t * lax.rsqrt(jnp.sum(t * t, axis=-1, keepdims=True) + EPS)


def centred_dwconv(x, w):
    k = w.shape[0]
    p = k // 2
    L = x.shape[1]
    xp = jnp.pad(x, ((0, 0), (p, p), (0, 0)))
    out = xp[:, 0:L] * w[0]
    for i in range(1, k):
        out = out + xp[:, i:i + L] * w[i]
    return out


def grid_pos_embed(n_tokens):
    rows = n_tokens // GRID_W
    r = jnp.repeat(jnp.arange(rows), GRID_W).astype(jnp.float32)
    col = jnp.tile(jnp.arange(GRID_W), rows).astype(jnp.float32)
    quarter = D_MODEL // 4
    omega = 1.0 / (10000.0 ** (jnp.arange(quarter, dtype=jnp.float32) / quarter))

    def emb(pos):
        a = pos[:, None] * omega[None, :]
        return jnp.concatenate([jnp.sin(a), jnp.cos(a)], axis=-1)

    return jnp.concatenate([emb(r), emb(col)], axis=-1)


def gated_delta_chunked(q, k, v, g, beta, s0):
    bn, L, H, _ = q.shape
    n = L // CHUNK

    def chunks(t):
        t = t.reshape((bn, n, CHUNK, H) + t.shape[3:])
        return jnp.moveaxis(t, 3, 1)

    q, k, v, g, beta = chunks(q), chunks(k), chunks(v), chunks(g), chunks(beta)
    gc = jnp.cumsum(g, axis=-1)
    idx = jnp.arange(CHUNK)
    incl = idx[:, None] >= idx[None, :]
    strict = idx[:, None] > idx[None, :]
    decay = jnp.exp(jnp.where(incl, gc[..., :, None] - gc[..., None, :], -jnp.inf))
    kb = k * beta[..., None]
    a_low = jnp.where(strict, jnp.einsum('bhnid,bhnjd->bhnij', kb, k) * decay, 0.0)
    m = a_low + jnp.eye(CHUNK, dtype=a_low.dtype)
    u = lax.linalg.triangular_solve(m, v * beta[..., None], left_side=True, lower=True, unit_diagonal=True)
    w = lax.linalg.triangular_solve(m, kb * jnp.exp(gc)[..., None], left_side=True, lower=True, unit_diagonal=True)
    qk = jnp.einsum('bhnid,bhnjd->bhnij', q, k) * decay
    qg = q * jnp.exp(gc)[..., None]
    kg = k * jnp.exp(gc[..., -1:] - gc)[..., None]
    glast = jnp.exp(gc[..., -1])

    def step(s, inp):
        u_n, w_n, qk_n, qg_n, kg_n, gl_n = inp
        v_new = u_n - jnp.einsum('bhcd,bhde->bhce', w_n, s)
        o = jnp.einsum('bhcd,bhde->bhce', qg_n, s) + jnp.einsum('bhij,bhje->bhie', qk_n, v_new)
        s = s * gl_n[..., None, None] + jnp.einsum('bhcd,bhce->bhde', kg_n, v_new)
        return s, o

    xs = (jnp.moveaxis(u, 2, 0), jnp.moveaxis(w, 2, 0), jnp.moveaxis(qk, 2, 0),
          jnp.moveaxis(qg, 2, 0), jnp.moveaxis(kg, 2, 0), jnp.moveaxis(glast, 2, 0))
    s_fin, o = lax.scan(step, s0, xs)
    o = jnp.transpose(o, (1, 0, 3, 2, 4)).reshape(bn, L, H, v.shape[-1])
    return o, s_fin


def delta_mixer(qkv_raw, z, b_raw, a_raw, conv_w, a_log, dt_bias, norm_w, s0):
    bn, L, _ = qkv_raw.shape
    f32 = jnp.float32
    qkv = jax.nn.silu(centred_dwconv(qkv_raw, conv_w).astype(f32))
    q = l2norm(qkv[..., :H_A * DK].reshape(bn, L, H_A, DK)) * (DK ** -0.5)
    k = l2norm(qkv[..., H_A * DK:2 * H_A * DK].reshape(bn, L, H_A, DK))
    v = qkv[..., 2 * H_A * DK:].reshape(bn, L, H_A, DV)
    beta = jax.nn.sigmoid(b_raw.astype(f32))
    g = -jnp.exp(a_log.astype(f32)) * jax.nn.softplus(a_raw.astype(f32) + dt_bias.astype(f32))
    flip = lambda t: t[:, ::-1]
    o_f, s_f = gated_delta_chunked(q, k, v, g[:, :, 0], beta[:, :, 0], s0[:, 0])
    o_b, s_b = gated_delta_chunked(flip(q), flip(k), flip(v), flip(g[:, :, 1]), flip(beta[:, :, 1]), s0[:, 1])
    o = o_f + flip(o_b)
    o = rmsnorm(o, norm_w) * jax.nn.silu(z.astype(f32).reshape(bn, L, H_A, DV))
    return o.reshape(bn, L, W_A), jnp.stack([s_f, s_b], axis=1)


def hyena_filters(L, w1, b1, freq, w2, b2, w3):
    f32 = jnp.float32
    bands = (HY_EMB - 1) // 2
    t = jnp.linspace(0.0, 1.0, L, dtype=f32)[:, None]
    wpos = (2.0 * math.pi / L) * jnp.arange(L, dtype=f32)[:, None]
    fr = jnp.linspace(1e-4, bands - 1, bands, dtype=f32)[None, :]
    zpos = jnp.concatenate([t, jnp.cos(fr * wpos), -jnp.sin(fr * wpos)], axis=-1)
    fq = freq.astype(f32)
    h = jnp.sin(fq * (zpos @ w1.astype(f32) + b1.astype(f32)))
    h = jnp.sin(fq * (h @ w2.astype(f32) + b2.astype(f32)))
    h = h @ w3.astype(f32)
    deltas = jnp.abs(jnp.linspace(math.log(HY_DECAY_TARGET) / HY_SLOW_PCT,
                                  math.log(HY_DECAY_TARGET) / HY_FAST_PCT, W_B, dtype=f32))
    window = jnp.exp(-t * deltas[None, :])
    return h.reshape(L, 2 * HY_ORDER, W_B) * window[:, None, :]


def hyena_mixer(xh, conv_w, w1, b1, freq, w2, b2, w3, bias):
    bn, L, _ = xh.shape
    uc = centred_dwconv(xh, conv_w).astype(jnp.float32)
    x1, x2, v = jnp.split(uc, 3, axis=-1)
    hf = hyena_filters(L, w1, b1, freq, w2, b2, w3)
    hspec = jnp.fft.rfft(hf, n=2 * L, axis=0)
    hk = hspec[:, 0::2] + jnp.conj(hspec[:, 1::2])
    bias = bias.astype(jnp.float32)
    z = v
    for o, gate in enumerate((x1, x2)):
        zs = jnp.fft.rfft(z, n=2 * L, axis=1)
        conv = jnp.fft.irfft(zs * hk[None, :, o], n=2 * L, axis=1)[:, :L]
        z = gate * (conv + bias[o] * z)
    return z


def fourier_mixer(xc):
    bn, L, _ = xc.shape
    y = jnp.fft.fft2(xc.astype(jnp.float32).reshape(bn, L, G_C, DC), axes=(1, 3), norm='ortho').real
    return y.reshape(bn, L, W_C)


def parallel_mixer(h, s0, p):
    bn, L, _ = h.shape
    proj = h @ p['w_in']
    y_a, s_fin = delta_mixer(proj[..., :QKV_W], proj[..., OFF_Z:OFF_B],
                             proj[..., OFF_B:OFF_A].reshape(bn, L, 2, H_A),
                             proj[..., OFF_A:OFF_HY].reshape(bn, L, 2, H_A),
                             p['conv_qkv'], p['a_log'], p['dt_bias'], p['norm_a'], s0)
    y_b = hyena_mixer(proj[..., OFF_HY:OFF_FN], p['conv_hy'], p['hy_w1'], p['hy_b1'], p['hy_freq'],
                      p['hy_w2'], p['hy_b2'], p['hy_w3'], p['hy_bias'])
    y_c = fourier_mixer(proj[..., OFF_FN:OFF_GATE])
    gates = jax.nn.sigmoid(proj[..., OFF_GATE:].astype(jnp.float32)).reshape(bn, L, N_BRANCH, D_MODEL)
    merged = (gates[:, :, 0] * (y_a @ p['w_pa']) + gates[:, :, 1] * (y_b @ p['w_pb'])
              + gates[:, :, 2] * (y_c @ p['w_pc']))
    return merged.astype(h.dtype) @ p['w_o'], s_fin


def swiglu(h, w_gu, w_down):
    gu = h @ w_gu
    gate, up = jnp.split(gu, 2, axis=-1)
    return (jax.nn.silu(gate) * up) @ w_down


def trunk_layer(x, mod, s0, p):
    sh1, sc1, g1, sh2, sc2, g2 = jnp.split(mod, 6, axis=-1)
    h = rmsnorm(x, p['norm1_g']) * (1.0 + sc1) + sh1
    y, s_fin = parallel_mixer(h, s0, p)
    x = x + g1 * y
    h = rmsnorm(x, p['norm2_g']) * (1.0 + sc2) + sh2
    x = x + g2 * swiglu(h, p['w_gu'], p['w_down'])
    return x, s_fin


def setup_inputs(seed: int = 0) -> dict:
    key = jax.random.key(seed)
    keys = list(jax.random.split(key, 32))
    f32 = jnp.float32

    def nrm(shape, scale):
        return jax.random.normal(keys.pop(), shape, f32) * scale

    def gain(shape):
        return 1.0 + nrm(shape, 0.02)

    x_prompt = nrm((BATCH, SEQ, D_MODEL), 1.0)
    x_sample = nrm((DEC_BATCH, DEC_SEQ, D_MODEL), 1.0)
    state_delta = nrm((DEC_BATCH, DEPTH, 2, H_A, DK, DV), 0.1)
    c = nrm((DEC_BATCH, D_MODEL), 1.0)
    c_ctx = nrm((D_MODEL,), 1.0)
    w_mod = nrm((DEPTH, D_MODEL, 6 * D_MODEL), 0.5 * D_MODEL ** -0.5)
    b_mod = nrm((DEPTH, 6 * D_MODEL), 0.01)
    norm1_g = gain((DEPTH, D_MODEL))
    norm2_g = gain((DEPTH, D_MODEL))
    w_in = nrm((DEPTH, D_MODEL, D_IN), D_MODEL ** -0.5)
    conv_qkv = nrm((DEPTH, CONV_K, QKV_W), CONV_K ** -0.5)
    a_log = jnp.log(jax.random.uniform(keys.pop(), (DEPTH, 2, H_A), f32, 1.0, 16.0))
    dt = jnp.exp(jax.random.uniform(keys.pop(), (DEPTH, 2, H_A), f32, math.log(1e-3), math.log(1e-1)))
    dt_bias = dt + jnp.log(-jnp.expm1(-dt))
    norm_a = gain((DEPTH, DV))
    conv_hy = nrm((DEPTH, CONV_K, (HY_ORDER + 1) * W_B), CONV_K ** -0.5)
    hy_w1 = nrm((DEPTH, HY_EMB, HY_HID), HY_EMB ** -0.5)
    hy_b1 = nrm((DEPTH, HY_HID), 0.02)
    hy_freq = gain((DEPTH, HY_HID))
    hy_w2 = nrm((DEPTH, HY_HID, HY_HID), HY_HID ** -0.5)
    hy_b2 = nrm((DEPTH, HY_HID), 0.02)
    hy_w3 = nrm((DEPTH, HY_HID, 2 * HY_ORDER * W_B), 0.02)
    hy_bias = nrm((DEPTH, HY_ORDER, W_B), 0.5)
    w_pa = nrm((DEPTH, W_A, D_MODEL), W_A ** -0.5)
    w_pb = nrm((DEPTH, W_B, D_MODEL), W_B ** -0.5)
    w_pc = nrm((DEPTH, W_C, D_MODEL), W_C ** -0.5)
    w_o = nrm((DEPTH, D_MODEL, D_MODEL), D_MODEL ** -0.5)
    w_gu = nrm((DEPTH, D_MODEL, 2 * D_FF), D_MODEL ** -0.5)
    w_down = nrm((DEPTH, D_FF, D_MODEL), D_FF ** -0.5)
    norm_f = gain((D_MODEL,))
    return {"x_prompt": x_prompt, "x_sample": x_sample, "state_delta": state_delta,
            "c": c, "c_ctx": c_ctx, "w_mod": w_mod, "b_mod": b_mod,
            "norm1_g": norm1_g, "norm2_g": norm2_g, "w_in": w_in, "conv_qkv": conv_qkv,
            "a_log": a_log, "dt_bias": dt_bias, "norm_a": norm_a, "conv_hy": conv_hy,
            "hy_w1": hy_w1, "hy_b1": hy_b1, "hy_freq": hy_freq, "hy_w2": hy_w2,
            "hy_b2": hy_b2, "hy_w3": hy_w3, "hy_bias": hy_bias, "w_pa": w_pa,
            "w_pb": w_pb, "w_pc": w_pc, "w_o": w_o, "w_gu": w_gu, "w_down": w_down,
            "norm_f": norm_f}


def reference(x_prompt, x_sample, state_delta, c, c_ctx, w_mod, b_mod, norm1_g, norm2_g,
              w_in, conv_qkv, a_log, dt_bias, norm_a, conv_hy, hy_w1, hy_b1, hy_freq,
              hy_w2, hy_b2, hy_w3, hy_bias, w_pa, w_pb, w_pc, w_o, w_gu, w_down, norm_f):
    xp = x_prompt
    xs = x_sample + grid_pos_embed(x_sample.shape[1]).astype(x_sample.dtype)[None]
    s_zero = jnp.zeros((x_prompt.shape[0], 2, H_A, DK, DV), jnp.float32)
    ctx_states = []
    for l in range(DEPTH):
        p = {'w_in': w_in[l], 'conv_qkv': conv_qkv[l], 'a_log': a_log[l], 'dt_bias': dt_bias[l],
             'norm_a': norm_a[l], 'conv_hy': conv_hy[l], 'hy_w1': hy_w1[l], 'hy_b1': hy_b1[l],
             'hy_freq': hy_freq[l], 'hy_w2': hy_w2[l], 'hy_b2': hy_b2[l], 'hy_w3': hy_w3[l],
             'hy_bias': hy_bias[l], 'w_pa': w_pa[l], 'w_pb': w_pb[l], 'w_pc': w_pc[l],
             'w_o': w_o[l], 'w_gu': w_gu[l], 'w_down': w_down[l],
             'norm1_g': norm1_g[l], 'norm2_g': norm2_g[l]}
        mod_ctx = (jax.nn.silu(c_ctx) @ w_mod[l] + b_mod[l])[None, None, :]
        mod_lat = (jax.nn.silu(c) @ w_mod[l] + b_mod[l])[:, None, :]
        xp, s_ctx = trunk_layer(xp, mod_ctx, s_zero, p)
        ctx_states.append(s_ctx)
        xs, _ = trunk_layer(xs, mod_lat, state_delta[:, l].astype(jnp.float32), p)
    y_prompt = rmsnorm(xp, norm_f)
    y_sample = rmsnorm(xs, norm_f)
    new_state_delta = jnp.stack(ctx_states, axis=1).astype(x_prompt.dtype)
    return (y_prompt, y_sample, new_state_delta)
```

```cpp
#include <hip/hip_runtime.h>
#include <cstdio>
#include <cstdint>

#ifndef MK_PER_PHASE
#define MK_PER_PHASE 0
#endif

#define LAS __attribute__((address_space(3)))
#define GAS __attribute__((address_space(1)))
typedef unsigned short bf16_t;
typedef short bf16x8 __attribute__((ext_vector_type(8)));
typedef float f32x4 __attribute__((ext_vector_type(4)));
typedef float f32x2 __attribute__((ext_vector_type(2)));
typedef unsigned u32x4 __attribute__((ext_vector_type(4)));
typedef unsigned u32x2 __attribute__((ext_vector_type(2)));

constexpr int DM = 1024, NTOK = 12288, NCTX = 8192, LCTX = 256, LLAT = 2048, BCTX = 32, BLAT = 2;
constexpr int HA = 8, QKVW = 1536, DFF = 2816, DIN = 7200;
constexpr int OFF_Z = 1536, OFF_B = 2048, OFF_HY = 2080, OFF_FN = 3616, OFF_GATE = 4128;
constexpr float EPS = 1e-6f;
enum { I_XP = 0, I_XS, I_STATE, I_C, I_CCTX, I_WMOD, I_BMOD, I_N1G, I_N2G, I_WIN, I_CONVQKV, I_ALOG, I_DTB, I_NORMA, I_CONVHY,
       I_HW1, I_HB1, I_HFREQ, I_HW2, I_HB2, I_HW3, I_HBIAS, I_WPA, I_WPB, I_WPC, I_WO, I_WGU, I_WDOWN, I_NORMF, N_IN };

constexpr size_t MiB = 1u << 20;
constexpr size_t WS_CTL = 0, CTL_ZERO_BYTES = 256 * 1024;
constexpr size_t WS_MOD = 1 * MiB;
constexpr size_t WS_TABC = 2 * MiB;
constexpr size_t WS_FILC = 3 * MiB;
constexpr size_t WS_FILL = 5 * MiB;
constexpr size_t WS_TABL = 21 * MiB;
constexpr size_t WS_W = 37 * MiB;
constexpr size_t W_N = WS_W;
constexpr size_t W_S = W_N + 2304 * 1024 * 2;
constexpr size_t W_G = W_S + 2560 * 1024 * 2;
constexpr size_t W_P = W_G + 3072 * 1024 * 2;
constexpr size_t W_O3 = W_P + 3 * 1024 * 512 * 2;
constexpr size_t W_GU = W_O3 + 1024 * 3072 * 2;
constexpr size_t W_DN = W_GU + 5632 * 1024 * 2;
constexpr size_t W_END = W_DN + 1024 * 2816 * 2;
static_assert(W_END <= 78 * MiB, "weights region");
constexpr size_t WS_A0 = 78 * MiB;
constexpr size_t WS_QKV = WS_A0, WS_OF = WS_A0, WS_OB = WS_A0 + 12 * MiB;
constexpr size_t WS_Z = 116 * MiB, WS_YA = WS_Z;
constexpr size_t WS_BA = 114 * MiB;
constexpr size_t WS_YB = 128 * MiB, WS_YC = 140 * MiB;
constexpr size_t WS_A5 = 152 * MiB;
constexpr size_t WS_H = WS_A5;
constexpr size_t WS_HYT = WS_A5 + 24 * MiB;
constexpr size_t WS_XCS = WS_A5 + 60 * MiB;
constexpr size_t WS_XCSL = WS_XCS, WS_XCSC = WS_XCS + 8 * MiB;
constexpr size_t WS_QN = WS_A5, WS_KN = WS_A5 + 12 * MiB;
constexpr size_t WS_U = WS_A5 + 24 * MiB;
constexpr size_t WS_WW = WS_A5 + 48 * MiB;
constexpr size_t WS_QK = WS_A5 + 72 * MiB;
constexpr size_t WS_GC = WS_A5 + 96 * MiB;
constexpr size_t WS_GATE = WS_A5 + 24 * MiB;
constexpr size_t WS_ACT = WS_A5 + 24 * MiB;
constexpr size_t WS_END = 256 * MiB;
static_assert(WS_GC + 2 * 8 * 192 * 64 * 4 <= WS_END && WS_GATE + (size_t)NTOK * 3072 * 2 <= WS_END, "ws map");
constexpr int CW_BAR = 4096;
constexpr int CW_Q = 16384;

constexpr int RING_BYTES = 131072, LDSCTL_OFF = RING_BYTES, MISC_OFF = LDSCTL_OFF + 320, LDS_BYTES = 147456;
constexpr int NWAVES = 8, NTHR = 512;

#define RLX_AGENT __ATOMIC_RELAXED, __HIP_MEMORY_SCOPE_AGENT
#define LDS_WAIT() asm volatile("s_waitcnt lgkmcnt(0)" ::: "memory")
__device__ __forceinline__ unsigned f2bf(float f) { unsigned u = __builtin_bit_cast(unsigned, f); return (u + 0x7fffu + ((u >> 16) & 1u)) >> 16; }
__device__ __forceinline__ unsigned pk2(float lo, float hi) { return f2bf(lo) | (f2bf(hi) << 16); }
__device__ __forceinline__ float bf2f(unsigned short b) { return __builtin_bit_cast(float, (unsigned)b << 16); }
__device__ __forceinline__ float bflo(unsigned w) { return __builtin_bit_cast(float, w << 16); }
__device__ __forceinline__ float bfhi(unsigned w) { return __builtin_bit_cast(float, w & 0xffff0000u); }
__device__ __forceinline__ float sin_rev(float r) { return __builtin_amdgcn_sinf(r - rintf(r)); }
__device__ __forceinline__ float cos_rev(float r) { return __builtin_amdgcn_cosf(r - rintf(r)); }
__device__ __forceinline__ float sin_rad(float x) { return sin_rev(x * 0.15915494309189535f); }
__device__ __forceinline__ float cos_rad(float x) { return cos_rev(x * 0.15915494309189535f); }
__device__ __forceinline__ float sigmoidf_(float x) { return 1.f / (1.f + __expf(-x)); }
__device__ __forceinline__ float siluf_(float x) { return x / (1.f + __expf(-x)); }
__device__ __forceinline__ float wave_sum(float v) {
#pragma unroll
    for (int o = 1; o < 64; o <<= 1) v += __shfl_xor(v, o);
    return v;
}
template <class T> __device__ __forceinline__ T* opq(T* p) {
    unsigned lo = (unsigned)(uintptr_t)p, hi = (unsigned)((uintptr_t)p >> 32); asm volatile("" : "+v"(lo), "+v"(hi));
    lo = __builtin_amdgcn_readfirstlane(lo); hi = __builtin_amdgcn_readfirstlane(hi); return (T*)(((uintptr_t)hi << 32) | (uintptr_t)lo);
}
__device__ __forceinline__ int seq_start(int s) { return s < 32 ? s * 256 : NCTX + (s - 32) * 2048; }
__device__ __forceinline__ int seq_len(int s) { return s < 32 ? 256 : 2048; }
__device__ __forceinline__ int mod_idx(int row) { return row < NCTX ? 0 : 1 + ((row - NCTX) >> 11); }

namespace pg8 {
constexpr int BM = 256, BK = 64, HALF = 128, HTB = HALF * BK * 2, STAGE_BYTES = 8 * HTB, NXCD = 8, WGM = 8;
__host__ __device__ __forceinline__ int lds_byte(int r, int c) { const int st = (r >> 4) * 2 + (c >> 5), rr = r & 15, cc = c & 31, ob = rr * 64 + cc * 2; return st * 1024 + (ob ^ (((ob >> 9) & 1) << 5)); }
__host__ __device__ __forceinline__ void stage_rc(int b, int& R, int& C) { const int st = b / 1024, sb = b % 1024, swz = sb ^ (((sb >> 9) & 1) << 5); R = (st >> 1) * 16 + swz / 64; C = (st & 1) * 32 + (swz % 64) / 2; }
__host__ __device__ __forceinline__ int perm32(int rho) { const int n = rho >> 4, i = rho & 15; return 8 * (i >> 2) + 4 * n + (i & 3); }

struct Unit { const char* a; const char* b; int r0, c0; };
struct Gemm { int K, lda, ldb; };

__device__ __forceinline__ bool static_order(long L, int nM, int nN, int& pm, int& pn) {
    const int nwg = nM * nN; if (L >= nwg) return false;
    int wgid = (int)L; { const int q = nwg / NXCD, r = nwg % NXCD, xcd = wgid % NXCD, off = wgid / NXCD; wgid = (xcd < r ? xcd * (q + 1) : r * (q + 1) + (xcd - r) * q) + off; }
    const int nig = WGM * nN, gid = wgid / nig, fm = gid * WGM, gsz = (nM - fm) < WGM ? (nM - fm) : WGM;
    pm = fm + ((wgid % nig) % gsz); pn = (wgid % nig) / gsz; return true;
}
__device__ __forceinline__ unsigned cvt_pk_bf16(float lo, float hi) { unsigned r; asm volatile("v_cvt_pk_bf16_f32 %0, %1, %2" : "=v"(r) : "v"(lo), "v"(hi)); return r; }

template <class Epi, class Sched, bool ALIGN_EPI, bool SP2>
__device__ __forceinline__ void gemm_phase(LAS unsigned char* lds, const Gemm g, const Sched& S, const Epi& E) {
    int tid_ = threadIdx.x; asm volatile("" : "+v"(tid_));
    const int tid = tid_, wid = __builtin_amdgcn_readfirstlane(tid >> 6), lane = tid & 63, wr = wid >> 2, wc = wid & 3, fr = lane & 15, fq = lane >> 4;
    const int K = g.K, nt = K / BK;
    unsigned voffA[2], voffB[2];
#pragma unroll
    for (int i = 0; i < 2; ++i) { int R, C; stage_rc(tid * 16 + i * 8192, R, C); const int Rb = Epi::PERM ? ((R & ~31) + perm32(R & 31)) : R;
        voffA[i] = (unsigned)(R * g.lda + C * 2); voffB[i] = (unsigned)(Rb * g.ldb + C * 2); }
    const size_t kstep = (size_t)(BK * 2);
    const size_t hstepA = (size_t)HALF * g.lda, hstepB = (size_t)HALF * g.ldb;
    const unsigned ldsw = (unsigned)wid * 1024u;
    const int aoff = lds_byte(wr * 64 + fr, fq * 8), boff = lds_byte(wc * 32 + fr, fq * 8);
#define PG8_SA(b, h) (((b) * 2 + (h)) * HTB)
#define PG8_SB(b, h) ((4 + (b) * 2 + (h)) * HTB)
#define PG8_STAGE(bufoff, gbase, voff) do { _Pragma("unroll") for (int _i = 0; _i < 2; ++_i) \
        __builtin_amdgcn_global_load_lds((const unsigned*)((const char*)(gbase) + (voff)[_i]), (LAS unsigned*)(lds + (bufoff) + ldsw + _i * 8192), 16, 0, 0); } while (0)
#define PG8_LDA(dst, b, h) do { _Pragma("unroll") for (int m = 0; m < 4; ++m) _Pragma("unroll") for (int k = 0; k < 2; ++k) dst[m][k] = *(const LAS bf16x8*)(lds + PG8_SA(b, h) + aoff + m * 2048 + k * 1024); } while (0)
#define PG8_LDB(dst, b, h) do { _Pragma("unroll") for (int n = 0; n < 2; ++n) _Pragma("unroll") for (int k = 0; k < 2; ++k) dst[n][k] = *(const LAS bf16x8*)(lds + PG8_SB(b, h) + boff + n * 2048 + k * 1024); } while (0)
#define PG8_MMA(ai, bj, At, Bt) do { __builtin_amdgcn_s_setprio(1); _Pragma("unroll") for (int m = 0; m < 4; ++m) _Pragma("unroll") for (int n = 0; n < 2; ++n) _Pragma("unroll") for (int k = 0; k < 2; ++k) \
        acc[ai][bj][m][n] = __builtin_amdgcn_mfma_f32_16x16x32_bf16(Bt[n][k], At[m][k], acc[ai][bj][m][n], 0, 0, 0); __builtin_amdgcn_s_setprio(0); } while (0)
#define PG8_WAIT_V(n) asm volatile("s_waitcnt vmcnt(" #n ")" ::: "memory")
#define PG8_WAIT_L(n) asm volatile("s_waitcnt lgkmcnt(" #n ")" ::: "memory")
#define PG8_BAR __builtin_amdgcn_s_barrier()
#define PG8_SCHED __builtin_amdgcn_sched_barrier(0)
    Unit cur, nxt; int ui = 0;
    if (!S.next(0, cur)) return;
    f32x4 acc[2][2][4][2];
#pragma unroll
    for (int a = 0; a < 2; ++a)
#pragma unroll
        for (int b = 0; b < 2; ++b)
#pragma unroll
            for (int m = 0; m < 4; ++m)
#pragma unroll
                for (int n = 0; n < 2; ++n) acc[a][b][m][n] = (f32x4){0.f, 0.f, 0.f, 0.f};
    bf16x8 At[4][2], B0[2][2], B1[2][2];
    const char* cA = cur.a; const char* cB = cur.b;
    if constexpr (SP2) {
        PG8_STAGE(PG8_SB(0, 0), cB, voffB); PG8_STAGE(PG8_SB(0, 1), cB + hstepB, voffB); PG8_STAGE(PG8_SA(0, 0), cA, voffA); PG8_STAGE(PG8_SA(0, 1), cA + hstepA, voffA);
        if (wr == 1) PG8_BAR;
        PG8_WAIT_V(2); PG8_BAR;
        PG8_STAGE(PG8_SB(1, 0), cB + kstep, voffB); PG8_STAGE(PG8_SA(1, 0), cA + kstep, voffA); PG8_STAGE(PG8_SB(1, 1), cB + hstepB + kstep, voffB);
        PG8_WAIT_V(6); PG8_BAR;
    } else {
        PG8_STAGE(PG8_SB(0, 0), cB, voffB); PG8_STAGE(PG8_SA(0, 0), cA, voffA); PG8_STAGE(PG8_SB(0, 1), cB + hstepB, voffB); PG8_STAGE(PG8_SA(0, 1), cA + hstepA, voffA);
        if (wr == 1) PG8_BAR;
        PG8_WAIT_V(4); PG8_BAR;
        PG8_STAGE(PG8_SB(1, 0), cB + kstep, voffB); PG8_STAGE(PG8_SA(1, 0), cA + kstep, voffA); PG8_STAGE(PG8_SB(1, 1), cB + hstepB + kstep, voffB);
        PG8_WAIT_V(6); PG8_BAR;
    }
    for (;;) {
        const bool has_next = S.next(ui + 1, nxt);
        const char* nA = has_next ? nxt.a : cA; const char* nB = has_next ? nxt.b : cB;
        for (int t = 0; t < nt; t += 2) {
            const bool last = (t == nt - 2);
            const char* a1 = cA + (size_t)(t + 1) * kstep;
            const char* a2 = last ? nA : cA + (size_t)(t + 2) * kstep; const char* b2 = last ? nB : cB + (size_t)(t + 2) * kstep;
            const char* a3 = a2 + kstep; const char* b3 = b2 + kstep;
            if constexpr (SP2) {
            PG8_LDB(B0, 0, 0); PG8_LDB(B1, 0, 1); PG8_SCHED; PG8_LDA(At, 0, 0); PG8_STAGE(PG8_SA(1, 1), a1 + hstepA, voffA);
            PG8_WAIT_V(8); PG8_WAIT_L(0); PG8_BAR; PG8_MMA(0, 0, At, B0); PG8_MMA(0, 1, At, B1); PG8_BAR; PG8_SCHED;
            PG8_LDA(At, 0, 1); PG8_STAGE(PG8_SB(0, 0), b2, voffB); PG8_STAGE(PG8_SB(0, 1), b2 + hstepB, voffB); PG8_STAGE(PG8_SA(0, 0), a2, voffA);
            PG8_WAIT_V(8); PG8_WAIT_L(0); PG8_BAR; PG8_MMA(1, 0, At, B0); PG8_MMA(1, 1, At, B1); PG8_BAR; PG8_SCHED;
            PG8_LDB(B0, 1, 0); PG8_LDB(B1, 1, 1); PG8_SCHED; PG8_LDA(At, 1, 0); PG8_STAGE(PG8_SA(0, 1), a2 + hstepA, voffA);
            PG8_WAIT_V(8); PG8_WAIT_L(0); PG8_BAR; PG8_MMA(0, 0, At, B0); PG8_MMA(0, 1, At, B1); PG8_BAR; PG8_SCHED;
            PG8_LDA(At, 1, 1); PG8_STAGE(PG8_SB(1, 0), b3, voffB); PG8_STAGE(PG8_SB(1, 1), b3 + hstepB, voffB); PG8_STAGE(PG8_SA(1, 0), a3, voffA);
            PG8_WAIT_V(8); PG8_WAIT_L(0); PG8_BAR; PG8_MMA(1, 0, At, B0); PG8_MMA(1, 1, At, B1); PG8_BAR; PG8_SCHED;
            } else {
            PG8_LDB(B0, 0, 0); PG8_SCHED; PG8_LDA(At, 0, 0); PG8_STAGE(PG8_SA(1, 1), a1 + hstepA, voffA);
            PG8_WAIT_L(8); PG8_BAR; PG8_WAIT_L(0); PG8_MMA(0, 0, At, B0); PG8_BAR; PG8_SCHED;
            PG8_LDB(B1, 0, 1); PG8_STAGE(PG8_SB(0, 0), b2, voffB);
            PG8_BAR; PG8_WAIT_L(0); PG8_MMA(0, 1, At, B1); PG8_BAR;
            PG8_LDA(At, 0, 1); PG8_STAGE(PG8_SA(0, 0), a2, voffA);
            PG8_BAR; PG8_WAIT_L(0); PG8_MMA(1, 0, At, B0); PG8_BAR; PG8_SCHED;
            PG8_STAGE(PG8_SB(0, 1), b2 + hstepB, voffB);
            PG8_WAIT_V(6); PG8_BAR; PG8_MMA(1, 1, At, B1); PG8_BAR;
            PG8_LDB(B0, 1, 0); PG8_SCHED; PG8_LDA(At, 1, 0); PG8_STAGE(PG8_SA(0, 1), a2 + hstepA, voffA);
            PG8_WAIT_L(8); PG8_BAR; PG8_WAIT_L(0); PG8_MMA(0, 0, At, B0); PG8_BAR; PG8_SCHED;
            PG8_LDB(B1, 1, 1); PG8_STAGE(PG8_SB(1, 0), b3, voffB);
            PG8_BAR; PG8_WAIT_L(0); PG8_MMA(0, 1, At, B1); PG8_BAR;
            PG8_LDA(At, 1, 1); PG8_STAGE(PG8_SA(1, 0), a3, voffA);
            PG8_BAR; PG8_WAIT_L(0); PG8_MMA(1, 0, At, B0); PG8_BAR; PG8_SCHED;
            PG8_STAGE(PG8_SB(1, 1), b3 + hstepB, voffB);
            PG8_WAIT_V(6); PG8_BAR; PG8_MMA(1, 1, At, B1); PG8_BAR;
            }
        }
        if constexpr (ALIGN_EPI) { if (wr == 0) PG8_BAR; }
        E(acc, cur, wr, wc, fr, fq);
        if (!has_next) break;
#pragma unroll
        for (int a = 0; a < 2; ++a)
#pragma unroll
            for (int b = 0; b < 2; ++b)
#pragma unroll
                for (int m = 0; m < 4; ++m)
#pragma unroll
                    for (int n = 0; n < 2; ++n) acc[a][b][m][n] = (f32x4){0.f, 0.f, 0.f, 0.f};
        cur = nxt; cA = nA; cB = nB; ++ui;
        if constexpr (ALIGN_EPI) { if (wr == 1) PG8_BAR; }
    }
    PG8_WAIT_V(0);
    if constexpr (!ALIGN_EPI) { if (wr == 0) PG8_BAR; }
    PG8_BAR;
#undef PG8_SA
#undef PG8_SB
#undef PG8_STAGE
#undef PG8_LDA
#undef PG8_LDB
#undef PG8_MMA
#undef PG8_WAIT_V
#undef PG8_WAIT_L
#undef PG8_BAR
#undef PG8_SCHED
}

struct Sched2D {
    const char* A; const char* B; size_t atile, btile; int nM, nN, G, c, r_base, c_base;
    __device__ __forceinline__ bool next(int i, Unit& u) const {
        if (c < 0) return false;
        int pm, pn; if (!static_order((long)i * G + c, nM, nN, pm, pn)) return false;
        u.a = A + (size_t)pm * atile; u.b = B + (size_t)pn * btile; u.r0 = r_base + pm * 256; u.c0 = c_base + pn * 256; return true;
    }
};
struct SchedMerge {
    const char *y0, *w0; int G, c;
    __device__ __forceinline__ bool next(int i, Unit& u) const {
        int pm, pn; if (!static_order((long)i * G + c, 48, 12, pm, pn)) return false;
        const int br = pn >> 2; const char* y = y0 + (size_t)br * (12u << 20); const char* w = w0 + (size_t)br * (1u << 20);
        u.a = y + (size_t)pm * 256 * 512 * 2; u.b = w + (size_t)(pn & 3) * 256 * 512 * 2; u.r0 = pm * 256; u.c0 = pn * 256; return true;
    }
};
struct SchedFourL {
    const char* tab; const char* xcs; int c;
    __device__ __forceinline__ bool next(int i, Unit& u) const {
        if (i > 0 || c < 0 || c >= 32) return false;
        const int b = c >> 4, pm = (c & 15) >> 1, pn = c & 1;
        u.a = tab + (size_t)pm * 256 * 4096 * 2; u.b = xcs + ((size_t)b * 512 + pn * 256) * 4096 * 2; u.r0 = NCTX + b * 2048 + pm * 256; u.c0 = pn * 256; return true;
    }
};
struct SchedFourC {
    const char* tab; const char* xcs; int c;
    __device__ __forceinline__ bool next(int i, Unit& u) const {
        if (i > 0 || c < 0 || c >= 64) return false;
        const int b = c >> 1, pn = c & 1;
        u.a = tab; u.b = xcs + ((size_t)b * 512 + pn * 256) * 512 * 2; u.r0 = b * 256; u.c0 = pn * 256; return true;
    }
};

typedef f32x4 Acc[2][2][4][2];
struct EpiInN {
    static constexpr bool PERM = true;
    bf16_t* qkv; bf16_t* z; float* ba;
    __device__ __forceinline__ void operator()(const Acc& acc, const Unit& u, int wr, int wc, int fr, int fq) const {
        const int colt = u.c0;
#pragma unroll
        for (int ai = 0; ai < 2; ++ai)
#pragma unroll
            for (int m = 0; m < 4; ++m) { const int row = u.r0 + ai * HALF + wr * 64 + m * 16 + fr;
#pragma unroll
                for (int bj = 0; bj < 2; ++bj) { const int col = colt + bj * HALF + wc * 32 + 8 * fq; const f32x4 v0 = acc[ai][bj][m][0], v1 = acc[ai][bj][m][1];
                    if (colt < 2048) { u32x4 w; w.x = cvt_pk_bf16(v0[0], v0[1]); w.y = cvt_pk_bf16(v0[2], v0[3]); w.z = cvt_pk_bf16(v1[0], v1[1]); w.w = cvt_pk_bf16(v1[2], v1[3]);
                        bf16_t* p = colt < 1536 ? qkv + (size_t)row * 1536 + col : z + (size_t)row * 512 + (col - 1536);
                        *(u32x4*)p = w; }
                    else if (col - 2048 < 32) { float* p = ba + (size_t)row * 32 + (col - 2048); *(f32x4*)p = v0; *(f32x4*)(p + 4) = v1; } } }
    }
};
struct EpiInS {
    static constexpr bool PERM = true;
    bf16_t* hyt; bf16_t* xcsl; bf16_t* xcsc;
    __device__ __forceinline__ void operator()(const Acc& acc, const Unit& u, int wr, int wc, int fr, int fq) const {
#pragma unroll
        for (int ai = 0; ai < 2; ++ai)
#pragma unroll
            for (int m = 0; m < 4; ++m) { const int ch = u.r0 + ai * HALF + wr * 64 + m * 16 + fr;
#pragma unroll
                for (int bj = 0; bj < 2; ++bj) { const int tok = u.c0 + bj * HALF + wc * 32 + 8 * fq; const f32x4 v0 = acc[ai][bj][m][0], v1 = acc[ai][bj][m][1];
                    u32x4 w; w.x = cvt_pk_bf16(v0[0], v0[1]); w.y = cvt_pk_bf16(v0[2], v0[3]); w.z = cvt_pk_bf16(v1[0], v1[1]); w.w = cvt_pk_bf16(v1[2], v1[3]);
                    bf16_t* p;
                    if (ch < 1536) p = hyt + (size_t)ch * NTOK + tok;
                    else { const int cc = ch - 1536, which = cc >> 9, n = cc & 511;
                        if (tok < NCTX) { const int b = tok >> 8, t = tok & 255; p = xcsc + ((size_t)(b * 512 + n) * 512 + which * 256 + t); }
                        else { const int tt = tok - NCTX, b = tt >> 11, t = tt & 2047; p = xcsl + ((size_t)(b * 512 + n) * 4096 + which * 2048 + t); } }
                    *(u32x4*)p = w; } }
    }
};
struct EpiScaleBf16 {
    static constexpr bool PERM = true;
    bf16_t* O; int ldc; float scale;
    __device__ __forceinline__ void operator()(const Acc& acc, const Unit& u, int wr, int wc, int fr, int fq) const {
#pragma unroll
        for (int ai = 0; ai < 2; ++ai)
#pragma unroll
            for (int m = 0; m < 4; ++m) { const int row = u.r0 + ai * HALF + wr * 64 + m * 16 + fr;
#pragma unroll
                for (int bj = 0; bj < 2; ++bj) { const int col = u.c0 + bj * HALF + wc * 32 + 8 * fq; const f32x4 v0 = acc[ai][bj][m][0] * scale, v1 = acc[ai][bj][m][1] * scale;
                    u32x4 w; w.x = cvt_pk_bf16(v0[0], v0[1]); w.y = cvt_pk_bf16(v0[2], v0[3]); w.z = cvt_pk_bf16(v1[0], v1[1]); w.w = cvt_pk_bf16(v1[2], v1[3]);
                    *(u32x4*)(O + (size_t)row * ldc + col) = w; } }
    }
};
struct EpiGate {
    static constexpr bool PERM = true;
    bf16_t* O;
    __device__ __forceinline__ void operator()(const Acc& acc, const Unit& u, int wr, int wc, int fr, int fq) const {
#pragma unroll
        for (int ai = 0; ai < 2; ++ai)
#pragma unroll
            for (int m = 0; m < 4; ++m) { const int row = u.r0 + ai * HALF + wr * 64 + m * 16 + fr;
#pragma unroll
                for (int bj = 0; bj < 2; ++bj) { const int col = u.c0 + bj * HALF + wc * 32 + 8 * fq; const f32x4 v0 = acc[ai][bj][m][0], v1 = acc[ai][bj][m][1];
                    u32x4 w; w.x = cvt_pk_bf16(sigmoidf_(v0[0]), sigmoidf_(v0[1])); w.y = cvt_pk_bf16(sigmoidf_(v0[2]), sigmoidf_(v0[3]));
                    w.z = cvt_pk_bf16(sigmoidf_(v1[0]), sigmoidf_(v1[1])); w.w = cvt_pk_bf16(sigmoidf_(v1[2]), sigmoidf_(v1[3]));
                    *(u32x4*)(O + (size_t)row * 3072 + col) = w; } }
    }
};
struct EpiMerge {
    static constexpr bool PERM = true;
    bf16_t* O;
    __device__ __forceinline__ void operator()(const Acc& acc, const Unit& u, int wr, int wc, int fr, int fq) const {
#pragma unroll
        for (int ai = 0; ai < 2; ++ai)
#pragma unroll
            for (int m = 0; m < 4; ++m) { const int row = u.r0 + ai * HALF + wr * 64 + m * 16 + fr;
#pragma unroll
                for (int bj = 0; bj < 2; ++bj) { const int col = u.c0 + bj * HALF + wc * 32 + 8 * fq; const f32x4 v0 = acc[ai][bj][m][0], v1 = acc[ai][bj][m][1];
                    bf16_t* p = O + (size_t)row * 3072 + col; const u32x4 gg = *(const u32x4*)p;
                    u32x4 w; w.x = cvt_pk_bf16(v0[0] * bflo(gg.x), v0[1] * bfhi(gg.x)); w.y = cvt_pk_bf16(v0[2] * bflo(gg.y), v0[3] * bfhi(gg.y));
                    w.z = cvt_pk_bf16(v1[0] * bflo(gg.z), v1[1] * bfhi(gg.z)); w.w = cvt_pk_bf16(v1[2] * bflo(gg.w), v1[3] * bfhi(gg.w));
                    *(u32x4*)p = w; } }
    }
};
struct EpiResid {
    static constexpr bool PERM = false;
    float* X; const float* gate;
    __device__ __forceinline__ void operator()(const Acc& acc, const Unit& u, int wr, int wc, int fr, int fq) const {
        const float* gp = gate + (size_t)mod_idx(u.r0) * 6144;
#pragma unroll
        for (int bj = 0; bj < 2; ++bj)
#pragma unroll
            for (int n = 0; n < 2; ++n) { const int col = u.c0 + bj * HALF + wc * 32 + 16 * n + 4 * fq; const f32x4 gv = *(const f32x4*)(gp + col);
#pragma unroll
                for (int ai = 0; ai < 2; ++ai)
#pragma unroll
                    for (int m = 0; m < 4; ++m) { const int row = u.r0 + ai * HALF + wr * 64 + m * 16 + fr; float* p = X + (size_t)row * DM + col;
                        const f32x4 x = *(const f32x4*)p; *(f32x4*)p = x + gv * acc[ai][bj][m][n]; } }
    }
};
struct EpiGU {
    static constexpr bool PERM = true;
    bf16_t* O;
    __device__ __forceinline__ void operator()(const Acc& acc, const Unit& u, int wr, int wc, int fr, int fq) const {
        const int col = (u.c0 >> 1) + wc * 32 + 8 * fq;
#pragma unroll
        for (int ai = 0; ai < 2; ++ai)
#pragma unroll
            for (int m = 0; m < 4; ++m) { const int row = u.r0 + ai * HALF + wr * 64 + m * 16 + fr;
                const f32x4 g0 = acc[ai][0][m][0], g1 = acc[ai][0][m][1], u0 = acc[ai][1][m][0], u1 = acc[ai][1][m][1];
                u32x4 w; w.x = cvt_pk_bf16(siluf_(g0[0]) * u0[0], siluf_(g0[1]) * u0[1]); w.y = cvt_pk_bf16(siluf_(g0[2]) * u0[2], siluf_(g0[3]) * u0[3]);
                w.z = cvt_pk_bf16(siluf_(g1[0]) * u1[0], siluf_(g1[1]) * u1[1]); w.w = cvt_pk_bf16(siluf_(g1[2]) * u1[2], siluf_(g1[3]) * u1[3]);
                *(u32x4*)(O + (size_t)row * DFF + col) = w; }
    }
};
}

#define XB_TMO      128
#define XB_XCNT(j)  (256  + 64 * (j))
#define XB_XSUB(j)  (1280 + 64 * (j))
#define XB_XGEN(j)  (2304 + 64 * (j))
#define XB_TOP      3328
#define XB_TOPGEN   3392
#define XCD_BAR_WORDS 3456
#define XB_SPIN_CAP (1u << 18)
__device__ __forceinline__ unsigned xb_ld(unsigned* p)              { return __hip_atomic_load(p, __ATOMIC_RELAXED, __HIP_MEMORY_SCOPE_AGENT); }
__device__ __forceinline__ unsigned xb_add(unsigned* p, unsigned v) { return __hip_atomic_fetch_add(p, v, __ATOMIC_RELAXED, __HIP_MEMORY_SCOPE_AGENT); }
__device__ __forceinline__ unsigned xb_xcc_id() { return (unsigned)__builtin_amdgcn_s_getreg((3 << 11) | 20) & 0xFu; }
#define XB_SPIN(cond, bar) do { unsigned _sp = 0; while (cond) { __builtin_amdgcn_s_sleep(1); \
    if ((++_sp & 255u) == 0u) { if (xb_ld(&(bar)[XB_TMO])) break; if (_sp > XB_SPIN_CAP) { atomicAdd(&(bar)[XB_TMO], 1u); break; } } } } while (0)
struct XcdBarrier { unsigned* bar; unsigned x; volatile LAS unsigned* st; };
__device__ __forceinline__ XcdBarrier xcd_barrier_post(unsigned* bar, volatile LAS unsigned* st) {
    XcdBarrier b; b.bar = bar; b.x = xb_xcc_id(); b.st = st;
    if (threadIdx.x == 0) (void)xb_add(&bar[XB_XCNT(b.x)], 1u);
    return b;
}
__device__ __forceinline__ void xcd_barrier_complete(unsigned* bar, unsigned x, unsigned& nloc, unsigned& nx) {
    const unsigned G = gridDim.x * gridDim.y * gridDim.z;
    unsigned sum, cnt, mine, sp = 0u;
    for (;;) {
        sum = 0u; cnt = 0u; mine = 0u;
#pragma unroll 1
        for (unsigned j = 0; j < 16; ++j) { const unsigned c = xb_ld(&bar[XB_XCNT(j)]); sum += c; cnt += (c > 0u) ? 1u : 0u; mine = (j == x) ? c : mine; }
        if (sum == G) break;
        __builtin_amdgcn_s_sleep(1);
        if ((++sp & 255u) == 0u) { if (xb_ld(&bar[XB_TMO])) break; if (sp > XB_SPIN_CAP) { atomicAdd(&bar[XB_TMO], 1u); break; } }
    }
    nloc = mine > 0u ? mine : 1u; nx = cnt > 0u ? cnt : 1u;
}
__device__ __forceinline__ void xcd_barrier(const XcdBarrier& b) {
    asm volatile("s_waitcnt vmcnt(0)" ::: "memory");
    __syncthreads();
    if (threadIdx.x == 0) {
        unsigned* bar = opq(b.bar);
        __builtin_amdgcn_s_waitcnt(0);
        unsigned nloc = b.st[0], nx = b.st[1];
        if (nloc == 0u) { xcd_barrier_complete(bar, b.x, nloc, nx); b.st[0] = nloc; b.st[1] = nx; }
        const unsigned old = xb_add(&bar[XB_XSUB(b.x)], 1u);
        const unsigned gen = old / nloc;
        if (old + 1u == (gen + 1u) * nloc) {
            __builtin_amdgcn_fence(__ATOMIC_RELEASE, "agent");
            asm volatile("s_waitcnt vmcnt(0)" ::: "memory");
            const unsigned og = xb_add(&bar[XB_TOP], 1u);
            const unsigned tg = og / nx;
            if (og + 1u == (tg + 1u) * nx) xb_add(&bar[XB_TOPGEN], 1u);
            else XB_SPIN(xb_ld(&bar[XB_TOPGEN]) == tg, bar);
            __builtin_amdgcn_fence(__ATOMIC_ACQUIRE, "agent");
            xb_add(&bar[XB_XGEN(b.x)], 1u);
            asm volatile("s_waitcnt vmcnt(0)" ::: "memory");
        } else {
            XB_SPIN(xb_ld(&bar[XB_XGEN(b.x)]) == gen, bar);
            __builtin_amdgcn_fence(__ATOMIC_ACQUIRE, "agent");
            asm volatile("s_waitcnt vmcnt(0)" ::: "memory");
        }
    }
    __syncthreads();
}

struct Args { const float* in[N_IN]; float* out; unsigned char* ws; int ph_lo, ph_hi, li, pad; };
struct Frame {
    LAS unsigned char* lds; const float* const* in; float* out; unsigned char* ws; unsigned* ctl;
    int tid, lane, wave, G, bid;
};
__device__ __forceinline__ int q_next(Frame& F, int qid) {
    volatile LAS int* slot = (volatile LAS int*)(F.lds + MISC_OFF + 64);
    __syncthreads();
    if (F.tid == 0) *slot = (int)__hip_atomic_fetch_add(F.ctl + CW_Q + 64 * qid, 1u, RLX_AGENT);
    __syncthreads();
    return *slot;
}

__device__ __forceinline__ void transpose_item(const float* W, int ld_src, int col0, bf16_t* WT, int ld_dst, int dst_k0, int row0, int k0, LAS float* scr, int lane) {
#pragma unroll 8
    for (int i = 0; i < 32; ++i) { const int kk = 2 * i + (lane >> 5); scr[kk * 33 + (lane & 31)] = W[(size_t)(k0 + kk) * ld_src + col0 + (lane & 31)]; }
    LDS_WAIT(); asm volatile("" ::: "memory");
    const int c = lane & 7;
#pragma unroll
    for (int j = 0; j < 4; ++j) { const int n = (lane >> 3) + 8 * j; const LAS float* s = scr + (8 * c) * 33 + n;
        u32x4 o; o.x = pk2(s[0 * 33], s[1 * 33]); o.y = pk2(s[2 * 33], s[3 * 33]); o.z = pk2(s[4 * 33], s[5 * 33]); o.w = pk2(s[6 * 33], s[7 * 33]);
        *(u32x4*)(WT + (size_t)(row0 + n) * ld_dst + dst_k0 + k0 + 8 * c) = o; }
    LDS_WAIT(); asm volatile("" ::: "memory");
}
__device__ __forceinline__ void prep_weights(Frame& F, int l) {
    LAS float* scr = (LAS float*)(F.lds + F.wave * 16384);
    const int gw = F.bid * NWAVES + F.wave, NGW = F.G * NWAVES;
    const float* w_in = F.in[I_WIN] + (size_t)l * DM * DIN;
    unsigned char* ws = F.ws;
    constexpr int NI_QKVZBA = 16 * (2080 / 32), NI_HY = 16 * 48, NI_G = 16 * 96, NI_P = 8 * 32, NI_O = 16 * 32, NI_GU = 16 * 176, NI_DN = 44 * 32;
    constexpr int NITEMS = NI_QKVZBA + NI_HY + NI_G + 3 * NI_P + 3 * NI_O + NI_GU + NI_DN;
#pragma unroll 1
    for (int it = gw; it < NITEMS; it += NGW) {
        int r = it;
        const float* src; int ld_src, col0, ld_dst, dst_k0, row0, k0; bf16_t* dst;
        if (r < NI_QKVZBA) { const int nb = r % 65, kb = r / 65; src = w_in; ld_src = DIN; col0 = nb * 32; dst = (bf16_t*)(ws + W_N); ld_dst = 1024; dst_k0 = 0; row0 = nb * 32; k0 = kb * 64; }
        else if ((r -= NI_QKVZBA) < NI_HY) { const int nb = r % 48, kb = r / 48; src = w_in; ld_src = DIN; col0 = OFF_HY + nb * 32; dst = (bf16_t*)(ws + W_S); ld_dst = 1024; dst_k0 = 0; row0 = nb * 32; k0 = kb * 64; }
        else if ((r -= NI_HY) < NI_G) { const int nb = r % 96, kb = r / 96; src = w_in; ld_src = DIN; col0 = OFF_GATE + nb * 32; dst = (bf16_t*)(ws + W_G); ld_dst = 1024; dst_k0 = 0; row0 = nb * 32; k0 = kb * 64; }
        else if ((r -= NI_G) < 3 * NI_P) { const int j = r / NI_P, q = r % NI_P, nb = q % 32, kb = q / 32; src = (j == 0 ? F.in[I_WPA] : (j == 1 ? F.in[I_WPB] : F.in[I_WPC])) + (size_t)l * 512 * 1024;
            ld_src = 1024; col0 = nb * 32; dst = (bf16_t*)(ws + W_P) + (size_t)j * 1024 * 512; ld_dst = 512; dst_k0 = 0; row0 = nb * 32; k0 = kb * 64; }
        else if ((r -= 3 * NI_P) < 3 * NI_O) { const int j = r / NI_O, q = r % NI_O, nb = q % 32, kb = q / 32; src = F.in[I_WO] + (size_t)l * 1024 * 1024;
            ld_src = 1024; col0 = nb * 32; dst = (bf16_t*)(ws + W_O3); ld_dst = 3072; dst_k0 = j * 1024; row0 = nb * 32; k0 = kb * 64; }
        else if ((r -= 3 * NI_O) < NI_GU) { const int nb = r % 176, kb = r / 176; const int n0 = nb * 32, up = n0 >= DFF ? 1 : 0, nn = n0 - up * DFF;
            src = F.in[I_WGU] + (size_t)l * 1024 * 5632; ld_src = 5632; col0 = n0; dst = (bf16_t*)(ws + W_GU); ld_dst = 1024; dst_k0 = 0; row0 = 256 * (nn / 128) + 128 * up + (nn % 128); k0 = kb * 64; }
        else { r -= NI_GU; const int nb = r % 32, kb = r / 32; src = F.in[I_WDOWN] + (size_t)l * DFF * 1024; ld_src = 1024; col0 = nb * 32; dst = (bf16_t*)(ws + W_DN); ld_dst = DFF; dst_k0 = 0; row0 = nb * 32; k0 = kb * 64; }
        transpose_item(src, ld_src, col0, dst, ld_dst, dst_k0, row0, k0, scr, F.lane);
    }
    { u32x4* z = (u32x4*)(ws + W_N + (size_t)2080 * 1024 * 2); const int n16 = 224 * 1024 * 2 / 16;
      for (int i = F.bid * NTHR + F.tid; i < n16; i += F.G * NTHR) z[i] = (u32x4){0u, 0u, 0u, 0u}; }
    __syncthreads();
    {
        LAS float* tile = (LAS float*)F.lds;
        LAS float* ctab = tile + 64 * 65;
        if (F.tid < 64) { ctab[F.tid] = cos_rev((float)F.tid / 64.0f); ctab[64 + F.tid] = sin_rev((float)F.tid / 64.0f); }
        for (int task = F.bid; task < 128; task += F.G) {
            const int kb = task >> 3, g = task & 7;
            __syncthreads();
            for (int i = F.tid; i < 4096; i += NTHR) { const int kk = i >> 6, cc = i & 63; tile[kk * 65 + cc] = w_in[(size_t)(kb * 64 + kk) * DIN + OFF_FN + g * 64 + cc]; }
            __syncthreads();
            const int kk = F.tid & 63, cq = F.tid >> 6;
#pragma unroll 1
            for (int j = 0; j < 8; ++j) { const int c = cq * 8 + j; float ac = 0.f, as = 0.f;
#pragma unroll 4
                for (int cp = 0; cp < 64; ++cp) { const float w = tile[kk * 65 + cp]; const int idx = (c * cp) & 63; ac += w * ctab[idx]; as += w * ctab[64 + idx]; }
                bf16_t* d = (bf16_t*)(ws + W_S);
                d[(size_t)(1536 + g * 64 + c) * 1024 + kb * 64 + kk] = (bf16_t)f2bf(ac);
                d[(size_t)(2048 + g * 64 + c) * 1024 + kb * 64 + kk] = (bf16_t)f2bf(as); }
        }
        __syncthreads();
    }
}
__device__ __forceinline__ void prep_filters(Frame& F, int l) {
    LAS float* zp = (LAS float*)F.lds;
    LAS float* h1 = zp + 64 * 33;
    LAS float* h2 = h1 + 64 * 64;
    const float* w1 = F.in[I_HW1] + l * 33 * 64; const float* b1 = F.in[I_HB1] + l * 64; const float* fq = F.in[I_HFREQ] + l * 64;
    const float* w2 = F.in[I_HW2] + l * 64 * 64; const float* b2 = F.in[I_HB2] + l * 64; const float* w3 = F.in[I_HW3] + (size_t)l * 64 * 2048;
    for (int task = F.G - 1 - F.bid; task < 36; task += F.G) {
        const int L = task < 32 ? LLAT : LCTX, t0 = (task < 32 ? task : task - 32) * 64;
        float* fil = (float*)(F.ws + (task < 32 ? WS_FILL : WS_FILC));
        __syncthreads();
        for (int i = F.tid; i < 64 * 33; i += NTHR) { const int tt = i / 33, e = i % 33; const int ti = t0 + tt;
            float v;
            if (e == 0) v = (float)ti / (float)(L - 1);
            else { const int b = (e - 1) & 15; const float fr = 1e-4f + (15.0f - 1e-4f) * (float)b / 15.0f; const float rv = fr * ((float)ti / (float)L);
                   v = e <= 16 ? cos_rev(rv) : -sin_rev(rv); }
            zp[i] = v; }
        __syncthreads();
        for (int i = F.tid; i < 4096; i += NTHR) { const int tt = i >> 6, j = i & 63; float a = b1[j];
            for (int e = 0; e < 33; ++e) a += zp[tt * 33 + e] * w1[e * 64 + j];
            h1[i] = sin_rad(fq[j] * a); }
        __syncthreads();
        for (int i = F.tid; i < 4096; i += NTHR) { const int tt = i >> 6, j = i & 63; float a = b2[j];
            for (int k = 0; k < 64; ++k) a += h1[tt * 64 + k] * w2[k * 64 + j];
            h2[i] = sin_rad(fq[j] * a); }
        __syncthreads();
        for (int q = 0; q < 4; ++q) { const int n = F.tid + 512 * q, c = n & 511;
            float wc[64];
#pragma unroll
            for (int k = 0; k < 64; ++k) wc[k] = w3[(size_t)k * 2048 + n];
            const float dmin = 4.605170185988091f / 1.5f, dmax = 4.605170185988091f / 0.3f;
            const float delta = dmin + (dmax - dmin) * (float)c / 511.0f;
            float* dst = fil + (size_t)n * L + t0;
#pragma unroll 1
            for (int tt = 0; tt < 64; ++tt) { float a = 0.f;
#pragma unroll
                for (int k = 0; k < 64; ++k) a += h2[tt * 64 + k] * wc[k];
                const float tl = (float)(t0 + tt) / (float)(L - 1); dst[tt] = a * expf(-tl * delta); } }
    }
    __syncthreads();
}
__device__ __forceinline__ void prep_mod(Frame& F) {
    LAS float* sc = (LAS float*)F.lds;
    LAS float* red = sc + 3 * 1024;
    __syncthreads();
    for (int i = F.tid; i < 3 * 1024; i += NTHR) { const int mi = i >> 10, k = i & 1023; const float v = mi == 0 ? F.in[I_CCTX][k] : F.in[I_C][(mi - 1) * 1024 + k]; sc[i] = v / (1.f + expf(-v)); }
    __syncthreads();
    float* mod = (float*)(F.ws + WS_MOD);
    for (int task = F.bid; task < 192; task += F.G) {
        const int l = task / 96, j = task % 96, n = j * 64 + F.lane;
        const float* w = F.in[I_WMOD] + (size_t)l * 1024 * 6144 + n;
        float a0 = 0.f, a1 = 0.f, a2 = 0.f;
        const int kb = F.wave * 128;
#pragma unroll 8
        for (int k = 0; k < 128; ++k) { const float wv = w[(size_t)(kb + k) * 6144]; a0 += sc[kb + k] * wv; a1 += sc[1024 + kb + k] * wv; a2 += sc[2048 + kb + k] * wv; }
        red[(F.wave * 3 + 0) * 64 + F.lane] = a0; red[(F.wave * 3 + 1) * 64 + F.lane] = a1; red[(F.wave * 3 + 2) * 64 + F.lane] = a2;
        __syncthreads();
        if (F.tid < 192) { const int mi = F.tid >> 6, ln = F.tid & 63; float s = F.in[I_BMOD][l * 6144 + j * 64 + ln];
            for (int w8 = 0; w8 < 8; ++w8) s += red[(w8 * 3 + mi) * 64 + ln];
            mod[((size_t)l * 3 + mi) * 6144 + j * 64 + ln] = s; }
        __syncthreads();
    }
}
__device__ __forceinline__ void prep_x_tables(Frame& F) {
    const int gt = F.bid * NTHR + F.tid, NG = F.G * NTHR;
    for (int i = gt; i < NTOK * DM / 4; i += NG) {
        const int row = i >> 8, c4 = (i & 255) * 4;
        f32x4 v;
        if (row < NCTX) v = *(const f32x4*)(F.in[I_XP] + (size_t)row * DM + c4);
        else { const int tt = row - NCTX, t = tt & 2047; v = *(const f32x4*)(F.in[I_XS] + (size_t)tt * DM + c4);
            const int seg = c4 >> 8; const float pos = (seg < 2) ? (float)(t >> 6) : (float)(t & 63);
#pragma unroll
            for (int u = 0; u < 4; ++u) { const int ii = (c4 + u) & 255; const float om = expf(-9.210340371976184f * (float)ii / 256.0f); const float a = pos * om;
                v[u] += (seg & 1) ? cos_rad(a) : sin_rad(a); } }
        *(f32x4*)(F.out + (size_t)row * DM + c4) = v;
    }
    for (int i = gt; i < 2048 * 4096 / 8; i += NG) { const int tp = i >> 9, k0 = (i & 511) * 8; unsigned w[4];
#pragma unroll
        for (int u = 0; u < 4; ++u) { float v[2];
#pragma unroll
            for (int e = 0; e < 2; ++e) { const int k = k0 + 2 * u + e; const int m = (tp * (k & 2047)) & 2047; const float x = (float)m / 2048.0f; v[e] = k < 2048 ? cos_rev(x) : -sin_rev(x); }
            w[u] = pk2(v[0], v[1]); }
        *(u32x4*)((bf16_t*)(F.ws + WS_TABL) + (size_t)tp * 4096 + k0) = (u32x4){w[0], w[1], w[2], w[3]}; }
    for (int i = gt; i < 256 * 512 / 8; i += NG) { const int tp = i >> 6, k0 = (i & 63) * 8; unsigned w[4];
#pragma unroll
        for (int u = 0; u < 4; ++u) { float v[2];
#pragma unroll
            for (int e = 0; e < 2; ++e) { const int k = k0 + 2 * u + e; const int m = (tp * (k & 255)) & 255; const float x = (float)m / 256.0f; v[e] = k < 256 ? cos_rev(x) : -sin_rev(x); }
            w[u] = pk2(v[0], v[1]); }
        *(u32x4*)((bf16_t*)(F.ws + WS_TABC) + (size_t)tp * 512 + k0) = (u32x4){w[0], w[1], w[2], w[3]}; }
}

__device__ __forceinline__ void phase_norm(Frame& F, const float* g, const float* modl, int sh_off, int sc_off, bf16_t* H) {
    const int gw = F.bid * NWAVES + F.wave, NGW = F.G * NWAVES;
    for (int row = gw; row < NTOK; row += NGW) {
        const f32x4* xr = (const f32x4*)(F.out + (size_t)row * DM) + F.lane;
        f32x4 v[4]; float s = 0.f;
#pragma unroll
        for (int j = 0; j < 4; ++j) { v[j] = xr[64 * j]; s += (v[j].x * v[j].x + v[j].y * v[j].y) + (v[j].z * v[j].z + v[j].w * v[j].w); }
        const float rstd = 1.0f / sqrtf(wave_sum(s) * (1.f / DM) + EPS);
        const float* mp = modl + (size_t)mod_idx(row) * 6144;
        u32x2* o = (u32x2*)(H + (size_t)row * DM) + F.lane;
#pragma unroll
        for (int j = 0; j < 4; ++j) { const int c = 4 * F.lane + 256 * j; const f32x4 gg = *(const f32x4*)(g + c), sh = *(const f32x4*)(mp + sh_off + c), sc = *(const f32x4*)(mp + sc_off + c);
            const f32x4 y = (v[j] * rstd) * gg * (sc + 1.0f) + sh;
            o[64 * j] = (u32x2){pk2(y.x, y.y), pk2(y.z, y.w)}; }
    }
}
__device__ __forceinline__ void phase_final(Frame& F) {
    const int gw = F.bid * NWAVES + F.wave, NGW = F.G * NWAVES; const float* g = F.in[I_NORMF];
    for (int row = gw; row < NTOK; row += NGW) {
        f32x4* xr = (f32x4*)(F.out + (size_t)row * DM) + F.lane;
        f32x4 v[4]; float s = 0.f;
#pragma unroll
        for (int j = 0; j < 4; ++j) { v[j] = xr[64 * j]; s += (v[j].x * v[j].x + v[j].y * v[j].y) + (v[j].z * v[j].z + v[j].w * v[j].w); }
        const float rstd = 1.0f / sqrtf(wave_sum(s) * (1.f / DM) + EPS);
#pragma unroll
        for (int j = 0; j < 4; ++j) { const int c = 4 * F.lane + 256 * j; const f32x4 gg = *(const f32x4*)(g + c); xr[64 * j] = (v[j] * rstd) * gg; }
    }
}

__device__ __forceinline__ void hyena_task(Frame& F, int l, int c, int s0, int L) {
    LAS float* X1 = (LAS float*)F.lds;
    LAS float* X2 = X1 + 2048;
    LAS float* ZV = X2 + 2048;
    LAS float* Z2 = ZV + 2048;
    LAS float* T0 = Z2 + 2048;
    LAS float* T1 = T0 + 4096 + 16;
    const bf16_t* hyt = (const bf16_t*)(F.ws + WS_HYT);
    const float* cw = F.in[I_CONVHY] + (size_t)l * 3 * 1536;
    const float* fil = (const float*)(F.ws + (L == LLAT ? WS_FILL : WS_FILC));
    const float* hb = F.in[I_HBIAS] + (size_t)l * 2 * 512;
    const int row0 = seq_start(s0);
    __syncthreads();
    for (int i = F.tid; i < 3 * 2048; i += NTHR) { const int st = i >> 11, p = i & 2047, t = p & (L - 1); const int ch = st * 512 + c;
        const bf16_t* src = hyt + (size_t)ch * NTOK + row0 + p;
        float a = bf2f(src[0]) * cw[1 * 1536 + ch];
        if (t > 0) a += bf2f(src[-1]) * cw[0 * 1536 + ch];
        if (t < L - 1) a += bf2f(src[1]) * cw[2 * 1536 + ch];
        (st == 0 ? X1 : (st == 1 ? X2 : ZV))[p] = a; }
    for (int i = F.tid; i < 2 * (2 * L + 16); i += NTHR) { const int o = i / (2 * L + 16), idx = i % (2 * L + 16); const int n = idx - L - 4;
        float v = 0.f;
        const float* ff = fil + ((size_t)(2 * o) * 512 + c) * L; const float* fb = fil + ((size_t)(2 * o + 1) * 512 + c) * L;
        if (n > 0 && n < L) v = ff[n]; else if (n < 0 && n > -L) v = fb[-n]; else if (n == 0) v = ff[0] + fb[0];
        (o == 0 ? T0 : T1)[idx] = v; }
    __syncthreads();
    const int q = F.tid / (L / 4), t0 = (F.tid % (L / 4)) * 4;
    bf16_t* yb = (bf16_t*)(F.ws + WS_YB);
#pragma unroll 1
    for (int o = 0; o < 2; ++o) {
        const LAS float* T = o == 0 ? T0 : T1; const LAS float* zin = (o == 0 ? ZV : Z2) + q * L;
        float acc[4] = {0.f, 0.f, 0.f, 0.f};
        f32x4 hi = *(const LAS f32x4*)(T + t0 + L + 4);
        for (int s = 0; s < L; s += 4) {
            const f32x4 lo = *(const LAS f32x4*)(T + t0 - s + L);
            const f32x4 zq = *(const LAS f32x4*)(zin + s);
            const float w[8] = {lo[0], lo[1], lo[2], lo[3], hi[0], hi[1], hi[2], hi[3]};
#pragma unroll
            for (int i = 0; i < 4; ++i)
#pragma unroll
                for (int j = 0; j < 4; ++j) acc[i] += w[4 + i - j] * zq[j];
            hi = lo;
        }
        const float bias = hb[o * 512 + c];
        if (o == 0) {
#pragma unroll
            for (int i = 0; i < 4; ++i) { const int p = q * L + t0 + i; Z2[p] = X1[p] * (acc[i] + bias * ZV[p]); }
            __syncthreads();
        } else {
#pragma unroll
            for (int i = 0; i < 4; ++i) { const int p = q * L + t0 + i; const float y = X2[p] * (acc[i] + bias * Z2[p]); yb[(size_t)(row0 + p) * 512 + c] = (bf16_t)f2bf(y); }
        }
    }
}

constexpr int D1_LD = 65;
__device__ __forceinline__ size_t chunk_lin(int s, int n) { return (size_t)(s < 32 ? s * 4 + n : 128 + (s - 32) * 32 + n); }
__device__ __forceinline__ void d1_task(Frame& F, int l, int s, int h, int n) {
    LAS float* qn = (LAS float*)F.lds;
    LAS float* kn = qn + 64 * D1_LD;
    LAS float* vv = kn + 64 * D1_LD;
    LAS float* Af = vv + 64 * D1_LD;
    LAS float* Ab = Af + 4096;
    LAS float* sm = Ab + 4096;
    LAS float* betaf = sm, *betab = sm + 64, *gcf = sm + 128, *gcb = sm + 192, *gfr = sm + 256, *gbr = sm + 320;
    const int L = seq_len(s), row0 = seq_start(s) + n * 64, tpos0 = n * 64;
    const bf16_t* qkv = (const bf16_t*)(F.ws + WS_QKV);
    const float* cw = F.in[I_CONVQKV] + (size_t)l * 3 * QKVW;
    __syncthreads();
    for (int i = F.tid; i < 64 * 192; i += NTHR) { const int t = i / 192, cc = i % 192, part = cc >> 6, d = cc & 63; const int ch = part * 512 + h * 64 + d;
        const bf16_t* src = qkv + (size_t)(row0 + t) * QKVW + ch; const int tp = tpos0 + t;
        float a = bf2f(src[0]) * cw[QKVW + ch];
        if (tp > 0) a += bf2f(src[-QKVW]) * cw[ch];
        if (tp < L - 1) a += bf2f(src[QKVW]) * cw[2 * QKVW + ch];
        a = a / (1.f + expf(-a));
        (part == 0 ? qn : (part == 1 ? kn : vv))[t * D1_LD + d] = a; }
    if (F.tid < 128) { const int dir = F.tid >> 6, t = F.tid & 63; const float* ba = (const float*)(F.ws + WS_BA) + (size_t)(row0 + t) * 32;
        const float braw = ba[dir * 8 + h], araw = ba[16 + dir * 8 + h];
        const float al = F.in[I_ALOG][l * 16 + dir * 8 + h], dtb = F.in[I_DTB][l * 16 + dir * 8 + h];
        const float xx = araw + dtb; const float sp = xx > 20.f ? xx : log1pf(expf(xx));
        (dir == 0 ? betaf : betab)[t] = 1.f / (1.f + expf(-braw)); (dir == 0 ? gfr : gbr)[t] = -expf(al) * sp; }
    __syncthreads();
    { const int t = F.tid >> 3, sub = F.tid & 7;
      float sq = 0.f, sk = 0.f;
#pragma unroll
      for (int j = 0; j < 8; ++j) { const float a = qn[t * D1_LD + sub * 8 + j], b = kn[t * D1_LD + sub * 8 + j]; sq += a * a; sk += b * b; }
      sq += __shfl_xor(sq, 1); sq += __shfl_xor(sq, 2); sq += __shfl_xor(sq, 4);
      sk += __shfl_xor(sk, 1); sk += __shfl_xor(sk, 2); sk += __shfl_xor(sk, 4);
      const float rq = 0.125f / sqrtf(sq + EPS), rk = 1.0f / sqrtf(sk + EPS);
      unsigned wq[4], wk[4];
#pragma unroll
      for (int j = 0; j < 8; j += 2) { const float a0 = qn[t * D1_LD + sub * 8 + j] * rq, a1 = qn[t * D1_LD + sub * 8 + j + 1] * rq, b0 = kn[t * D1_LD + sub * 8 + j] * rk, b1 = kn[t * D1_LD + sub * 8 + j + 1] * rk;
          qn[t * D1_LD + sub * 8 + j] = a0; qn[t * D1_LD + sub * 8 + j + 1] = a1; kn[t * D1_LD + sub * 8 + j] = b0; kn[t * D1_LD + sub * 8 + j + 1] = b1;
          wq[j >> 1] = pk2(a0, a1); wk[j >> 1] = pk2(b0, b1); }
      *(u32x4*)((bf16_t*)(F.ws + WS_QN) + (size_t)(row0 + t) * 512 + h * 64 + sub * 8) = (u32x4){wq[0], wq[1], wq[2], wq[3]};
      *(u32x4*)((bf16_t*)(F.ws + WS_KN) + (size_t)(row0 + t) * 512 + h * 64 + sub * 8) = (u32x4){wk[0], wk[1], wk[2], wk[3]}; }
    if (F.tid == 0) { float a = 0.f; for (int t = 0; t < 64; ++t) { a += gfr[t]; gcf[t] = a; } }
    if (F.tid == 64) { float a = 0.f; for (int t = 63; t >= 0; --t) { a += gbr[t]; gcb[t] = a; } }
    __syncthreads();
    const size_t cl = chunk_lin(s, n);
    const size_t offF = ((size_t)(0 * 8 + h) * 192 + cl) * 4096, offB = ((size_t)(1 * 8 + h) * 192 + cl) * 4096;
    if (F.tid < 64) ((float*)(F.ws + WS_GC))[((size_t)(0 * 8 + h) * 192 + cl) * 64 + F.tid] = gcf[F.tid];
    else if (F.tid < 128) { const int p = F.tid - 64; ((float*)(F.ws + WS_GC))[((size_t)(1 * 8 + h) * 192 + cl) * 64 + p] = gcb[63 - p]; }
    { const int a = F.tid >> 4, b = F.tid & 15; const int i0 = 2 * a, j0 = 4 * b;
      float kk[2][4], qk[2][4];
#pragma unroll
      for (int x = 0; x < 2; ++x)
#pragma unroll
          for (int y = 0; y < 4; ++y) { kk[x][y] = 0.f; qk[x][y] = 0.f; }
      for (int d = 0; d < 64; ++d) { float ki[2], qi[2], kj[4];
#pragma unroll
          for (int x = 0; x < 2; ++x) { ki[x] = kn[(i0 + x) * D1_LD + d]; qi[x] = qn[(i0 + x) * D1_LD + d]; }
#pragma unroll
          for (int y = 0; y < 4; ++y) kj[y] = kn[(j0 + y) * D1_LD + d];
#pragma unroll
          for (int x = 0; x < 2; ++x)
#pragma unroll
              for (int y = 0; y < 4; ++y) { kk[x][y] += ki[x] * kj[y]; qk[x][y] += qi[x] * kj[y]; } }
      bf16_t* QKo = (bf16_t*)(F.ws + WS_QK);
#pragma unroll
      for (int x = 0; x < 2; ++x) { const int i = i0 + x; float ff[4], fb[4];
#pragma unroll
          for (int y = 0; y < 4; ++y) { const int j = j0 + y;
              const float df = i >= j ? expf(gcf[i] - gcf[j]) : 0.f;
              const float db = i <= j ? expf(gcb[i] - gcb[j]) : 0.f;
              if (i > j) Af[i * 64 + j] = betaf[i] * kk[x][y] * df;
              if (i < j) Ab[(63 - i) * 64 + (63 - j)] = betab[i] * kk[x][y] * db;
              ff[y] = qk[x][y] * df; fb[y] = qk[x][y] * db; }
          *(u32x2*)(QKo + offF + (size_t)i * 64 + j0) = (u32x2){pk2(ff[0], ff[1]), pk2(ff[2], ff[3])};
          *(u32x2*)(QKo + offB + (size_t)(63 - i) * 64 + (60 - j0)) = (u32x2){pk2(fb[3], fb[2]), pk2(fb[1], fb[0])}; } }
    __syncthreads();
    if (F.wave < 4) {
        const int dir = F.wave >> 1, isw = F.wave & 1, c = F.lane;
        int vzero; asm volatile("v_mov_b32 %0, 0" : "=v"(vzero));
        const LAS float* A = (dir == 0 ? Af : Ab) + vzero;
        float x[64];
#pragma unroll
        for (int p = 0; p < 64; ++p) { const int t = dir == 0 ? p : 63 - p; const float be = dir == 0 ? betaf[t] : betab[t];
            x[p] = isw ? kn[t * D1_LD + c] * be * expf(dir == 0 ? gcf[t] : gcb[t]) : vv[t * D1_LD + c] * be; }
#pragma unroll
        for (int p = 1; p < 64; ++p) { float a = x[p];
#pragma unroll
            for (int pp = 0; pp < p; ++pp) a -= A[p * 64 + pp] * x[pp];
            x[p] = a; }
        bf16_t* dst = (bf16_t*)(F.ws + (isw ? WS_WW : WS_U)) + (dir == 0 ? offF : offB) + c;
#pragma unroll
        for (int p = 0; p < 64; ++p) dst[p * 64] = (bf16_t)f2bf(x[p]);
    }
}

constexpr int D2_LD = 65;
__device__ __forceinline__ void d2_task(Frame& F, int l, int s, int h, int dir, int sl) {
    LAS float* Wl = (LAS float*)F.lds;
    LAS float* QKl = Wl + 64 * D2_LD;
    LAS float* QGl = QKl + 64 * D2_LD;
    LAS float* KGl = QGl + 64 * D2_LD;
    LAS float* Ul = KGl + 64 * D2_LD;
    LAS float* VN = Ul + 64 * 17;
    LAS float* Sl = VN + 64 * 17;
    LAS float* gcl = Sl + 64 * 17;
    const int nch = s < 32 ? 4 : 32, e0 = sl * 16;
    const int tid = F.tid;
    __syncthreads();
    for (int i = tid; i < 64 * 16; i += NTHR) { const int d = i >> 4, e = i & 15; float v = 0.f;
        if (s >= 32) v = F.in[I_STATE][((((size_t)(s - 32) * 2 + l) * 2 + dir) * 8 + h) * 4096 + d * 64 + e0 + e];
        Sl[d * 17 + e] = v; }
    const bf16_t* QN = (const bf16_t*)(F.ws + WS_QN); const bf16_t* KN = (const bf16_t*)(F.ws + WS_KN);
    bf16_t* O = (bf16_t*)(F.ws + (dir == 0 ? WS_OF : WS_OB));
    for (int step = 0; step < nch; ++step) {
        const int n = dir == 0 ? step : nch - 1 - step; const size_t cl = chunk_lin(s, n);
        const size_t off = ((size_t)(dir * 8 + h) * 192 + cl) * 4096; const int row0 = seq_start(s) + n * 64;
        __syncthreads();
        if (tid < 64) gcl[tid] = ((const float*)(F.ws + WS_GC))[((size_t)(dir * 8 + h) * 192 + cl) * 64 + tid];
        __syncthreads();
        const float gl = gcl[63];
        for (int i = tid; i < 4096; i += NTHR) { const int c = i >> 6, d = i & 63; const int tok = row0 + (dir == 0 ? c : 63 - c);
            Wl[c * D2_LD + d] = bf2f(((const bf16_t*)(F.ws + WS_WW))[off + i]);
            QKl[c * D2_LD + d] = bf2f(((const bf16_t*)(F.ws + WS_QK))[off + i]);
            const float g = gcl[c];
            QGl[c * D2_LD + d] = bf2f(QN[(size_t)tok * 512 + h * 64 + d]) * expf(g);
            KGl[c * D2_LD + d] = bf2f(KN[(size_t)tok * 512 + h * 64 + d]) * expf(gl - g); }
        for (int i = tid; i < 1024; i += NTHR) { const int c = i >> 4, e = i & 15; Ul[c * 17 + e] = bf2f(((const bf16_t*)(F.ws + WS_U))[off + c * 64 + e0 + e]); }
        __syncthreads();
        const int c = tid >> 3, ep = (tid & 7) * 2;
        { float a0 = Ul[c * 17 + ep], a1 = Ul[c * 17 + ep + 1];
          for (int d = 0; d < 64; ++d) { const float w = Wl[c * D2_LD + d]; a0 -= w * Sl[d * 17 + ep]; a1 -= w * Sl[d * 17 + ep + 1]; }
          VN[c * 17 + ep] = a0; VN[c * 17 + ep + 1] = a1; }
        __syncthreads();
        { float a0 = 0.f, a1 = 0.f;
          for (int d = 0; d < 64; ++d) { const float qg = QGl[c * D2_LD + d]; a0 += qg * Sl[d * 17 + ep]; a1 += qg * Sl[d * 17 + ep + 1]; }
          for (int j = 0; j < 64; ++j) { const float qk = QKl[c * D2_LD + j]; a0 += qk * VN[j * 17 + ep]; a1 += qk * VN[j * 17 + ep + 1]; }
          const int tok = row0 + (dir == 0 ? c : 63 - c);
          *(unsigned*)(O + (size_t)tok * 512 + h * 64 + e0 + ep) = pk2(a0, a1); }
        __syncthreads();
        { const float eg = expf(gl); float a0 = Sl[c * 17 + ep] * eg, a1 = Sl[c * 17 + ep + 1] * eg;
          for (int j = 0; j < 64; ++j) { const float kg = KGl[j * D2_LD + c]; a0 += kg * VN[j * 17 + ep]; a1 += kg * VN[j * 17 + ep + 1]; }
          Sl[c * 17 + ep] = a0; Sl[c * 17 + ep + 1] = a1; }
    }
    __syncthreads();
    if (s < 32) { float* so = F.out + (size_t)NTOK * DM + ((((size_t)s * 2 + l) * 2 + dir) * 8 + h) * 4096;
        for (int i = tid; i < 1024; i += NTHR) { const int d = i >> 4, e = i & 15; so[d * 64 + e0 + e] = Sl[d * 17 + e]; } }
}

__device__ __forceinline__ void phase_combine(Frame& F, int l) {
    const bf16_t* of = (const bf16_t*)(F.ws + WS_OF); const bf16_t* ob = (const bf16_t*)(F.ws + WS_OB); const bf16_t* z = (const bf16_t*)(F.ws + WS_Z);
    bf16_t* ya = (bf16_t*)(F.ws + WS_YA); const float* na = F.in[I_NORMA] + l * 64;
    for (int i = F.bid * NTHR + F.tid; i < NTOK * 64; i += F.G * NTHR) {
        const size_t off = (size_t)i * 8; const int e0 = (i & 7) * 8;
        const u32x4 a = *(const u32x4*)(of + off), b = *(const u32x4*)(ob + off), zz = *(const u32x4*)(z + off);
        float o[8]; const unsigned aw[4] = {a.x, a.y, a.z, a.w}, bw[4] = {b.x, b.y, b.z, b.w}, zw[4] = {zz.x, zz.y, zz.z, zz.w};
        float ss = 0.f;
#pragma unroll
        for (int j = 0; j < 4; ++j) { o[2 * j] = bflo(aw[j]) + bflo(bw[j]); o[2 * j + 1] = bfhi(aw[j]) + bfhi(bw[j]); ss += o[2 * j] * o[2 * j] + o[2 * j + 1] * o[2 * j + 1]; }
        ss += __shfl_xor(ss, 1); ss += __shfl_xor(ss, 2); ss += __shfl_xor(ss, 4);
        const float rs = 1.0f / sqrtf(ss * (1.f / 64.f) + EPS);
        unsigned w[4];
#pragma unroll
        for (int j = 0; j < 4; ++j) { const float z0 = bflo(zw[j]), z1 = bfhi(zw[j]);
            w[j] = pk2(o[2 * j] * rs * na[e0 + 2 * j] * siluf_(z0), o[2 * j + 1] * rs * na[e0 + 2 * j + 1] * siluf_(z1)); }
        *(u32x4*)(ya + off) = (u32x4){w[0], w[1], w[2], w[3]};
    }
}

constexpr int N_PHASES = 26;
__global__ void __launch_bounds__(NTHR, 2) mk_fwd(Args args) {
    extern __shared__ __attribute__((aligned(16))) unsigned char lds_raw[];
    Frame F;
    F.lds = (LAS unsigned char*)lds_raw; F.in = args.in; F.out = args.out; F.ws = args.ws; F.ctl = (unsigned*)(args.ws + WS_CTL);
    F.tid = threadIdx.x; F.lane = F.tid & 63; F.wave = __builtin_amdgcn_readfirstlane(F.tid >> 6); F.G = gridDim.x; F.bid = blockIdx.x;
    for (int u = F.tid; u < (LDS_BYTES - LDSCTL_OFF) / 4; u += NTHR) ((LAS unsigned*)(F.lds + LDSCTL_OFF))[u] = 0u;
    __syncthreads();
    XcdBarrier bar; bar.bar = F.ctl + CW_BAR; bar.x = 0; bar.st = nullptr;
    if (!MK_PER_PHASE) bar = xcd_barrier_post(F.ctl + CW_BAR, (volatile LAS unsigned*)(F.lds + MISC_OFF) + 8);
    const int lo = args.ph_lo, hi = args.ph_hi;
    using namespace pg8;
#define IN(k) (lo <= (k) && (k) < hi)
#define SEAM(k) do { if (IN(k) && IN((k) + 1)) { if (!MK_PER_PHASE) xcd_barrier(bar); } } while (0)
#define PHASE_FRAME() Frame P = F; P.ws = opq(P.ws); P.out = opq(P.out); P.ctl = opq(P.ctl); asm volatile("" : "+v"(P.tid)); P.lane = P.tid & 63; P.wave = __builtin_amdgcn_readfirstlane(P.tid >> 6); \
    unsigned char* ws = P.ws; LAS unsigned char* ring = P.lds; (void)ws; (void)ring

    if (IN(0)) { PHASE_FRAME(); prep_x_tables(P); prep_mod(P); prep_weights(P, 0); prep_filters(P, 0); }
    SEAM(0);
#pragma unroll 1
    for (int l = 0; l < 2; ++l) {
        const int pb = 1 + 12 * l;
#define MODL ((const float*)(ws + WS_MOD) + (size_t)l * 3 * 6144)
        if (IN(pb + 0)) { PHASE_FRAME(); if (l == 1) { prep_weights(P, 1); prep_filters(P, 1); }
            phase_norm(P, P.in[I_N1G] + l * DM, MODL, 0, 1024, (bf16_t*)(ws + WS_H)); }
        SEAM(pb + 0);
        if (IN(pb + 1)) { PHASE_FRAME();
            { Gemm g{1024, 2048, 2048}; Sched2D S{(const char*)(ws + WS_H), (const char*)(ws + W_N), (size_t)256 * 2048, (size_t)256 * 2048, 48, 9, P.G, P.bid, 0, 0};
              EpiInN E{(bf16_t*)(ws + WS_QKV), (bf16_t*)(ws + WS_Z), (float*)(ws + WS_BA)};
              gemm_phase<EpiInN, Sched2D, true, true>(ring, g, S, E); }
            { Gemm g{1024, 2048, 2048}; Sched2D S{(const char*)(ws + W_S), (const char*)(ws + WS_H), (size_t)256 * 2048, (size_t)256 * 2048, 10, 48, P.G, P.bid, 0, 0};
              EpiInS E{(bf16_t*)(ws + WS_HYT), (bf16_t*)(ws + WS_XCSL), (bf16_t*)(ws + WS_XCSC)};
              gemm_phase<EpiInS, Sched2D, true, true>(ring, g, S, E); }
        }
        SEAM(pb + 1);
        if (IN(pb + 2)) {
            { PHASE_FRAME(); Gemm g{4096, 8192, 8192}; SchedFourL S{(const char*)(ws + WS_TABL), (const char*)(ws + WS_XCSL), P.bid};
              EpiScaleBf16 E{(bf16_t*)(ws + WS_YC), 512, 1.0f / sqrtf(64.0f * 2048.0f)};
              gemm_phase<EpiScaleBf16, SchedFourL, true, true>(ring, g, S, E); }
            { PHASE_FRAME(); Gemm g{512, 1024, 1024}; SchedFourC S{(const char*)(ws + WS_TABC), (const char*)(ws + WS_XCSC), P.bid - 32};
              EpiScaleBf16 E{(bf16_t*)(ws + WS_YC), 512, 1.0f / sqrtf(64.0f * 256.0f)};
              gemm_phase<EpiScaleBf16, SchedFourC, true, true>(ring, g, S, E); }
            { PHASE_FRAME(); __syncthreads();
              for (int t = q_next(P, 2 * l + 0); t < 1024 + 2048; t = q_next(P, 2 * l + 0)) {
                if (t < 1024) hyena_task(P, l, t >> 1, 32 + (t & 1), LLAT);
                else { const int tt = t - 1024; hyena_task(P, l, tt >> 2, (tt & 3) * 8, LCTX); }
              } }
        }
        SEAM(pb + 2);
        if (IN(pb + 3)) { PHASE_FRAME();
            for (int t = P.bid; t < 1536; t += P.G) {
                int s, h, n;
                if (t < 1024) { s = t >> 5; h = (t >> 2) & 7; n = t & 3; } else { const int tt = t - 1024; s = 32 + (tt >> 8); h = (tt >> 5) & 7; n = tt & 31; }
                d1_task(P, l, s, h, n);
            }
        }
        SEAM(pb + 3);
        if (IN(pb + 4)) { PHASE_FRAME();
            for (int t = q_next(P, 2 * l + 1); t < 128 + 2048; t = q_next(P, 2 * l + 1)) {
                int s, h, dir, sl;
                if (t < 128) { s = 32 + (t >> 6); h = (t >> 3) & 7; dir = (t >> 2) & 1; sl = t & 3; }
                else { const int tt = t - 128; s = tt >> 6; h = (tt >> 3) & 7; dir = (tt >> 2) & 1; sl = tt & 3; }
                d2_task(P, l, s, h, dir, sl);
            }
        }
        SEAM(pb + 4);
        if (IN(pb + 5)) { PHASE_FRAME(); phase_combine(P, l); phase_norm(P, P.in[I_N1G] + l * DM, MODL, 0, 1024, (bf16_t*)(ws + WS_H)); }
        SEAM(pb + 5);
        if (IN(pb + 6)) { PHASE_FRAME(); Gemm g{1024, 2048, 2048}; Sched2D S{(const char*)(ws + WS_H), (const char*)(ws + W_G), (size_t)256 * 2048, (size_t)256 * 2048, 48, 12, P.G, P.bid, 0, 0};
            EpiGate E{(bf16_t*)(ws + WS_GATE)};
            gemm_phase<EpiGate, Sched2D, true, true>(ring, g, S, E); }
        SEAM(pb + 6);
        if (IN(pb + 7)) { PHASE_FRAME(); Gemm g{512, 1024, 1024};
            static_assert(WS_YB == WS_YA + 12 * MiB && WS_YC == WS_YB + 12 * MiB, "y buffers 12 MiB apart");
            SchedMerge S{(const char*)(ws + WS_YA), (const char*)(ws + W_P), P.G, P.bid};
            EpiMerge E{(bf16_t*)(ws + WS_GATE)};
            gemm_phase<EpiMerge, SchedMerge, true, true>(ring, g, S, E); }
        SEAM(pb + 7);
        if (IN(pb + 8)) { PHASE_FRAME(); Gemm g{3072, 6144, 6144}; Sched2D S{(const char*)(ws + WS_GATE), (const char*)(ws + W_O3), (size_t)256 * 6144, (size_t)256 * 6144, 48, 4, P.G, P.bid, 0, 0};
            EpiResid E{P.out, MODL + 2048};
            gemm_phase<EpiResid, Sched2D, false, true>(ring, g, S, E); }
        SEAM(pb + 8);
        if (IN(pb + 9)) { PHASE_FRAME(); phase_norm(P, P.in[I_N2G] + l * DM, MODL, 3072, 4096, (bf16_t*)(ws + WS_H)); }
        SEAM(pb + 9);
        if (IN(pb + 10)) { PHASE_FRAME(); Gemm g{1024, 2048, 2048}; Sched2D S{(const char*)(ws + WS_H), (const char*)(ws + W_GU), (size_t)256 * 2048, (size_t)256 * 2048, 48, 22, P.G, P.bid, 0, 0};
            EpiGU E{(bf16_t*)(ws + WS_ACT)};
            gemm_phase<EpiGU, Sched2D, true, true>(ring, g, S, E); }
        SEAM(pb + 10);
        if (IN(pb + 11)) { PHASE_FRAME(); Gemm g{DFF, DFF * 2, DFF * 2}; Sched2D S{(const char*)(ws + WS_ACT), (const char*)(ws + W_DN), (size_t)256 * DFF * 2, (size_t)256 * DFF * 2, 48, 4, P.G, P.bid, 0, 0};
            EpiResid E{P.out, MODL + 5120};
            gemm_phase<EpiResid, Sched2D, false, true>(ring, g, S, E); }
        SEAM(pb + 11);
    }
    if (IN(25)) { PHASE_FRAME(); phase_final(P); }
#undef IN
#undef SEAM
}

extern "C" void kernel_launch(void* const* d_in, const int* in_sizes, int n_in, void* d_out, int out_size, void* d_ws, size_t ws_size, hipStream_t stream) {
    static int grid = 0;
    if (grid == 0) {
        if (n_in != N_IN || out_size != NTOK * DM + 32 * 2 * 2 * 8 * 4096 || ws_size < WS_END) { fprintf(stderr, "kernel_launch: unexpected shapes (n_in %d out %d ws %zu); nothing launched\n", n_in, out_size, ws_size); grid = -1; return; }
        int dev = 0, cus = 0, per_cu = 0;
        if (hipGetDevice(&dev) != hipSuccess || hipDeviceGetAttribute(&cus, hipDeviceAttributeMultiprocessorCount, dev) != hipSuccess) { grid = -1; return; }
        if (hipFuncSetAttribute((const void*)mk_fwd, hipFuncAttributeMaxDynamicSharedMemorySize, LDS_BYTES) != hipSuccess) { fprintf(stderr, "kernel_launch: hipFuncSetAttribute failed\n"); grid = -1; return; }
        if (hipOccupancyMaxActiveBlocksPerMultiprocessor(&per_cu, (const void*)mk_fwd, NTHR, LDS_BYTES) != hipSuccess || per_cu < 1) { fprintf(stderr, "kernel_launch: occupancy query says %d blocks per CU; nothing launched\n", per_cu); (void)hipGetLastError(); grid = -1; return; }
        grid = cus;
    }
    if (grid < 0) return;
    if (hipMemsetAsync((char*)d_ws + WS_CTL, 0, CTL_ZERO_BYTES, stream) != hipSuccess) return;
    Args a{};
    for (int i = 0; i < N_IN; ++i) a.in[i] = (const float*)d_in[i];
    a.out = (float*)d_out; a.ws = (unsigned char*)d_ws;
#if MK_PER_PHASE
    for (int p = 0; p < N_PHASES; ++p) { a.ph_lo = p; a.ph_hi = p + 1; a.li = 0; hipLaunchKernelGGL(mk_fwd, dim3(grid), dim3(NTHR), LDS_BYTES, stream, a); }
#else
    a.ph_lo = 0; a.ph_hi = N_PHASES; a.li = 0;
    hipLaunchKernelGGL(mk_fwd, dim3(grid), dim3(NTHR), LDS_BYTES, stream, a);
#endif
}
```

```cpp
#include <hip/hip_runtime.h>
#include <cstdio>
#include <cstdint>

#ifndef MK_PER_PHASE
#define MK_PER_PHASE 0
#endif

#ifndef REPMASK
#define REPMASK 0
#endif
#define NREP(k) (((REPMASK >> (k)) & 1) ? 2 : 1)
#define LAS __attribute__((address_space(3)))
#define GAS __attribute__((address_space(1)))
typedef unsigned short bf16_t;
typedef short bf16x8 __attribute__((ext_vector_type(8)));
typedef float f32x4 __attribute__((ext_vector_type(4)));
typedef float f32x2 __attribute__((ext_vector_type(2)));
typedef unsigned u32x4 __attribute__((ext_vector_type(4)));
typedef unsigned u32x2 __attribute__((ext_vector_type(2)));

constexpr int DM = 1024, NTOK = 12288, NCTX = 8192, LCTX = 256, LLAT = 2048, BCTX = 32, BLAT = 2;
constexpr int HA = 8, QKVW = 1536, DFF = 2816, DIN = 7200;
constexpr int OFF_Z = 1536, OFF_B = 2048, OFF_HY = 2080, OFF_FN = 3616, OFF_GATE = 4128;
constexpr float EPS = 1e-6f;
enum { I_XP = 0, I_XS, I_STATE, I_C, I_CCTX, I_WMOD, I_BMOD, I_N1G, I_N2G, I_WIN, I_CONVQKV, I_ALOG, I_DTB, I_NORMA, I_CONVHY,
       I_HW1, I_HB1, I_HFREQ, I_HW2, I_HB2, I_HW3, I_HBIAS, I_WPA, I_WPB, I_WPC, I_WO, I_WGU, I_WDOWN, I_NORMF, N_IN };

constexpr size_t MiB = 1u << 20;
constexpr size_t WS_CTL = 0, CTL_ZERO_BYTES = 256 * 1024;
constexpr size_t WS_MOD = 1 * MiB;
constexpr size_t WS_TABC = 2 * MiB;
constexpr size_t WS_FILC = 3 * MiB;
constexpr size_t WS_FILL = 5 * MiB;
constexpr size_t WS_TABL = 21 * MiB;
constexpr size_t WS_W = 37 * MiB;
constexpr size_t W_N = WS_W;
constexpr size_t W_S = W_N + 2304 * 1024 * 2;
constexpr size_t W_G = W_S + 2560 * 1024 * 2;
constexpr size_t W_P = W_G + 3072 * 1024 * 2;
constexpr size_t W_O3 = W_P + 3 * 1024 * 512 * 2;
constexpr size_t W_GU = W_O3 + 1024 * 3072 * 2;
constexpr size_t W_DN = W_GU + 5632 * 1024 * 2;
constexpr size_t W_END = W_DN + 1024 * 2816 * 2;
static_assert(W_END <= 78 * MiB, "weights region");
constexpr size_t WS_A0 = 78 * MiB;
constexpr size_t WS_QKV = WS_A0, WS_OF = WS_A0, WS_OB = WS_A0 + 12 * MiB;
constexpr size_t WS_Z = 116 * MiB, WS_YA = WS_Z;
constexpr size_t WS_BA = 114 * MiB;
constexpr size_t WS_YB = 128 * MiB, WS_YC = 140 * MiB;
constexpr size_t WS_A5 = 152 * MiB;
constexpr size_t WS_H = WS_A5;
constexpr size_t WS_HYT = WS_A5 + 24 * MiB;
constexpr size_t WS_XCS = WS_A5 + 60 * MiB;
constexpr size_t WS_XCSL = WS_XCS, WS_XCSC = WS_XCS + 8 * MiB;
constexpr size_t WS_QN = WS_A5, WS_KN = WS_A5 + 12 * MiB;
constexpr size_t WS_U = WS_A5 + 24 * MiB;
constexpr size_t WS_WW = WS_A5 + 48 * MiB;
constexpr size_t WS_QK = WS_A5 + 72 * MiB;
constexpr size_t WS_GC = WS_A5 + 96 * MiB;
constexpr size_t WS_GATE = WS_A5 + 24 * MiB;
constexpr size_t WS_ACT = WS_A5 + 24 * MiB;
constexpr size_t WS_END = 256 * MiB;
static_assert(WS_GC + 2 * 8 * 192 * 64 * 4 <= WS_END && WS_GATE + (size_t)NTOK * 3072 * 2 <= WS_END, "ws map");
constexpr int CW_BAR = 4096;
constexpr int CW_Q = 16384;

constexpr int RING_BYTES = 131072, LDSCTL_OFF = RING_BYTES, MISC_OFF = LDSCTL_OFF + 320, LDS_BYTES = 147456;
constexpr int NWAVES = 8, NTHR = 512;

#define RLX_AGENT __ATOMIC_RELAXED, __HIP_MEMORY_SCOPE_AGENT
#define LDS_WAIT() asm volatile("s_waitcnt lgkmcnt(0)" ::: "memory")
__device__ __forceinline__ unsigned f2bf(float f) { unsigned u = __builtin_bit_cast(unsigned, f); return (u + 0x7fffu + ((u >> 16) & 1u)) >> 16; }
__device__ __forceinline__ unsigned pk2(float lo, float hi) { return f2bf(lo) | (f2bf(hi) << 16); }
__device__ __forceinline__ float bf2f(unsigned short b) { return __builtin_bit_cast(float, (unsigned)b << 16); }
__device__ __forceinline__ float bflo(unsigned w) { return __builtin_bit_cast(float, w << 16); }
__device__ __forceinline__ float bfhi(unsigned w) { return __builtin_bit_cast(float, w & 0xffff0000u); }
__device__ __forceinline__ float sin_rev(float r) { return __builtin_amdgcn_sinf(r - rintf(r)); }
__device__ __forceinline__ float cos_rev(float r) { return __builtin_amdgcn_cosf(r - rintf(r)); }
__device__ __forceinline__ float sin_rad(float x) { return sin_rev(x * 0.15915494309189535f); }
__device__ __forceinline__ float cos_rad(float x) { return cos_rev(x * 0.15915494309189535f); }
__device__ __forceinline__ float sigmoidf_(float x) { return 1.f / (1.f + __expf(-x)); }
__device__ __forceinline__ float siluf_(float x) { return x / (1.f + __expf(-x)); }
__device__ __forceinline__ float wave_sum(float v) {
#pragma unroll
    for (int o = 1; o < 64; o <<= 1) v += __shfl_xor(v, o);
    return v;
}
template <class T> __device__ __forceinline__ T* opq(T* p) {
    unsigned lo = (unsigned)(uintptr_t)p, hi = (unsigned)((uintptr_t)p >> 32); asm volatile("" : "+v"(lo), "+v"(hi));
    lo = __builtin_amdgcn_readfirstlane(lo); hi = __builtin_amdgcn_readfirstlane(hi); return (T*)(((uintptr_t)hi << 32) | (uintptr_t)lo);
}
__device__ __forceinline__ int seq_start(int s) { return s < 32 ? s * 256 : NCTX + (s - 32) * 2048; }
__device__ __forceinline__ int seq_len(int s) { return s < 32 ? 256 : 2048; }
__device__ __forceinline__ int mod_idx(int row) { return row < NCTX ? 0 : 1 + ((row - NCTX) >> 11); }

namespace pg8 {
constexpr int BM = 256, BK = 64, HALF = 128, HTB = HALF * BK * 2, STAGE_BYTES = 8 * HTB, NXCD = 8, WGM = 8;
__host__ __device__ __forceinline__ int lds_byte(int r, int c) { const int st = (r >> 4) * 2 + (c >> 5), rr = r & 15, cc = c & 31, ob = rr * 64 + cc * 2; return st * 1024 + (ob ^ (((ob >> 9) & 1) << 5)); }
__host__ __device__ __forceinline__ void stage_rc(int b, int& R, int& C) { const int st = b / 1024, sb = b % 1024, swz = sb ^ (((sb >> 9) & 1) << 5); R = (st >> 1) * 16 + swz / 64; C = (st & 1) * 32 + (swz % 64) / 2; }
__host__ __device__ __forceinline__ int perm32(int rho) { const int n = rho >> 4, i = rho & 15; return 8 * (i >> 2) + 4 * n + (i & 3); }

struct Unit { const char* a; const char* b; int r0, c0; };
struct Gemm { int K, lda, ldb; };

__device__ __forceinline__ bool static_order(long L, int nM, int nN, int& pm, int& pn) {
    const int nwg = nM * nN; if (L >= nwg) return false;
    int wgid = (int)L; { const int q = nwg / NXCD, r = nwg % NXCD, xcd = wgid % NXCD, off = wgid / NXCD; wgid = (xcd < r ? xcd * (q + 1) : r * (q + 1) + (xcd - r) * q) + off; }
    const int nig = WGM * nN, gid = wgid / nig, fm = gid * WGM, gsz = (nM - fm) < WGM ? (nM - fm) : WGM;
    pm = fm + ((wgid % nig) % gsz); pn = (wgid % nig) / gsz; return true;
}
__device__ __forceinline__ unsigned cvt_pk_bf16(float lo, float hi) { unsigned r; asm volatile("v_cvt_pk_bf16_f32 %0, %1, %2" : "=v"(r) : "v"(lo), "v"(hi)); return r; }

template <class Epi, class Sched, bool ALIGN_EPI, bool SP2>
__device__ __forceinline__ void gemm_phase(LAS unsigned char* lds, const Gemm g, const Sched& S, const Epi& E) {
    int tid_ = threadIdx.x; asm volatile("" : "+v"(tid_));
    const int tid = tid_, wid = __builtin_amdgcn_readfirstlane(tid >> 6), lane = tid & 63, wr = wid >> 2, wc = wid & 3, fr = lane & 15, fq = lane >> 4;
    const int K = g.K, nt = K / BK;
    unsigned voffA[2], voffB[2];
#pragma unroll
    for (int i = 0; i < 2; ++i) { int R, C; stage_rc(tid * 16 + i * 8192, R, C); const int Rb = Epi::PERM ? ((R & ~31) + perm32(R & 31)) : R;
        voffA[i] = (unsigned)(R * g.lda + C * 2); voffB[i] = (unsigned)(Rb * g.ldb + C * 2); }
    const size_t kstep = (size_t)(BK * 2);
    const size_t hstepA = (size_t)HALF * g.lda, hstepB = (size_t)HALF * g.ldb;
    const unsigned ldsw = (unsigned)wid * 1024u;
    const int aoff = lds_byte(wr * 64 + fr, fq * 8), boff = lds_byte(wc * 32 + fr, fq * 8);
#define PG8_SA(b, h) (((b) * 2 + (h)) * HTB)
#define PG8_SB(b, h) ((4 + (b) * 2 + (h)) * HTB)
#define PG8_STAGE(bufoff, gbase, voff) do { _Pragma("unroll") for (int _i = 0; _i < 2; ++_i) \
        __builtin_amdgcn_global_load_lds((const unsigned*)((const char*)(gbase) + (voff)[_i]), (LAS unsigned*)(lds + (bufoff) + ldsw + _i * 8192), 16, 0, 0); } while (0)
#define PG8_LDA(dst, b, h) do { _Pragma("unroll") for (int m = 0; m < 4; ++m) _Pragma("unroll") for (int k = 0; k < 2; ++k) dst[m][k] = *(const LAS bf16x8*)(lds + PG8_SA(b, h) + aoff + m * 2048 + k * 1024); } while (0)
#define PG8_LDB(dst, b, h) do { _Pragma("unroll") for (int n = 0; n < 2; ++n) _Pragma("unroll") for (int k = 0; k < 2; ++k) dst[n][k] = *(const LAS bf16x8*)(lds + PG8_SB(b, h) + boff + n * 2048 + k * 1024); } while (0)
#define PG8_MMA(ai, bj, At, Bt) do { __builtin_amdgcn_s_setprio(1); _Pragma("unroll") for (int m = 0; m < 4; ++m) _Pragma("unroll") for (int n = 0; n < 2; ++n) _Pragma("unroll") for (int k = 0; k < 2; ++k) \
        acc[ai][bj][m][n] = __builtin_amdgcn_mfma_f32_16x16x32_bf16(Bt[n][k], At[m][k], acc[ai][bj][m][n], 0, 0, 0); __builtin_amdgcn_s_setprio(0); } while (0)
#define PG8_WAIT_V(n) asm volatile("s_waitcnt vmcnt(" #n ")" ::: "memory")
#define PG8_WAIT_L(n) asm volatile("s_waitcnt lgkmcnt(" #n ")" ::: "memory")
#define PG8_BAR __builtin_amdgcn_s_barrier()
#define PG8_SCHED __builtin_amdgcn_sched_barrier(0)
    Unit cur, nxt; int ui = 0;
    if (!S.next(0, cur)) return;
    f32x4 acc[2][2][4][2];
#pragma unroll
    for (int a = 0; a < 2; ++a)
#pragma unroll
        for (int b = 0; b < 2; ++b)
#pragma unroll
            for (int m = 0; m < 4; ++m)
#pragma unroll
                for (int n = 0; n < 2; ++n) acc[a][b][m][n] = (f32x4){0.f, 0.f, 0.f, 0.f};
    bf16x8 At[4][2], B0[2][2], B1[2][2];
    const char* cA = cur.a; const char* cB = cur.b;
    if constexpr (SP2) {
        PG8_STAGE(PG8_SB(0, 0), cB, voffB); PG8_STAGE(PG8_SB(0, 1), cB + hstepB, voffB); PG8_STAGE(PG8_SA(0, 0), cA, voffA); PG8_STAGE(PG8_SA(0, 1), cA + hstepA, voffA);
        if (wr == 1) PG8_BAR;
        PG8_WAIT_V(2); PG8_BAR;
        PG8_STAGE(PG8_SB(1, 0), cB + kstep, voffB); PG8_STAGE(PG8_SA(1, 0), cA + kstep, voffA); PG8_STAGE(PG8_SB(1, 1), cB + hstepB + kstep, voffB);
        PG8_WAIT_V(6); PG8_BAR;
    } else {
        PG8_STAGE(PG8_SB(0, 0), cB, voffB); PG8_STAGE(PG8_SA(0, 0), cA, voffA); PG8_STAGE(PG8_SB(0, 1), cB + hstepB, voffB); PG8_STAGE(PG8_SA(0, 1), cA + hstepA, voffA);
        if (wr == 1) PG8_BAR;
        PG8_WAIT_V(4); PG8_BAR;
        PG8_STAGE(PG8_SB(1, 0), cB + kstep, voffB); PG8_STAGE(PG8_SA(1, 0), cA + kstep, voffA); PG8_STAGE(PG8_SB(1, 1), cB + hstepB + kstep, voffB);
        PG8_WAIT_V(6); PG8_BAR;
    }
    for (;;) {
        const bool has_next = S.next(ui + 1, nxt);
        const char* nA = has_next ? nxt.a : cA; const char* nB = has_next ? nxt.b : cB;
        for (int t = 0; t < nt; t += 2) {
            const bool last = (t == nt - 2);
            const char* a1 = cA + (size_t)(t + 1) * kstep;
            const char* a2 = last ? nA : cA + (size_t)(t + 2) * kstep; const char* b2 = last ? nB : cB + (size_t)(t + 2) * kstep;
            const char* a3 = a2 + kstep; const char* b3 = b2 + kstep;
            if constexpr (SP2) {
            PG8_LDB(B0, 0, 0); PG8_LDB(B1, 0, 1); PG8_SCHED; PG8_LDA(At, 0, 0); PG8_STAGE(PG8_SA(1, 1), a1 + hstepA, voffA);
            PG8_WAIT_V(8); PG8_WAIT_L(0); PG8_BAR; PG8_MMA(0, 0, At, B0); PG8_MMA(0, 1, At, B1); PG8_BAR; PG8_SCHED;
            PG8_LDA(At, 0, 1); PG8_STAGE(PG8_SB(0, 0), b2, voffB); PG8_STAGE(PG8_SB(0, 1), b2 + hstepB, voffB); PG8_STAGE(PG8_SA(0, 0), a2, voffA);
            PG8_WAIT_V(8); PG8_WAIT_L(0); PG8_BAR; PG8_MMA(1, 0, At, B0); PG8_MMA(1, 1, At, B1); PG8_BAR; PG8_SCHED;
            PG8_LDB(B0, 1, 0); PG8_LDB(B1, 1, 1); PG8_SCHED; PG8_LDA(At, 1, 0); PG8_STAGE(PG8_SA(0, 1), a2 + hstepA, voffA);
            PG8_WAIT_V(8); PG8_WAIT_L(0); PG8_BAR; PG8_MMA(0, 0, At, B0); PG8_MMA(0, 1, At, B1); PG8_BAR; PG8_SCHED;
            PG8_LDA(At, 1, 1); PG8_STAGE(PG8_SB(1, 0), b3, voffB); PG8_STAGE(PG8_SB(1, 1), b3 + hstepB, voffB); PG8_STAGE(PG8_SA(1, 0), a3, voffA);
            PG8_WAIT_V(8); PG8_WAIT_L(0); PG8_BAR; PG8_MMA(1, 0, At, B0); PG8_MMA(1, 1, At, B1); PG8_BAR; PG8_SCHED;
            } else {
            PG8_LDB(B0, 0, 0); PG8_SCHED; PG8_LDA(At, 0, 0); PG8_STAGE(PG8_SA(1, 1), a1 + hstepA, voffA);
            PG8_WAIT_L(8); PG8_BAR; PG8_WAIT_L(0); PG8_MMA(0, 0, At, B0); PG8_BAR; PG8_SCHED;
            PG8_LDB(B1, 0, 1); PG8_STAGE(PG8_SB(0, 0), b2, voffB);
            PG8_BAR; PG8_WAIT_L(0); PG8_MMA(0, 1, At, B1); PG8_BAR;
            PG8_LDA(At, 0, 1); PG8_STAGE(PG8_SA(0, 0), a2, voffA);
            PG8_BAR; PG8_WAIT_L(0); PG8_MMA(1, 0, At, B0); PG8_BAR; PG8_SCHED;
            PG8_STAGE(PG8_SB(0, 1), b2 + hstepB, voffB);
            PG8_WAIT_V(6); PG8_BAR; PG8_MMA(1, 1, At, B1); PG8_BAR;
            PG8_LDB(B0, 1, 0); PG8_SCHED; PG8_LDA(At, 1, 0); PG8_STAGE(PG8_SA(0, 1), a2 + hstepA, voffA);
            PG8_WAIT_L(8); PG8_BAR; PG8_WAIT_L(0); PG8_MMA(0, 0, At, B0); PG8_BAR; PG8_SCHED;
            PG8_LDB(B1, 1, 1); PG8_STAGE(PG8_SB(1, 0), b3, voffB);
            PG8_BAR; PG8_WAIT_L(0); PG8_MMA(0, 1, At, B1); PG8_BAR;
            PG8_LDA(At, 1, 1); PG8_STAGE(PG8_SA(1, 0), a3, voffA);
            PG8_BAR; PG8_WAIT_L(0); PG8_MMA(1, 0, At, B0); PG8_BAR; PG8_SCHED;
            PG8_STAGE(PG8_SB(1, 1), b3 + hstepB, voffB);
            PG8_WAIT_V(6); PG8_BAR; PG8_MMA(1, 1, At, B1); PG8_BAR;
            }
        }
        if constexpr (ALIGN_EPI) { if (wr == 0) PG8_BAR; }
        E(acc, cur, wr, wc, fr, fq);
        if (!has_next) break;
#pragma unroll
        for (int a = 0; a < 2; ++a)
#pragma unroll
            for (int b = 0; b < 2; ++b)
#pragma unroll
                for (int m = 0; m < 4; ++m)
#pragma unroll
                    for (int n = 0; n < 2; ++n) acc[a][b][m][n] = (f32x4){0.f, 0.f, 0.f, 0.f};
        cur = nxt; cA = nA; cB = nB; ++ui;
        if constexpr (ALIGN_EPI) { if (wr == 1) PG8_BAR; }
    }
    PG8_WAIT_V(0);
    if constexpr (!ALIGN_EPI) { if (wr == 0) PG8_BAR; }
    PG8_BAR;
#undef PG8_SA
#undef PG8_SB
#undef PG8_STAGE
#undef PG8_LDA
#undef PG8_LDB
#undef PG8_MMA
#undef PG8_WAIT_V
#undef PG8_WAIT_L
#undef PG8_BAR
#undef PG8_SCHED
}

struct Sched2D {
    const char* A; const char* B; size_t atile, btile; int nM, nN, G, c, r_base, c_base;
    __device__ __forceinline__ bool next(int i, Unit& u) const {
        if (c < 0) return false;
        int pm, pn; if (!static_order((long)i * G + c, nM, nN, pm, pn)) return false;
        u.a = A + (size_t)pm * atile; u.b = B + (size_t)pn * btile; u.r0 = r_base + pm * 256; u.c0 = c_base + pn * 256; return true;
    }
};
struct SchedMerge {
    const char *y0, *w0; int G, c;
    __device__ __forceinline__ bool next(int i, Unit& u) const {
        int pm, pn; if (!static_order((long)i * G + c, 48, 12, pm, pn)) return false;
        const int br = pn >> 2; const char* y = y0 + (size_t)br * (12u << 20); const char* w = w0 + (size_t)br * (1u << 20);
        u.a = y + (size_t)pm * 256 * 512 * 2; u.b = w + (size_t)(pn & 3) * 256 * 512 * 2; u.r0 = pm * 256; u.c0 = pn * 256; return true;
    }
};
struct SchedFourL {
    const char* tab; const char* xcs; int c;
    __device__ __forceinline__ bool next(int i, Unit& u) const {
        if (i > 0 || c < 0 || c >= 32) return false;
        const int b = c >> 4, pm = (c & 15) >> 1, pn = c & 1;
        u.a = tab + (size_t)pm * 256 * 4096 * 2; u.b = xcs + ((size_t)b * 512 + pn * 256) * 4096 * 2; u.r0 = NCTX + b * 2048 + pm * 256; u.c0 = pn * 256; return true;
    }
};
struct SchedFourC {
    const char* tab; const char* xcs; int c;
    __device__ __forceinline__ bool next(int i, Unit& u) const {
        if (i > 0 || c < 0 || c >= 64) return false;
        const int b = c >> 1, pn = c & 1;
        u.a = tab; u.b = xcs + ((size_t)b * 512 + pn * 256) * 512 * 2; u.r0 = b * 256; u.c0 = pn * 256; return true;
    }
};

typedef f32x4 Acc[2][2][4][2];
struct EpiInN {
    static constexpr bool PERM = true;
    bf16_t* qkv; bf16_t* z; float* ba;
    __device__ __forceinline__ void operator()(const Acc& acc, const Unit& u, int wr, int wc, int fr, int fq) const {
        const int colt = u.c0;
#pragma unroll
        for (int ai = 0; ai < 2; ++ai)
#pragma unroll
            for (int m = 0; m < 4; ++m) { const int row = u.r0 + ai * HALF + wr * 64 + m * 16 + fr;
#pragma unroll
                for (int bj = 0; bj < 2; ++bj) { const int col = colt + bj * HALF + wc * 32 + 8 * fq; const f32x4 v0 = acc[ai][bj][m][0], v1 = acc[ai][bj][m][1];
                    if (colt < 2048) { u32x4 w; w.x = cvt_pk_bf16(v0[0], v0[1]); w.y = cvt_pk_bf16(v0[2], v0[3]); w.z = cvt_pk_bf16(v1[0], v1[1]); w.w = cvt_pk_bf16(v1[2], v1[3]);
                        bf16_t* p = colt < 1536 ? qkv + (size_t)row * 1536 + col : z + (size_t)row * 512 + (col - 1536);
                        *(u32x4*)p = w; }
                    else if (col - 2048 < 32) { float* p = ba + (size_t)row * 32 + (col - 2048); *(f32x4*)p = v0; *(f32x4*)(p + 4) = v1; } } }
    }
};
struct EpiInS {
    static constexpr bool PERM = true;
    bf16_t* hyt; bf16_t* xcsl; bf16_t* xcsc;
    __device__ __forceinline__ void operator()(const Acc& acc, const Unit& u, int wr, int wc, int fr, int fq) const {
#pragma unroll
        for (int ai = 0; ai < 2; ++ai)
#pragma unroll
            for (int m = 0; m < 4; ++m) { const int ch = u.r0 + ai * HALF + wr * 64 + m * 16 + fr;
#pragma unroll
                for (int bj = 0; bj < 2; ++bj) { const int tok = u.c0 + bj * HALF + wc * 32 + 8 * fq; const f32x4 v0 = acc[ai][bj][m][0], v1 = acc[ai][bj][m][1];
                    u32x4 w; w.x = cvt_pk_bf16(v0[0], v0[1]); w.y = cvt_pk_bf16(v0[2], v0[3]); w.z = cvt_pk_bf16(v1[0], v1[1]); w.w = cvt_pk_bf16(v1[2], v1[3]);
                    bf16_t* p;
                    if (ch < 1536) p = hyt + (size_t)ch * NTOK + tok;
                    else { const int cc = ch - 1536, which = cc >> 9, n = cc & 511;
                        if (tok < NCTX) { const int b = tok >> 8, t = tok & 255; p = xcsc + ((size_t)(b * 512 + n) * 512 + which * 256 + t); }
                        else { const int tt = tok - NCTX, b = tt >> 11, t = tt & 2047; p = xcsl + ((size_t)(b * 512 + n) * 4096 + which * 2048 + t); } }
                    *(u32x4*)p = w; } }
    }
};
struct EpiScaleBf16 {
    static constexpr bool PERM = true;
    bf16_t* O; int ldc; float scale;
    __device__ __forceinline__ void operator()(const Acc& acc, const Unit& u, int wr, int wc, int fr, int fq) const {
#pragma unroll
        for (int ai = 0; ai < 2; ++ai)
#pragma unroll
            for (int m = 0; m < 4; ++m) { const int row = u.r0 + ai * HALF + wr * 64 + m * 16 + fr;
#pragma unroll
                for (int bj = 0; bj < 2; ++bj) { const int col = u.c0 + bj * HALF + wc * 32 + 8 * fq; const f32x4 v0 = acc[ai][bj][m][0] * scale, v1 = acc[ai][bj][m][1] * scale;
                    u32x4 w; w.x = cvt_pk_bf16(v0[0], v0[1]); w.y = cvt_pk_bf16(v0[2], v0[3]); w.z = cvt_pk_bf16(v1[0], v1[1]); w.w = cvt_pk_bf16(v1[2], v1[3]);
                    *(u32x4*)(O + (size_t)row * ldc + col) = w; } }
    }
};
struct EpiGate {
    static constexpr bool PERM = true;
    bf16_t* O;
    __device__ __forceinline__ void operator()(const Acc& acc, const Unit& u, int wr, int wc, int fr, int fq) const {
#pragma unroll
        for (int ai = 0; ai < 2; ++ai)
#pragma unroll
            for (int m = 0; m < 4; ++m) { const int row = u.r0 + ai * HALF + wr * 64 + m * 16 + fr;
#pragma unroll
                for (int bj = 0; bj < 2; ++bj) { const int col = u.c0 + bj * HALF + wc * 32 + 8 * fq; const f32x4 v0 = acc[ai][bj][m][0], v1 = acc[ai][bj][m][1];
                    u32x4 w; w.x = cvt_pk_bf16(sigmoidf_(v0[0]), sigmoidf_(v0[1])); w.y = cvt_pk_bf16(sigmoidf_(v0[2]), sigmoidf_(v0[3]));
                    w.z = cvt_pk_bf16(sigmoidf_(v1[0]), sigmoidf_(v1[1])); w.w = cvt_pk_bf16(sigmoidf_(v1[2]), sigmoidf_(v1[3]));
                    *(u32x4*)(O + (size_t)row * 3072 + col) = w; } }
    }
};
struct EpiMerge {
    static constexpr bool PERM = true;
    bf16_t* O;
    __device__ __forceinline__ void operator()(const Acc& acc, const Unit& u, int wr, int wc, int fr, int fq) const {
#pragma unroll
        for (int ai = 0; ai < 2; ++ai)
#pragma unroll
            for (int m = 0; m < 4; ++m) { const int row = u.r0 + ai * HALF + wr * 64 + m * 16 + fr;
#pragma unroll
                for (int bj = 0; bj < 2; ++bj) { const int col = u.c0 + bj * HALF + wc * 32 + 8 * fq; const f32x4 v0 = acc[ai][bj][m][0], v1 = acc[ai][bj][m][1];
                    bf16_t* p = O + (size_t)row * 3072 + col; const u32x4 gg = *(const u32x4*)p;
                    u32x4 w; w.x = cvt_pk_bf16(v0[0] * bflo(gg.x), v0[1] * bfhi(gg.x)); w.y = cvt_pk_bf16(v0[2] * bflo(gg.y), v0[3] * bfhi(gg.y));
                    w.z = cvt_pk_bf16(v1[0] * bflo(gg.z), v1[1] * bfhi(gg.z)); w.w = cvt_pk_bf16(v1[2] * bflo(gg.w), v1[3] * bfhi(gg.w));
                    *(u32x4*)p = w; } }
    }
};
struct EpiResid {
    static constexpr bool PERM = false;
    float* X; const float* gate;
    __device__ __forceinline__ void operator()(const Acc& acc, const Unit& u, int wr, int wc, int fr, int fq) const {
        const float* gp = gate + (size_t)mod_idx(u.r0) * 6144;
#pragma unroll
        for (int bj = 0; bj < 2; ++bj)
#pragma unroll
            for (int n = 0; n < 2; ++n) { const int col = u.c0 + bj * HALF + wc * 32 + 16 * n + 4 * fq; const f32x4 gv = *(const f32x4*)(gp + col);
#pragma unroll
                for (int ai = 0; ai < 2; ++ai)
#pragma unroll
                    for (int m = 0; m < 4; ++m) { const int row = u.r0 + ai * HALF + wr * 64 + m * 16 + fr; float* p = X + (size_t)row * DM + col;
                        const f32x4 x = *(const f32x4*)p; *(f32x4*)p = x + gv * acc[ai][bj][m][n]; } }
    }
};
struct EpiGU {
    static constexpr bool PERM = true;
    bf16_t* O;
    __device__ __forceinline__ void operator()(const Acc& acc, const Unit& u, int wr, int wc, int fr, int fq) const {
        const int col = (u.c0 >> 1) + wc * 32 + 8 * fq;
#pragma unroll
        for (int ai = 0; ai < 2; ++ai)
#pragma unroll
            for (int m = 0; m < 4; ++m) { const int row = u.r0 + ai * HALF + wr * 64 + m * 16 + fr;
                const f32x4 g0 = acc[ai][0][m][0], g1 = acc[ai][0][m][1], u0 = acc[ai][1][m][0], u1 = acc[ai][1][m][1];
                u32x4 w; w.x = cvt_pk_bf16(siluf_(g0[0]) * u0[0], siluf_(g0[1]) * u0[1]); w.y = cvt_pk_bf16(siluf_(g0[2]) * u0[2], siluf_(g0[3]) * u0[3]);
                w.z = cvt_pk_bf16(siluf_(g1[0]) * u1[0], siluf_(g1[1]) * u1[1]); w.w = cvt_pk_bf16(siluf_(g1[2]) * u1[2], siluf_(g1[3]) * u1[3]);
                *(u32x4*)(O + (size_t)row * DFF + col) = w; }
    }
};
}

#define XB_TMO      128
#define XB_XCNT(j)  (256  + 64 * (j))
#define XB_XSUB(j)  (1280 + 64 * (j))
#define XB_XGEN(j)  (2304 + 64 * (j))
#define XB_TOP      3328
#define XB_TOPGEN   3392
#define XCD_BAR_WORDS 3456
#define XB_SPIN_CAP (1u << 18)
__device__ __forceinline__ unsigned xb_ld(unsigned* p)              { return __hip_atomic_load(p, __ATOMIC_RELAXED, __HIP_MEMORY_SCOPE_AGENT); }
__device__ __forceinline__ unsigned xb_add(unsigned* p, unsigned v) { return __hip_atomic_fetch_add(p, v, __ATOMIC_RELAXED, __HIP_MEMORY_SCOPE_AGENT); }
__device__ __forceinline__ unsigned xb_xcc_id() { return (unsigned)__builtin_amdgcn_s_getreg((3 << 11) | 20) & 0xFu; }
#define XB_SPIN(cond, bar) do { unsigned _sp = 0; while (cond) { __builtin_amdgcn_s_sleep(1); \
    if ((++_sp & 255u) == 0u) { if (xb_ld(&(bar)[XB_TMO])) break; if (_sp > XB_SPIN_CAP) { atomicAdd(&(bar)[XB_TMO], 1u); break; } } } } while (0)
struct XcdBarrier { unsigned* bar; unsigned x; volatile LAS unsigned* st; };
__device__ __forceinline__ XcdBarrier xcd_barrier_post(unsigned* bar, volatile LAS unsigned* st) {
    XcdBarrier b; b.bar = bar; b.x = xb_xcc_id(); b.st = st;
    if (threadIdx.x == 0) (void)xb_add(&bar[XB_XCNT(b.x)], 1u);
    return b;
}
__device__ __forceinline__ void xcd_barrier_complete(unsigned* bar, unsigned x, unsigned& nloc, unsigned& nx) {
    const unsigned G = gridDim.x * gridDim.y * gridDim.z;
    unsigned sum, cnt, mine, sp = 0u;
    for (;;) {
        sum = 0u; cnt = 0u; mine = 0u;
#pragma unroll 1
        for (unsigned j = 0; j < 16; ++j) { const unsigned c = xb_ld(&bar[XB_XCNT(j)]); sum += c; cnt += (c > 0u) ? 1u : 0u; mine = (j == x) ? c : mine; }
        if (sum == G) break;
        __builtin_amdgcn_s_sleep(1);
        if ((++sp & 255u) == 0u) { if (xb_ld(&bar[XB_TMO])) break; if (sp > XB_SPIN_CAP) { atomicAdd(&bar[XB_TMO], 1u); break; } }
    }
    nloc = mine > 0u ? mine : 1u; nx = cnt > 0u ? cnt : 1u;
}
__device__ __forceinline__ void xcd_barrier(const XcdBarrier& b) {
    asm volatile("s_waitcnt vmcnt(0)" ::: "memory");
    __syncthreads();
    if (threadIdx.x == 0) {
        unsigned* bar = opq(b.bar);
        __builtin_amdgcn_s_waitcnt(0);
        unsigned nloc = b.st[0], nx = b.st[1];
        if (nloc == 0u) { xcd_barrier_complete(bar, b.x, nloc, nx); b.st[0] = nloc; b.st[1] = nx; }
        const unsigned old = xb_add(&bar[XB_XSUB(b.x)], 1u);
        const unsigned gen = old / nloc;
        if (old + 1u == (gen + 1u) * nloc) {
            __builtin_amdgcn_fence(__ATOMIC_RELEASE, "agent");
            asm volatile("s_waitcnt vmcnt(0)" ::: "memory");
            const unsigned og = xb_add(&bar[XB_TOP], 1u);
            const unsigned tg = og / nx;
            if (og + 1u == (tg + 1u) * nx) xb_add(&bar[XB_TOPGEN], 1u);
            else XB_SPIN(xb_ld(&bar[XB_TOPGEN]) == tg, bar);
            __builtin_amdgcn_fence(__ATOMIC_ACQUIRE, "agent");
            xb_add(&bar[XB_XGEN(b.x)], 1u);
            asm volatile("s_waitcnt vmcnt(0)" ::: "memory");
        } else {
            XB_SPIN(xb_ld(&bar[XB_XGEN(b.x)]) == gen, bar);
            __builtin_amdgcn_fence(__ATOMIC_ACQUIRE, "agent");
            asm volatile("s_waitcnt vmcnt(0)" ::: "memory");
        }
    }
    __syncthreads();
}

struct Args { const float* in[N_IN]; float* out; unsigned char* ws; int ph_lo, ph_hi, li, pad; };
struct Frame {
    LAS unsigned char* lds; const float* const* in; float* out; unsigned char* ws; unsigned* ctl;
    int tid, lane, wave, G, bid;
};
__device__ __forceinline__ int q_next(Frame& F, int qid) {
    volatile LAS int* slot = (volatile LAS int*)(F.lds + MISC_OFF + 64);
    __syncthreads();
    if (F.tid == 0) *slot = (int)__hip_atomic_fetch_add(F.ctl + CW_Q + 64 * qid, 1u, RLX_AGENT);
    __syncthreads();
    return *slot;
}

__device__ __forceinline__ void transpose_item(const float* W, int ld_src, int col0, bf16_t* WT, int ld_dst, int dst_k0, int row0, int k0, LAS float* scr, int lane) {
#pragma unroll 8
    for (int i = 0; i < 32; ++i) { const int kk = 2 * i + (lane >> 5); scr[kk * 33 + (lane & 31)] = W[(size_t)(k0 + kk) * ld_src + col0 + (lane & 31)]; }
    LDS_WAIT(); asm volatile("" ::: "memory");
    const int c = lane & 7;
#pragma unroll
    for (int j = 0; j < 4; ++j) { const int n = (lane >> 3) + 8 * j; const LAS float* s = scr + (8 * c) * 33 + n;
        u32x4 o; o.x = pk2(s[0 * 33], s[1 * 33]); o.y = pk2(s[2 * 33], s[3 * 33]); o.z = pk2(s[4 * 33], s[5 * 33]); o.w = pk2(s[6 * 33], s[7 * 33]);
        *(u32x4*)(WT + (size_t)(row0 + n) * ld_dst + dst_k0 + k0 + 8 * c) = o; }
    LDS_WAIT(); asm volatile("" ::: "memory");
}
__device__ __forceinline__ void prep_weights(Frame& F, int l) {
    LAS float* scr = (LAS float*)(F.lds + F.wave * 16384);
    const int gw = F.bid * NWAVES + F.wave, NGW = F.G * NWAVES;
    const float* w_in = F.in[I_WIN] + (size_t)l * DM * DIN;
    unsigned char* ws = F.ws;
    constexpr int NI_QKVZBA = 16 * (2080 / 32), NI_HY = 16 * 48, NI_G = 16 * 96, NI_P = 8 * 32, NI_O = 16 * 32, NI_GU = 16 * 176, NI_DN = 44 * 32;
    constexpr int NITEMS = NI_QKVZBA + NI_HY + NI_G + 3 * NI_P + 3 * NI_O + NI_GU + NI_DN;
#pragma unroll 1
    for (int it = gw; it < NITEMS; it += NGW) {
        int r = it;
        const float* src; int ld_src, col0, ld_dst, dst_k0, row0, k0; bf16_t* dst;
        if (r < NI_QKVZBA) { const int nb = r % 65, kb = r / 65; src = w_in; ld_src = DIN; col0 = nb * 32; dst = (bf16_t*)(ws + W_N); ld_dst = 1024; dst_k0 = 0; row0 = nb * 32; k0 = kb * 64; }
        else if ((r -= NI_QKVZBA) < NI_HY) { const int nb = r % 48, kb = r / 48; src = w_in; ld_src = DIN; col0 = OFF_HY + nb * 32; dst = (bf16_t*)(ws + W_S); ld_dst = 1024; dst_k0 = 0; row0 = nb * 32; k0 = kb * 64; }
        else if ((r -= NI_HY) < NI_G) { const int nb = r % 96, kb = r / 96; src = w_in; ld_src = DIN; col0 = OFF_GATE + nb * 32; dst = (bf16_t*)(ws + W_G); ld_dst = 1024; dst_k0 = 0; row0 = nb * 32; k0 = kb * 64; }
        else if ((r -= NI_G) < 3 * NI_P) { const int j = r / NI_P, q = r % NI_P, nb = q % 32, kb = q / 32; src = (j == 0 ? F.in[I_WPA] : (j == 1 ? F.in[I_WPB] : F.in[I_WPC])) + (size_t)l * 512 * 1024;
            ld_src = 1024; col0 = nb * 32; dst = (bf16_t*)(ws + W_P) + (size_t)j * 1024 * 512; ld_dst = 512; dst_k0 = 0; row0 = nb * 32; k0 = kb * 64; }
        else if ((r -= 3 * NI_P) < 3 * NI_O) { const int j = r / NI_O, q = r % NI_O, nb = q % 32, kb = q / 32; src = F.in[I_WO] + (size_t)l * 1024 * 1024;
            ld_src = 1024; col0 = nb * 32; dst = (bf16_t*)(ws + W_O3); ld_dst = 3072; dst_k0 = j * 1024; row0 = nb * 32; k0 = kb * 64; }
        else if ((r -= 3 * NI_O) < NI_GU) { const int nb = r % 176, kb = r / 176; const int n0 = nb * 32, up = n0 >= DFF ? 1 : 0, nn = n0 - up * DFF;
            src = F.in[I_WGU] + (size_t)l * 1024 * 5632; ld_src = 5632; col0 = n0; dst = (bf16_t*)(ws + W_GU); ld_dst = 1024; dst_k0 = 0; row0 = 256 * (nn / 128) + 128 * up + (nn % 128); k0 = kb * 64; }
        else { r -= NI_GU; const int nb = r % 32, kb = r / 32; src = F.in[I_WDOWN] + (size_t)l * DFF * 1024; ld_src = 1024; col0 = nb * 32; dst = (bf16_t*)(ws + W_DN); ld_dst = DFF; dst_k0 = 0; row0 = nb * 32; k0 = kb * 64; }
        transpose_item(src, ld_src, col0, dst, ld_dst, dst_k0, row0, k0, scr, F.lane);
    }
    { u32x4* z = (u32x4*)(ws + W_N + (size_t)2080 * 1024 * 2); const int n16 = 224 * 1024 * 2 / 16;
      for (int i = F.bid * NTHR + F.tid; i < n16; i += F.G * NTHR) z[i] = (u32x4){0u, 0u, 0u, 0u}; }
    __syncthreads();
    {
        LAS float* tile = (LAS float*)F.lds;
        LAS float* ctab = tile + 64 * 65;
        if (F.tid < 64) { ctab[F.tid] = cos_rev((float)F.tid / 64.0f); ctab[64 + F.tid] = sin_rev((float)F.tid / 64.0f); }
        for (int task = F.bid; task < 128; task += F.G) {
            const int kb = task >> 3, g = task & 7;
            __syncthreads();
            for (int i = F.tid; i < 4096; i += NTHR) { const int kk = i >> 6, cc = i & 63; tile[kk * 65 + cc] = w_in[(size_t)(kb * 64 + kk) * DIN + OFF_FN + g * 64 + cc]; }
            __syncthreads();
            const int kk = F.tid & 63, cq = F.tid >> 6;
#pragma unroll 1
            for (int j = 0; j < 8; ++j) { const int c = cq * 8 + j; float ac = 0.f, as = 0.f;
#pragma unroll 4
                for (int cp = 0; cp < 64; ++cp) { const float w = tile[kk * 65 + cp]; const int idx = (c * cp) & 63; ac += w * ctab[idx]; as += w * ctab[64 + idx]; }
                bf16_t* d = (bf16_t*)(ws + W_S);
                d[(size_t)(1536 + g * 64 + c) * 1024 + kb * 64 + kk] = (bf16_t)f2bf(ac);
                d[(size_t)(2048 + g * 64 + c) * 1024 + kb * 64 + kk] = (bf16_t)f2bf(as); }
        }
        __syncthreads();
    }
}
__device__ __forceinline__ void prep_filters(Frame& F, int l) {
    LAS float* zp = (LAS float*)F.lds;
    LAS float* h1 = zp + 64 * 33;
    LAS float* h2 = h1 + 64 * 64;
    const float* w1 = F.in[I_HW1] + l * 33 * 64; const float* b1 = F.in[I_HB1] + l * 64; const float* fq = F.in[I_HFREQ] + l * 64;
    const float* w2 = F.in[I_HW2] + l * 64 * 64; const float* b2 = F.in[I_HB2] + l * 64; const float* w3 = F.in[I_HW3] + (size_t)l * 64 * 2048;
    for (int task = F.G - 1 - F.bid; task < 36; task += F.G) {
        const int L = task < 32 ? LLAT : LCTX, t0 = (task < 32 ? task : task - 32) * 64;
        float* fil = (float*)(F.ws + (task < 32 ? WS_FILL : WS_FILC));
        __syncthreads();
        for (int i = F.tid; i < 64 * 33; i += NTHR) { const int tt = i / 33, e = i % 33; const int ti = t0 + tt;
            float v;
            if (e == 0) v = (float)ti / (float)(L - 1);
            else { const int b = (e - 1) & 15; const float fr = 1e-4f + (15.0f - 1e-4f) * (float)b / 15.0f; const float rv = fr * ((float)ti / (float)L);
                   v = e <= 16 ? cos_rev(rv) : -sin_rev(rv); }
            zp[i] = v; }
        __syncthreads();
        for (int i = F.tid; i < 4096; i += NTHR) { const int tt = i >> 6, j = i & 63; float a = b1[j];
            for (int e = 0; e < 33; ++e) a += zp[tt * 33 + e] * w1[e * 64 + j];
            h1[i] = sin_rad(fq[j] * a); }
        __syncthreads();
        for (int i = F.tid; i < 4096; i += NTHR) { const int tt = i >> 6, j = i & 63; float a = b2[j];
            for (int k = 0; k < 64; ++k) a += h1[tt * 64 + k] * w2[k * 64 + j];
            h2[i] = sin_rad(fq[j] * a); }
        __syncthreads();
        for (int q = 0; q < 4; ++q) { const int n = F.tid + 512 * q, c = n & 511;
            float wc[64];
#pragma unroll
            for (int k = 0; k < 64; ++k) wc[k] = w3[(size_t)k * 2048 + n];
            const float dmin = 4.605170185988091f / 1.5f, dmax = 4.605170185988091f / 0.3f;
            const float delta = dmin + (dmax - dmin) * (float)c / 511.0f;
            float* dst = fil + (size_t)n * L + t0;
#pragma unroll 1
            for (int tt = 0; tt < 64; ++tt) { float a = 0.f;
#pragma unroll
                for (int k = 0; k < 64; ++k) a += h2[tt * 64 + k] * wc[k];
                const float tl = (float)(t0 + tt) / (float)(L - 1); dst[tt] = a * expf(-tl * delta); } }
    }
    __syncthreads();
}
__device__ __forceinline__ void prep_mod(Frame& F) {
    LAS float* sc = (LAS float*)F.lds;
    LAS float* red = sc + 3 * 1024;
    __syncthreads();
    for (int i = F.tid; i < 3 * 1024; i += NTHR) { const int mi = i >> 10, k = i & 1023; const float v = mi == 0 ? F.in[I_CCTX][k] : F.in[I_C][(mi - 1) * 1024 + k]; sc[i] = v / (1.f + expf(-v)); }
    __syncthreads();
    float* mod = (float*)(F.ws + WS_MOD);
    for (int task = F.bid; task < 192; task += F.G) {
        const int l = task / 96, j = task % 96, n = j * 64 + F.lane;
        const float* w = F.in[I_WMOD] + (size_t)l * 1024 * 6144 + n;
        float a0 = 0.f, a1 = 0.f, a2 = 0.f;
        const int kb = F.wave * 128;
#pragma unroll 8
        for (int k = 0; k < 128; ++k) { const float wv = w[(size_t)(kb + k) * 6144]; a0 += sc[kb + k] * wv; a1 += sc[1024 + kb + k] * wv; a2 += sc[2048 + kb + k] * wv; }
        red[(F.wave * 3 + 0) * 64 + F.lane] = a0; red[(F.wave * 3 + 1) * 64 + F.lane] = a1; red[(F.wave * 3 + 2) * 64 + F.lane] = a2;
        __syncthreads();
        if (F.tid < 192) { const int mi = F.tid >> 6, ln = F.tid & 63; float s = F.in[I_BMOD][l * 6144 + j * 64 + ln];
            for (int w8 = 0; w8 < 8; ++w8) s += red[(w8 * 3 + mi) * 64 + ln];
            mod[((size_t)l * 3 + mi) * 6144 + j * 64 + ln] = s; }
        __syncthreads();
    }
}
__device__ __forceinline__ void prep_x_tables(Frame& F) {
    const int gt = F.bid * NTHR + F.tid, NG = F.G * NTHR;
    for (int i = gt; i < NTOK * DM / 4; i += NG) {
        const int row = i >> 8, c4 = (i & 255) * 4;
        f32x4 v;
        if (row < NCTX) v = *(const f32x4*)(F.in[I_XP] + (size_t)row * DM + c4);
        else { const int tt = row - NCTX, t = tt & 2047; v = *(const f32x4*)(F.in[I_XS] + (size_t)tt * DM + c4);
            const int seg = c4 >> 8; const float pos = (seg < 2) ? (float)(t >> 6) : (float)(t & 63);
#pragma unroll
            for (int u = 0; u < 4; ++u) { const int ii = (c4 + u) & 255; const float om = expf(-9.210340371976184f * (float)ii / 256.0f); const float a = pos * om;
                v[u] += (seg & 1) ? cos_rad(a) : sin_rad(a); } }
        *(f32x4*)(F.out + (size_t)row * DM + c4) = v;
    }
    for (int i = gt; i < 2048 * 4096 / 8; i += NG) { const int tp = i >> 9, k0 = (i & 511) * 8; unsigned w[4];
#pragma unroll
        for (int u = 0; u < 4; ++u) { float v[2];
#pragma unroll
            for (int e = 0; e < 2; ++e) { const int k = k0 + 2 * u + e; const int m = (tp * (k & 2047)) & 2047; const float x = (float)m / 2048.0f; v[e] = k < 2048 ? cos_rev(x) : -sin_rev(x); }
            w[u] = pk2(v[0], v[1]); }
        *(u32x4*)((bf16_t*)(F.ws + WS_TABL) + (size_t)tp * 4096 + k0) = (u32x4){w[0], w[1], w[2], w[3]}; }
    for (int i = gt; i < 256 * 512 / 8; i += NG) { const int tp = i >> 6, k0 = (i & 63) * 8; unsigned w[4];
#pragma unroll
        for (int u = 0; u < 4; ++u) { float v[2];
#pragma unroll
            for (int e = 0; e < 2; ++e) { const int k = k0 + 2 * u + e; const int m = (tp * (k & 255)) & 255; const float x = (float)m / 256.0f; v[e] = k < 256 ? cos_rev(x) : -sin_rev(x); }
            w[u] = pk2(v[0], v[1]); }
        *(u32x4*)((bf16_t*)(F.ws + WS_TABC) + (size_t)tp * 512 + k0) = (u32x4){w[0], w[1], w[2], w[3]}; }
}

__device__ __forceinline__ void phase_norm(Frame& F, const float* g, const float* modl, int sh_off, int sc_off, bf16_t* H) {
    const int gw = F.bid * NWAVES + F.wave, NGW = F.G * NWAVES;
    for (int row = gw; row < NTOK; row += NGW) {
        const f32x4* xr = (const f32x4*)(F.out + (size_t)row * DM) + F.lane;
        f32x4 v[4]; float s = 0.f;
#pragma unroll
        for (int j = 0; j < 4; ++j) { v[j] = xr[64 * j]; s += (v[j].x * v[j].x + v[j].y * v[j].y) + (v[j].z * v[j].z + v[j].w * v[j].w); }
        const float rstd = 1.0f / sqrtf(wave_sum(s) * (1.f / DM) + EPS);
        const float* mp = modl + (size_t)mod_idx(row) * 6144;
        u32x2* o = (u32x2*)(H + (size_t)row * DM) + F.lane;
#pragma unroll
        for (int j = 0; j < 4; ++j) { const int c = 4 * F.lane + 256 * j; const f32x4 gg = *(const f32x4*)(g + c), sh = *(const f32x4*)(mp + sh_off + c), sc = *(const f32x4*)(mp + sc_off + c);
            const f32x4 y = (v[j] * rstd) * gg * (sc + 1.0f) + sh;
            o[64 * j] = (u32x2){pk2(y.x, y.y), pk2(y.z, y.w)}; }
    }
}
__device__ __forceinline__ void phase_final(Frame& F) {
    const int gw = F.bid * NWAVES + F.wave, NGW = F.G * NWAVES; const float* g = F.in[I_NORMF];
    for (int row = gw; row < NTOK; row += NGW) {
        f32x4* xr = (f32x4*)(F.out + (size_t)row * DM) + F.lane;
        f32x4 v[4]; float s = 0.f;
#pragma unroll
        for (int j = 0; j < 4; ++j) { v[j] = xr[64 * j]; s += (v[j].x * v[j].x + v[j].y * v[j].y) + (v[j].z * v[j].z + v[j].w * v[j].w); }
        const float rstd = 1.0f / sqrtf(wave_sum(s) * (1.f / DM) + EPS);
#pragma unroll
        for (int j = 0; j < 4; ++j) { const int c = 4 * F.lane + 256 * j; const f32x4 gg = *(const f32x4*)(g + c); xr[64 * j] = (v[j] * rstd) * gg; }
    }
}

typedef float f32x16 __attribute__((ext_vector_type(16)));
constexpr int HY_X1 = 0, HY_X2 = 8192, HY_ZP1 = 16384, HY_ZP2 = 47104, HY_TR = 77824, HY_TRCOPY = 8256, HY_TRORD = 16512, HY_RED = 110848;
static_assert(HY_RED + 16384 <= RING_BYTES, "hyena LDS map");
__device__ __forceinline__ void hyena_task(Frame& F, int l, int c, int grp) {
    int tid_ = F.tid; asm volatile("" : "+v"(tid_));
    const int tid = tid_, lane = tid & 63, wave = __builtin_amdgcn_readfirstlane(tid >> 6);
    const int L = grp == 0 ? LLAT : LCTX, nb = L >> 5, ZSEQ = (3 * L / 32) * 40, row0 = grp == 0 ? NCTX : (grp - 1) * 4096;
    LAS unsigned char* lds = F.lds;
    const bf16_t* hyt = (const bf16_t*)(F.ws + WS_HYT);
    const float* cw = F.in[I_CONVHY] + (size_t)l * 3 * 1536;
    const float* fil = (const float*)(F.ws + (grp == 0 ? WS_FILL : WS_FILC));
    const float* hb = F.in[I_HBIAS] + (size_t)l * 2 * 512;
    __syncthreads();
    {
        const int p = 8 * tid, t = p & (L - 1), qs = p / L;
#pragma unroll
        for (int st = 0; st < 3; ++st) { const int ch = st * 512 + c; const bf16_t* src = hyt + (size_t)ch * NTOK + row0 + p;
            const u32x4 rv = *(const u32x4*)src; const float xm = t > 0 ? bf2f(src[-1]) : 0.f, xp = t + 8 < L ? bf2f(src[8]) : 0.f;
            const float w0 = cw[ch], w1 = cw[1536 + ch], w2 = cw[2 * 1536 + ch];
            const float x[10] = {xm, bflo(rv.x), bfhi(rv.x), bflo(rv.y), bfhi(rv.y), bflo(rv.z), bfhi(rv.z), bflo(rv.w), bfhi(rv.w), xp};
            float o[8];
#pragma unroll
            for (int e = 0; e < 8; ++e) o[e] = w0 * x[e] + w1 * x[e + 1] + w2 * x[e + 2];
            const u32x4 pk = (u32x4){pk2(o[0], o[1]), pk2(o[2], o[3]), pk2(o[4], o[5]), pk2(o[6], o[7])};
            if (st < 2) *(LAS u32x4*)(lds + (st == 0 ? HY_X1 : HY_X2) + p * 2) = pk;
            else *(LAS u32x4*)(lds + HY_ZP1 + (qs * ZSEQ + (nb + (t >> 5)) * 40 + (t & 31)) * 2) = pk; }
        const int npad = (4096 / L) * 2 * nb;
        for (int i2 = tid; i2 < 2 * npad * 5; i2 += NTHR) { const int img = i2 / (npad * 5), rem = i2 % (npad * 5), pbk = rem / 5, piece = rem % 5;
            const int qs2 = pbk / (2 * nb), bb = pbk % (2 * nb), blk = bb < nb ? bb : bb + nb;
            *(LAS u32x4*)(lds + (img == 0 ? HY_ZP1 : HY_ZP2) + (qs2 * ZSEQ + blk * 40) * 2 + piece * 16) = (u32x4){0u, 0u, 0u, 0u}; }
    }
#pragma unroll 1
    for (int o = 0; o < 2; ++o) { const float* ff = fil + ((size_t)(2 * o) * 512 + c) * L; const float* fb = fil + ((size_t)(2 * o + 1) * 512 + c) * L;
        const float t00 = ff[0] + fb[0];
        for (int k = tid; k < L; k += NTHR) { float v[3];
#pragma unroll
            for (int e = 0; e < 3; ++e) { const int m = 2 * k + e - L; v[e] = m < 0 ? (m > -L ? ff[-m] : 0.f) : (m == 0 ? t00 : (m < L ? fb[m] : 0.f)); }
            *(LAS unsigned*)(lds + HY_TR + o * HY_TRORD + 4 * k) = pk2(v[0], v[1]); *(LAS unsigned*)(lds + HY_TR + o * HY_TRORD + HY_TRCOPY + 4 * k) = pk2(v[1], v[2]); } }
    __syncthreads();
    const int tile = wave & 3, half = wave >> 2, r = lane & 31, hh = lane >> 5, colg = 32 * tile + r;
    int qs, ib, imin, imax;
    if (grp == 0) { qs = colg >> 6; ib = colg & 63; imin = 32 * (tile & 1); imax = imin + 31; } else { qs = colg >> 3; ib = colg & 7; imin = 0; imax = 7; }
    const int dlo = imin - nb + 1, cnt = imax - imin + nb, mid = dlo + (cnt >> 1);
    const int d0 = half == 0 ? dlo : mid, d1 = half == 0 ? mid : dlo + cnt;
    const int par = r & 1;
    const int aoff = par * HY_TRCOPY + (L + 8 * hh - r - 32 * d0 - par) * 2;
    const int boff = (qs * ZSEQ + (nb + ib - d0) * 40 + 8 * hh) * 2;
    const float bias0 = hb[c], bias1 = hb[512 + c];
    bf16_t* yb = (bf16_t*)(F.ws + WS_YB);
#pragma unroll 1
    for (int o = 0; o < 2; ++o) {
        f32x16 acc;
#pragma unroll
        for (int e = 0; e < 16; ++e) acc[e] = 0.f;
        const LAS unsigned char* Ap = lds + HY_TR + o * HY_TRORD + aoff; const LAS unsigned char* Bp = lds + (o == 0 ? HY_ZP1 : HY_ZP2) + boff;
#pragma unroll 2
        for (int d = d0; d < d1; ++d) {
#pragma unroll
            for (int ks = 0; ks < 2; ++ks) { const LAS unsigned* ap = (const LAS unsigned*)(Ap + 32 * ks);
                const u32x4 aw = (u32x4){ap[0], ap[1], ap[2], ap[3]};
                acc = __builtin_amdgcn_mfma_f32_32x32x16_bf16(__builtin_bit_cast(bf16x8, aw), *(const LAS bf16x8*)(Bp + 32 * ks), acc, 0, 0, 0); }
            Ap -= 64; Bp -= 80; }
        LAS float* red = (LAS float*)(lds + HY_RED);
        if (half == 1) {
#pragma unroll
            for (int e = 0; e < 16; ++e) red[(tile * 16 + e) * 64 + lane] = acc[e]; }
        __syncthreads();
        if (half == 0) {
#pragma unroll
            for (int e = 0; e < 16; ++e) acc[e] += red[(tile * 16 + e) * 64 + lane];
#pragma unroll
            for (int g = 0; g < 4; ++g) { const int a4 = 8 * g + 4 * hh, p = qs * L + 32 * ib + a4, zo = (qs * ZSEQ + (nb + ib) * 40 + a4) * 2;
                const u32x2 gx = *(const LAS u32x2*)(lds + (o == 0 ? HY_X1 : HY_X2) + p * 2), zz = *(const LAS u32x2*)(lds + (o == 0 ? HY_ZP1 : HY_ZP2) + zo);
                const float gv[4] = {bflo(gx.x), bfhi(gx.x), bflo(gx.y), bfhi(gx.y)}, zv[4] = {bflo(zz.x), bfhi(zz.x), bflo(zz.y), bfhi(zz.y)};
                float y[4];
#pragma unroll
                for (int e = 0; e < 4; ++e) y[e] = gv[e] * (acc[4 * g + e] + (o == 0 ? bias0 : bias1) * zv[e]);
                if (o == 0) *(LAS u32x2*)(lds + HY_ZP2 + zo) = (u32x2){pk2(y[0], y[1]), pk2(y[2], y[3])};
                else {
#pragma unroll
                    for (int e = 0; e < 4; ++e) yb[(size_t)(row0 + p + e) * 512 + c] = (bf16_t)f2bf(y[e]); } }
        }
        __syncthreads();
    }
}

__device__ __forceinline__ int kpos32(int k) { return (k & ~31) | (((k >> 2) & 3) << 3) | (((k >> 4) & 1) << 2) | (k & 3); }
__device__ __forceinline__ size_t chunk_lin(int s, int n) { return (size_t)(s < 32 ? s * 4 + n : 128 + (s - 32) * 32 + n); }
__device__ __forceinline__ void d1_task(Frame& F, int l, int s, int h, int n) {
    LAS bf16_t* qb = (LAS bf16_t*)F.lds;
    LAS bf16_t* kb = qb + 64 * 72;
    LAS float* kf = (LAS float*)(kb + 64 * 72);
    LAS float* vf = kf + 4096;
    LAS float* ATf = vf + 4096;
    LAS float* ATb = ATf + 4096;
    LAS float* sm = ATb + 4096;
    LAS float* betaf = sm, *betab = sm + 64, *gcf = sm + 128, *gcb = sm + 192;
    int tid_ = F.tid; asm volatile("" : "+v"(tid_));
    const int tid = tid_, lane = tid & 63, wave = __builtin_amdgcn_readfirstlane(tid >> 6);
    const int L = seq_len(s), row0 = seq_start(s) + n * 64, tpos0 = n * 64;
    const bf16_t* qkv = (const bf16_t*)(F.ws + WS_QKV);
    const float* cw = F.in[I_CONVQKV] + (size_t)l * 3 * QKVW;
    const size_t cl = chunk_lin(s, n);
    __syncthreads();
    {
        const int t = tid >> 3, sub = tid & 7, tp = tpos0 + t;
        const float m0 = tp > 0 ? 1.f : 0.f, m2 = tp < L - 1 ? 1.f : 0.f;
#pragma unroll
        for (int part = 0; part < 3; ++part) {
            const int ch = part * 512 + h * 64 + sub * 8;
            const bf16_t* src = qkv + (size_t)(row0 + t) * QKVW + ch;
            const u32x4 r1 = *(const u32x4*)src, r0 = *(const u32x4*)(tp > 0 ? src - QKVW : src), r2 = *(const u32x4*)(tp < L - 1 ? src + QKVW : src);
            const f32x4 w0a = *(const f32x4*)(cw + ch), w0b = *(const f32x4*)(cw + ch + 4), w1a = *(const f32x4*)(cw + QKVW + ch), w1b = *(const f32x4*)(cw + QKVW + ch + 4),
                        w2a = *(const f32x4*)(cw + 2 * QKVW + ch), w2b = *(const f32x4*)(cw + 2 * QKVW + ch + 4);
            const unsigned a0[4] = {r0.x, r0.y, r0.z, r0.w}, a1[4] = {r1.x, r1.y, r1.z, r1.w}, a2[4] = {r2.x, r2.y, r2.z, r2.w};
            const float w0[8] = {w0a[0], w0a[1], w0a[2], w0a[3], w0b[0], w0b[1], w0b[2], w0b[3]}, w1[8] = {w1a[0], w1a[1], w1a[2], w1a[3], w1b[0], w1b[1], w1b[2], w1b[3]},
                        w2[8] = {w2a[0], w2a[1], w2a[2], w2a[3], w2b[0], w2b[1], w2b[2], w2b[3]};
            float v[8]; float ss = 0.f;
#pragma unroll
            for (int e = 0; e < 8; ++e) { const float x0 = (e & 1) ? bfhi(a0[e >> 1]) : bflo(a0[e >> 1]), x1 = (e & 1) ? bfhi(a1[e >> 1]) : bflo(a1[e >> 1]), x2 = (e & 1) ? bfhi(a2[e >> 1]) : bflo(a2[e >> 1]);
                float a = x1 * w1[e] + m0 * x0 * w0[e] + m2 * x2 * w2[e]; a = a / (1.f + __expf(-a)); v[e] = a; ss += a * a; }
            if (part < 2) { ss += __shfl_xor(ss, 1); ss += __shfl_xor(ss, 2); ss += __shfl_xor(ss, 4);
                const float rs = (part == 0 ? 0.125f : 1.0f) / sqrtf(ss + EPS);
#pragma unroll
                for (int e = 0; e < 8; ++e) v[e] *= rs; }
            if (part == 2) { *(LAS f32x4*)(vf + t * 64 + sub * 8) = (f32x4){v[0], v[1], v[2], v[3]}; *(LAS f32x4*)(vf + t * 64 + sub * 8 + 4) = (f32x4){v[4], v[5], v[6], v[7]}; }
            else { const u32x4 pk = (u32x4){pk2(v[0], v[1]), pk2(v[2], v[3]), pk2(v[4], v[5]), pk2(v[6], v[7])};
                *(LAS u32x4*)((part == 0 ? qb : kb) + t * 72 + sub * 8) = pk;
                if (part == 0) { bf16_t* qo = (bf16_t*)(F.ws + WS_QN) + (size_t)(row0 + t) * 512 + h * 64;
                    *(u32x2*)(qo + kpos32(sub * 8)) = (u32x2){pk.x, pk.y}; *(u32x2*)(qo + kpos32(sub * 8 + 4)) = (u32x2){pk.z, pk.w}; }
                else { *(LAS f32x4*)(kf + t * 64 + sub * 8) = (f32x4){v[0], v[1], v[2], v[3]}; *(LAS f32x4*)(kf + t * 64 + sub * 8 + 4) = (f32x4){v[4], v[5], v[6], v[7]}; } }
        }
    }
    if (wave < 2) { const int dir = wave, t = lane; const float* ba = (const float*)(F.ws + WS_BA) + (size_t)(row0 + t) * 32;
        const float braw = ba[dir * 8 + h], araw = ba[16 + dir * 8 + h];
        const float al = F.in[I_ALOG][l * 16 + dir * 8 + h], dtb = F.in[I_DTB][l * 16 + dir * 8 + h];
        const float xx = araw + dtb; const float sp = xx > 20.f ? xx : log1pf(expf(xx));
        float a = -expf(al) * sp;
#pragma unroll
        for (int o = 1; o < 64; o <<= 1) { const float y = dir == 0 ? __shfl_up(a, o) : __shfl_down(a, o); if (dir == 0 ? (lane >= o) : (lane + o < 64)) a += y; }
        (dir == 0 ? betaf : betab)[t] = 1.f / (1.f + expf(-braw)); (dir == 0 ? gcf : gcb)[t] = a;
        ((float*)(F.ws + WS_GC))[((size_t)(dir * 8 + h) * 192 + cl) * 64 + t] = a; }
    __syncthreads();
    {
        const int prod = wave >> 2, ti = (wave >> 1) & 1, tj = wave & 1, r = lane & 31, hh = lane >> 5;
        const LAS bf16_t* Am = kb + (32 * ti + r) * 72 + 8 * hh; const LAS bf16_t* Bm = (prod == 0 ? kb : qb) + (32 * tj + r) * 72 + 8 * hh;
        f32x16 acc;
#pragma unroll
        for (int e = 0; e < 16; ++e) acc[e] = 0.f;
#pragma unroll
        for (int ks = 0; ks < 4; ++ks) acc = __builtin_amdgcn_mfma_f32_32x32x16_bf16(*(const LAS bf16x8*)(Am + 16 * ks), *(const LAS bf16x8*)(Bm + 16 * ks), acc, 0, 0, 0);
        const int col = 32 * tj + r;
        const size_t offF = ((size_t)(0 * 8 + h) * 192 + cl) * 4096, offB = ((size_t)(1 * 8 + h) * 192 + cl) * 4096;
        if (prod == 0) {
            const int j = col; const float gfj = gcf[j], gbj = gcb[j];
#pragma unroll
            for (int g = 0; g < 4; ++g) { const int i4 = 32 * ti + 8 * g + 4 * hh; float ff[4], fb[4];
#pragma unroll
                for (int e = 0; e < 4; ++e) { const int i = i4 + e; const float v = acc[4 * g + e];
                    ff[e] = i > j ? betaf[i] * v * __expf(gcf[i] - gfj) : 0.f; fb[e] = i < j ? betab[i] * v * __expf(gcb[i] - gbj) : 0.f; }
                *(LAS f32x4*)(ATf + j * 64 + i4) = (f32x4){ff[0], ff[1], ff[2], ff[3]};
                *(LAS f32x4*)(ATb + (63 - j) * 64 + (60 - i4)) = (f32x4){fb[3], fb[2], fb[1], fb[0]}; }
        } else {
            const int i = col; const float gfi = gcf[i], gbi = gcb[i]; bf16_t* QKo = (bf16_t*)(F.ws + WS_QK);
#pragma unroll
            for (int g = 0; g < 4; ++g) { const int j4 = 32 * ti + 8 * g + 4 * hh; float ff[4], fb[4];
#pragma unroll
                for (int e = 0; e < 4; ++e) { const int j = j4 + e; const float v = acc[4 * g + e];
                    ff[e] = i >= j ? v * __expf(gfi - gcf[j]) : 0.f; fb[e] = i <= j ? v * __expf(gbi - gcb[j]) : 0.f; }
                const int pj = kpos32(j4);
                *(u32x2*)(QKo + offF + (size_t)i * 64 + pj) = (u32x2){pk2(ff[0], ff[1]), pk2(ff[2], ff[3])};
                *(u32x2*)(QKo + offB + (size_t)i * 64 + pj) = (u32x2){pk2(fb[0], fb[1]), pk2(fb[2], fb[3])}; }
        }
    }
    __syncthreads();
    const size_t offF = ((size_t)(0 * 8 + h) * 192 + cl) * 4096, offB = ((size_t)(1 * 8 + h) * 192 + cl) * 4096;
    if (wave >= 4) {
        const int t2 = tid - 256, d = t2 >> 2, cg = t2 & 3; bf16_t* kt = (bf16_t*)(F.ws + WS_KN) + ((size_t)h * 192 + cl) * 4096 + d * 64;
#pragma unroll
        for (int g = 0; g < 4; ++g) { const int c = 16 * cg + 4 * g;
            const unsigned w0 = (unsigned)kb[(c + 0) * 72 + d] | ((unsigned)kb[(c + 1) * 72 + d] << 16), w1 = (unsigned)kb[(c + 2) * 72 + d] | ((unsigned)kb[(c + 3) * 72 + d] << 16);
            *(u32x2*)(kt + kpos32(c)) = (u32x2){w0, w1}; }
    } else {
        const int c = lane;
        int dmask = (wave >> 1) * 63, isw = wave & 1;
        asm volatile("" : "+v"(dmask), "+v"(isw));
        const bool bdir = dmask != 0, bw = isw != 0;
        const LAS float* AT = ATf + (bdir ? 4096 : 0);
        const LAS float* bet = betaf + (bdir ? 64 : 0); const LAS float* gcc = gcf + (bdir ? 64 : 0);
        const LAS float* srcm = (bw ? kf : vf) + c;
        float x[64];
#pragma unroll
        for (int p = 0; p < 64; ++p) { const int t = p ^ dmask; const float be = bet[t]; const float eg = __expf(gcc[t]);
            x[p] = srcm[t * 64] * (bw ? be * eg : be); }
#pragma unroll
        for (int j = 0; j < 63; ++j) { const float xj = x[j];
#pragma unroll
            for (int i = j + 1; i < 64; ++i) x[i] -= AT[j * 64 + i] * xj;
            if ((j & 3) == 3) __builtin_amdgcn_sched_barrier(0); }
        __builtin_amdgcn_sched_barrier(0);
        int dmask2 = dmask; asm volatile("" : "+v"(dmask2));
        const size_t offD = bdir ? offB : offF;
        if (!bw) {
            bf16_t* dst = (bf16_t*)(F.ws + WS_U) + offD + (size_t)c * 64;
#pragma unroll
            for (int g = 0; g < 8; ++g) { unsigned w[4];
#pragma unroll
                for (int k = 0; k < 4; ++k) { const float a = x[8 * g + 2 * k], b = x[8 * g + 2 * k + 1]; w[k] = pk2(bdir ? b : a, bdir ? a : b); }
                const u32x4 o = bdir ? (u32x4){w[3], w[2], w[1], w[0]} : (u32x4){w[0], w[1], w[2], w[3]};
                *(u32x4*)(dst + (bdir ? 56 - 8 * g : 8 * g)) = o; }
        } else {
            bf16_t* dst = (bf16_t*)(F.ws + WS_WW) + offD + kpos32(c);
#pragma unroll
            for (int p = 0; p < 64; ++p) dst[(p ^ dmask2) * 64] = (bf16_t)f2bf(-x[p]);
        }
    }
}

__device__ __forceinline__ bf16x8 pack8(const f32x4 a, const f32x4 b) {
    u32x4 w; w.x = pg8::cvt_pk_bf16(a[0], a[1]); w.y = pg8::cvt_pk_bf16(a[2], a[3]); w.z = pg8::cvt_pk_bf16(b[0], b[1]); w.w = pg8::cvt_pk_bf16(b[2], b[3]);
    return __builtin_bit_cast(bf16x8, w);
}
__device__ __forceinline__ void d2_wave_task(Frame& F, int l, int s, int h, int dir, int sl) {
    int lane_ = F.lane; asm volatile("" : "+v"(lane_));
    const int lane = lane_, r16 = lane & 15, q = lane >> 4, e0 = sl * 16;
    const int nch = s < 32 ? 4 : 32;
    LAS float* lo = (LAS float*)(F.lds + F.wave * 4608);
    f32x4 S[4];
#pragma unroll
    for (int t = 0; t < 4; ++t)
#pragma unroll
        for (int rg = 0; rg < 4; ++rg) { const int d = 16 * t + 4 * q + rg;
            S[t][rg] = s >= 32 ? F.in[I_STATE][((((size_t)(s - 32) * 2 + l) * 2 + dir) * 8 + h) * 4096 + d * 64 + e0 + r16] : 0.f; }
    const bf16_t* Wg = (const bf16_t*)(F.ws + WS_WW); const bf16_t* QKg = (const bf16_t*)(F.ws + WS_QK); const bf16_t* Ug = (const bf16_t*)(F.ws + WS_U);
    const bf16_t* QNg = (const bf16_t*)(F.ws + WS_QN); const bf16_t* KTg = (const bf16_t*)(F.ws + WS_KN); const float* GCg = (const float*)(F.ws + WS_GC);
    bf16_t* Og = (bf16_t*)(F.ws + (dir == 0 ? WS_OF : WS_OB));
    const int fo = r16 * 64 + 8 * q;
#pragma unroll 1
    for (int step = 0; step < nch; ++step) {
        const int n = dir == 0 ? step : nch - 1 - step; const size_t cl = chunk_lin(s, n);
        const size_t off = ((size_t)(dir * 8 + h) * 192 + cl) * 4096; const int tok0 = seq_start(s) + n * 64;
        const bf16_t* Wp = Wg + off + fo; const bf16_t* QKp = QKg + off + fo; const bf16_t* KTp = KTg + ((size_t)h * 192 + cl) * 4096 + fo;
        const bf16_t* Qp = QNg + (size_t)(tok0 + r16) * 512 + h * 64 + 8 * q; const bf16_t* Up = Ug + off + (size_t)(e0 + r16) * 64 + 4 * q;
        const float* gcp = GCg + ((size_t)(dir * 8 + h) * 192 + cl) * 64;
        bf16x8 Wf[4][2], Qf[4][2], QKf[4][2], KTf[4][2]; u32x2 Uv[4]; f32x4 gcv[4];
#pragma unroll
        for (int t = 0; t < 4; ++t) { Uv[t] = *(const u32x2*)(Up + 16 * t); gcv[t] = *(const f32x4*)(gcp + 16 * t + 4 * q);
#pragma unroll
            for (int ks = 0; ks < 2; ++ks) { Wf[t][ks] = *(const bf16x8*)(Wp + t * 1024 + 32 * ks); Qf[t][ks] = *(const bf16x8*)(Qp + (size_t)t * 16 * 512 + 32 * ks);
                QKf[t][ks] = *(const bf16x8*)(QKp + t * 1024 + 32 * ks); KTf[t][ks] = *(const bf16x8*)(KTp + t * 1024 + 32 * ks); } }
        const float gl = gcp[dir == 0 ? 63 : 0];
        bf16x8 Sb[2] = {pack8(S[0], S[1]), pack8(S[2], S[3])};
        f32x4 VN[4], O[4];
#pragma unroll
        for (int t = 0; t < 4; ++t) { VN[t] = (f32x4){bflo(Uv[t].x), bfhi(Uv[t].x), bflo(Uv[t].y), bfhi(Uv[t].y)}; O[t] = (f32x4){0.f, 0.f, 0.f, 0.f};
#pragma unroll
            for (int ks = 0; ks < 2; ++ks) { VN[t] = __builtin_amdgcn_mfma_f32_16x16x32_bf16(Wf[t][ks], Sb[ks], VN[t], 0, 0, 0); O[t] = __builtin_amdgcn_mfma_f32_16x16x32_bf16(Qf[t][ks], Sb[ks], O[t], 0, 0, 0); } }
        f32x4 VS[4];
#pragma unroll
        for (int t = 0; t < 4; ++t)
#pragma unroll
            for (int rg = 0; rg < 4; ++rg) { O[t][rg] *= __expf(gcv[t][rg]); VS[t][rg] = VN[t][rg] * __expf(gl - gcv[t][rg]); }
        const bf16x8 VNb[2] = {pack8(VN[0], VN[1]), pack8(VN[2], VN[3])}, VSb[2] = {pack8(VS[0], VS[1]), pack8(VS[2], VS[3])};
        const float egl = __expf(gl);
#pragma unroll
        for (int t = 0; t < 4; ++t) { S[t] = S[t] * egl;
#pragma unroll
            for (int ks = 0; ks < 2; ++ks) { O[t] = __builtin_amdgcn_mfma_f32_16x16x32_bf16(QKf[t][ks], VNb[ks], O[t], 0, 0, 0); S[t] = __builtin_amdgcn_mfma_f32_16x16x32_bf16(KTf[t][ks], VSb[ks], S[t], 0, 0, 0); } }
#pragma unroll
        for (int t = 0; t < 4; ++t)
#pragma unroll
            for (int rg = 0; rg < 4; ++rg) lo[(16 * t + 4 * q + rg) * 17 + r16] = O[t][rg];
        asm volatile("s_waitcnt lgkmcnt(0)" ::: "memory");
        { float ov[16];
#pragma unroll
          for (int e = 0; e < 16; ++e) ov[e] = lo[lane * 17 + e];
          bf16_t* op = Og + (size_t)(tok0 + lane) * 512 + h * 64 + e0;
          *(u32x4*)op = (u32x4){pk2(ov[0], ov[1]), pk2(ov[2], ov[3]), pk2(ov[4], ov[5]), pk2(ov[6], ov[7])};
          *(u32x4*)(op + 8) = (u32x4){pk2(ov[8], ov[9]), pk2(ov[10], ov[11]), pk2(ov[12], ov[13]), pk2(ov[14], ov[15])}; }
        asm volatile("s_waitcnt lgkmcnt(0)" ::: "memory");
    }
    if (s < 32) { float* so = F.out + (size_t)NTOK * DM + ((((size_t)s * 2 + l) * 2 + dir) * 8 + h) * 4096;
#pragma unroll
        for (int t = 0; t < 4; ++t)
#pragma unroll
            for (int rg = 0; rg < 4; ++rg) so[(16 * t + 4 * q + rg) * 64 + e0 + r16] = S[t][rg]; }
}

__device__ __forceinline__ void phase_combine(Frame& F, int l) {
    const bf16_t* of = (const bf16_t*)(F.ws + WS_OF); const bf16_t* ob = (const bf16_t*)(F.ws + WS_OB); const bf16_t* z = (const bf16_t*)(F.ws + WS_Z);
    bf16_t* ya = (bf16_t*)(F.ws + WS_YA); const float* na = F.in[I_NORMA] + l * 64;
    for (int i = F.bid * NTHR + F.tid; i < NTOK * 64; i += F.G * NTHR) {
        const size_t off = (size_t)i * 8; const int e0 = (i & 7) * 8;
        const u32x4 a = *(const u32x4*)(of + off), b = *(const u32x4*)(ob + off), zz = *(const u32x4*)(z + off);
        float o[8]; const unsigned aw[4] = {a.x, a.y, a.z, a.w}, bw[4] = {b.x, b.y, b.z, b.w}, zw[4] = {zz.x, zz.y, zz.z, zz.w};
        float ss = 0.f;
#pragma unroll
        for (int j = 0; j < 4; ++j) { o[2 * j] = bflo(aw[j]) + bflo(bw[j]); o[2 * j + 1] = bfhi(aw[j]) + bfhi(bw[j]); ss += o[2 * j] * o[2 * j] + o[2 * j + 1] * o[2 * j + 1]; }
        ss += __shfl_xor(ss, 1); ss += __shfl_xor(ss, 2); ss += __shfl_xor(ss, 4);
        const float rs = 1.0f / sqrtf(ss * (1.f / 64.f) + EPS);
        unsigned w[4];
#pragma unroll
        for (int j = 0; j < 4; ++j) { const float z0 = bflo(zw[j]), z1 = bfhi(zw[j]);
            w[j] = pk2(o[2 * j] * rs * na[e0 + 2 * j] * siluf_(z0), o[2 * j + 1] * rs * na[e0 + 2 * j + 1] * siluf_(z1)); }
        *(u32x4*)(ya + off) = (u32x4){w[0], w[1], w[2], w[3]};
    }
}

constexpr int N_PHASES = 26;
__global__ void __launch_bounds__(NTHR, 2) mk_fwd(Args args) {
    extern __shared__ __attribute__((aligned(16))) unsigned char lds_raw[];
    Frame F;
    F.lds = (LAS unsigned char*)lds_raw; F.in = args.in; F.out = args.out; F.ws = args.ws; F.ctl = (unsigned*)(args.ws + WS_CTL);
    F.tid = threadIdx.x; F.lane = F.tid & 63; F.wave = __builtin_amdgcn_readfirstlane(F.tid >> 6); F.G = gridDim.x; F.bid = blockIdx.x;
    for (int u = F.tid; u < (LDS_BYTES - LDSCTL_OFF) / 4; u += NTHR) ((LAS unsigned*)(F.lds + LDSCTL_OFF))[u] = 0u;
    __syncthreads();
    XcdBarrier bar; bar.bar = F.ctl + CW_BAR; bar.x = 0; bar.st = nullptr;
    if (!MK_PER_PHASE) bar = xcd_barrier_post(F.ctl + CW_BAR, (volatile LAS unsigned*)(F.lds + MISC_OFF) + 8);
    const int lo = args.ph_lo, hi = args.ph_hi;
    using namespace pg8;
#define IN(k) (lo <= (k) && (k) < hi)
#define SEAM(k) do { if (IN(k) && IN((k) + 1)) { if (!MK_PER_PHASE) xcd_barrier(bar); } } while (0)
#define PHASE_FRAME() Frame P = F; P.ws = opq(P.ws); P.out = opq(P.out); P.ctl = opq(P.ctl); asm volatile("" : "+v"(P.tid)); P.lane = P.tid & 63; P.wave = __builtin_amdgcn_readfirstlane(P.tid >> 6); \
    unsigned char* ws = P.ws; LAS unsigned char* ring = P.lds; (void)ws; (void)ring

    if (IN(0)) for (int rep = 0; rep < NREP(13); ++rep) { PHASE_FRAME(); prep_x_tables(P); prep_mod(P); prep_weights(P, 0); prep_filters(P, 0); }
    SEAM(0);
#pragma unroll 1
    for (int l = 0; l < 2; ++l) {
        const int pb = 1 + 12 * l;
#define MODL ((const float*)(ws + WS_MOD) + (size_t)l * 3 * 6144)
        if (IN(pb + 0)) { PHASE_FRAME(); if (l == 1) { prep_weights(P, 1); prep_filters(P, 1); }
            for (int rep = 0; rep < NREP(0); ++rep) phase_norm(P, P.in[I_N1G] + l * DM, MODL, 0, 1024, (bf16_t*)(ws + WS_H)); }
        SEAM(pb + 0);
        if (IN(pb + 1)) for (int rep = 0; rep < NREP(1); ++rep) { PHASE_FRAME();
            { Gemm g{1024, 2048, 2048}; Sched2D S{(const char*)(ws + WS_H), (const char*)(ws + W_N), (size_t)256 * 2048, (size_t)256 * 2048, 48, 9, P.G, P.bid, 0, 0};
              EpiInN E{(bf16_t*)(ws + WS_QKV), (bf16_t*)(ws + WS_Z), (float*)(ws + WS_BA)};
              gemm_phase<EpiInN, Sched2D, true, true>(ring, g, S, E); }
            { Gemm g{1024, 2048, 2048}; Sched2D S{(const char*)(ws + W_S), (const char*)(ws + WS_H), (size_t)256 * 2048, (size_t)256 * 2048, 10, 48, P.G, P.bid, 0, 0};
              EpiInS E{(bf16_t*)(ws + WS_HYT), (bf16_t*)(ws + WS_XCSL), (bf16_t*)(ws + WS_XCSC)};
              gemm_phase<EpiInS, Sched2D, true, true>(ring, g, S, E); }
        }
        SEAM(pb + 1);
        if (IN(pb + 2)) {
            for (int rep = 0; rep < NREP(12); ++rep) { PHASE_FRAME(); Gemm g{4096, 8192, 8192}; SchedFourL S{(const char*)(ws + WS_TABL), (const char*)(ws + WS_XCSL), P.bid};
              EpiScaleBf16 E{(bf16_t*)(ws + WS_YC), 512, 1.0f / sqrtf(64.0f * 2048.0f)};
              gemm_phase<EpiScaleBf16, SchedFourL, true, true>(ring, g, S, E); }
            { PHASE_FRAME(); Gemm g{512, 1024, 1024}; SchedFourC S{(const char*)(ws + WS_TABC), (const char*)(ws + WS_XCSC), P.bid - 32};
              EpiScaleBf16 E{(bf16_t*)(ws + WS_YC), 512, 1.0f / sqrtf(64.0f * 256.0f)};
              gemm_phase<EpiScaleBf16, SchedFourC, true, true>(ring, g, S, E); }
            for (int rep = 0; rep < NREP(2); ++rep) { PHASE_FRAME(); __syncthreads();
              for (int t = q_next(P, 2 * l + 0 + 4 * rep); t < 1536; t = q_next(P, 2 * l + 0 + 4 * rep)) {
                if (t < 512) hyena_task(P, l, t, 0);
                else { const int tt = t - 512; hyena_task(P, l, tt >> 1, 1 + (tt & 1)); }
              } }
        }
        SEAM(pb + 2);
        if (IN(pb + 3)) for (int rep = 0; rep < NREP(3); ++rep) { PHASE_FRAME();
            for (int t = P.bid; t < 1536; t += P.G) {
                int s, h, n;
                if (t < 1024) { s = t >> 5; h = (t >> 2) & 7; n = t & 3; } else { const int tt = t - 1024; s = 32 + (tt >> 8); h = (tt >> 5) & 7; n = tt & 31; }
                d1_task(P, l, s, h, n);
            }
        }
        SEAM(pb + 3);
        if (IN(pb + 4)) for (int rep = 0; rep < NREP(4); ++rep) { PHASE_FRAME();
            const int gw = P.wave * P.G + P.bid, NW = NWAVES * P.G;
            if (gw < 128) { d2_wave_task(P, l, 32 + (gw >> 6), (gw >> 3) & 7, (gw >> 2) & 1, gw & 3); }
            else for (int tt = gw - 128; tt < 2048; tt += NW - 128) d2_wave_task(P, l, tt >> 6, (tt >> 3) & 7, (tt >> 2) & 1, tt & 3);
        }
        SEAM(pb + 4);
        if (IN(pb + 5)) { PHASE_FRAME(); phase_combine(P, l); phase_norm(P, P.in[I_N1G] + l * DM, MODL, 0, 1024, (bf16_t*)(ws + WS_H)); }
        SEAM(pb + 5);
        if (IN(pb + 6)) for (int rep = 0; rep < NREP(6); ++rep) { PHASE_FRAME(); Gemm g{1024, 2048, 2048}; Sched2D S{(const char*)(ws + WS_H), (const char*)(ws + W_G), (size_t)256 * 2048, (size_t)256 * 2048, 48, 12, P.G, P.bid, 0, 0};
            EpiGate E{(bf16_t*)(ws + WS_GATE)};
            gemm_phase<EpiGate, Sched2D, true, true>(ring, g, S, E); }
        SEAM(pb + 6);
        if (IN(pb + 7)) { PHASE_FRAME(); Gemm g{512, 1024, 1024};
            static_assert(WS_YB == WS_YA + 12 * MiB && WS_YC == WS_YB + 12 * MiB, "y buffers 12 MiB apart");
            SchedMerge S{(const char*)(ws + WS_YA), (const char*)(ws + W_P), P.G, P.bid};
            EpiMerge E{(bf16_t*)(ws + WS_GATE)};
            gemm_phase<EpiMerge, SchedMerge, true, true>(ring, g, S, E); }
        SEAM(pb + 7);
        if (IN(pb + 8)) { PHASE_FRAME(); Gemm g{3072, 6144, 6144}; Sched2D S{(const char*)(ws + WS_GATE), (const char*)(ws + W_O3), (size_t)256 * 6144, (size_t)256 * 6144, 48, 4, P.G, P.bid, 0, 0};
            EpiResid E{P.out, MODL + 2048};
            gemm_phase<EpiResid, Sched2D, false, true>(ring, g, S, E); }
        SEAM(pb + 8);
        if (IN(pb + 9)) { PHASE_FRAME(); phase_norm(P, P.in[I_N2G] + l * DM, MODL, 3072, 4096, (bf16_t*)(ws + WS_H)); }
        SEAM(pb + 9);
        if (IN(pb + 10)) for (int rep = 0; rep < NREP(10); ++rep) { PHASE_FRAME(); Gemm g{1024, 2048, 2048}; Sched2D S{(const char*)(ws + WS_H), (const char*)(ws + W_GU), (size_t)256 * 2048, (size_t)256 * 2048, 48, 22, P.G, P.bid, 0, 0};
            EpiGU E{(bf16_t*)(ws + WS_ACT)};
            gemm_phase<EpiGU, Sched2D, true, true>(ring, g, S, E); }
        SEAM(pb + 10);
        if (IN(pb + 11)) { PHASE_FRAME(); Gemm g{DFF, DFF * 2, DFF * 2}; Sched2D S{(const char*)(ws + WS_ACT), (const char*)(ws + W_DN), (size_t)256 * DFF * 2, (size_t)256 * DFF * 2, 48, 4, P.G, P.bid, 0, 0};
            EpiResid E{P.out, MODL + 5120};
            gemm_phase<EpiResid, Sched2D, false, true>(ring, g, S, E); }
        SEAM(pb + 11);
    }
    if (IN(25)) { PHASE_FRAME(); phase_final(P); }
#undef IN
#undef SEAM
}

extern "C" void kernel_launch(void* const* d_in, const int* in_sizes, int n_in, void* d_out, int out_size, void* d_ws, size_t ws_size, hipStream_t stream) {
    static int grid = 0;
    if (grid == 0) {
        if (n_in != N_IN || out_size != NTOK * DM + 32 * 2 * 2 * 8 * 4096 || ws_size < WS_END) { fprintf(stderr, "kernel_launch: unexpected shapes (n_in %d out %d ws %zu); nothing launched\n", n_in, out_size, ws_size); grid = -1; return; }
        int dev = 0, cus = 0, per_cu = 0;
        if (hipGetDevice(&dev) != hipSuccess || hipDeviceGetAttribute(&cus, hipDeviceAttributeMultiprocessorCount, dev) != hipSuccess) { grid = -1; return; }
        if (hipFuncSetAttribute((const void*)mk_fwd, hipFuncAttributeMaxDynamicSharedMemorySize, LDS_BYTES) != hipSuccess) { fprintf(stderr, "kernel_launch: hipFuncSetAttribute failed\n"); grid = -1; return; }
        if (hipOccupancyMaxActiveBlocksPerMultiprocessor(&per_cu, (const void*)mk_fwd, NTHR, LDS_BYTES) != hipSuccess || per_cu < 1) { fprintf(stderr, "kernel_launch: occupancy query says %d blocks per CU; nothing launched\n", per_cu); (void)hipGetLastError(); grid = -1; return; }
        grid = cus;
    }
    if (grid < 0) return;
    if (hipMemsetAsync((char*)d_ws + WS_CTL, 0, CTL_ZERO_BYTES, stream) != hipSuccess) return;
    Args a{};
    for (int i = 0; i < N_IN; ++i) a.in[i] = (const float*)d_in[i];
    a.out = (float*)d_out; a.ws = (unsigned char*)d_ws;
#if MK_PER_PHASE
    for (int p = 0; p < N_PHASES; ++p) { a.ph_lo = p; a.ph_hi = p + 1; a.li = 0; hipLaunchKernelGGL(mk_fwd, dim3(grid), dim3(NTHR), LDS_BYTES, stream, a); }
#else
    a.ph_lo = 0; a.ph_hi = N_PHASES; a.li = 0;
    hipLaunchKernelGGL(mk_fwd, dim3(grid), dim3(NTHR), LDS_BYTES, stream, a);
#endif
}
```

```cpp
#include <hip/hip_runtime.h>
#include <cstdio>
#include <cstdint>

#ifndef MK_PER_PHASE
#define MK_PER_PHASE 0
#endif

#ifndef REPMASK
#define REPMASK 0
#endif
#define NREP(k) (((REPMASK >> (k)) & 1) ? 2 : 1)
#define LAS __attribute__((address_space(3)))
#define GAS __attribute__((address_space(1)))
typedef unsigned short bf16_t;
typedef short bf16x8 __attribute__((ext_vector_type(8)));
typedef float f32x4 __attribute__((ext_vector_type(4)));
typedef float f32x2 __attribute__((ext_vector_type(2)));
typedef unsigned u32x4 __attribute__((ext_vector_type(4)));
typedef unsigned u32x2 __attribute__((ext_vector_type(2)));

constexpr int DM = 1024, NTOK = 12288, NCTX = 8192, LCTX = 256, LLAT = 2048, BCTX = 32, BLAT = 2;
constexpr int HA = 8, QKVW = 1536, DFF = 2816, DIN = 7200;
constexpr int OFF_Z = 1536, OFF_B = 2048, OFF_HY = 2080, OFF_FN = 3616, OFF_GATE = 4128;
constexpr float EPS = 1e-6f;
enum { I_XP = 0, I_XS, I_STATE, I_C, I_CCTX, I_WMOD, I_BMOD, I_N1G, I_N2G, I_WIN, I_CONVQKV, I_ALOG, I_DTB, I_NORMA, I_CONVHY,
       I_HW1, I_HB1, I_HFREQ, I_HW2, I_HB2, I_HW3, I_HBIAS, I_WPA, I_WPB, I_WPC, I_WO, I_WGU, I_WDOWN, I_NORMF, N_IN };

constexpr size_t MiB = 1u << 20;
constexpr size_t WS_CTL = 0, CTL_ZERO_BYTES = 256 * 1024;
constexpr size_t WS_MOD = 1 * MiB;
constexpr size_t WS_TABC = 2 * MiB;
constexpr size_t WS_FILC = 3 * MiB;
constexpr size_t WS_FILL = 5 * MiB;
constexpr size_t WS_TABL = 21 * MiB;
constexpr size_t WS_W = 37 * MiB;
constexpr size_t W_N = WS_W;
constexpr size_t W_S = W_N + 2304 * 1024 * 2;
constexpr size_t W_G = W_S + 2560 * 1024 * 2;
constexpr size_t W_P = W_G + 3072 * 1024 * 2;
constexpr size_t W_O3 = W_P + 3 * 1024 * 512 * 2;
constexpr size_t W_GU = W_O3 + 1024 * 3072 * 2;
constexpr size_t W_DN = W_GU + 5632 * 1024 * 2;
constexpr size_t W_END = W_DN + 1024 * 2816 * 2;
static_assert(W_END <= 78 * MiB, "weights region");
constexpr size_t WS_A0 = 78 * MiB;
constexpr size_t WS_QKV = WS_A0, WS_OF = WS_A0, WS_OB = WS_A0 + 12 * MiB, WS_MRG = WS_A0;
constexpr size_t WS_Z = 116 * MiB, WS_YA = WS_Z;
constexpr size_t WS_BA = 114 * MiB;
constexpr size_t WS_YB = 128 * MiB, WS_YC = 140 * MiB;
constexpr size_t WS_A5 = 152 * MiB;
constexpr size_t WS_H = WS_A5;
constexpr size_t WS_HYT = WS_A5 + 24 * MiB;
constexpr size_t WS_XCS = WS_A5 + 60 * MiB;
constexpr size_t WS_XCSL = WS_XCS, WS_XCSC = WS_XCS + 8 * MiB;
constexpr size_t WS_QN = WS_A5, WS_KN = WS_A5 + 12 * MiB;
constexpr size_t WS_U = WS_A5 + 24 * MiB;
constexpr size_t WS_WW = WS_A5 + 48 * MiB;
constexpr size_t WS_QK = WS_A5 + 72 * MiB;
constexpr size_t WS_GC = WS_A5 + 96 * MiB;
constexpr size_t WS_GATE = WS_A5 + 24 * MiB;
constexpr size_t WS_ACT = WS_A5 + 24 * MiB;
constexpr size_t WS_END = 256 * MiB;
static_assert(WS_GC + 2 * 8 * 192 * 64 * 4 <= WS_END && WS_GATE + (size_t)NTOK * 3072 * 2 <= WS_END, "ws map");
constexpr int CW_BAR = 4096;
constexpr int CW_Q = 16384;

constexpr int RING_BYTES = 131072, LDSCTL_OFF = RING_BYTES, MISC_OFF = LDSCTL_OFF + 320, LDS_BYTES = 147456;
constexpr int NWAVES = 8, NTHR = 512;

#define RLX_AGENT __ATOMIC_RELAXED, __HIP_MEMORY_SCOPE_AGENT
#define LDS_WAIT() asm volatile("s_waitcnt lgkmcnt(0)" ::: "memory")
__device__ __forceinline__ unsigned f2bf(float f) { unsigned u = __builtin_bit_cast(unsigned, f); return (u + 0x7fffu + ((u >> 16) & 1u)) >> 16; }
__device__ __forceinline__ unsigned pk2(float lo, float hi) { return f2bf(lo) | (f2bf(hi) << 16); }
__device__ __forceinline__ float bf2f(unsigned short b) { return __builtin_bit_cast(float, (unsigned)b << 16); }
__device__ __forceinline__ float bflo(unsigned w) { return __builtin_bit_cast(float, w << 16); }
__device__ __forceinline__ float bfhi(unsigned w) { return __builtin_bit_cast(float, w & 0xffff0000u); }
__device__ __forceinline__ float sin_rev(float r) { return __builtin_amdgcn_sinf(r - rintf(r)); }
__device__ __forceinline__ float cos_rev(float r) { return __builtin_amdgcn_cosf(r - rintf(r)); }
__device__ __forceinline__ float sin_rad(float x) { return sin_rev(x * 0.15915494309189535f); }
__device__ __forceinline__ float cos_rad(float x) { return cos_rev(x * 0.15915494309189535f); }
__device__ __forceinline__ float sigmoidf_(float x) { return 1.f / (1.f + __expf(-x)); }
__device__ __forceinline__ float siluf_(float x) { return x / (1.f + __expf(-x)); }
__device__ __forceinline__ float wave_sum(float v) {
#pragma unroll
    for (int o = 1; o < 64; o <<= 1) v += __shfl_xor(v, o);
    return v;
}
template <class T> __device__ __forceinline__ T* opq(T* p) {
    unsigned lo = (unsigned)(uintptr_t)p, hi = (unsigned)((uintptr_t)p >> 32); asm volatile("" : "+v"(lo), "+v"(hi));
    lo = __builtin_amdgcn_readfirstlane(lo); hi = __builtin_amdgcn_readfirstlane(hi); return (T*)(((uintptr_t)hi << 32) | (uintptr_t)lo);
}
__device__ __forceinline__ int seq_start(int s) { return s < 32 ? s * 256 : NCTX + (s - 32) * 2048; }
__device__ __forceinline__ int seq_len(int s) { return s < 32 ? 256 : 2048; }
__device__ __forceinline__ int mod_idx(int row) { return row < NCTX ? 0 : 1 + ((row - NCTX) >> 11); }

namespace pg8 {
constexpr int BM = 256, BK = 64, HALF = 128, HTB = HALF * BK * 2, STAGE_BYTES = 8 * HTB, NXCD = 8, WGM = 8;
__host__ __device__ __forceinline__ int lds_byte(int r, int c) { const int st = (r >> 4) * 2 + (c >> 5), rr = r & 15, cc = c & 31, ob = rr * 64 + cc * 2; return st * 1024 + (ob ^ (((ob >> 9) & 1) << 5)); }
__host__ __device__ __forceinline__ void stage_rc(int b, int& R, int& C) { const int st = b / 1024, sb = b % 1024, swz = sb ^ (((sb >> 9) & 1) << 5); R = (st >> 1) * 16 + swz / 64; C = (st & 1) * 32 + (swz % 64) / 2; }
__host__ __device__ __forceinline__ int perm32(int rho) { const int n = rho >> 4, i = rho & 15; return 8 * (i >> 2) + 4 * n + (i & 3); }

struct Unit { const char* a; const char* b; int r0, c0; };
struct Gemm { int K, lda, ldb; };

__device__ __forceinline__ bool static_order(long L, int nM, int nN, int& pm, int& pn) {
    const int nwg = nM * nN; if (L >= nwg) return false;
    int wgid = (int)L; { const int q = nwg / NXCD, r = nwg % NXCD, xcd = wgid % NXCD, off = wgid / NXCD; wgid = (xcd < r ? xcd * (q + 1) : r * (q + 1) + (xcd - r) * q) + off; }
    const int nig = WGM * nN, gid = wgid / nig, fm = gid * WGM, gsz = (nM - fm) < WGM ? (nM - fm) : WGM;
    pm = fm + ((wgid % nig) % gsz); pn = (wgid % nig) / gsz; return true;
}
__device__ __forceinline__ unsigned cvt_pk_bf16(float lo, float hi) { unsigned r; asm volatile("v_cvt_pk_bf16_f32 %0, %1, %2" : "=v"(r) : "v"(lo), "v"(hi)); return r; }

template <class Epi, class Sched, bool ALIGN_EPI, bool SP2>
__device__ __forceinline__ void gemm_phase(LAS unsigned char* lds, const Gemm g, const Sched& S, const Epi& E) {
    int tid_ = threadIdx.x; asm volatile("" : "+v"(tid_));
    const int tid = tid_, wid = __builtin_amdgcn_readfirstlane(tid >> 6), lane = tid & 63, wr = wid >> 2, wc = wid & 3, fr = lane & 15, fq = lane >> 4;
    const int K = g.K, nt = K / BK;
    unsigned voffA[2], voffB[2];
#pragma unroll
    for (int i = 0; i < 2; ++i) { int R, C; stage_rc(tid * 16 + i * 8192, R, C); const int Rb = Epi::PERM ? ((R & ~31) + perm32(R & 31)) : R;
        voffA[i] = (unsigned)(R * g.lda + C * 2); voffB[i] = (unsigned)(Rb * g.ldb + C * 2); }
    const size_t kstep = (size_t)(BK * 2);
    const size_t hstepA = (size_t)HALF * g.lda, hstepB = (size_t)HALF * g.ldb;
    const unsigned ldsw = (unsigned)wid * 1024u;
    const int aoff = lds_byte(wr * 64 + fr, fq * 8), boff = lds_byte(wc * 32 + fr, fq * 8);
#define PG8_SA(b, h) (((b) * 2 + (h)) * HTB)
#define PG8_SB(b, h) ((4 + (b) * 2 + (h)) * HTB)
#define PG8_STAGE(bufoff, gbase, voff) do { _Pragma("unroll") for (int _i = 0; _i < 2; ++_i) \
        __builtin_amdgcn_global_load_lds((const unsigned*)((const char*)(gbase) + (voff)[_i]), (LAS unsigned*)(lds + (bufoff) + ldsw + _i * 8192), 16, 0, 0); } while (0)
#define PG8_LDA(dst, b, h) do { _Pragma("unroll") for (int m = 0; m < 4; ++m) _Pragma("unroll") for (int k = 0; k < 2; ++k) dst[m][k] = *(const LAS bf16x8*)(lds + PG8_SA(b, h) + aoff + m * 2048 + k * 1024); } while (0)
#define PG8_LDB(dst, b, h) do { _Pragma("unroll") for (int n = 0; n < 2; ++n) _Pragma("unroll") for (int k = 0; k < 2; ++k) dst[n][k] = *(const LAS bf16x8*)(lds + PG8_SB(b, h) + boff + n * 2048 + k * 1024); } while (0)
#define PG8_MMA(ai, bj, At, Bt) do { __builtin_amdgcn_s_setprio(1); _Pragma("unroll") for (int m = 0; m < 4; ++m) _Pragma("unroll") for (int n = 0; n < 2; ++n) _Pragma("unroll") for (int k = 0; k < 2; ++k) \
        acc[ai][bj][m][n] = __builtin_amdgcn_mfma_f32_16x16x32_bf16(Bt[n][k], At[m][k], acc[ai][bj][m][n], 0, 0, 0); __builtin_amdgcn_s_setprio(0); } while (0)
#define PG8_WAIT_V(n) asm volatile("s_waitcnt vmcnt(" #n ")" ::: "memory")
#define PG8_WAIT_L(n) asm volatile("s_waitcnt lgkmcnt(" #n ")" ::: "memory")
#define PG8_BAR __builtin_amdgcn_s_barrier()
#define PG8_SCHED __builtin_amdgcn_sched_barrier(0)
    Unit cur, nxt; int ui = 0;
    if (!S.next(0, cur)) return;
    f32x4 acc[2][2][4][2];
#pragma unroll
    for (int a = 0; a < 2; ++a)
#pragma unroll
        for (int b = 0; b < 2; ++b)
#pragma unroll
            for (int m = 0; m < 4; ++m)
#pragma unroll
                for (int n = 0; n < 2; ++n) acc[a][b][m][n] = (f32x4){0.f, 0.f, 0.f, 0.f};
    bf16x8 At[4][2], B0[2][2], B1[2][2];
    const char* cA = cur.a; const char* cB = cur.b;
    if constexpr (SP2) {
        PG8_STAGE(PG8_SB(0, 0), cB, voffB); PG8_STAGE(PG8_SB(0, 1), cB + hstepB, voffB); PG8_STAGE(PG8_SA(0, 0), cA, voffA); PG8_STAGE(PG8_SA(0, 1), cA + hstepA, voffA);
        if (wr == 1) PG8_BAR;
        PG8_WAIT_V(2); PG8_BAR;
        PG8_STAGE(PG8_SB(1, 0), cB + kstep, voffB); PG8_STAGE(PG8_SA(1, 0), cA + kstep, voffA); PG8_STAGE(PG8_SB(1, 1), cB + hstepB + kstep, voffB);
        PG8_WAIT_V(6); PG8_BAR;
    } else {
        PG8_STAGE(PG8_SB(0, 0), cB, voffB); PG8_STAGE(PG8_SA(0, 0), cA, voffA); PG8_STAGE(PG8_SB(0, 1), cB + hstepB, voffB); PG8_STAGE(PG8_SA(0, 1), cA + hstepA, voffA);
        if (wr == 1) PG8_BAR;
        PG8_WAIT_V(4); PG8_BAR;
        PG8_STAGE(PG8_SB(1, 0), cB + kstep, voffB); PG8_STAGE(PG8_SA(1, 0), cA + kstep, voffA); PG8_STAGE(PG8_SB(1, 1), cB + hstepB + kstep, voffB);
        PG8_WAIT_V(6); PG8_BAR;
    }
    for (;;) {
        const bool has_next = S.next(ui + 1, nxt);
        const char* nA = has_next ? nxt.a : cA; const char* nB = has_next ? nxt.b : cB;
        for (int t = 0; t < nt; t += 2) {
            const bool last = (t == nt - 2);
            const char* a1 = cA + (size_t)(t + 1) * kstep;
            const char* a2 = last ? nA : cA + (size_t)(t + 2) * kstep; const char* b2 = last ? nB : cB + (size_t)(t + 2) * kstep;
            const char* a3 = a2 + kstep; const char* b3 = b2 + kstep;
            if constexpr (SP2) {
            PG8_LDB(B0, 0, 0); PG8_LDB(B1, 0, 1); PG8_SCHED; PG8_LDA(At, 0, 0); PG8_STAGE(PG8_SA(1, 1), a1 + hstepA, voffA);
            PG8_WAIT_V(8); PG8_WAIT_L(0); PG8_BAR; PG8_MMA(0, 0, At, B0); PG8_MMA(0, 1, At, B1); PG8_BAR; PG8_SCHED;
            PG8_LDA(At, 0, 1); PG8_STAGE(PG8_SB(0, 0), b2, voffB); PG8_STAGE(PG8_SB(0, 1), b2 + hstepB, voffB); PG8_STAGE(PG8_SA(0, 0), a2, voffA);
            PG8_WAIT_V(8); PG8_WAIT_L(0); PG8_BAR; PG8_MMA(1, 0, At, B0); PG8_MMA(1, 1, At, B1); PG8_BAR; PG8_SCHED;
            PG8_LDB(B0, 1, 0); PG8_LDB(B1, 1, 1); PG8_SCHED; PG8_LDA(At, 1, 0); PG8_STAGE(PG8_SA(0, 1), a2 + hstepA, voffA);
            PG8_WAIT_V(8); PG8_WAIT_L(0); PG8_BAR; PG8_MMA(0, 0, At, B0); PG8_MMA(0, 1, At, B1); PG8_BAR; PG8_SCHED;
            PG8_LDA(At, 1, 1); PG8_STAGE(PG8_SB(1, 0), b3, voffB); PG8_STAGE(PG8_SB(1, 1), b3 + hstepB, voffB); PG8_STAGE(PG8_SA(1, 0), a3, voffA);
            PG8_WAIT_V(8); PG8_WAIT_L(0); PG8_BAR; PG8_MMA(1, 0, At, B0); PG8_MMA(1, 1, At, B1); PG8_BAR; PG8_SCHED;
            } else {
            PG8_LDB(B0, 0, 0); PG8_SCHED; PG8_LDA(At, 0, 0); PG8_STAGE(PG8_SA(1, 1), a1 + hstepA, voffA);
            PG8_WAIT_L(8); PG8_BAR; PG8_WAIT_L(0); PG8_MMA(0, 0, At, B0); PG8_BAR; PG8_SCHED;
            PG8_LDB(B1, 0, 1); PG8_STAGE(PG8_SB(0, 0), b2, voffB);
            PG8_BAR; PG8_WAIT_L(0); PG8_MMA(0, 1, At, B1); PG8_BAR;
            PG8_LDA(At, 0, 1); PG8_STAGE(PG8_SA(0, 0), a2, voffA);
            PG8_BAR; PG8_WAIT_L(0); PG8_MMA(1, 0, At, B0); PG8_BAR; PG8_SCHED;
            PG8_STAGE(PG8_SB(0, 1), b2 + hstepB, voffB);
            PG8_WAIT_V(6); PG8_BAR; PG8_MMA(1, 1, At, B1); PG8_BAR;
            PG8_LDB(B0, 1, 0); PG8_SCHED; PG8_LDA(At, 1, 0); PG8_STAGE(PG8_SA(0, 1), a2 + hstepA, voffA);
            PG8_WAIT_L(8); PG8_BAR; PG8_WAIT_L(0); PG8_MMA(0, 0, At, B0); PG8_BAR; PG8_SCHED;
            PG8_LDB(B1, 1, 1); PG8_STAGE(PG8_SB(1, 0), b3, voffB);
            PG8_BAR; PG8_WAIT_L(0); PG8_MMA(0, 1, At, B1); PG8_BAR;
            PG8_LDA(At, 1, 1); PG8_STAGE(PG8_SA(1, 0), a3, voffA);
            PG8_BAR; PG8_WAIT_L(0); PG8_MMA(1, 0, At, B0); PG8_BAR; PG8_SCHED;
            PG8_STAGE(PG8_SB(1, 1), b3 + hstepB, voffB);
            PG8_WAIT_V(6); PG8_BAR; PG8_MMA(1, 1, At, B1); PG8_BAR;
            }
        }
        if constexpr (ALIGN_EPI) { if (wr == 0) PG8_BAR; }
        E(acc, cur, wr, wc, fr, fq);
        if (!has_next) break;
#pragma unroll
        for (int a = 0; a < 2; ++a)
#pragma unroll
            for (int b = 0; b < 2; ++b)
#pragma unroll
                for (int m = 0; m < 4; ++m)
#pragma unroll
                    for (int n = 0; n < 2; ++n) acc[a][b][m][n] = (f32x4){0.f, 0.f, 0.f, 0.f};
        cur = nxt; cA = nA; cB = nB; ++ui;
        if constexpr (ALIGN_EPI) { if (wr == 1) PG8_BAR; }
    }
    PG8_WAIT_V(0);
    if constexpr (!ALIGN_EPI) { if (wr == 0) PG8_BAR; }
    PG8_BAR;
#undef PG8_SA
#undef PG8_SB
#undef PG8_STAGE
#undef PG8_LDA
#undef PG8_LDB
#undef PG8_MMA
#undef PG8_WAIT_V
#undef PG8_WAIT_L
#undef PG8_BAR
#undef PG8_SCHED
}

struct Sched2D {
    const char* A; const char* B; size_t atile, btile; int nM, nN, G, c, r_base, c_base;
    __device__ __forceinline__ bool next(int i, Unit& u) const {
        if (c < 0) return false;
        int pm, pn; if (!static_order((long)i * G + c, nM, nN, pm, pn)) return false;
        u.a = A + (size_t)pm * atile; u.b = B + (size_t)pn * btile; u.r0 = r_base + pm * 256; u.c0 = c_base + pn * 256; return true;
    }
};
struct SchedMerge {
    const char *y0, *w0; int G, c;
    __device__ __forceinline__ bool next(int i, Unit& u) const {
        int pm, pn; if (!static_order((long)i * G + c, 48, 12, pm, pn)) return false;
        const int br = pn >> 2; const char* y = y0 + (size_t)br * (12u << 20); const char* w = w0 + (size_t)br * (1u << 20);
        u.a = y + (size_t)pm * 256 * 512 * 2; u.b = w + (size_t)(pn & 3) * 256 * 512 * 2; u.r0 = pm * 256; u.c0 = pn * 256; return true;
    }
};
struct SchedFourL {
    const char* tab; const char* xcs; int c;
    __device__ __forceinline__ bool next(int i, Unit& u) const {
        if (i > 0 || c < 0 || c >= 32) return false;
        const int b = c >> 4, pm = (c & 15) >> 1, pn = c & 1;
        u.a = tab + (size_t)pm * 256 * 4096 * 2; u.b = xcs + ((size_t)b * 512 + pn * 256) * 4096 * 2; u.r0 = NCTX + b * 2048 + pm * 256; u.c0 = pn * 256; return true;
    }
};
struct SchedFourC {
    const char* tab; const char* xcs; int c;
    __device__ __forceinline__ bool next(int i, Unit& u) const {
        if (i > 0 || c < 0 || c >= 64) return false;
        const int b = c >> 1, pn = c & 1;
        u.a = tab; u.b = xcs + ((size_t)b * 512 + pn * 256) * 512 * 2; u.r0 = b * 256; u.c0 = pn * 256; return true;
    }
};

typedef f32x4 Acc[2][2][4][2];
struct EpiInN {
    static constexpr bool PERM = true;
    bf16_t* qkv; bf16_t* z; float* ba;
    __device__ __forceinline__ void operator()(const Acc& acc, const Unit& u, int wr, int wc, int fr, int fq) const {
        const int colt = u.c0;
#pragma unroll
        for (int ai = 0; ai < 2; ++ai)
#pragma unroll
            for (int m = 0; m < 4; ++m) { const int row = u.r0 + ai * HALF + wr * 64 + m * 16 + fr;
#pragma unroll
                for (int bj = 0; bj < 2; ++bj) { const int col = colt + bj * HALF + wc * 32 + 8 * fq; const f32x4 v0 = acc[ai][bj][m][0], v1 = acc[ai][bj][m][1];
                    if (colt < 2048) { u32x4 w; w.x = cvt_pk_bf16(v0[0], v0[1]); w.y = cvt_pk_bf16(v0[2], v0[3]); w.z = cvt_pk_bf16(v1[0], v1[1]); w.w = cvt_pk_bf16(v1[2], v1[3]);
                        bf16_t* p = colt < 1536 ? qkv + (size_t)row * 1536 + col : z + (size_t)row * 512 + (col - 1536);
                        *(u32x4*)p = w; }
                    else if (col - 2048 < 32) { float* p = ba + (size_t)row * 32 + (col - 2048); *(f32x4*)p = v0; *(f32x4*)(p + 4) = v1; } } }
    }
};
struct EpiInS {
    static constexpr bool PERM = true;
    bf16_t* hyt; bf16_t* xcsl; bf16_t* xcsc;
    __device__ __forceinline__ void operator()(const Acc& acc, const Unit& u, int wr, int wc, int fr, int fq) const {
#pragma unroll
        for (int ai = 0; ai < 2; ++ai)
#pragma unroll
            for (int m = 0; m < 4; ++m) { const int ch = u.r0 + ai * HALF + wr * 64 + m * 16 + fr;
#pragma unroll
                for (int bj = 0; bj < 2; ++bj) { const int tok = u.c0 + bj * HALF + wc * 32 + 8 * fq; const f32x4 v0 = acc[ai][bj][m][0], v1 = acc[ai][bj][m][1];
                    u32x4 w; w.x = cvt_pk_bf16(v0[0], v0[1]); w.y = cvt_pk_bf16(v0[2], v0[3]); w.z = cvt_pk_bf16(v1[0], v1[1]); w.w = cvt_pk_bf16(v1[2], v1[3]);
                    bf16_t* p;
                    if (ch < 1536) p = hyt + (size_t)ch * NTOK + tok;
                    else { const int cc = ch - 1536, which = cc >> 9, n = cc & 511;
                        if (tok < NCTX) { const int b = tok >> 8, t = tok & 255; p = xcsc + ((size_t)(b * 512 + n) * 512 + which * 256 + t); }
                        else { const int tt = tok - NCTX, b = tt >> 11, t = tt & 2047; p = xcsl + ((size_t)(b * 512 + n) * 4096 + which * 2048 + t); } }
                    *(u32x4*)p = w; } }
    }
};
struct EpiScaleBf16 {
    static constexpr bool PERM = true;
    bf16_t* O; int ldc; float scale;
    __device__ __forceinline__ void operator()(const Acc& acc, const Unit& u, int wr, int wc, int fr, int fq) const {
#pragma unroll
        for (int ai = 0; ai < 2; ++ai)
#pragma unroll
            for (int m = 0; m < 4; ++m) { const int row = u.r0 + ai * HALF + wr * 64 + m * 16 + fr;
#pragma unroll
                for (int bj = 0; bj < 2; ++bj) { const int col = u.c0 + bj * HALF + wc * 32 + 8 * fq; const f32x4 v0 = acc[ai][bj][m][0] * scale, v1 = acc[ai][bj][m][1] * scale;
                    u32x4 w; w.x = cvt_pk_bf16(v0[0], v0[1]); w.y = cvt_pk_bf16(v0[2], v0[3]); w.z = cvt_pk_bf16(v1[0], v1[1]); w.w = cvt_pk_bf16(v1[2], v1[3]);
                    *(u32x4*)(O + (size_t)row * ldc + col) = w; } }
    }
};
struct EpiGate {
    static constexpr bool PERM = true;
    bf16_t* O;
    __device__ __forceinline__ void operator()(const Acc& acc, const Unit& u, int wr, int wc, int fr, int fq) const {
#pragma unroll
        for (int ai = 0; ai < 2; ++ai)
#pragma unroll
            for (int m = 0; m < 4; ++m) { const int row = u.r0 + ai * HALF + wr * 64 + m * 16 + fr;
#pragma unroll
                for (int bj = 0; bj < 2; ++bj) { const int col = u.c0 + bj * HALF + wc * 32 + 8 * fq; const f32x4 v0 = acc[ai][bj][m][0], v1 = acc[ai][bj][m][1];
                    u32x4 w; w.x = cvt_pk_bf16(sigmoidf_(v0[0]), sigmoidf_(v0[1])); w.y = cvt_pk_bf16(sigmoidf_(v0[2]), sigmoidf_(v0[3]));
                    w.z = cvt_pk_bf16(sigmoidf_(v1[0]), sigmoidf_(v1[1])); w.w = cvt_pk_bf16(sigmoidf_(v1[2]), sigmoidf_(v1[3]));
                    *(u32x4*)(O + (size_t)row * 3072 + col) = w; } }
    }
};
struct EpiMerge {
    static constexpr bool PERM = true;
    bf16_t* O;
    __device__ __forceinline__ void operator()(const Acc& acc, const Unit& u, int wr, int wc, int fr, int fq) const {
#pragma unroll
        for (int ai = 0; ai < 2; ++ai)
#pragma unroll
            for (int m = 0; m < 4; ++m) { const int row = u.r0 + ai * HALF + wr * 64 + m * 16 + fr;
#pragma unroll
                for (int bj = 0; bj < 2; ++bj) { const int col = u.c0 + bj * HALF + wc * 32 + 8 * fq; const f32x4 v0 = acc[ai][bj][m][0], v1 = acc[ai][bj][m][1];
                    bf16_t* p = O + (size_t)row * 3072 + col; const u32x4 gg = *(const u32x4*)p;
                    u32x4 w; w.x = cvt_pk_bf16(v0[0] * bflo(gg.x), v0[1] * bfhi(gg.x)); w.y = cvt_pk_bf16(v0[2] * bflo(gg.y), v0[3] * bfhi(gg.y));
                    w.z = cvt_pk_bf16(v1[0] * bflo(gg.z), v1[1] * bfhi(gg.z)); w.w = cvt_pk_bf16(v1[2] * bflo(gg.w), v1[3] * bfhi(gg.w));
                    *(u32x4*)p = w; } }
    }
};
struct EpiMergeAcc {
    static constexpr bool PERM = true;
    bf16_t* M; const bf16_t* G; int gcol0; int first;
    __device__ __forceinline__ void operator()(const Acc& acc, const Unit& u, int wr, int wc, int fr, int fq) const {
#pragma unroll
        for (int ai = 0; ai < 2; ++ai)
#pragma unroll
            for (int m = 0; m < 4; ++m) { const int row = u.r0 + ai * HALF + wr * 64 + m * 16 + fr;
#pragma unroll
                for (int bj = 0; bj < 2; ++bj) { const int col = u.c0 + bj * HALF + wc * 32 + 8 * fq; const f32x4 v0 = acc[ai][bj][m][0], v1 = acc[ai][bj][m][1];
                    const u32x4 gg = *(const u32x4*)(G + (size_t)row * 3072 + gcol0 + col); bf16_t* p = M + (size_t)row * 1024 + col;
                    float o[8] = {v0[0] * bflo(gg.x), v0[1] * bfhi(gg.x), v0[2] * bflo(gg.y), v0[3] * bfhi(gg.y), v1[0] * bflo(gg.z), v1[1] * bfhi(gg.z), v1[2] * bflo(gg.w), v1[3] * bfhi(gg.w)};
                    if (!first) { const u32x4 mm = *(const u32x4*)p; o[0] += bflo(mm.x); o[1] += bfhi(mm.x); o[2] += bflo(mm.y); o[3] += bfhi(mm.y); o[4] += bflo(mm.z); o[5] += bfhi(mm.z); o[6] += bflo(mm.w); o[7] += bfhi(mm.w); }
                    u32x4 w; w.x = cvt_pk_bf16(o[0], o[1]); w.y = cvt_pk_bf16(o[2], o[3]); w.z = cvt_pk_bf16(o[4], o[5]); w.w = cvt_pk_bf16(o[6], o[7]);
                    *(u32x4*)p = w; } }
    }
};
struct EpiResid {
    static constexpr bool PERM = false;
    float* X; const float* gate;
    __device__ __forceinline__ void operator()(const Acc& acc, const Unit& u, int wr, int wc, int fr, int fq) const {
        const float* gp = gate + (size_t)mod_idx(u.r0) * 6144;
#pragma unroll
        for (int bj = 0; bj < 2; ++bj)
#pragma unroll
            for (int n = 0; n < 2; ++n) { const int col = u.c0 + bj * HALF + wc * 32 + 16 * n + 4 * fq; const f32x4 gv = *(const f32x4*)(gp + col);
#pragma unroll
                for (int ai = 0; ai < 2; ++ai)
#pragma unroll
                    for (int m = 0; m < 4; ++m) { const int row = u.r0 + ai * HALF + wr * 64 + m * 16 + fr; float* p = X + (size_t)row * DM + col;
                        const f32x4 x = *(const f32x4*)p; *(f32x4*)p = x + gv * acc[ai][bj][m][n]; } }
    }
};
struct EpiGU {
    static constexpr bool PERM = true;
    bf16_t* O;
    __device__ __forceinline__ void operator()(const Acc& acc, const Unit& u, int wr, int wc, int fr, int fq) const {
        const int col = (u.c0 >> 1) + wc * 32 + 8 * fq;
#pragma unroll
        for (int ai = 0; ai < 2; ++ai)
#pragma unroll
            for (int m = 0; m < 4; ++m) { const int row = u.r0 + ai * HALF + wr * 64 + m * 16 + fr;
                const f32x4 g0 = acc[ai][0][m][0], g1 = acc[ai][0][m][1], u0 = acc[ai][1][m][0], u1 = acc[ai][1][m][1];
                u32x4 w; w.x = cvt_pk_bf16(siluf_(g0[0]) * u0[0], siluf_(g0[1]) * u0[1]); w.y = cvt_pk_bf16(siluf_(g0[2]) * u0[2], siluf_(g0[3]) * u0[3]);
                w.z = cvt_pk_bf16(siluf_(g1[0]) * u1[0], siluf_(g1[1]) * u1[1]); w.w = cvt_pk_bf16(siluf_(g1[2]) * u1[2], siluf_(g1[3]) * u1[3]);
                *(u32x4*)(O + (size_t)row * DFF + col) = w; }
    }
};
}

#define XB_TMO      128
#define XB_XCNT(j)  (256  + 64 * (j))
#define XB_XSUB(j)  (1280 + 64 * (j))
#define XB_XGEN(j)  (2304 + 64 * (j))
#define XB_TOP      3328
#define XB_TOPGEN   3392
#define XCD_BAR_WORDS 3456
#define XB_SPIN_CAP (1u << 18)
__device__ __forceinline__ unsigned xb_ld(unsigned* p)              { return __hip_atomic_load(p, __ATOMIC_RELAXED, __HIP_MEMORY_SCOPE_AGENT); }
__device__ __forceinline__ unsigned xb_add(unsigned* p, unsigned v) { return __hip_atomic_fetch_add(p, v, __ATOMIC_RELAXED, __HIP_MEMORY_SCOPE_AGENT); }
__device__ __forceinline__ unsigned xb_xcc_id() { return (unsigned)__builtin_amdgcn_s_getreg((3 << 11) | 20) & 0xFu; }
#define XB_SPIN(cond, bar) do { unsigned _sp = 0; while (cond) { __builtin_amdgcn_s_sleep(1); \
    if ((++_sp & 255u) == 0u) { if (xb_ld(&(bar)[XB_TMO])) break; if (_sp > XB_SPIN_CAP) { atomicAdd(&(bar)[XB_TMO], 1u); break; } } } } while (0)
struct XcdBarrier { unsigned* bar; unsigned x; volatile LAS unsigned* st; };
__device__ __forceinline__ XcdBarrier xcd_barrier_post(unsigned* bar, volatile LAS unsigned* st) {
    XcdBarrier b; b.bar = bar; b.x = xb_xcc_id(); b.st = st;
    if (threadIdx.x == 0) (void)xb_add(&bar[XB_XCNT(b.x)], 1u);
    return b;
}
__device__ __forceinline__ void xcd_barrier_complete(unsigned* bar, unsigned x, unsigned& nloc, unsigned& nx) {
    const unsigned G = gridDim.x * gridDim.y * gridDim.z;
    unsigned sum, cnt, mine, sp = 0u;
    for (;;) {
        sum = 0u; cnt = 0u; mine = 0u;
#pragma unroll 1
        for (unsigned j = 0; j < 16; ++j) { const unsigned c = xb_ld(&bar[XB_XCNT(j)]); sum += c; cnt += (c > 0u) ? 1u : 0u; mine = (j == x) ? c : mine; }
        if (sum == G) break;
        __builtin_amdgcn_s_sleep(1);
        if ((++sp & 255u) == 0u) { if (xb_ld(&bar[XB_TMO])) break; if (sp > XB_SPIN_CAP) { atomicAdd(&bar[XB_TMO], 1u); break; } }
    }
    nloc = mine > 0u ? mine : 1u; nx = cnt > 0u ? cnt : 1u;
}
__device__ __forceinline__ void xcd_barrier(const XcdBarrier& b) {
    asm volatile("s_waitcnt vmcnt(0)" ::: "memory");
    __syncthreads();
    if (threadIdx.x == 0) {
        unsigned* bar = opq(b.bar);
        __builtin_amdgcn_s_waitcnt(0);
        unsigned nloc = b.st[0], nx = b.st[1];
        if (nloc == 0u) { xcd_barrier_complete(bar, b.x, nloc, nx); b.st[0] = nloc; b.st[1] = nx; }
        const unsigned old = xb_add(&bar[XB_XSUB(b.x)], 1u);
        const unsigned gen = old / nloc;
        if (old + 1u == (gen + 1u) * nloc) {
            __builtin_amdgcn_fence(__ATOMIC_RELEASE, "agent");
            asm volatile("s_waitcnt vmcnt(0)" ::: "memory");
            const unsigned og = xb_add(&bar[XB_TOP], 1u);
            const unsigned tg = og / nx;
            if (og + 1u == (tg + 1u) * nx) xb_add(&bar[XB_TOPGEN], 1u);
            else XB_SPIN(xb_ld(&bar[XB_TOPGEN]) == tg, bar);
            __builtin_amdgcn_fence(__ATOMIC_ACQUIRE, "agent");
            xb_add(&bar[XB_XGEN(b.x)], 1u);
            asm volatile("s_waitcnt vmcnt(0)" ::: "memory");
        } else {
            XB_SPIN(xb_ld(&bar[XB_XGEN(b.x)]) == gen, bar);
            __builtin_amdgcn_fence(__ATOMIC_ACQUIRE, "agent");
            asm volatile("s_waitcnt vmcnt(0)" ::: "memory");
        }
    }
    __syncthreads();
}

struct Args { const float* in[N_IN]; float* out; unsigned char* ws; int ph_lo, ph_hi, li, pad; };
struct Frame {
    LAS unsigned char* lds; const float* const* in; float* out; unsigned char* ws; unsigned* ctl;
    int tid, lane, wave, G, bid;
};
__device__ __forceinline__ int q_next(Frame& F, int qid) {
    volatile LAS int* slot = (volatile LAS int*)(F.lds + MISC_OFF + 64);
    __syncthreads();
    if (F.tid == 0) *slot = (int)__hip_atomic_fetch_add(F.ctl + CW_Q + 64 * qid, 1u, RLX_AGENT);
    __syncthreads();
    return *slot;
}

__device__ __forceinline__ void transpose_item(const float* W, int ld_src, int col0, bf16_t* WT, int ld_dst, int dst_k0, int row0, int k0, LAS float* scr, int lane) {
    float tv[32];
#pragma unroll
    for (int i = 0; i < 32; ++i) tv[i] = W[(size_t)(k0 + 2 * i + (lane >> 5)) * ld_src + col0 + (lane & 31)];
#pragma unroll
    for (int i = 0; i < 32; ++i) scr[(2 * i + (lane >> 5)) * 33 + (lane & 31)] = tv[i];
    LDS_WAIT(); asm volatile("" ::: "memory");
    const int c = lane & 7;
#pragma unroll
    for (int j = 0; j < 4; ++j) { const int n = (lane >> 3) + 8 * j; const LAS float* s = scr + (8 * c) * 33 + n;
        u32x4 o; o.x = pk2(s[0 * 33], s[1 * 33]); o.y = pk2(s[2 * 33], s[3 * 33]); o.z = pk2(s[4 * 33], s[5 * 33]); o.w = pk2(s[6 * 33], s[7 * 33]);
        *(u32x4*)(WT + (size_t)(row0 + n) * ld_dst + dst_k0 + k0 + 8 * c) = o; }
    LDS_WAIT(); asm volatile("" ::: "memory");
}
__device__ __forceinline__ void prep_weights(Frame& F, int l) {
    LAS float* scr = (LAS float*)(F.lds + F.wave * 16384);
    const int gw = F.bid * NWAVES + F.wave, NGW = F.G * NWAVES;
    const float* w_in = F.in[I_WIN] + (size_t)l * DM * DIN;
    unsigned char* ws = F.ws;
    constexpr int NI_QKVZBA = 16 * (2080 / 32), NI_HY = 16 * 48, NI_G = 16 * 96, NI_P = 8 * 32, NI_O = 16 * 32, NI_GU = 16 * 176, NI_DN = 44 * 32;
    constexpr int NITEMS = NI_QKVZBA + NI_HY + NI_G + 3 * NI_P + 3 * NI_O + NI_GU + NI_DN;
#pragma unroll 1
    for (int it = gw; it < NITEMS; it += NGW) {
        int r = it;
        const float* src; int ld_src, col0, ld_dst, dst_k0, row0, k0; bf16_t* dst;
        if (r < NI_QKVZBA) { const int nb = r % 65, kb = r / 65; src = w_in; ld_src = DIN; col0 = nb * 32; dst = (bf16_t*)(ws + W_N); ld_dst = 1024; dst_k0 = 0; row0 = nb * 32; k0 = kb * 64; }
        else if ((r -= NI_QKVZBA) < NI_HY) { const int nb = r % 48, kb = r / 48; src = w_in; ld_src = DIN; col0 = OFF_HY + nb * 32; dst = (bf16_t*)(ws + W_S); ld_dst = 1024; dst_k0 = 0; row0 = nb * 32; k0 = kb * 64; }
        else if ((r -= NI_HY) < NI_G) { const int nb = r % 96, kb = r / 96; src = w_in; ld_src = DIN; col0 = OFF_GATE + nb * 32; dst = (bf16_t*)(ws + W_G); ld_dst = 1024; dst_k0 = 0; row0 = nb * 32; k0 = kb * 64; }
        else if ((r -= NI_G) < 3 * NI_P) { const int j = r / NI_P, q = r % NI_P, nb = q % 32, kb = q / 32; src = (j == 0 ? F.in[I_WPA] : (j == 1 ? F.in[I_WPB] : F.in[I_WPC])) + (size_t)l * 512 * 1024;
            ld_src = 1024; col0 = nb * 32; dst = (bf16_t*)(ws + W_P) + (size_t)j * 1024 * 512; ld_dst = 512; dst_k0 = 0; row0 = nb * 32; k0 = kb * 64; }
        else if ((r -= 3 * NI_P) < 3 * NI_O) { const int j = r / NI_O, q = r % NI_O, nb = q % 32, kb = q / 32; src = F.in[I_WO] + (size_t)l * 1024 * 1024;
            ld_src = 1024; col0 = nb * 32; dst = (bf16_t*)(ws + W_O3); ld_dst = 3072; dst_k0 = j * 1024; row0 = nb * 32; k0 = kb * 64; }
        else if ((r -= 3 * NI_O) < NI_GU) { const int nb = r % 176, kb = r / 176; const int n0 = nb * 32, up = n0 >= DFF ? 1 : 0, nn = n0 - up * DFF;
            src = F.in[I_WGU] + (size_t)l * 1024 * 5632; ld_src = 5632; col0 = n0; dst = (bf16_t*)(ws + W_GU); ld_dst = 1024; dst_k0 = 0; row0 = 256 * (nn / 128) + 128 * up + (nn % 128); k0 = kb * 64; }
        else { r -= NI_GU; const int nb = r % 32, kb = r / 32; src = F.in[I_WDOWN] + (size_t)l * DFF * 1024; ld_src = 1024; col0 = nb * 32; dst = (bf16_t*)(ws + W_DN); ld_dst = DFF; dst_k0 = 0; row0 = nb * 32; k0 = kb * 64; }
        transpose_item(src, ld_src, col0, dst, ld_dst, dst_k0, row0, k0, scr, F.lane);
    }
    { u32x4* z = (u32x4*)(ws + W_N + (size_t)2080 * 1024 * 2); const int n16 = 224 * 1024 * 2 / 16;
      for (int i = F.bid * NTHR + F.tid; i < n16; i += F.G * NTHR) z[i] = (u32x4){0u, 0u, 0u, 0u}; }
    __syncthreads();
    {
        LAS float* tile = (LAS float*)F.lds;
        LAS float* ctab = tile + 64 * 65;
        if (F.tid < 64) { ctab[F.tid] = cos_rev((float)F.tid / 64.0f); ctab[64 + F.tid] = sin_rev((float)F.tid / 64.0f); }
        for (int task = F.bid; task < 128; task += F.G) {
            const int kb = task >> 3, g = task & 7;
            __syncthreads();
            for (int i = F.tid; i < 4096; i += NTHR) { const int kk = i >> 6, cc = i & 63; tile[kk * 65 + cc] = w_in[(size_t)(kb * 64 + kk) * DIN + OFF_FN + g * 64 + cc]; }
            __syncthreads();
            const int kk = F.tid & 63, cq = F.tid >> 6;
#pragma unroll 1
            for (int j = 0; j < 8; ++j) { const int c = cq * 8 + j; float ac = 0.f, as = 0.f;
#pragma unroll 4
                for (int cp = 0; cp < 64; ++cp) { const float w = tile[kk * 65 + cp]; const int idx = (c * cp) & 63; ac += w * ctab[idx]; as += w * ctab[64 + idx]; }
                bf16_t* d = (bf16_t*)(ws + W_S);
                d[(size_t)(1536 + g * 64 + c) * 1024 + kb * 64 + kk] = (bf16_t)f2bf(ac);
                d[(size_t)(2048 + g * 64 + c) * 1024 + kb * 64 + kk] = (bf16_t)f2bf(as); }
        }
        __syncthreads();
    }
}
__device__ __forceinline__ void prep_filters(Frame& F, int l) {
    LAS float* zp = (LAS float*)F.lds;
    LAS float* h1 = zp + 64 * 33;
    LAS float* h2 = h1 + 64 * 64;
    const float* w1 = F.in[I_HW1] + l * 33 * 64; const float* b1 = F.in[I_HB1] + l * 64; const float* fq = F.in[I_HFREQ] + l * 64;
    const float* w2 = F.in[I_HW2] + l * 64 * 64; const float* b2 = F.in[I_HB2] + l * 64; const float* w3 = F.in[I_HW3] + (size_t)l * 64 * 2048;
    for (int task4 = F.G - 1 - F.bid; task4 < 144; task4 += F.G) {
        const int task = task4 >> 2, qsel = task4 & 3;
        const int L = task < 32 ? LLAT : LCTX, t0 = (task < 32 ? task : task - 32) * 64;
        float* fil = (float*)(F.ws + (task < 32 ? WS_FILL : WS_FILC));
        __syncthreads();
        for (int i = F.tid; i < 64 * 33; i += NTHR) { const int tt = i / 33, e = i % 33; const int ti = t0 + tt;
            float v;
            if (e == 0) v = (float)ti / (float)(L - 1);
            else { const int b = (e - 1) & 15; const float fr = 1e-4f + (15.0f - 1e-4f) * (float)b / 15.0f; const float rv = fr * ((float)ti / (float)L);
                   v = e <= 16 ? cos_rev(rv) : -sin_rev(rv); }
            zp[i] = v; }
        __syncthreads();
        for (int i = F.tid; i < 4096; i += NTHR) { const int tt = i >> 6, j = i & 63; float a = b1[j];
            for (int e = 0; e < 33; ++e) a += zp[tt * 33 + e] * w1[e * 64 + j];
            h1[i] = sin_rad(fq[j] * a); }
        __syncthreads();
        for (int i = F.tid; i < 4096; i += NTHR) { const int tt = i >> 6, j = i & 63; float a = b2[j];
            for (int k = 0; k < 64; ++k) a += h1[tt * 64 + k] * w2[k * 64 + j];
            h2[i] = sin_rad(fq[j] * a); }
        __syncthreads();
        { const int n = F.tid + 512 * qsel, c = n & 511;
            float wc[64];
#pragma unroll
            for (int k = 0; k < 64; ++k) wc[k] = w3[(size_t)k * 2048 + n];
            const float dmin = 4.605170185988091f / 1.5f, dmax = 4.605170185988091f / 0.3f;
            const float delta = dmin + (dmax - dmin) * (float)c / 511.0f;
            float* dst = fil + (size_t)n * L + t0;
#pragma unroll 1
            for (int tt = 0; tt < 64; ++tt) { float a = 0.f;
#pragma unroll
                for (int k = 0; k < 64; ++k) a += h2[tt * 64 + k] * wc[k];
                const float tl = (float)(t0 + tt) / (float)(L - 1); dst[tt] = a * expf(-tl * delta); } }
    }
    __syncthreads();
}
__device__ __forceinline__ void prep_mod(Frame& F) {
    LAS float* sc = (LAS float*)F.lds;
    LAS float* red = sc + 3 * 1024;
    __syncthreads();
    for (int i = F.tid; i < 3 * 1024; i += NTHR) { const int mi = i >> 10, k = i & 1023; const float v = mi == 0 ? F.in[I_CCTX][k] : F.in[I_C][(mi - 1) * 1024 + k]; sc[i] = v / (1.f + expf(-v)); }
    __syncthreads();
    float* mod = (float*)(F.ws + WS_MOD);
    for (int task = F.bid; task < 192; task += F.G) {
        const int l = task / 96, j = task % 96, n = j * 64 + F.lane;
        const float* w = F.in[I_WMOD] + (size_t)l * 1024 * 6144 + n;
        float a0 = 0.f, a1 = 0.f, a2 = 0.f;
        const int kb = F.wave * 128;
#pragma unroll 32
        for (int k = 0; k < 128; ++k) { const float wv = w[(size_t)(kb + k) * 6144]; a0 += sc[kb + k] * wv; a1 += sc[1024 + kb + k] * wv; a2 += sc[2048 + kb + k] * wv; }
        red[(F.wave * 3 + 0) * 64 + F.lane] = a0; red[(F.wave * 3 + 1) * 64 + F.lane] = a1; red[(F.wave * 3 + 2) * 64 + F.lane] = a2;
        __syncthreads();
        if (F.tid < 192) { const int mi = F.tid >> 6, ln = F.tid & 63; float s = F.in[I_BMOD][l * 6144 + j * 64 + ln];
            for (int w8 = 0; w8 < 8; ++w8) s += red[(w8 * 3 + mi) * 64 + ln];
            mod[((size_t)l * 3 + mi) * 6144 + j * 64 + ln] = s; }
        __syncthreads();
    }
}
__device__ __forceinline__ void prep_x_tables(Frame& F) {
    const int gt = F.bid * NTHR + F.tid, NG = F.G * NTHR;
    for (int i = gt; i < NTOK * DM / 4; i += NG) {
        const int row = i >> 8, c4 = (i & 255) * 4;
        f32x4 v;
        if (row < NCTX) v = *(const f32x4*)(F.in[I_XP] + (size_t)row * DM + c4);
        else { const int tt = row - NCTX, t = tt & 2047; v = *(const f32x4*)(F.in[I_XS] + (size_t)tt * DM + c4);
            const int seg = c4 >> 8; const float pos = (seg < 2) ? (float)(t >> 6) : (float)(t & 63);
#pragma unroll
            for (int u = 0; u < 4; ++u) { const int ii = (c4 + u) & 255; const float om = expf(-9.210340371976184f * (float)ii / 256.0f); const float a = pos * om;
                v[u] += (seg & 1) ? cos_rad(a) : sin_rad(a); } }
        *(f32x4*)(F.out + (size_t)row * DM + c4) = v;
    }
    for (int i = gt; i < 2048 * 4096 / 8; i += NG) { const int tp = i >> 9, k0 = (i & 511) * 8; unsigned w[4];
#pragma unroll
        for (int u = 0; u < 4; ++u) { float v[2];
#pragma unroll
            for (int e = 0; e < 2; ++e) { const int k = k0 + 2 * u + e; const int m = (tp * (k & 2047)) & 2047; const float x = (float)m / 2048.0f; v[e] = k < 2048 ? cos_rev(x) : -sin_rev(x); }
            w[u] = pk2(v[0], v[1]); }
        *(u32x4*)((bf16_t*)(F.ws + WS_TABL) + (size_t)tp * 4096 + k0) = (u32x4){w[0], w[1], w[2], w[3]}; }
    for (int i = gt; i < 256 * 512 / 8; i += NG) { const int tp = i >> 6, k0 = (i & 63) * 8; unsigned w[4];
#pragma unroll
        for (int u = 0; u < 4; ++u) { float v[2];
#pragma unroll
            for (int e = 0; e < 2; ++e) { const int k = k0 + 2 * u + e; const int m = (tp * (k & 255)) & 255; const float x = (float)m / 256.0f; v[e] = k < 256 ? cos_rev(x) : -sin_rev(x); }
            w[u] = pk2(v[0], v[1]); }
        *(u32x4*)((bf16_t*)(F.ws + WS_TABC) + (size_t)tp * 512 + k0) = (u32x4){w[0], w[1], w[2], w[3]}; }
}

__device__ __forceinline__ void phase_norm(Frame& F, const float* g, const float* modl, int sh_off, int sc_off, bf16_t* H) {
    const int gw = F.bid * NWAVES + F.wave, NGW = F.G * NWAVES;
    for (int row = gw; row < NTOK; row += NGW) {
        const f32x4* xr = (const f32x4*)(F.out + (size_t)row * DM) + F.lane;
        f32x4 v[4]; float s = 0.f;
#pragma unroll
        for (int j = 0; j < 4; ++j) { v[j] = xr[64 * j]; s += (v[j].x * v[j].x + v[j].y * v[j].y) + (v[j].z * v[j].z + v[j].w * v[j].w); }
        const float rstd = 1.0f / sqrtf(wave_sum(s) * (1.f / DM) + EPS);
        const float* mp = modl + (size_t)mod_idx(row) * 6144;
        u32x2* o = (u32x2*)(H + (size_t)row * DM) + F.lane;
#pragma unroll
        for (int j = 0; j < 4; ++j) { const int c = 4 * F.lane + 256 * j; const f32x4 gg = *(const f32x4*)(g + c), sh = *(const f32x4*)(mp + sh_off + c), sc = *(const f32x4*)(mp + sc_off + c);
            const f32x4 y = (v[j] * rstd) * gg * (sc + 1.0f) + sh;
            o[64 * j] = (u32x2){pk2(y.x, y.y), pk2(y.z, y.w)}; }
    }
}
__device__ __forceinline__ void phase_final(Frame& F) {
    const int gw = F.bid * NWAVES + F.wave, NGW = F.G * NWAVES; const float* g = F.in[I_NORMF];
    for (int row = gw; row < NTOK; row += NGW) {
        f32x4* xr = (f32x4*)(F.out + (size_t)row * DM) + F.lane;
        f32x4 v[4]; float s = 0.f;
#pragma unroll
        for (int j = 0; j < 4; ++j) { v[j] = xr[64 * j]; s += (v[j].x * v[j].x + v[j].y * v[j].y) + (v[j].z * v[j].z + v[j].w * v[j].w); }
        const float rstd = 1.0f / sqrtf(wave_sum(s) * (1.f / DM) + EPS);
#pragma unroll
        for (int j = 0; j < 4; ++j) { const int c = 4 * F.lane + 256 * j; const f32x4 gg = *(const f32x4*)(g + c); xr[64 * j] = (v[j] * rstd) * gg; }
    }
}

typedef float f32x16 __attribute__((ext_vector_type(16)));
constexpr int HY_X1 = 0, HY_X2 = 8192, HY_ZP1 = 16384, HY_ZP2 = 47104, HY_TR = 77824, HY_TRCOPY = 8256, HY_TRORD = 16512, HY_RED = 110848;
static_assert(HY_RED + 16384 <= RING_BYTES, "hyena LDS map");
__device__ __forceinline__ void hyena_task(Frame& F, int l, int c, int grp) {
    int tid_ = F.tid; asm volatile("" : "+v"(tid_));
    const int tid = tid_, lane = tid & 63, wave = __builtin_amdgcn_readfirstlane(tid >> 6);
    const int L = grp == 0 ? LLAT : LCTX, nb = L >> 5, ZSEQ = (3 * L / 32) * 40, row0 = grp == 0 ? NCTX : (grp - 1) * 4096;
    LAS unsigned char* lds = F.lds;
    const bf16_t* hyt = (const bf16_t*)(F.ws + WS_HYT);
    const float* cw = F.in[I_CONVHY] + (size_t)l * 3 * 1536;
    const float* fil = (const float*)(F.ws + (grp == 0 ? WS_FILL : WS_FILC));
    const float* hb = F.in[I_HBIAS] + (size_t)l * 2 * 512;
    __syncthreads();
    {
        const int p = 8 * tid, t = p & (L - 1), qs = p / L;
#pragma unroll
        for (int st = 0; st < 3; ++st) { const int ch = st * 512 + c; const bf16_t* src = hyt + (size_t)ch * NTOK + row0 + p;
            const u32x4 rv = *(const u32x4*)src; const float xm = t > 0 ? bf2f(src[-1]) : 0.f, xp = t + 8 < L ? bf2f(src[8]) : 0.f;
            const float w0 = cw[ch], w1 = cw[1536 + ch], w2 = cw[2 * 1536 + ch];
            const float x[10] = {xm, bflo(rv.x), bfhi(rv.x), bflo(rv.y), bfhi(rv.y), bflo(rv.z), bfhi(rv.z), bflo(rv.w), bfhi(rv.w), xp};
            float o[8];
#pragma unroll
            for (int e = 0; e < 8; ++e) o[e] = w0 * x[e] + w1 * x[e + 1] + w2 * x[e + 2];
            const u32x4 pk = (u32x4){pk2(o[0], o[1]), pk2(o[2], o[3]), pk2(o[4], o[5]), pk2(o[6], o[7])};
            if (st < 2) *(LAS u32x4*)(lds + (st == 0 ? HY_X1 : HY_X2) + p * 2) = pk;
            else *(LAS u32x4*)(lds + HY_ZP1 + (qs * ZSEQ + (nb + (t >> 5)) * 40 + (t & 31)) * 2) = pk; }
        const int npad = (4096 / L) * 2 * nb;
        for (int i2 = tid; i2 < 2 * npad * 5; i2 += NTHR) { const int img = i2 / (npad * 5), rem = i2 % (npad * 5), pbk = rem / 5, piece = rem % 5;
            const int qs2 = pbk / (2 * nb), bb = pbk % (2 * nb), blk = bb < nb ? bb : bb + nb;
            *(LAS u32x4*)(lds + (img == 0 ? HY_ZP1 : HY_ZP2) + (qs2 * ZSEQ + blk * 40) * 2 + piece * 16) = (u32x4){0u, 0u, 0u, 0u}; }
    }
#pragma unroll 1
    for (int o = 0; o < 2; ++o) { const float* ff = fil + ((size_t)(2 * o) * 512 + c) * L; const float* fb = fil + ((size_t)(2 * o + 1) * 512 + c) * L;
        const float t00 = ff[0] + fb[0];
        for (int k = tid; k < L; k += NTHR) { float v[3];
#pragma unroll
            for (int e = 0; e < 3; ++e) { const int m = 2 * k + e - L; v[e] = m < 0 ? (m > -L ? ff[-m] : 0.f) : (m == 0 ? t00 : (m < L ? fb[m] : 0.f)); }
            *(LAS unsigned*)(lds + HY_TR + o * HY_TRORD + 4 * k) = pk2(v[0], v[1]); *(LAS unsigned*)(lds + HY_TR + o * HY_TRORD + HY_TRCOPY + 4 * k) = pk2(v[1], v[2]); } }
    __syncthreads();
    const int tile = wave & 3, half = wave >> 2, r = lane & 31, hh = lane >> 5, colg = 32 * tile + r;
    int qs, ib, imin, imax;
    if (grp == 0) { qs = colg >> 6; ib = colg & 63; imin = 32 * (tile & 1); imax = imin + 31; } else { qs = colg >> 3; ib = colg & 7; imin = 0; imax = 7; }
    const int dlo = imin - nb + 1, cnt = imax - imin + nb, mid = dlo + (cnt >> 1);
    const int d0 = half == 0 ? dlo : mid, d1 = half == 0 ? mid : dlo + cnt;
    const int par = r & 1;
    const int aoff = par * HY_TRCOPY + (L + 8 * hh - r - 32 * d0 - par) * 2;
    const int boff = (qs * ZSEQ + (nb + ib - d0) * 40 + 8 * hh) * 2;
    const float bias0 = hb[c], bias1 = hb[512 + c];
    bf16_t* yb = (bf16_t*)(F.ws + WS_YB);
#pragma unroll 1
    for (int o = 0; o < 2; ++o) {
        f32x16 acc;
#pragma unroll
        for (int e = 0; e < 16; ++e) acc[e] = 0.f;
        const LAS unsigned char* Ap = lds + HY_TR + o * HY_TRORD + aoff; const LAS unsigned char* Bp = lds + (o == 0 ? HY_ZP1 : HY_ZP2) + boff;
#pragma unroll 2
        for (int d = d0; d < d1; ++d) {
#pragma unroll
            for (int ks = 0; ks < 2; ++ks) { const LAS unsigned* ap = (const LAS unsigned*)(Ap + 32 * ks);
                const u32x4 aw = (u32x4){ap[0], ap[1], ap[2], ap[3]};
                acc = __builtin_amdgcn_mfma_f32_32x32x16_bf16(__builtin_bit_cast(bf16x8, aw), *(const LAS bf16x8*)(Bp + 32 * ks), acc, 0, 0, 0); }
            Ap -= 64; Bp -= 80; }
        LAS float* red = (LAS float*)(lds + HY_RED);
        if (half == 1) {
#pragma unroll
            for (int e = 0; e < 16; ++e) red[(tile * 16 + e) * 64 + lane] = acc[e]; }
        __syncthreads();
        if (half == 0) {
#pragma unroll
            for (int e = 0; e < 16; ++e) acc[e] += red[(tile * 16 + e) * 64 + lane];
#pragma unroll
            for (int g = 0; g < 4; ++g) { const int a4 = 8 * g + 4 * hh, p = qs * L + 32 * ib + a4, zo = (qs * ZSEQ + (nb + ib) * 40 + a4) * 2;
                const u32x2 gx = *(const LAS u32x2*)(lds + (o == 0 ? HY_X1 : HY_X2) + p * 2), zz = *(const LAS u32x2*)(lds + (o == 0 ? HY_ZP1 : HY_ZP2) + zo);
                const float gv[4] = {bflo(gx.x), bfhi(gx.x), bflo(gx.y), bfhi(gx.y)}, zv[4] = {bflo(zz.x), bfhi(zz.x), bflo(zz.y), bfhi(zz.y)};
                float y[4];
#pragma unroll
                for (int e = 0; e < 4; ++e) y[e] = gv[e] * (acc[4 * g + e] + (o == 0 ? bias0 : bias1) * zv[e]);
                if (o == 0) *(LAS u32x2*)(lds + HY_ZP2 + zo) = (u32x2){pk2(y[0], y[1]), pk2(y[2], y[3])};
                else {
#pragma unroll
                    for (int e = 0; e < 4; ++e) yb[(size_t)(row0 + p + e) * 512 + c] = (bf16_t)f2bf(y[e]); } }
        }
        __syncthreads();
    }
}

__device__ __forceinline__ int kpos32(int k) { return (k & ~31) | (((k >> 2) & 3) << 3) | (((k >> 4) & 1) << 2) | (k & 3); }
__device__ __forceinline__ size_t chunk_lin(int s, int n) { return (size_t)(s < 32 ? s * 4 + n : 128 + (s - 32) * 32 + n); }
constexpr int D1_GRP_BYTES = 61440;
__device__ __forceinline__ void d1_task(Frame& F, int l, int s, int h, int n) {
    int tid_ = F.tid; asm volatile("" : "+v"(tid_));
    const int tid = tid_, lane = tid & 63, wave = __builtin_amdgcn_readfirstlane(tid >> 6), lw = wave & 3, lt = tid & 255;
    LAS unsigned char* base = F.lds + (wave >> 2) * D1_GRP_BYTES;
    LAS bf16_t* qb = (LAS bf16_t*)base;
    LAS bf16_t* kb = qb + 64 * 72;
    LAS bf16_t* vb = kb + 64 * 72;
    LAS float* ATf = (LAS float*)(vb + 64 * 72);
    LAS float* ATb = ATf + 4096;
    LAS float* sm = ATb + 4096;
    LAS float* betaf = sm, *betab = sm + 64, *gcf = sm + 128, *gcb = sm + 192;
    const int L = seq_len(s), row0 = seq_start(s) + n * 64, tpos0 = n * 64;
    const bf16_t* qkv = (const bf16_t*)(F.ws + WS_QKV);
    const float* cw = F.in[I_CONVQKV] + (size_t)l * 3 * QKVW;
    const size_t cl = chunk_lin(s, n);
    float braw = 0.f, araw = 0.f, al = 0.f, dtb = 0.f;
    if (lw < 2) { const float* ba = (const float*)(F.ws + WS_BA) + (size_t)(row0 + lane) * 32; braw = ba[lw * 8 + h]; araw = ba[16 + lw * 8 + h];
        al = F.in[I_ALOG][l * 16 + lw * 8 + h]; dtb = F.in[I_DTB][l * 16 + lw * 8 + h]; }
    __syncthreads();
#pragma unroll 1
    for (int th2 = 0; th2 < 2 * NREP(14); ++th2) { const int th = th2 & 1;
        const int t = (lt >> 3) + 32 * th, sub = lt & 7, tp = tpos0 + t;
        const float m0 = tp > 0 ? 1.f : 0.f, m2 = tp < L - 1 ? 1.f : 0.f;
#pragma unroll
        for (int part = 0; part < 3; ++part) {
            const int ch = part * 512 + h * 64 + sub * 8;
            const bf16_t* src = qkv + (size_t)(row0 + t) * QKVW + ch;
            const u32x4 r1 = *(const u32x4*)src, r0 = *(const u32x4*)(tp > 0 ? src - QKVW : src), r2 = *(const u32x4*)(tp < L - 1 ? src + QKVW : src);
            const f32x4 w0a = *(const f32x4*)(cw + ch), w0b = *(const f32x4*)(cw + ch + 4), w1a = *(const f32x4*)(cw + QKVW + ch), w1b = *(const f32x4*)(cw + QKVW + ch + 4),
                        w2a = *(const f32x4*)(cw + 2 * QKVW + ch), w2b = *(const f32x4*)(cw + 2 * QKVW + ch + 4);
            const unsigned a0[4] = {r0.x, r0.y, r0.z, r0.w}, a1[4] = {r1.x, r1.y, r1.z, r1.w}, a2[4] = {r2.x, r2.y, r2.z, r2.w};
            const float w0[8] = {w0a[0], w0a[1], w0a[2], w0a[3], w0b[0], w0b[1], w0b[2], w0b[3]}, w1[8] = {w1a[0], w1a[1], w1a[2], w1a[3], w1b[0], w1b[1], w1b[2], w1b[3]},
                        w2[8] = {w2a[0], w2a[1], w2a[2], w2a[3], w2b[0], w2b[1], w2b[2], w2b[3]};
            float v[8]; float ss = 0.f;
#pragma unroll
            for (int e = 0; e < 8; ++e) { const float x0 = (e & 1) ? bfhi(a0[e >> 1]) : bflo(a0[e >> 1]), x1 = (e & 1) ? bfhi(a1[e >> 1]) : bflo(a1[e >> 1]), x2 = (e & 1) ? bfhi(a2[e >> 1]) : bflo(a2[e >> 1]);
                float a = x1 * w1[e] + m0 * x0 * w0[e] + m2 * x2 * w2[e]; a = a / (1.f + __expf(-a)); v[e] = a; ss += a * a; }
            if (part < 2) { ss += __shfl_xor(ss, 1); ss += __shfl_xor(ss, 2); ss += __shfl_xor(ss, 4);
                const float rs = (part == 0 ? 0.125f : 1.0f) / sqrtf(ss + EPS);
#pragma unroll
                for (int e = 0; e < 8; ++e) v[e] *= rs; }
            const u32x4 pk = (u32x4){pk2(v[0], v[1]), pk2(v[2], v[3]), pk2(v[4], v[5]), pk2(v[6], v[7])};
            *(LAS u32x4*)((part == 0 ? qb : (part == 1 ? kb : vb)) + t * 72 + sub * 8) = pk;
            if (part == 0) { bf16_t* qo = (bf16_t*)(F.ws + WS_QN) + (size_t)(row0 + t) * 512 + h * 64;
                *(u32x2*)(qo + kpos32(sub * 8)) = (u32x2){pk.x, pk.y}; *(u32x2*)(qo + kpos32(sub * 8 + 4)) = (u32x2){pk.z, pk.w}; }
        }
    }
    if (lw < 2) { const int dir = lw, t = lane;
        const float xx = araw + dtb; const float sp = xx > 20.f ? xx : log1pf(expf(xx));
        float a = -expf(al) * sp;
#pragma unroll
        for (int o = 1; o < 64; o <<= 1) { const float y = dir == 0 ? __shfl_up(a, o) : __shfl_down(a, o); if (dir == 0 ? (lane >= o) : (lane + o < 64)) a += y; }
        (dir == 0 ? betaf : betab)[t] = 1.f / (1.f + expf(-braw)); (dir == 0 ? gcf : gcb)[t] = a;
        ((float*)(F.ws + WS_GC))[((size_t)(dir * 8 + h) * 192 + cl) * 64 + t] = a; }
    __syncthreads();
    const size_t offF = ((size_t)(0 * 8 + h) * 192 + cl) * 4096, offB = ((size_t)(1 * 8 + h) * 192 + cl) * 4096;
    {
        const int ti = lw >> 1, tj = lw & 1, r = lane & 31, hh = lane >> 5, col = 32 * tj + r;
#pragma unroll 1
        for (int prod2 = 0; prod2 < 2 * NREP(15); ++prod2) { const int prod = prod2 & 1;
            const LAS bf16_t* Am = kb + (32 * ti + r) * 72 + 8 * hh; const LAS bf16_t* Bm = (prod == 0 ? kb : qb) + (32 * tj + r) * 72 + 8 * hh;
            f32x16 acc;
#pragma unroll
            for (int e = 0; e < 16; ++e) acc[e] = 0.f;
#pragma unroll
            for (int ks = 0; ks < 4; ++ks) acc = __builtin_amdgcn_mfma_f32_32x32x16_bf16(*(const LAS bf16x8*)(Am + 16 * ks), *(const LAS bf16x8*)(Bm + 16 * ks), acc, 0, 0, 0);
            if (prod == 0) {
                const int j = col; const float gfj = gcf[j], gbj = gcb[j];
#pragma unroll
                for (int g = 0; g < 4; ++g) { const int i4 = 32 * ti + 8 * g + 4 * hh; float ff[4], fb[4];
#pragma unroll
                    for (int e = 0; e < 4; ++e) { const int i = i4 + e; const float v = acc[4 * g + e];
                        ff[e] = i > j ? betaf[i] * v * __expf(gcf[i] - gfj) : 0.f; fb[e] = i < j ? betab[i] * v * __expf(gcb[i] - gbj) : 0.f; }
                    *(LAS f32x4*)(ATf + j * 64 + i4) = (f32x4){ff[0], ff[1], ff[2], ff[3]};
                    *(LAS f32x4*)(ATb + (63 - j) * 64 + (60 - i4)) = (f32x4){fb[3], fb[2], fb[1], fb[0]}; }
            } else {
                const int i = col; const float gfi = gcf[i], gbi = gcb[i]; bf16_t* QKo = (bf16_t*)(F.ws + WS_QK);
#pragma unroll
                for (int g = 0; g < 4; ++g) { const int j4 = 32 * ti + 8 * g + 4 * hh; float ff[4], fb[4];
#pragma unroll
                    for (int e = 0; e < 4; ++e) { const int j = j4 + e; const float v = acc[4 * g + e];
                        ff[e] = i >= j ? v * __expf(gfi - gcf[j]) : 0.f; fb[e] = i <= j ? v * __expf(gbi - gcb[j]) : 0.f; }
                    const int pj = kpos32(j4);
                    *(u32x2*)(QKo + offF + (size_t)i * 64 + pj) = (u32x2){pk2(ff[0], ff[1]), pk2(ff[2], ff[3])};
                    *(u32x2*)(QKo + offB + (size_t)i * 64 + pj) = (u32x2){pk2(fb[0], fb[1]), pk2(fb[2], fb[3])}; }
            }
        }
    }
    { const int d = lt >> 2, cg = lt & 3; bf16_t* kt = (bf16_t*)(F.ws + WS_KN) + ((size_t)h * 192 + cl) * 4096 + d * 64;
#pragma unroll
      for (int g = 0; g < 4; ++g) { const int c = 16 * cg + 4 * g;
          const unsigned w0 = (unsigned)kb[(c + 0) * 72 + d] | ((unsigned)kb[(c + 1) * 72 + d] << 16), w1 = (unsigned)kb[(c + 2) * 72 + d] | ((unsigned)kb[(c + 3) * 72 + d] << 16);
          *(u32x2*)(kt + kpos32(c)) = (u32x2){w0, w1}; } }
    __syncthreads();
#pragma unroll 1
    for (int srep = 0; srep < NREP(16); ++srep) {
        const int c = lane;
        int dmask = (lw >> 1) * 63, isw = lw & 1;
        asm volatile("" : "+v"(dmask), "+v"(isw));
        const bool bdir = dmask != 0, bw = isw != 0;
        const LAS float* AT = ATf + (bdir ? 4096 : 0) + c;
        const LAS float* bet = betaf + (bdir ? 64 : 0); const LAS float* gcc = gcf + (bdir ? 64 : 0);
        const LAS bf16_t* srcm = (bw ? kb : vb) + c;
        float x[64];
#pragma unroll
        for (int p = 0; p < 64; ++p) { const int t = p ^ dmask; const float be = bet[t]; const float eg = __expf(gcc[t]);
            x[p] = bf2f(srcm[t * 72]) * (bw ? be * eg : be); }
        float arow = AT[0];
#pragma unroll
        for (int j = 0; j < 63; ++j) { const float anext = AT[(j < 62 ? j + 1 : j) * 64]; const float xj = x[j];
#pragma unroll
            for (int i = j + 1; i < 64; ++i) { const float a = __builtin_bit_cast(float, __builtin_amdgcn_readlane(__builtin_bit_cast(int, arow), i)); x[i] -= a * xj; }
            arow = anext; }
        __builtin_amdgcn_sched_barrier(0);
        int dmask2 = dmask; asm volatile("" : "+v"(dmask2));
        const size_t offD = bdir ? offB : offF;
        if (!bw) {
            bf16_t* dst = (bf16_t*)(F.ws + WS_U) + offD + (size_t)c * 64;
#pragma unroll
            for (int g = 0; g < 8; ++g) { unsigned w[4];
#pragma unroll
                for (int k = 0; k < 4; ++k) { const float a = x[8 * g + 2 * k], b = x[8 * g + 2 * k + 1]; w[k] = pk2(bdir ? b : a, bdir ? a : b); }
                const u32x4 o = bdir ? (u32x4){w[3], w[2], w[1], w[0]} : (u32x4){w[0], w[1], w[2], w[3]};
                *(u32x4*)(dst + (bdir ? 56 - 8 * g : 8 * g)) = o; }
        } else {
            bf16_t* dst = (bf16_t*)(F.ws + WS_WW) + offD + kpos32(c);
#pragma unroll
            for (int p = 0; p < 64; ++p) dst[(p ^ dmask2) * 64] = (bf16_t)f2bf(-x[p]);
        }
    }
}

__device__ __forceinline__ bf16x8 pack8(const f32x4 a, const f32x4 b) {
    u32x4 w; w.x = pg8::cvt_pk_bf16(a[0], a[1]); w.y = pg8::cvt_pk_bf16(a[2], a[3]); w.z = pg8::cvt_pk_bf16(b[0], b[1]); w.w = pg8::cvt_pk_bf16(b[2], b[3]);
    return __builtin_bit_cast(bf16x8, w);
}
__device__ __forceinline__ void d2_wave_task(Frame& F, int l, int s, int h, int dir, int sl) {
    int lane_ = F.lane; asm volatile("" : "+v"(lane_));
    const int lane = lane_, r16 = lane & 15, q = lane >> 4, e0 = sl * 16;
    const int nch = s < 32 ? 4 : 32;
    LAS float* lo = (LAS float*)(F.lds + F.wave * 4608);
    f32x4 S[4];
#pragma unroll
    for (int t = 0; t < 4; ++t)
#pragma unroll
        for (int rg = 0; rg < 4; ++rg) { const int d = 16 * t + 4 * q + rg;
            S[t][rg] = s >= 32 ? F.in[I_STATE][((((size_t)(s - 32) * 2 + l) * 2 + dir) * 8 + h) * 4096 + d * 64 + e0 + r16] : 0.f; }
    const bf16_t* Wg = (const bf16_t*)(F.ws + WS_WW); const bf16_t* QKg = (const bf16_t*)(F.ws + WS_QK); const bf16_t* Ug = (const bf16_t*)(F.ws + WS_U);
    const bf16_t* QNg = (const bf16_t*)(F.ws + WS_QN); const bf16_t* KTg = (const bf16_t*)(F.ws + WS_KN); const float* GCg = (const float*)(F.ws + WS_GC);
    bf16_t* Og = (bf16_t*)(F.ws + (dir == 0 ? WS_OF : WS_OB));
    const int fo = r16 * 64 + 8 * q;
#pragma unroll 1
    for (int step = 0; step < nch; ++step) {
        const int n = dir == 0 ? step : nch - 1 - step; const size_t cl = chunk_lin(s, n);
        const size_t off = ((size_t)(dir * 8 + h) * 192 + cl) * 4096; const int tok0 = seq_start(s) + n * 64;
        const bf16_t* Wp = Wg + off + fo; const bf16_t* QKp = QKg + off + fo; const bf16_t* KTp = KTg + ((size_t)h * 192 + cl) * 4096 + fo;
        const bf16_t* Qp = QNg + (size_t)(tok0 + r16) * 512 + h * 64 + 8 * q; const bf16_t* Up = Ug + off + (size_t)(e0 + r16) * 64 + 4 * q;
        const float* gcp = GCg + ((size_t)(dir * 8 + h) * 192 + cl) * 64;
        bf16x8 Wf[4][2], Qf[4][2], QKf[4][2], KTf[4][2]; u32x2 Uv[4]; f32x4 gcv[4];
#pragma unroll
        for (int t = 0; t < 4; ++t) { Uv[t] = *(const u32x2*)(Up + 16 * t); gcv[t] = *(const f32x4*)(gcp + 16 * t + 4 * q);
#pragma unroll
            for (int ks = 0; ks < 2; ++ks) { Wf[t][ks] = *(const bf16x8*)(Wp + t * 1024 + 32 * ks); Qf[t][ks] = *(const bf16x8*)(Qp + (size_t)t * 16 * 512 + 32 * ks);
                QKf[t][ks] = *(const bf16x8*)(QKp + t * 1024 + 32 * ks); KTf[t][ks] = *(const bf16x8*)(KTp + t * 1024 + 32 * ks); } }
        const float gl = gcp[dir == 0 ? 63 : 0];
        bf16x8 Sb[2] = {pack8(S[0], S[1]), pack8(S[2], S[3])};
        f32x4 VN[4], O[4];
#pragma unroll
        for (int t = 0; t < 4; ++t) { VN[t] = (f32x4){bflo(Uv[t].x), bfhi(Uv[t].x), bflo(Uv[t].y), bfhi(Uv[t].y)}; O[t] = (f32x4){0.f, 0.f, 0.f, 0.f};
#pragma unroll
            for (int ks = 0; ks < 2; ++ks) { VN[t] = __builtin_amdgcn_mfma_f32_16x16x32_bf16(Wf[t][ks], Sb[ks], VN[t], 0, 0, 0); O[t] = __builtin_amdgcn_mfma_f32_16x16x32_bf16(Qf[t][ks], Sb[ks], O[t], 0, 0, 0); } }
        f32x4 VS[4];
#pragma unroll
        for (int t = 0; t < 4; ++t)
#pragma unroll
            for (int rg = 0; rg < 4; ++rg) { O[t][rg] *= __expf(gcv[t][rg]); VS[t][rg] = VN[t][rg] * __expf(gl - gcv[t][rg]); }
        const bf16x8 VNb[2] = {pack8(VN[0], VN[1]), pack8(VN[2], VN[3])}, VSb[2] = {pack8(VS[0], VS[1]), pack8(VS[2], VS[3])};
        const float egl = __expf(gl);
#pragma unroll
        for (int t = 0; t < 4; ++t) { S[t] = S[t] * egl;
#pragma unroll
            for (int ks = 0; ks < 2; ++ks) { O[t] = __builtin_amdgcn_mfma_f32_16x16x32_bf16(QKf[t][ks], VNb[ks], O[t], 0, 0, 0); S[t] = __builtin_amdgcn_mfma_f32_16x16x32_bf16(KTf[t][ks], VSb[ks], S[t], 0, 0, 0); } }
#pragma unroll
        for (int t = 0; t < 4; ++t)
#pragma unroll
            for (int rg = 0; rg < 4; ++rg) lo[(16 * t + 4 * q + rg) * 17 + r16] = O[t][rg];
        asm volatile("s_waitcnt lgkmcnt(0)" ::: "memory");
        { float ov[16];
#pragma unroll
          for (int e = 0; e < 16; ++e) ov[e] = lo[lane * 17 + e];
          bf16_t* op = Og + (size_t)(tok0 + lane) * 512 + h * 64 + e0;
          *(u32x4*)op = (u32x4){pk2(ov[0], ov[1]), pk2(ov[2], ov[3]), pk2(ov[4], ov[5]), pk2(ov[6], ov[7])};
          *(u32x4*)(op + 8) = (u32x4){pk2(ov[8], ov[9]), pk2(ov[10], ov[11]), pk2(ov[12], ov[13]), pk2(ov[14], ov[15])}; }
        asm volatile("s_waitcnt lgkmcnt(0)" ::: "memory");
    }
    if (s < 32) { float* so = F.out + (size_t)NTOK * DM + ((((size_t)s * 2 + l) * 2 + dir) * 8 + h) * 4096;
#pragma unroll
        for (int t = 0; t < 4; ++t)
#pragma unroll
            for (int rg = 0; rg < 4; ++rg) so[(16 * t + 4 * q + rg) * 64 + e0 + r16] = S[t][rg]; }
}

__device__ __forceinline__ void phase_combine(Frame& F, int l) {
    const bf16_t* of = (const bf16_t*)(F.ws + WS_OF); const bf16_t* ob = (const bf16_t*)(F.ws + WS_OB); const bf16_t* z = (const bf16_t*)(F.ws + WS_Z);
    bf16_t* ya = (bf16_t*)(F.ws + WS_YA); const float* na = F.in[I_NORMA] + l * 64;
    for (int i = F.bid * NTHR + F.tid; i < NTOK * 64; i += F.G * NTHR) {
        const size_t off = (size_t)i * 8; const int e0 = (i & 7) * 8;
        const u32x4 a = *(const u32x4*)(of + off), b = *(const u32x4*)(ob + off), zz = *(const u32x4*)(z + off);
        float o[8]; const unsigned aw[4] = {a.x, a.y, a.z, a.w}, bw[4] = {b.x, b.y, b.z, b.w}, zw[4] = {zz.x, zz.y, zz.z, zz.w};
        float ss = 0.f;
#pragma unroll
        for (int j = 0; j < 4; ++j) { o[2 * j] = bflo(aw[j]) + bflo(bw[j]); o[2 * j + 1] = bfhi(aw[j]) + bfhi(bw[j]); ss += o[2 * j] * o[2 * j] + o[2 * j + 1] * o[2 * j + 1]; }
        ss += __shfl_xor(ss, 1); ss += __shfl_xor(ss, 2); ss += __shfl_xor(ss, 4);
        const float rs = 1.0f / sqrtf(ss * (1.f / 64.f) + EPS);
        unsigned w[4];
#pragma unroll
        for (int j = 0; j < 4; ++j) { const float z0 = bflo(zw[j]), z1 = bfhi(zw[j]);
            w[j] = pk2(o[2 * j] * rs * na[e0 + 2 * j] * siluf_(z0), o[2 * j + 1] * rs * na[e0 + 2 * j + 1] * siluf_(z1)); }
        *(u32x4*)(ya + off) = (u32x4){w[0], w[1], w[2], w[3]};
    }
}

constexpr int N_PHASES = 26;
__global__ void __launch_bounds__(NTHR, 2) mk_fwd(Args args) {
    extern __shared__ __attribute__((aligned(16))) unsigned char lds_raw[];
    Frame F;
    F.lds = (LAS unsigned char*)lds_raw; F.in = args.in; F.out = args.out; F.ws = args.ws; F.ctl = (unsigned*)(args.ws + WS_CTL);
    F.tid = threadIdx.x; F.lane = F.tid & 63; F.wave = __builtin_amdgcn_readfirstlane(F.tid >> 6); F.G = gridDim.x; F.bid = blockIdx.x;
    for (int u = F.tid; u < (LDS_BYTES - LDSCTL_OFF) / 4; u += NTHR) ((LAS unsigned*)(F.lds + LDSCTL_OFF))[u] = 0u;
    __syncthreads();
    XcdBarrier bar; bar.bar = F.ctl + CW_BAR; bar.x = 0; bar.st = nullptr;
    if (!MK_PER_PHASE) bar = xcd_barrier_post(F.ctl + CW_BAR, (volatile LAS unsigned*)(F.lds + MISC_OFF) + 8);
    const int lo = args.ph_lo, hi = args.ph_hi;
    using namespace pg8;
#define IN(k) (lo <= (k) && (k) < hi)
#define SEAM(k) do { if (IN(k) && IN((k) + 1)) { if (!MK_PER_PHASE) xcd_barrier(bar); } } while (0)
#define PHASE_FRAME() Frame P = F; P.ws = opq(P.ws); P.out = opq(P.out); P.ctl = opq(P.ctl); asm volatile("" : "+v"(P.tid)); P.lane = P.tid & 63; P.wave = __builtin_amdgcn_readfirstlane(P.tid >> 6); \
    unsigned char* ws = P.ws; LAS unsigned char* ring = P.lds; (void)ws; (void)ring

    if (IN(0)) for (int rep = 0; rep < NREP(13); ++rep) { PHASE_FRAME(); prep_x_tables(P); prep_mod(P); prep_weights(P, 0); prep_filters(P, 0); }
    SEAM(0);
#pragma unroll 1
    for (int l = 0; l < 2; ++l) {
        const int pb = 1 + 12 * l;
#define MODL ((const float*)(ws + WS_MOD) + (size_t)l * 3 * 6144)
        if (IN(pb + 0)) { PHASE_FRAME(); if (l == 1) { prep_weights(P, 1); prep_filters(P, 1); }
            for (int rep = 0; rep < NREP(0); ++rep) phase_norm(P, P.in[I_N1G] + l * DM, MODL, 0, 1024, (bf16_t*)(ws + WS_H)); }
        SEAM(pb + 0);
        if (IN(pb + 1)) for (int rep = 0; rep < NREP(1); ++rep) { PHASE_FRAME();
            { Gemm g{1024, 2048, 2048}; Sched2D S{(const char*)(ws + WS_H), (const char*)(ws + W_N), (size_t)256 * 2048, (size_t)256 * 2048, 48, 9, P.G, P.bid, 0, 0};
              EpiInN E{(bf16_t*)(ws + WS_QKV), (bf16_t*)(ws + WS_Z), (float*)(ws + WS_BA)};
              gemm_phase<EpiInN, Sched2D, true, true>(ring, g, S, E); }
            { Gemm g{1024, 2048, 2048}; Sched2D S{(const char*)(ws + W_S), (const char*)(ws + WS_H), (size_t)256 * 2048, (size_t)256 * 2048, 10, 48, P.G, P.bid, 0, 0};
              EpiInS E{(bf16_t*)(ws + WS_HYT), (bf16_t*)(ws + WS_XCSL), (bf16_t*)(ws + WS_XCSC)};
              gemm_phase<EpiInS, Sched2D, true, true>(ring, g, S, E); }
        }
        SEAM(pb + 1);
        if (IN(pb + 2)) {
            for (int rep = 0; rep < NREP(12); ++rep) { PHASE_FRAME(); Gemm g{4096, 8192, 8192}; SchedFourL S{(const char*)(ws + WS_TABL), (const char*)(ws + WS_XCSL), P.bid};
              EpiScaleBf16 E{(bf16_t*)(ws + WS_YC), 512, 1.0f / sqrtf(64.0f * 2048.0f)};
              gemm_phase<EpiScaleBf16, SchedFourL, true, true>(ring, g, S, E); }
            { PHASE_FRAME(); Gemm g{512, 1024, 1024}; SchedFourC S{(const char*)(ws + WS_TABC), (const char*)(ws + WS_XCSC), P.bid - 32};
              EpiScaleBf16 E{(bf16_t*)(ws + WS_YC), 512, 1.0f / sqrtf(64.0f * 256.0f)};
              gemm_phase<EpiScaleBf16, SchedFourC, true, true>(ring, g, S, E); }
            for (int rep = 0; rep < NREP(2); ++rep) { PHASE_FRAME(); __syncthreads();
              for (int t = q_next(P, 2 * l + 0 + 4 * rep); t < 1536; t = q_next(P, 2 * l + 0 + 4 * rep)) {
                if (t < 512) hyena_task(P, l, t, 0);
                else { const int tt = t - 512; hyena_task(P, l, tt >> 1, 1 + (tt & 1)); }
              } }
        }
        SEAM(pb + 2);
        if (IN(pb + 3)) for (int rep = 0; rep < NREP(3); ++rep) { PHASE_FRAME();
            for (int t0 = 2 * P.bid; t0 < 1536; t0 += 2 * P.G) { const int t = t0 + (P.wave >> 2);
                int s, h, n;
                if (t < 1024) { s = t >> 5; h = (t >> 2) & 7; n = t & 3; } else { const int tt = t - 1024; s = 32 + (tt >> 8); h = (tt >> 5) & 7; n = tt & 31; }
                d1_task(P, l, s, h, n);
            }
        }
        SEAM(pb + 3);
        if (IN(pb + 4)) for (int rep = 0; rep < NREP(4); ++rep) { PHASE_FRAME();
            const int gw = P.wave * P.G + P.bid, NW = NWAVES * P.G;
            if (gw < 128) { d2_wave_task(P, l, 32 + (gw >> 6), (gw >> 3) & 7, (gw >> 2) & 1, gw & 3); }
            else for (int tt = gw - 128; tt < 2048; tt += NW - 128) d2_wave_task(P, l, tt >> 6, (tt >> 3) & 7, (tt >> 2) & 1, tt & 3);
        }
        SEAM(pb + 4);
        if (IN(pb + 5)) { PHASE_FRAME(); phase_combine(P, l); phase_norm(P, P.in[I_N1G] + l * DM, MODL, 0, 1024, (bf16_t*)(ws + WS_H)); }
        SEAM(pb + 5);
        if (IN(pb + 6)) for (int rep = 0; rep < NREP(6); ++rep) { PHASE_FRAME(); Gemm g{1024, 2048, 2048}; Sched2D S{(const char*)(ws + WS_H), (const char*)(ws + W_G), (size_t)256 * 2048, (size_t)256 * 2048, 48, 12, P.G, P.bid, 0, 0};
            EpiGate E{(bf16_t*)(ws + WS_GATE)};
            gemm_phase<EpiGate, Sched2D, true, true>(ring, g, S, E); }
        SEAM(pb + 6);
        if (IN(pb + 7)) {
            static_assert(WS_YB == WS_YA + 12 * MiB && WS_YC == WS_YB + 12 * MiB, "y buffers 12 MiB apart");
#pragma unroll 1
            for (int br = 0; br < 3; ++br) { PHASE_FRAME(); Gemm g{512, 1024, 1024};
                Sched2D S{(const char*)(ws + WS_YA + (size_t)br * 12 * MiB), (const char*)(ws + W_P + (size_t)br * MiB), (size_t)256 * 1024, (size_t)256 * 1024, 48, 4, P.G, P.bid, 0, 0};
                EpiMergeAcc E{(bf16_t*)(ws + WS_MRG), (const bf16_t*)(ws + WS_GATE), br * 1024, br == 0 ? 1 : 0};
                gemm_phase<EpiMergeAcc, Sched2D, true, true>(ring, g, S, E); }
        }
        SEAM(pb + 7);
        if (IN(pb + 8)) { PHASE_FRAME(); Gemm g{1024, 2048, 6144}; Sched2D S{(const char*)(ws + WS_MRG), (const char*)(ws + W_O3), (size_t)256 * 2048, (size_t)256 * 6144, 48, 4, P.G, P.bid, 0, 0};
            EpiResid E{P.out, MODL + 2048};
            gemm_phase<EpiResid, Sched2D, false, true>(ring, g, S, E); }
        SEAM(pb + 8);
        if (IN(pb + 9)) { PHASE_FRAME(); phase_norm(P, P.in[I_N2G] + l * DM, MODL, 3072, 4096, (bf16_t*)(ws + WS_H)); }
        SEAM(pb + 9);
        if (IN(pb + 10)) for (int rep = 0; rep < NREP(10); ++rep) { PHASE_FRAME(); Gemm g{1024, 2048, 2048}; Sched2D S{(const char*)(ws + WS_H), (const char*)(ws + W_GU), (size_t)256 * 2048, (size_t)256 * 2048, 48, 22, P.G, P.bid, 0, 0};
            EpiGU E{(bf16_t*)(ws + WS_ACT)};
            gemm_phase<EpiGU, Sched2D, true, true>(ring, g, S, E); }
        SEAM(pb + 10);
        if (IN(pb + 11)) { PHASE_FRAME(); Gemm g{DFF, DFF * 2, DFF * 2}; Sched2D S{(const char*)(ws + WS_ACT), (const char*)(ws + W_DN), (size_t)256 * DFF * 2, (size_t)256 * DFF * 2, 48, 4, P.G, P.bid, 0, 0};
            EpiResid E{P.out, MODL + 5120};
            gemm_phase<EpiResid, Sched2D, false, true>(ring, g, S, E); }
        SEAM(pb + 11);
    }
    if (IN(25)) { PHASE_FRAME(); phase_final(P); }
#undef IN
#undef SEAM
}

extern "C" void kernel_launch(void* const* d_in, const int* in_sizes, int n_in, void* d_out, int out_size, void* d_ws, size_t ws_size, hipStream_t stream) {
    static int grid = 0;
    if (grid == 0) {
        if (n_in != N_IN || out_size != NTOK * DM + 32 * 2 * 2 * 8 * 4096 || ws_size < WS_END) { fprintf(stderr, "kernel_launch: unexpected shapes (n_in %d out %d ws %zu); nothing launched\n", n_in, out_size, ws_size); grid = -1; return; }
        int dev = 0, cus = 0, per_cu = 0;
        if (hipGetDevice(&dev) != hipSuccess || hipDeviceGetAttribute(&cus, hipDeviceAttributeMultiprocessorCount, dev) != hipSuccess) { grid = -1; return; }
        if (hipFuncSetAttribute((const void*)mk_fwd, hipFuncAttributeMaxDynamicSharedMemorySize, LDS_BYTES) != hipSuccess) { fprintf(stderr, "kernel_launch: hipFuncSetAttribute failed\n"); grid = -1; return; }
        if (hipOccupancyMaxActiveBlocksPerMultiprocessor(&per_cu, (const void*)mk_fwd, NTHR, LDS_BYTES) != hipSuccess || per_cu < 1) { fprintf(stderr, "kernel_launch: occupancy query says %d blocks per CU; nothing launched\n", per_cu); (void)hipGetLastError(); grid = -1; return; }
        grid = cus;
    }
    if (grid < 0) return;
    if (hipMemsetAsync((char*)d_ws + WS_CTL, 0, CTL_ZERO_BYTES, stream) != hipSuccess) return;
    Args a{};
    for (int i = 0; i < N_IN; ++i) a.in[i] = (const float*)d_in[i];
    a.out = (float*)d_out; a.ws = (unsigned char*)d_ws;
#if MK_PER_PHASE
    for (int p = 0; p < N_PHASES; ++p) { a.ph_lo = p; a.ph_hi = p + 1; a.li = 0; hipLaunchKernelGGL(mk_fwd, dim3(grid), dim3(NTHR), LDS_BYTES, stream, a); }
#else
    a.ph_lo = 0; a.ph_hi = N_PHASES; a.li = 0;
    hipLaunchKernelGGL(mk_fwd, dim3(grid), dim3(NTHR), LDS_BYTES, stream, a);
#endif
}
```

```cpp
#include <hip/hip_runtime.h>
#include <cstdio>
#include <cstdint>

#ifndef MK_PER_PHASE
#define MK_PER_PHASE 0
#endif

#ifndef REPMASK
#define REPMASK 0
#endif
#define NREP(k) (((REPMASK >> (k)) & 1) ? 2 : 1)
#ifndef PROBE_ID
#define PROBE_ID 0
#endif
#define PROBE_AMP 10
#ifndef PROBE_BLK
#define PROBE_BLK 150
#endif
#ifndef PROBE_BLK
#define PROBE_BLK 200
#endif
#define PROF_COUNT(id) do { if (PROBE_ID == (id) && blockIdx.x == PROBE_BLK && threadIdx.x == 0) { *PROF_WORD(0) = *PROF_WORD(0) + 1000u; } } while (0)
#ifndef PROBE_BLK
#define PROBE_BLK 200
#endif
#define PROF_COUNT(id) do { if (PROBE_ID == (id) && blockIdx.x == PROBE_BLK && threadIdx.x == 0) { *PROF_WORD(0) = *PROF_WORD(0) + 1000u; } } while (0)
#define PROF_WORD(i) ((volatile __attribute__((address_space(3))) unsigned*)(F.lds + MISC_OFF + 96 + 4 * (i)))
#define PROF_BEGIN(id) do { if (PROBE_ID == (id) && blockIdx.x == PROBE_BLK && threadIdx.x == 0) { *PROF_WORD(1) = (unsigned)__builtin_amdgcn_s_memrealtime(); } } while (0)
#define PROF_END(id) do { if (PROBE_ID == (id) && blockIdx.x == PROBE_BLK && threadIdx.x == 0) { asm volatile("s_waitcnt vmcnt(0) lgkmcnt(0)" ::: "memory"); *PROF_WORD(0) = *PROF_WORD(0) + ((unsigned)__builtin_amdgcn_s_memrealtime() - *PROF_WORD(1)); } } while (0)
#define LAS __attribute__((address_space(3)))
#define GAS __attribute__((address_space(1)))
typedef unsigned short bf16_t;
typedef short bf16x8 __attribute__((ext_vector_type(8)));
typedef float f32x4 __attribute__((ext_vector_type(4)));
typedef float f32x2 __attribute__((ext_vector_type(2)));
typedef unsigned u32x4 __attribute__((ext_vector_type(4)));
typedef unsigned u32x2 __attribute__((ext_vector_type(2)));

constexpr int DM = 1024, NTOK = 12288, NCTX = 8192, LCTX = 256, LLAT = 2048, BCTX = 32, BLAT = 2;
constexpr int HA = 8, QKVW = 1536, DFF = 2816, DIN = 7200;
constexpr int OFF_Z = 1536, OFF_B = 2048, OFF_HY = 2080, OFF_FN = 3616, OFF_GATE = 4128;
constexpr float EPS = 1e-6f;
enum { I_XP = 0, I_XS, I_STATE, I_C, I_CCTX, I_WMOD, I_BMOD, I_N1G, I_N2G, I_WIN, I_CONVQKV, I_ALOG, I_DTB, I_NORMA, I_CONVHY,
       I_HW1, I_HB1, I_HFREQ, I_HW2, I_HB2, I_HW3, I_HBIAS, I_WPA, I_WPB, I_WPC, I_WO, I_WGU, I_WDOWN, I_NORMF, N_IN };

constexpr size_t MiB = 1u << 20;
constexpr size_t WS_CTL = 0, CTL_ZERO_BYTES = 256 * 1024;
constexpr size_t WS_MOD = 1 * MiB;
constexpr size_t WS_B0 = 1 * MiB + 512 * 1024;
constexpr size_t WS_TABC = 2 * MiB;
constexpr size_t WS_FILC = 3 * MiB;
constexpr size_t WS_FILL = 5 * MiB;
constexpr size_t WS_YF = 13 * MiB;
constexpr size_t WS_TABL = 21 * MiB;
constexpr size_t WS_W = 37 * MiB;
constexpr size_t W_N = WS_W;
constexpr size_t W_S = W_N + 2304 * 1024 * 2;
constexpr size_t W_G = W_S + 2560 * 1024 * 2;
constexpr size_t W_P = W_G + 3072 * 1024 * 2;
constexpr size_t W_O3 = W_P + 3 * 1024 * 512 * 2;
constexpr size_t W_GU = W_O3 + 1024 * 3072 * 2;
constexpr size_t W_DN = W_GU + 5632 * 1024 * 2;
constexpr size_t W_END = W_DN + 1024 * 2816 * 2;
static_assert(W_END <= 78 * MiB, "weights region");
constexpr size_t WS_A0 = 78 * MiB;
constexpr size_t WS_QKV = WS_A0, WS_OF = WS_A0, WS_OB = WS_A0 + 12 * MiB, WS_MRG = WS_A0;
constexpr size_t WS_Z = 116 * MiB, WS_YA = WS_Z;
constexpr size_t WS_BA = 114 * MiB;
constexpr size_t WS_YB = 128 * MiB, WS_YC = 140 * MiB;
constexpr size_t WS_A5 = 152 * MiB;
constexpr size_t WS_H = WS_A5;
constexpr size_t WS_HYT = WS_A5 + 24 * MiB;
constexpr size_t WS_XCS = WS_A5 + 60 * MiB;
constexpr size_t WS_XCSL = WS_XCS, WS_XCSC = WS_XCS + 8 * MiB;
constexpr size_t WS_QN = WS_A5, WS_KN = WS_A5 + 12 * MiB;
constexpr size_t WS_U = WS_A5 + 24 * MiB;
constexpr size_t WS_WW = WS_A5 + 48 * MiB;
constexpr size_t WS_QK = WS_A5 + 72 * MiB;
constexpr size_t WS_GC = WS_A5 + 96 * MiB;
constexpr size_t WS_GATE = WS_A5 + 24 * MiB;
constexpr size_t WS_ACT = WS_A5 + 24 * MiB;
constexpr size_t WS_END = 256 * MiB;
static_assert(WS_GC + 2 * 8 * 192 * 64 * 4 <= WS_END && WS_GATE + (size_t)NTOK * 3072 * 2 <= WS_END, "ws map");
constexpr int CW_BAR = 4096;
constexpr int CW_Q = 16384;

constexpr int RING_BYTES = 131072, LDSCTL_OFF = RING_BYTES, MISC_OFF = LDSCTL_OFF + 320, LDS_BYTES = 147456;
constexpr int NWAVES = 8, NTHR = 512;

#define RLX_AGENT __ATOMIC_RELAXED, __HIP_MEMORY_SCOPE_AGENT
#define LDS_WAIT() asm volatile("s_waitcnt lgkmcnt(0)" ::: "memory")
__device__ __forceinline__ unsigned f2bf(float f) { unsigned u = __builtin_bit_cast(unsigned, f); return (u + 0x7fffu + ((u >> 16) & 1u)) >> 16; }
__device__ __forceinline__ unsigned pk2(float lo, float hi) { return f2bf(lo) | (f2bf(hi) << 16); }
__device__ __forceinline__ float bf2f(unsigned short b) { return __builtin_bit_cast(float, (unsigned)b << 16); }
__device__ __forceinline__ float bflo(unsigned w) { return __builtin_bit_cast(float, w << 16); }
__device__ __forceinline__ float bfhi(unsigned w) { return __builtin_bit_cast(float, w & 0xffff0000u); }
__device__ __forceinline__ float sin_rev(float r) { return __builtin_amdgcn_sinf(r - rintf(r)); }
__device__ __forceinline__ float cos_rev(float r) { return __builtin_amdgcn_cosf(r - rintf(r)); }
__device__ __forceinline__ float sin_rad(float x) { return sin_rev(x * 0.15915494309189535f); }
__device__ __forceinline__ float cos_rad(float x) { return cos_rev(x * 0.15915494309189535f); }
__device__ __forceinline__ float sigmoidf_(float x) { return 1.f / (1.f + __expf(-x)); }
__device__ __forceinline__ float siluf_(float x) { return x / (1.f + __expf(-x)); }
__device__ __forceinline__ float wave_sum(float v) {
#pragma unroll
    for (int o = 1; o < 64; o <<= 1) v += __shfl_xor(v, o);
    return v;
}
template <class T> __device__ __forceinline__ T* opq(T* p) {
    unsigned lo = (unsigned)(uintptr_t)p, hi = (unsigned)((uintptr_t)p >> 32); asm volatile("" : "+v"(lo), "+v"(hi));
    lo = __builtin_amdgcn_readfirstlane(lo); hi = __builtin_amdgcn_readfirstlane(hi); return (T*)(((uintptr_t)hi << 32) | (uintptr_t)lo);
}
__device__ __forceinline__ int seq_start(int s) { return s < 32 ? s * 256 : NCTX + (s - 32) * 2048; }
__device__ __forceinline__ int seq_len(int s) { return s < 32 ? 256 : 2048; }
__device__ __forceinline__ int mod_idx(int row) { return row < NCTX ? 0 : 1 + ((row - NCTX) >> 11); }

namespace pg8 {
constexpr int BM = 256, BK = 64, HALF = 128, HTB = HALF * BK * 2, STAGE_BYTES = 8 * HTB, NXCD = 8, WGM = 8;
__host__ __device__ __forceinline__ int lds_byte(int r, int c) { const int st = (r >> 4) * 2 + (c >> 5), rr = r & 15, cc = c & 31, ob = rr * 64 + cc * 2; return st * 1024 + (ob ^ (((ob >> 9) & 1) << 5)); }
__host__ __device__ __forceinline__ void stage_rc(int b, int& R, int& C) { const int st = b / 1024, sb = b % 1024, swz = sb ^ (((sb >> 9) & 1) << 5); R = (st >> 1) * 16 + swz / 64; C = (st & 1) * 32 + (swz % 64) / 2; }
__host__ __device__ __forceinline__ int perm32(int rho) { const int n = rho >> 4, i = rho & 15; return 8 * (i >> 2) + 4 * n + (i & 3); }

struct Unit { const char* a; const char* b; int r0, c0; };
struct Gemm { int K, lda, ldb; };

__device__ __forceinline__ bool static_order(long L, int nM, int nN, int& pm, int& pn) {
    const int nwg = nM * nN; if (L >= nwg) return false;
    int wgid = (int)L; { const int q = nwg / NXCD, r = nwg % NXCD, xcd = wgid % NXCD, off = wgid / NXCD; wgid = (xcd < r ? xcd * (q + 1) : r * (q + 1) + (xcd - r) * q) + off; }
    const int nig = WGM * nN, gid = wgid / nig, fm = gid * WGM, gsz = (nM - fm) < WGM ? (nM - fm) : WGM;
    pm = fm + ((wgid % nig) % gsz); pn = (wgid % nig) / gsz; return true;
}
__device__ __forceinline__ unsigned cvt_pk_bf16(float lo, float hi) { unsigned r; asm volatile("v_cvt_pk_bf16_f32 %0, %1, %2" : "=v"(r) : "v"(lo), "v"(hi)); return r; }

template <class Epi, class Sched, bool ALIGN_EPI, bool SP2>
__device__ __forceinline__ void gemm_phase(LAS unsigned char* lds, const Gemm g, const Sched& S, const Epi& E) {
    int tid_ = threadIdx.x; asm volatile("" : "+v"(tid_));
    const int tid = tid_, wid = __builtin_amdgcn_readfirstlane(tid >> 6), lane = tid & 63, wr = wid >> 2, wc = wid & 3, fr = lane & 15, fq = lane >> 4;
    const int K = g.K, nt = K / BK;
    unsigned voffA[2], voffB[2];
#pragma unroll
    for (int i = 0; i < 2; ++i) { int R, C; stage_rc(tid * 16 + i * 8192, R, C); const int Rb = Epi::PERM ? ((R & ~31) + perm32(R & 31)) : R;
        voffA[i] = (unsigned)(R * g.lda + C * 2); voffB[i] = (unsigned)(Rb * g.ldb + C * 2); }
    const size_t kstep = (size_t)(BK * 2);
    const size_t hstepA = (size_t)HALF * g.lda, hstepB = (size_t)HALF * g.ldb;
    const unsigned ldsw = (unsigned)wid * 1024u;
    const int aoff = lds_byte(wr * 64 + fr, fq * 8), boff = lds_byte(wc * 32 + fr, fq * 8);
#define PG8_SA(b, h) (((b) * 2 + (h)) * HTB)
#define PG8_SB(b, h) ((4 + (b) * 2 + (h)) * HTB)
#define PG8_STAGE(bufoff, gbase, voff) do { _Pragma("unroll") for (int _i = 0; _i < 2; ++_i) \
        __builtin_amdgcn_global_load_lds((const unsigned*)((const char*)(gbase) + (voff)[_i]), (LAS unsigned*)(lds + (bufoff) + ldsw + _i * 8192), 16, 0, 0); } while (0)
#define PG8_LDA(dst, b, h) do { _Pragma("unroll") for (int m = 0; m < 4; ++m) _Pragma("unroll") for (int k = 0; k < 2; ++k) dst[m][k] = *(const LAS bf16x8*)(lds + PG8_SA(b, h) + aoff + m * 2048 + k * 1024); } while (0)
#define PG8_LDB(dst, b, h) do { _Pragma("unroll") for (int n = 0; n < 2; ++n) _Pragma("unroll") for (int k = 0; k < 2; ++k) dst[n][k] = *(const LAS bf16x8*)(lds + PG8_SB(b, h) + boff + n * 2048 + k * 1024); } while (0)
#define PG8_MMA(ai, bj, At, Bt) do { __builtin_amdgcn_s_setprio(1); _Pragma("unroll") for (int m = 0; m < 4; ++m) _Pragma("unroll") for (int n = 0; n < 2; ++n) _Pragma("unroll") for (int k = 0; k < 2; ++k) \
        acc[ai][bj][m][n] = __builtin_amdgcn_mfma_f32_16x16x32_bf16(Bt[n][k], At[m][k], acc[ai][bj][m][n], 0, 0, 0); __builtin_amdgcn_s_setprio(0); } while (0)
#define PG8_WAIT_V(n) asm volatile("s_waitcnt vmcnt(" #n ")" ::: "memory")
#define PG8_WAIT_L(n) asm volatile("s_waitcnt lgkmcnt(" #n ")" ::: "memory")
#define PG8_BAR __builtin_amdgcn_s_barrier()
#define PG8_SCHED __builtin_amdgcn_sched_barrier(0)
    Unit cur, nxt; int ui = 0;
    if (!S.next(0, cur)) return;
    f32x4 acc[2][2][4][2];
#pragma unroll
    for (int a = 0; a < 2; ++a)
#pragma unroll
        for (int b = 0; b < 2; ++b)
#pragma unroll
            for (int m = 0; m < 4; ++m)
#pragma unroll
                for (int n = 0; n < 2; ++n) acc[a][b][m][n] = (f32x4){0.f, 0.f, 0.f, 0.f};
    bf16x8 At[4][2], B0[2][2], B1[2][2];
    const char* cA = cur.a; const char* cB = cur.b;
    if constexpr (SP2) {
        PG8_STAGE(PG8_SB(0, 0), cB, voffB); PG8_STAGE(PG8_SB(0, 1), cB + hstepB, voffB); PG8_STAGE(PG8_SA(0, 0), cA, voffA); PG8_STAGE(PG8_SA(0, 1), cA + hstepA, voffA);
        if (wr == 1) PG8_BAR;
        PG8_WAIT_V(2); PG8_BAR;
        PG8_STAGE(PG8_SB(1, 0), cB + kstep, voffB); PG8_STAGE(PG8_SA(1, 0), cA + kstep, voffA); PG8_STAGE(PG8_SB(1, 1), cB + hstepB + kstep, voffB);
        PG8_WAIT_V(6); PG8_BAR;
    } else {
        PG8_STAGE(PG8_SB(0, 0), cB, voffB); PG8_STAGE(PG8_SA(0, 0), cA, voffA); PG8_STAGE(PG8_SB(0, 1), cB + hstepB, voffB); PG8_STAGE(PG8_SA(0, 1), cA + hstepA, voffA);
        if (wr == 1) PG8_BAR;
        PG8_WAIT_V(4); PG8_BAR;
        PG8_STAGE(PG8_SB(1, 0), cB + kstep, voffB); PG8_STAGE(PG8_SA(1, 0), cA + kstep, voffA); PG8_STAGE(PG8_SB(1, 1), cB + hstepB + kstep, voffB);
        PG8_WAIT_V(6); PG8_BAR;
    }
    for (;;) {
        const bool has_next = S.next(ui + 1, nxt);
        const char* nA = has_next ? nxt.a : cA; const char* nB = has_next ? nxt.b : cB;
        for (int t = 0; t < nt; t += 2) {
            const bool last = (t == nt - 2);
            const char* a1 = cA + (size_t)(t + 1) * kstep;
            const char* a2 = last ? nA : cA + (size_t)(t + 2) * kstep; const char* b2 = last ? nB : cB + (size_t)(t + 2) * kstep;
            const char* a3 = a2 + kstep; const char* b3 = b2 + kstep;
            if constexpr (SP2) {
            PG8_LDB(B0, 0, 0); PG8_LDB(B1, 0, 1); PG8_SCHED; PG8_LDA(At, 0, 0); PG8_STAGE(PG8_SA(1, 1), a1 + hstepA, voffA);
            PG8_WAIT_V(8); PG8_WAIT_L(0); PG8_BAR; PG8_MMA(0, 0, At, B0); PG8_MMA(0, 1, At, B1); PG8_BAR; PG8_SCHED;
            PG8_LDA(At, 0, 1); PG8_STAGE(PG8_SB(0, 0), b2, voffB); PG8_STAGE(PG8_SB(0, 1), b2 + hstepB, voffB); PG8_STAGE(PG8_SA(0, 0), a2, voffA);
            PG8_WAIT_V(8); PG8_WAIT_L(0); PG8_BAR; PG8_MMA(1, 0, At, B0); PG8_MMA(1, 1, At, B1); PG8_BAR; PG8_SCHED;
            PG8_LDB(B0, 1, 0); PG8_LDB(B1, 1, 1); PG8_SCHED; PG8_LDA(At, 1, 0); PG8_STAGE(PG8_SA(0, 1), a2 + hstepA, voffA);
            PG8_WAIT_V(8); PG8_WAIT_L(0); PG8_BAR; PG8_MMA(0, 0, At, B0); PG8_MMA(0, 1, At, B1); PG8_BAR; PG8_SCHED;
            PG8_LDA(At, 1, 1); PG8_STAGE(PG8_SB(1, 0), b3, voffB); PG8_STAGE(PG8_SB(1, 1), b3 + hstepB, voffB); PG8_STAGE(PG8_SA(1, 0), a3, voffA);
            PG8_WAIT_V(8); PG8_WAIT_L(0); PG8_BAR; PG8_MMA(1, 0, At, B0); PG8_MMA(1, 1, At, B1); PG8_BAR; PG8_SCHED;
            } else {
            PG8_LDB(B0, 0, 0); PG8_SCHED; PG8_LDA(At, 0, 0); PG8_STAGE(PG8_SA(1, 1), a1 + hstepA, voffA);
            PG8_WAIT_L(8); PG8_BAR; PG8_WAIT_L(0); PG8_MMA(0, 0, At, B0); PG8_BAR; PG8_SCHED;
            PG8_LDB(B1, 0, 1); PG8_STAGE(PG8_SB(0, 0), b2, voffB);
            PG8_BAR; PG8_WAIT_L(0); PG8_MMA(0, 1, At, B1); PG8_BAR;
            PG8_LDA(At, 0, 1); PG8_STAGE(PG8_SA(0, 0), a2, voffA);
            PG8_BAR; PG8_WAIT_L(0); PG8_MMA(1, 0, At, B0); PG8_BAR; PG8_SCHED;
            PG8_STAGE(PG8_SB(0, 1), b2 + hstepB, voffB);
            PG8_WAIT_V(6); PG8_BAR; PG8_MMA(1, 1, At, B1); PG8_BAR;
            PG8_LDB(B0, 1, 0); PG8_SCHED; PG8_LDA(At, 1, 0); PG8_STAGE(PG8_SA(0, 1), a2 + hstepA, voffA);
            PG8_WAIT_L(8); PG8_BAR; PG8_WAIT_L(0); PG8_MMA(0, 0, At, B0); PG8_BAR; PG8_SCHED;
            PG8_LDB(B1, 1, 1); PG8_STAGE(PG8_SB(1, 0), b3, voffB);
            PG8_BAR; PG8_WAIT_L(0); PG8_MMA(0, 1, At, B1); PG8_BAR;
            PG8_LDA(At, 1, 1); PG8_STAGE(PG8_SA(1, 0), a3, voffA);
            PG8_BAR; PG8_WAIT_L(0); PG8_MMA(1, 0, At, B0); PG8_BAR; PG8_SCHED;
            PG8_STAGE(PG8_SB(1, 1), b3 + hstepB, voffB);
            PG8_WAIT_V(6); PG8_BAR; PG8_MMA(1, 1, At, B1); PG8_BAR;
            }
        }
        if constexpr (ALIGN_EPI) { if (wr == 0) PG8_BAR; }
        E(acc, cur, wr, wc, fr, fq);
        if (!has_next) break;
#pragma unroll
        for (int a = 0; a < 2; ++a)
#pragma unroll
            for (int b = 0; b < 2; ++b)
#pragma unroll
                for (int m = 0; m < 4; ++m)
#pragma unroll
                    for (int n = 0; n < 2; ++n) acc[a][b][m][n] = (f32x4){0.f, 0.f, 0.f, 0.f};
        cur = nxt; cA = nA; cB = nB; ++ui;
        if constexpr (ALIGN_EPI) { if (wr == 1) PG8_BAR; }
    }
    PG8_WAIT_V(0);
    if constexpr (!ALIGN_EPI) { if (wr == 0) PG8_BAR; }
    PG8_BAR;
#undef PG8_SA
#undef PG8_SB
#undef PG8_STAGE
#undef PG8_LDA
#undef PG8_LDB
#undef PG8_MMA
#undef PG8_WAIT_V
#undef PG8_WAIT_L
#undef PG8_BAR
#undef PG8_SCHED
}

struct Sched2D {
    const char* A; const char* B; size_t atile, btile; int nM, nN, G, c, r_base, c_base;
    __device__ __forceinline__ bool next(int i, Unit& u) const {
        if (c < 0) return false;
        int pm, pn; if (!static_order((long)i * G + c, nM, nN, pm, pn)) return false;
        u.a = A + (size_t)pm * atile; u.b = B + (size_t)pn * btile; u.r0 = r_base + pm * 256; u.c0 = c_base + pn * 256; return true;
    }
};
struct SchedMerge {
    const char *y0, *w0; int G, c;
    __device__ __forceinline__ bool next(int i, Unit& u) const {
        int pm, pn; if (!static_order((long)i * G + c, 48, 12, pm, pn)) return false;
        const int br = pn >> 2; const char* y = y0 + (size_t)br * (12u << 20); const char* w = w0 + (size_t)br * (1u << 20);
        u.a = y + (size_t)pm * 256 * 512 * 2; u.b = w + (size_t)(pn & 3) * 256 * 512 * 2; u.r0 = pm * 256; u.c0 = pn * 256; return true;
    }
};
struct SchedFourL {
    const char* tab; const char* xcs; int c;
    __device__ __forceinline__ bool next(int i, Unit& u) const {
        if (i > 0 || c < 0 || c >= 64) return false;
        const int ks = c >> 5, b = (c >> 4) & 1, pm = (c & 15) >> 1, pn = c & 1;
        u.a = tab + (size_t)pm * 256 * 4096 * 2 + (size_t)ks * 2048 * 2; u.b = xcs + ((size_t)b * 512 + pn * 256) * 4096 * 2 + (size_t)ks * 2048 * 2; u.r0 = ks * 4096 + b * 2048 + pm * 256; u.c0 = pn * 256; return true;
    }
};
struct SchedFourC {
    const char* tab; const char* xcs; int c;
    __device__ __forceinline__ bool next(int i, Unit& u) const {
        if (i > 0 || c < 0 || c >= 64) return false;
        const int b = c >> 1, pn = c & 1;
        u.a = tab; u.b = xcs + ((size_t)b * 512 + pn * 256) * 512 * 2; u.r0 = b * 256; u.c0 = pn * 256; return true;
    }
};

typedef f32x4 Acc[2][2][4][2];
struct EpiInN {
    static constexpr bool PERM = true;
    bf16_t* qkv; bf16_t* z; float* ba;
    __device__ __forceinline__ void operator()(const Acc& acc, const Unit& u, int wr, int wc, int fr, int fq) const {
        const int colt = u.c0;
#pragma unroll
        for (int ai = 0; ai < 2; ++ai)
#pragma unroll
            for (int m = 0; m < 4; ++m) { const int row = u.r0 + ai * HALF + wr * 64 + m * 16 + fr;
#pragma unroll
                for (int bj = 0; bj < 2; ++bj) { const int col = colt + bj * HALF + wc * 32 + 8 * fq; const f32x4 v0 = acc[ai][bj][m][0], v1 = acc[ai][bj][m][1];
                    if (colt < 2048) { u32x4 w; w.x = cvt_pk_bf16(v0[0], v0[1]); w.y = cvt_pk_bf16(v0[2], v0[3]); w.z = cvt_pk_bf16(v1[0], v1[1]); w.w = cvt_pk_bf16(v1[2], v1[3]);
                        bf16_t* p = colt < 1536 ? qkv + (size_t)row * 1536 + col : z + (size_t)row * 512 + (col - 1536);
                        *(u32x4*)p = w; }
                    else if (col - 2048 < 32) { float* p = ba + (size_t)row * 32 + (col - 2048); *(f32x4*)p = v0; *(f32x4*)(p + 4) = v1; } } }
    }
};
struct EpiInS {
    static constexpr bool PERM = true;
    bf16_t* hyt; bf16_t* xcsl; bf16_t* xcsc;
    __device__ __forceinline__ void operator()(const Acc& acc, const Unit& u, int wr, int wc, int fr, int fq) const {
#pragma unroll
        for (int ai = 0; ai < 2; ++ai)
#pragma unroll
            for (int m = 0; m < 4; ++m) { const int ch = u.r0 + ai * HALF + wr * 64 + m * 16 + fr;
#pragma unroll
                for (int bj = 0; bj < 2; ++bj) { const int tok = u.c0 + bj * HALF + wc * 32 + 8 * fq; const f32x4 v0 = acc[ai][bj][m][0], v1 = acc[ai][bj][m][1];
                    u32x4 w; w.x = cvt_pk_bf16(v0[0], v0[1]); w.y = cvt_pk_bf16(v0[2], v0[3]); w.z = cvt_pk_bf16(v1[0], v1[1]); w.w = cvt_pk_bf16(v1[2], v1[3]);
                    bf16_t* p;
                    if (ch < 1536) p = hyt + (size_t)ch * NTOK + tok;
                    else { const int cc = ch - 1536, which = cc >> 9, n = cc & 511;
                        if (tok < NCTX) { const int b = tok >> 8, t = tok & 255; p = xcsc + ((size_t)(b * 512 + n) * 512 + which * 256 + t); }
                        else { const int tt = tok - NCTX, b = tt >> 11, t = tt & 2047; p = xcsl + ((size_t)(b * 512 + n) * 4096 + which * 2048 + t); } }
                    *(u32x4*)p = w; } }
    }
};
struct EpiScaleBf16 {
    static constexpr bool PERM = true;
    bf16_t* O; int ldc; float scale;
    __device__ __forceinline__ void operator()(const Acc& acc, const Unit& u, int wr, int wc, int fr, int fq) const {
#pragma unroll
        for (int ai = 0; ai < 2; ++ai)
#pragma unroll
            for (int m = 0; m < 4; ++m) { const int row = u.r0 + ai * HALF + wr * 64 + m * 16 + fr;
#pragma unroll
                for (int bj = 0; bj < 2; ++bj) { const int col = u.c0 + bj * HALF + wc * 32 + 8 * fq; const f32x4 v0 = acc[ai][bj][m][0] * scale, v1 = acc[ai][bj][m][1] * scale;
                    u32x4 w; w.x = cvt_pk_bf16(v0[0], v0[1]); w.y = cvt_pk_bf16(v0[2], v0[3]); w.z = cvt_pk_bf16(v1[0], v1[1]); w.w = cvt_pk_bf16(v1[2], v1[3]);
                    *(u32x4*)(O + (size_t)row * ldc + col) = w; } }
    }
};
struct EpiAtomicF32 {
    static constexpr bool PERM = false;
    float* C; int ldc;
    __device__ __forceinline__ void operator()(const Acc& acc, const Unit& u, int wr, int wc, int fr, int fq) const {
#pragma unroll
        for (int ai = 0; ai < 2; ++ai)
#pragma unroll
            for (int m = 0; m < 4; ++m) { float* rowp = C + (size_t)(u.r0 + ai * HALF + wr * 64 + m * 16 + fr) * ldc + u.c0 + wc * 32 + 4 * fq;
#pragma unroll
                for (int bj = 0; bj < 2; ++bj)
#pragma unroll
                    for (int n = 0; n < 2; ++n)
#pragma unroll
                        for (int e = 0; e < 4; ++e) unsafeAtomicAdd(rowp + bj * HALF + n * 16 + e, acc[ai][bj][m][n][e]); }
    }
};
struct EpiGate {
    static constexpr bool PERM = true;
    bf16_t* O;
    __device__ __forceinline__ void operator()(const Acc& acc, const Unit& u, int wr, int wc, int fr, int fq) const {
#pragma unroll
        for (int ai = 0; ai < 2; ++ai)
#pragma unroll
            for (int m = 0; m < 4; ++m) { const int row = u.r0 + ai * HALF + wr * 64 + m * 16 + fr;
#pragma unroll
                for (int bj = 0; bj < 2; ++bj) { const int col = u.c0 + bj * HALF + wc * 32 + 8 * fq; const f32x4 v0 = acc[ai][bj][m][0], v1 = acc[ai][bj][m][1];
                    u32x4 w; w.x = cvt_pk_bf16(sigmoidf_(v0[0]), sigmoidf_(v0[1])); w.y = cvt_pk_bf16(sigmoidf_(v0[2]), sigmoidf_(v0[3]));
                    w.z = cvt_pk_bf16(sigmoidf_(v1[0]), sigmoidf_(v1[1])); w.w = cvt_pk_bf16(sigmoidf_(v1[2]), sigmoidf_(v1[3]));
                    *(u32x4*)(O + (size_t)row * 3072 + col) = w; } }
    }
};
struct EpiMerge {
    static constexpr bool PERM = true;
    bf16_t* O;
    __device__ __forceinline__ void operator()(const Acc& acc, const Unit& u, int wr, int wc, int fr, int fq) const {
#pragma unroll
        for (int ai = 0; ai < 2; ++ai)
#pragma unroll
            for (int m = 0; m < 4; ++m) { const int row = u.r0 + ai * HALF + wr * 64 + m * 16 + fr;
#pragma unroll
                for (int bj = 0; bj < 2; ++bj) { const int col = u.c0 + bj * HALF + wc * 32 + 8 * fq; const f32x4 v0 = acc[ai][bj][m][0], v1 = acc[ai][bj][m][1];
                    bf16_t* p = O + (size_t)row * 3072 + col; const u32x4 gg = *(const u32x4*)p;
                    u32x4 w; w.x = cvt_pk_bf16(v0[0] * bflo(gg.x), v0[1] * bfhi(gg.x)); w.y = cvt_pk_bf16(v0[2] * bflo(gg.y), v0[3] * bfhi(gg.y));
                    w.z = cvt_pk_bf16(v1[0] * bflo(gg.z), v1[1] * bfhi(gg.z)); w.w = cvt_pk_bf16(v1[2] * bflo(gg.w), v1[3] * bfhi(gg.w));
                    *(u32x4*)p = w; } }
    }
};
struct EpiMergeAcc {
    static constexpr bool PERM = true;
    bf16_t* M; const bf16_t* G; int gcol0; int first;
    __device__ __forceinline__ void operator()(const Acc& acc, const Unit& u, int wr, int wc, int fr, int fq) const {
#pragma unroll
        for (int ai = 0; ai < 2; ++ai)
#pragma unroll
            for (int m = 0; m < 4; ++m) { const int row = u.r0 + ai * HALF + wr * 64 + m * 16 + fr;
#pragma unroll
                for (int bj = 0; bj < 2; ++bj) { const int col = u.c0 + bj * HALF + wc * 32 + 8 * fq; const f32x4 v0 = acc[ai][bj][m][0], v1 = acc[ai][bj][m][1];
                    const u32x4 gg = *(const u32x4*)(G + (size_t)row * 3072 + gcol0 + col); bf16_t* p = M + (size_t)row * 1024 + col;
                    float o[8] = {v0[0] * bflo(gg.x), v0[1] * bfhi(gg.x), v0[2] * bflo(gg.y), v0[3] * bfhi(gg.y), v1[0] * bflo(gg.z), v1[1] * bfhi(gg.z), v1[2] * bflo(gg.w), v1[3] * bfhi(gg.w)};
                    if (!first) { const u32x4 mm = *(const u32x4*)p; o[0] += bflo(mm.x); o[1] += bfhi(mm.x); o[2] += bflo(mm.y); o[3] += bfhi(mm.y); o[4] += bflo(mm.z); o[5] += bfhi(mm.z); o[6] += bflo(mm.w); o[7] += bfhi(mm.w); }
                    u32x4 w; w.x = cvt_pk_bf16(o[0], o[1]); w.y = cvt_pk_bf16(o[2], o[3]); w.z = cvt_pk_bf16(o[4], o[5]); w.w = cvt_pk_bf16(o[6], o[7]);
                    *(u32x4*)p = w; } }
    }
};
struct EpiResid {
    static constexpr bool PERM = false;
    float* X; const float* gate;
    __device__ __forceinline__ void operator()(const Acc& acc, const Unit& u, int wr, int wc, int fr, int fq) const {
        const float* gp = gate + (size_t)mod_idx(u.r0) * 6144;
#pragma unroll
        for (int bj = 0; bj < 2; ++bj)
#pragma unroll
            for (int n = 0; n < 2; ++n) { const int col = u.c0 + bj * HALF + wc * 32 + 16 * n + 4 * fq; const f32x4 gv = *(const f32x4*)(gp + col);
#pragma unroll
                for (int ai = 0; ai < 2; ++ai)
#pragma unroll
                    for (int m = 0; m < 4; ++m) { const int row = u.r0 + ai * HALF + wr * 64 + m * 16 + fr; float* p = X + (size_t)row * DM + col;
                        const f32x4 x = *(const f32x4*)p; *(f32x4*)p = x + gv * acc[ai][bj][m][n]; } }
    }
};
struct EpiGU {
    static constexpr bool PERM = true;
    bf16_t* O;
    __device__ __forceinline__ void operator()(const Acc& acc, const Unit& u, int wr, int wc, int fr, int fq) const {
        const int col = (u.c0 >> 1) + wc * 32 + 8 * fq;
#pragma unroll
        for (int ai = 0; ai < 2; ++ai)
#pragma unroll
            for (int m = 0; m < 4; ++m) { const int row = u.r0 + ai * HALF + wr * 64 + m * 16 + fr;
                const f32x4 g0 = acc[ai][0][m][0], g1 = acc[ai][0][m][1], u0 = acc[ai][1][m][0], u1 = acc[ai][1][m][1];
                u32x4 w; w.x = cvt_pk_bf16(siluf_(g0[0]) * u0[0], siluf_(g0[1]) * u0[1]); w.y = cvt_pk_bf16(siluf_(g0[2]) * u0[2], siluf_(g0[3]) * u0[3]);
                w.z = cvt_pk_bf16(siluf_(g1[0]) * u1[0], siluf_(g1[1]) * u1[1]); w.w = cvt_pk_bf16(siluf_(g1[2]) * u1[2], siluf_(g1[3]) * u1[3]);
                *(u32x4*)(O + (size_t)row * DFF + col) = w; }
    }
};
}

#define XB_TMO      128
#define XB_XCNT(j)  (256  + 64 * (j))
#define XB_XSUB(j)  (1280 + 64 * (j))
#define XB_XGEN(j)  (2304 + 64 * (j))
#define XB_TOP      3328
#define XB_TOPGEN   3392
#define XCD_BAR_WORDS 3456
#define XB_SPIN_CAP (1u << 18)
__device__ __forceinline__ unsigned xb_ld(unsigned* p)              { return __hip_atomic_load(p, __ATOMIC_RELAXED, __HIP_MEMORY_SCOPE_AGENT); }
__device__ __forceinline__ unsigned xb_add(unsigned* p, unsigned v) { return __hip_atomic_fetch_add(p, v, __ATOMIC_RELAXED, __HIP_MEMORY_SCOPE_AGENT); }
__device__ __forceinline__ unsigned xb_xcc_id() { return (unsigned)__builtin_amdgcn_s_getreg((3 << 11) | 20) & 0xFu; }
#define XB_SPIN(cond, bar) do { unsigned _sp = 0; while (cond) { __builtin_amdgcn_s_sleep(1); \
    if ((++_sp & 255u) == 0u) { if (xb_ld(&(bar)[XB_TMO])) break; if (_sp > XB_SPIN_CAP) { atomicAdd(&(bar)[XB_TMO], 1u); break; } } } } while (0)
struct XcdBarrier { unsigned* bar; unsigned x; volatile LAS unsigned* st; };
__device__ __forceinline__ XcdBarrier xcd_barrier_post(unsigned* bar, volatile LAS unsigned* st) {
    XcdBarrier b; b.bar = bar; b.x = xb_xcc_id(); b.st = st;
    if (threadIdx.x == 0) (void)xb_add(&bar[XB_XCNT(b.x)], 1u);
    return b;
}
__device__ __forceinline__ void xcd_barrier_complete(unsigned* bar, unsigned x, unsigned& nloc, unsigned& nx) {
    const unsigned G = gridDim.x * gridDim.y * gridDim.z;
    unsigned sum, cnt, mine, sp = 0u;
    for (;;) {
        sum = 0u; cnt = 0u; mine = 0u;
#pragma unroll 1
        for (unsigned j = 0; j < 16; ++j) { const unsigned c = xb_ld(&bar[XB_XCNT(j)]); sum += c; cnt += (c > 0u) ? 1u : 0u; mine = (j == x) ? c : mine; }
        if (sum == G) break;
        __builtin_amdgcn_s_sleep(1);
        if ((++sp & 255u) == 0u) { if (xb_ld(&bar[XB_TMO])) break; if (sp > XB_SPIN_CAP) { atomicAdd(&bar[XB_TMO], 1u); break; } }
    }
    nloc = mine > 0u ? mine : 1u; nx = cnt > 0u ? cnt : 1u;
}
__device__ __forceinline__ void xcd_barrier(const XcdBarrier& b) {
    asm volatile("s_waitcnt vmcnt(0)" ::: "memory");
    __syncthreads();
    if (threadIdx.x == 0) {
        unsigned* bar = opq(b.bar);
        __builtin_amdgcn_s_waitcnt(0);
        unsigned nloc = b.st[0], nx = b.st[1];
        if (nloc == 0u) { xcd_barrier_complete(bar, b.x, nloc, nx); b.st[0] = nloc; b.st[1] = nx; }
        const unsigned old = xb_add(&bar[XB_XSUB(b.x)], 1u);
        const unsigned gen = old / nloc;
        if (old + 1u == (gen + 1u) * nloc) {
            __builtin_amdgcn_fence(__ATOMIC_RELEASE, "agent");
            asm volatile("s_waitcnt vmcnt(0)" ::: "memory");
            const unsigned og = xb_add(&bar[XB_TOP], 1u);
            const unsigned tg = og / nx;
            if (og + 1u == (tg + 1u) * nx) xb_add(&bar[XB_TOPGEN], 1u);
            else XB_SPIN(xb_ld(&bar[XB_TOPGEN]) == tg, bar);
            __builtin_amdgcn_fence(__ATOMIC_ACQUIRE, "agent");
            xb_add(&bar[XB_XGEN(b.x)], 1u);
            asm volatile("s_waitcnt vmcnt(0)" ::: "memory");
        } else {
            XB_SPIN(xb_ld(&bar[XB_XGEN(b.x)]) == gen, bar);
            __builtin_amdgcn_fence(__ATOMIC_ACQUIRE, "agent");
            asm volatile("s_waitcnt vmcnt(0)" ::: "memory");
        }
    }
    __syncthreads();
}

struct Args { const float* in[N_IN]; float* out; unsigned char* ws; int ph_lo, ph_hi, li, pad; };
struct Frame {
    LAS unsigned char* lds; const float* const* in; float* out; unsigned char* ws; unsigned* ctl;
    int tid, lane, wave, G, bid;
};
#define PROF_DECL do {} while (0)
#define PROF_FLUSH() do {} while (0)
__device__ __forceinline__ int q_next(Frame& F, int qid) {
    volatile LAS int* slot = (volatile LAS int*)(F.lds + MISC_OFF + 64);
    __syncthreads();
    if (F.tid == 0) *slot = (int)__hip_atomic_fetch_add(F.ctl + CW_Q + 64 * qid, 1u, RLX_AGENT);
    __syncthreads();
    return *slot;
}

__device__ __forceinline__ void transpose_item(const float* W, int ld_src, int col0, bf16_t* WT, int ld_dst, int dst_k0, int row0, int k0, LAS float* scr, int lane) {
    float tv[32];
#pragma unroll
    for (int i = 0; i < 32; ++i) tv[i] = W[(size_t)(k0 + 2 * i + (lane >> 5)) * ld_src + col0 + (lane & 31)];
#pragma unroll
    for (int i = 0; i < 32; ++i) scr[(2 * i + (lane >> 5)) * 33 + (lane & 31)] = tv[i];
    LDS_WAIT(); asm volatile("" ::: "memory");
    const int c = lane & 7;
#pragma unroll
    for (int j = 0; j < 4; ++j) { const int n = (lane >> 3) + 8 * j; const LAS float* s = scr + (8 * c) * 33 + n;
        u32x4 o; o.x = pk2(s[0 * 33], s[1 * 33]); o.y = pk2(s[2 * 33], s[3 * 33]); o.z = pk2(s[4 * 33], s[5 * 33]); o.w = pk2(s[6 * 33], s[7 * 33]);
        *(u32x4*)(WT + (size_t)(row0 + n) * ld_dst + dst_k0 + k0 + 8 * c) = o; }
    LDS_WAIT(); asm volatile("" ::: "memory");
}
__device__ __forceinline__ void prep_weights(Frame& F, int l) {
    LAS float* scr = (LAS float*)(F.lds + F.wave * 16384);
    const int gw = F.bid * NWAVES + F.wave, NGW = F.G * NWAVES;
    const float* w_in = F.in[I_WIN] + (size_t)l * DM * DIN;
    unsigned char* ws = F.ws;
    constexpr int NI_QKVZBA = 16 * (2080 / 32), NI_HY = 16 * 48, NI_G = 16 * 96, NI_P = 8 * 32, NI_O = 16 * 32, NI_GU = 16 * 176, NI_DN = 44 * 32;
    constexpr int NITEMS = NI_QKVZBA + NI_HY + NI_G + 3 * NI_P + 3 * NI_O + NI_GU + NI_DN;
#pragma unroll 1
    for (int it = gw; it < NITEMS; it += NGW) {
        int r = it;
        const float* src; int ld_src, col0, ld_dst, dst_k0, row0, k0; bf16_t* dst;
        if (r < NI_QKVZBA) { const int nb = r % 65, kb = r / 65; src = w_in; ld_src = DIN; col0 = nb * 32; dst = (bf16_t*)(ws + W_N); ld_dst = 1024; dst_k0 = 0; row0 = nb * 32; k0 = kb * 64; }
        else if ((r -= NI_QKVZBA) < NI_HY) { const int nb = r % 48, kb = r / 48; src = w_in; ld_src = DIN; col0 = OFF_HY + nb * 32; dst = (bf16_t*)(ws + W_S); ld_dst = 1024; dst_k0 = 0; row0 = nb * 32; k0 = kb * 64; }
        else if ((r -= NI_HY) < NI_G) { const int nb = r % 96, kb = r / 96; src = w_in; ld_src = DIN; col0 = OFF_GATE + nb * 32; dst = (bf16_t*)(ws + W_G); ld_dst = 1024; dst_k0 = 0; row0 = nb * 32; k0 = kb * 64; }
        else if ((r -= NI_G) < 3 * NI_P) { const int j = r / NI_P, q = r % NI_P, nb = q % 32, kb = q / 32; src = (j == 0 ? F.in[I_WPA] : (j == 1 ? F.in[I_WPB] : F.in[I_WPC])) + (size_t)l * 512 * 1024;
            ld_src = 1024; col0 = nb * 32; dst = (bf16_t*)(ws + W_P) + (size_t)j * 1024 * 512; ld_dst = 512; dst_k0 = 0; row0 = nb * 32; k0 = kb * 64; }
        else if ((r -= 3 * NI_P) < 3 * NI_O) { const int j = r / NI_O, q = r % NI_O, nb = q % 32, kb = q / 32; src = F.in[I_WO] + (size_t)l * 1024 * 1024;
            ld_src = 1024; col0 = nb * 32; dst = (bf16_t*)(ws + W_O3); ld_dst = 3072; dst_k0 = j * 1024; row0 = nb * 32; k0 = kb * 64; }
        else if ((r -= 3 * NI_O) < NI_GU) { const int nb = r % 176, kb = r / 176; const int n0 = nb * 32, up = n0 >= DFF ? 1 : 0, nn = n0 - up * DFF;
            src = F.in[I_WGU] + (size_t)l * 1024 * 5632; ld_src = 5632; col0 = n0; dst = (bf16_t*)(ws + W_GU); ld_dst = 1024; dst_k0 = 0; row0 = 256 * (nn / 128) + 128 * up + (nn % 128); k0 = kb * 64; }
        else { r -= NI_GU; const int nb = r % 32, kb = r / 32; src = F.in[I_WDOWN] + (size_t)l * DFF * 1024; ld_src = 1024; col0 = nb * 32; dst = (bf16_t*)(ws + W_DN); ld_dst = DFF; dst_k0 = 0; row0 = nb * 32; k0 = kb * 64; }
        transpose_item(src, ld_src, col0, dst, ld_dst, dst_k0, row0, k0, scr, F.lane);
    }
    { u32x4* z = (u32x4*)(ws + W_N + (size_t)2080 * 1024 * 2); const int n16 = 224 * 1024 * 2 / 16;
      for (int i = F.bid * NTHR + F.tid; i < n16; i += F.G * NTHR) z[i] = (u32x4){0u, 0u, 0u, 0u}; }
    __syncthreads();
    {
        LAS float* tile = (LAS float*)F.lds;
        LAS float* ctab = tile + 64 * 65;
        if (F.tid < 64) { ctab[F.tid] = cos_rev((float)F.tid / 64.0f); ctab[64 + F.tid] = sin_rev((float)F.tid / 64.0f); }
        for (int task = F.bid; task < 128; task += F.G) {
            const int kb = task >> 3, g = task & 7;
            __syncthreads();
            for (int i = F.tid; i < 4096; i += NTHR) { const int kk = i >> 6, cc = i & 63; tile[kk * 65 + cc] = w_in[(size_t)(kb * 64 + kk) * DIN + OFF_FN + g * 64 + cc]; }
            __syncthreads();
            const int kk = F.tid & 63, cq = F.tid >> 6;
#pragma unroll 1
            for (int j = 0; j < 8; ++j) { const int c = cq * 8 + j; float ac = 0.f, as = 0.f;
#pragma unroll 4
                for (int cp = 0; cp < 64; ++cp) { const float w = tile[kk * 65 + cp]; const int idx = (c * cp) & 63; ac += w * ctab[idx]; as += w * ctab[64 + idx]; }
                bf16_t* d = (bf16_t*)(ws + W_S);
                d[(size_t)(1536 + g * 64 + c) * 1024 + kb * 64 + kk] = (bf16_t)f2bf(ac);
                d[(size_t)(2048 + g * 64 + c) * 1024 + kb * 64 + kk] = (bf16_t)f2bf(as); }
        }
        __syncthreads();
    }
}
__device__ __forceinline__ void prep_filters(Frame& F, int l) {
    LAS float* zp = (LAS float*)F.lds;
    LAS float* h1 = zp + 64 * 33;
    LAS float* h2 = h1 + 64 * 64;
    LAS float* w1s = h2 + 64 * 64;
    LAS float* w2s = w1s + 33 * 64;
    const float* w1 = F.in[I_HW1] + l * 33 * 64; const float* b1 = F.in[I_HB1] + l * 64; const float* fq = F.in[I_HFREQ] + l * 64;
    const float* w2 = F.in[I_HW2] + l * 64 * 64; const float* b2 = F.in[I_HB2] + l * 64; const float* w3 = F.in[I_HW3] + (size_t)l * 64 * 2048;
    for (int task4 = F.G - 1 - F.bid; task4 < 144; task4 += F.G) {
        const int task = task4 >> 2, qsel = task4 & 3;
        const int L = task < 32 ? LLAT : LCTX, t0 = (task < 32 ? task : task - 32) * 64;
        float* fil = (float*)(F.ws + (task < 32 ? WS_FILL : WS_FILC));
        __syncthreads();
        for (int i = F.tid; i < 33 * 64; i += NTHR) w1s[i] = w1[i];
        for (int i = F.tid; i < 64 * 64; i += NTHR) w2s[i] = w2[i];
        for (int i = F.tid; i < 64 * 33; i += NTHR) { const int tt = i / 33, e = i % 33; const int ti = t0 + tt;
            float v;
            if (e == 0) v = (float)ti / (float)(L - 1);
            else { const int b = (e - 1) & 15; const float fr = 1e-4f + (15.0f - 1e-4f) * (float)b / 15.0f; const float rv = fr * ((float)ti / (float)L);
                   v = e <= 16 ? cos_rev(rv) : -sin_rev(rv); }
            zp[i] = v; }
        __syncthreads();
        for (int i = F.tid; i < 4096; i += NTHR) { const int tt = i >> 6, j = i & 63; float a = b1[j];
            for (int e = 0; e < 33; ++e) a += zp[tt * 33 + e] * w1s[e * 64 + j];
            h1[i] = sin_rad(fq[j] * a); }
        __syncthreads();
        for (int i = F.tid; i < 4096; i += NTHR) { const int tt = i >> 6, j = i & 63; float a = b2[j];
            for (int k = 0; k < 64; ++k) a += h1[tt * 64 + k] * w2s[k * 64 + j];
            h2[i] = sin_rad(fq[j] * a); }
        __syncthreads();
        { const int n = F.tid + 512 * qsel, c = n & 511;
            float wc[64];
#pragma unroll
            for (int k = 0; k < 64; ++k) wc[k] = w3[(size_t)k * 2048 + n];
            const float dmin = 4.605170185988091f / 1.5f, dmax = 4.605170185988091f / 0.3f;
            const float delta = dmin + (dmax - dmin) * (float)c / 511.0f;
            bf16_t* dst = (bf16_t*)fil + (size_t)n * L + t0;
#pragma unroll 1
            for (int tg = 0; tg < 64; tg += 8) { unsigned wv[4];
#pragma unroll
                for (int u2 = 0; u2 < 4; ++u2) { float vv[2];
#pragma unroll
                    for (int e = 0; e < 2; ++e) { const int tt = tg + 2 * u2 + e; float a = 0.f;
#pragma unroll
                        for (int k = 0; k < 64; ++k) a += h2[tt * 64 + k] * wc[k];
                        const float tl = (float)(t0 + tt) / (float)(L - 1); vv[e] = a * expf(-tl * delta); }
                    wv[u2] = pk2(vv[0], vv[1]); }
                *(u32x4*)(dst + tg) = (u32x4){wv[0], wv[1], wv[2], wv[3]}; } }
    }
    __syncthreads();
}
__device__ __forceinline__ void prep_mod(Frame& F) {
    LAS float* sc = (LAS float*)F.lds;
    LAS float* red = sc + 3 * 1024;
    __syncthreads();
    for (int i = F.tid; i < 3 * 1024; i += NTHR) { const int mi = i >> 10, k = i & 1023; const float v = mi == 0 ? F.in[I_CCTX][k] : F.in[I_C][(mi - 1) * 1024 + k]; sc[i] = v / (1.f + expf(-v)); }
    __syncthreads();
    float* mod = (float*)(F.ws + WS_MOD);
    for (int task = F.bid; task < 192; task += F.G) {
        const int l = task / 96, j = task % 96, n = j * 64 + F.lane;
        const float* w = F.in[I_WMOD] + (size_t)l * 1024 * 6144 + n;
        float a0 = 0.f, a1 = 0.f, a2 = 0.f;
        const int kb = F.wave * 128;
#pragma unroll 32
        for (int k = 0; k < 128; ++k) { const float wv = w[(size_t)(kb + k) * 6144]; a0 += sc[kb + k] * wv; a1 += sc[1024 + kb + k] * wv; a2 += sc[2048 + kb + k] * wv; }
        red[(F.wave * 3 + 0) * 64 + F.lane] = a0; red[(F.wave * 3 + 1) * 64 + F.lane] = a1; red[(F.wave * 3 + 2) * 64 + F.lane] = a2;
        __syncthreads();
        if (F.tid < 192) { const int mi = F.tid >> 6, ln = F.tid & 63; float s = F.in[I_BMOD][l * 6144 + j * 64 + ln];
            for (int w8 = 0; w8 < 8; ++w8) s += red[(w8 * 3 + mi) * 64 + ln];
            mod[((size_t)l * 3 + mi) * 6144 + j * 64 + ln] = s; }
        __syncthreads();
    }
}
__device__ __forceinline__ void prep_x_tables(Frame& F) {
    const int gt = F.bid * NTHR + F.tid, NG = F.G * NTHR;
    for (int i = gt; i < NTOK * DM / 4; i += NG) {
        const int row = i >> 8, c4 = (i & 255) * 4;
        f32x4 v;
        if (row < NCTX) v = *(const f32x4*)(F.in[I_XP] + (size_t)row * DM + c4);
        else { const int tt = row - NCTX, t = tt & 2047; v = *(const f32x4*)(F.in[I_XS] + (size_t)tt * DM + c4);
            const int seg = c4 >> 8; const float pos = (seg < 2) ? (float)(t >> 6) : (float)(t & 63);
#pragma unroll
            for (int u = 0; u < 4; ++u) { const int ii = (c4 + u) & 255; const float om = expf(-9.210340371976184f * (float)ii / 256.0f); const float a = pos * om;
                v[u] += (seg & 1) ? cos_rad(a) : sin_rad(a); } }
        *(f32x4*)(F.out + (size_t)row * DM + c4) = v;
    }
    for (int i = gt; i < 2048 * 4096 / 8; i += NG) { const int tp = i >> 9, k0 = (i & 511) * 8; unsigned w[4];
#pragma unroll
        for (int u = 0; u < 4; ++u) { float v[2];
#pragma unroll
            for (int e = 0; e < 2; ++e) { const int k = k0 + 2 * u + e; const int m = (tp * (k & 2047)) & 2047; const float x = (float)m / 2048.0f; v[e] = k < 2048 ? cos_rev(x) : -sin_rev(x); }
            w[u] = pk2(v[0], v[1]); }
        *(u32x4*)((bf16_t*)(F.ws + WS_TABL) + (size_t)tp * 4096 + k0) = (u32x4){w[0], w[1], w[2], w[3]}; }
    for (int i = gt; i < 256 * 512 / 8; i += NG) { const int tp = i >> 6, k0 = (i & 63) * 8; unsigned w[4];
#pragma unroll
        for (int u = 0; u < 4; ++u) { float v[2];
#pragma unroll
            for (int e = 0; e < 2; ++e) { const int k = k0 + 2 * u + e; const int m = (tp * (k & 255)) & 255; const float x = (float)m / 256.0f; v[e] = k < 256 ? cos_rev(x) : -sin_rev(x); }
            w[u] = pk2(v[0], v[1]); }
        *(u32x4*)((bf16_t*)(F.ws + WS_TABC) + (size_t)tp * 512 + k0) = (u32x4){w[0], w[1], w[2], w[3]}; }
}

__device__ __forceinline__ void phase_norm(Frame& F, const float* g, const float* modl, int sh_off, int sc_off, bf16_t* H) {
    const int gw = F.bid * NWAVES + F.wave, NGW = F.G * NWAVES;
    for (int row0 = gw; row0 < NTOK; row0 += 2 * NGW) {
        const int row1 = row0 + NGW < NTOK ? row0 + NGW : row0;
        const f32x4* xr0 = (const f32x4*)(F.out + (size_t)row0 * DM) + F.lane; const f32x4* xr1 = (const f32x4*)(F.out + (size_t)row1 * DM) + F.lane;
        f32x4 v0[4], v1[4]; float s0 = 0.f, s1 = 0.f;
#pragma unroll
        for (int j = 0; j < 4; ++j) { v0[j] = xr0[64 * j]; v1[j] = xr1[64 * j]; }
#pragma unroll
        for (int j = 0; j < 4; ++j) { s0 += (v0[j].x * v0[j].x + v0[j].y * v0[j].y) + (v0[j].z * v0[j].z + v0[j].w * v0[j].w); s1 += (v1[j].x * v1[j].x + v1[j].y * v1[j].y) + (v1[j].z * v1[j].z + v1[j].w * v1[j].w); }
        const float rstd0 = 1.0f / sqrtf(wave_sum(s0) * (1.f / DM) + EPS), rstd1 = 1.0f / sqrtf(wave_sum(s1) * (1.f / DM) + EPS);
        const float* mp0 = modl + (size_t)mod_idx(row0) * 6144; const float* mp1 = modl + (size_t)mod_idx(row1) * 6144;
        u32x2* o0 = (u32x2*)(H + (size_t)row0 * DM) + F.lane; u32x2* o1 = (u32x2*)(H + (size_t)row1 * DM) + F.lane;
#pragma unroll
        for (int j = 0; j < 4; ++j) { const int c = 4 * F.lane + 256 * j; const f32x4 gg = *(const f32x4*)(g + c);
            const f32x4 y0 = (v0[j] * rstd0) * gg * (*(const f32x4*)(mp0 + sc_off + c) + 1.0f) + *(const f32x4*)(mp0 + sh_off + c);
            const f32x4 y1 = (v1[j] * rstd1) * gg * (*(const f32x4*)(mp1 + sc_off + c) + 1.0f) + *(const f32x4*)(mp1 + sh_off + c);
            o0[64 * j] = (u32x2){pk2(y0.x, y0.y), pk2(y0.z, y0.w)};
            if (row1 != row0) o1[64 * j] = (u32x2){pk2(y1.x, y1.y), pk2(y1.z, y1.w)}; }
    }
}
__device__ __forceinline__ void phase_final(Frame& F) {
    const int gw = F.bid * NWAVES + F.wave, NGW = F.G * NWAVES; const float* g = F.in[I_NORMF];
    for (int row = gw; row < NTOK; row += NGW) {
        f32x4* xr = (f32x4*)(F.out + (size_t)row * DM) + F.lane;
        f32x4 v[4]; float s = 0.f;
#pragma unroll
        for (int j = 0; j < 4; ++j) { v[j] = xr[64 * j]; s += (v[j].x * v[j].x + v[j].y * v[j].y) + (v[j].z * v[j].z + v[j].w * v[j].w); }
        const float rstd = 1.0f / sqrtf(wave_sum(s) * (1.f / DM) + EPS);
#pragma unroll
        for (int j = 0; j < 4; ++j) { const int c = 4 * F.lane + 256 * j; const f32x4 gg = *(const f32x4*)(g + c); xr[64 * j] = (v[j] * rstd) * gg; }
    }
}

typedef float f32x16 __attribute__((ext_vector_type(16)));
constexpr int HY_X1 = 0, HY_X2 = 8192, HY_ZP1 = 16384, HY_ZP2 = 47104, HY_TR = 77824, HY_TRCOPY = 8256, HY_TRORD = 16512, HY_RED = 110848;
static_assert(HY_RED + 16384 <= RING_BYTES, "hyena LDS map");
__device__ __forceinline__ void hyena_task(Frame& F, int l, int c, int grp) {
    int tid_ = F.tid; asm volatile("" : "+v"(tid_));
    const int tid = tid_, lane = tid & 63, wave = __builtin_amdgcn_readfirstlane(tid >> 6);
    const int L = grp == 0 ? LLAT : LCTX, nb = L >> 5, ZSEQ = (3 * L / 32) * 40, row0 = grp == 0 ? NCTX : (grp - 1) * 4096;
    LAS unsigned char* lds = F.lds;
    const bf16_t* hyt = (const bf16_t*)(F.ws + WS_HYT);
    const float* cw = F.in[I_CONVHY] + (size_t)l * 3 * 1536;
    const float* fil = (const float*)(F.ws + (grp == 0 ? WS_FILL : WS_FILC));
    const float* hb = F.in[I_HBIAS] + (size_t)l * 2 * 512;
    PROF_DECL;
    __syncthreads();
    if (grp == 0) PROF_COUNT(4); else PROF_COUNT(5);
    PROF_BEGIN(1);
    {
        const int p = 8 * tid, t = p & (L - 1), qs = p / L;
#pragma unroll
        for (int st = 0; st < 3; ++st) { const int ch = st * 512 + c; const bf16_t* src = hyt + (size_t)ch * NTOK + row0 + p;
            const u32x4 rv = *(const u32x4*)src; const float xm_ = bf2f(src[t > 0 ? -1 : 0]), xp_ = bf2f(src[t + 8 < L ? 8 : 0]); const float xm = t > 0 ? xm_ : 0.f, xp = t + 8 < L ? xp_ : 0.f;
            const float w0 = cw[ch], w1 = cw[1536 + ch], w2 = cw[2 * 1536 + ch];
            const float x[10] = {xm, bflo(rv.x), bfhi(rv.x), bflo(rv.y), bfhi(rv.y), bflo(rv.z), bfhi(rv.z), bflo(rv.w), bfhi(rv.w), xp};
            float o[8];
#pragma unroll
            for (int e = 0; e < 8; ++e) o[e] = w0 * x[e] + w1 * x[e + 1] + w2 * x[e + 2];
            const u32x4 pk = (u32x4){pk2(o[0], o[1]), pk2(o[2], o[3]), pk2(o[4], o[5]), pk2(o[6], o[7])};
            if (st < 2) *(LAS u32x4*)(lds + (st == 0 ? HY_X1 : HY_X2) + p * 2) = pk;
            else *(LAS u32x4*)(lds + HY_ZP1 + (qs * ZSEQ + (nb + (t >> 5)) * 40 + (t & 31)) * 2) = pk; }
        const int npad = (4096 / L) * 2 * nb;
        for (int i2 = tid; i2 < 2 * npad * 5; i2 += NTHR) { const int img = i2 / (npad * 5), rem = i2 % (npad * 5), pbk = rem / 5, piece = rem % 5;
            const int qs2 = pbk / (2 * nb), bb = pbk % (2 * nb), blk = bb < nb ? bb : bb + nb;
            *(LAS u32x4*)(lds + (img == 0 ? HY_ZP1 : HY_ZP2) + (qs2 * ZSEQ + blk * 40) * 2 + piece * 16) = (u32x4){0u, 0u, 0u, 0u}; }
    }
    PROF_END(1); PROF_BEGIN(2);
    { const bf16_t* fb16 = (const bf16_t*)fil; const int npc = L / 8;
      for (int i2 = tid; i2 < 4 * npc; i2 += NTHR) { const int jd = i2 / npc, k = i2 % npc, o = jd >> 1, dirn = jd & 1;
          const u32x4 v = *(const u32x4*)(fb16 + ((size_t)jd * 512 + c) * L + 8 * k);
          LAS unsigned char* c0 = lds + HY_TR + o * HY_TRORD; LAS unsigned char* c1 = c0 + HY_TRCOPY;
          const unsigned e0 = v.x & 0xffffu, e1 = v.x >> 16, e2 = v.y & 0xffffu, e3 = v.y >> 16, e4 = v.z & 0xffffu, e5 = v.z >> 16, e6 = v.w & 0xffffu, e7 = v.w >> 16;
          if (dirn == 0) {
              const int p1 = L - 8 * k - 8;
              *(LAS u32x4*)(c1 + p1 * 2) = (u32x4){e7 | (e6 << 16), e5 | (e4 << 16), e3 | (e2 << 16), e1 | (e0 << 16)};
              const int p0 = L - 8 * k - 7;
              *(LAS unsigned short*)(c0 + p0 * 2) = (unsigned short)e7;
              *(LAS unsigned*)(c0 + (p0 + 1) * 2) = e6 | (e5 << 16); *(LAS unsigned*)(c0 + (p0 + 3) * 2) = e4 | (e3 << 16); *(LAS unsigned*)(c0 + (p0 + 5) * 2) = e2 | (e1 << 16);
              *(LAS unsigned short*)(c0 + (p0 + 7) * 2) = (unsigned short)e0;
          } else {
              const int q0 = L + 8 * k;
              if (k > 0) *(LAS u32x4*)(c0 + q0 * 2) = v;
              else { *(LAS unsigned short*)(c0 + (q0 + 1) * 2) = (unsigned short)e1; *(LAS unsigned*)(c0 + (q0 + 2) * 2) = v.y; *(LAS unsigned*)(c0 + (q0 + 4) * 2) = v.z; *(LAS unsigned*)(c0 + (q0 + 6) * 2) = v.w; }
              const int q1 = q0 - 1;
              if (k > 0) *(LAS unsigned short*)(c1 + q1 * 2) = (unsigned short)e0;
              *(LAS unsigned*)(c1 + (q1 + 1) * 2) = e1 | (e2 << 16); *(LAS unsigned*)(c1 + (q1 + 3) * 2) = e3 | (e4 << 16); *(LAS unsigned*)(c1 + (q1 + 5) * 2) = e5 | (e6 << 16);
              *(LAS unsigned short*)(c1 + (q1 + 7) * 2) = (unsigned short)e7;
          } } }
    __syncthreads();
    PROF_END(2); PROF_BEGIN(3);
    const int tile = wave & 3, half = wave >> 2, r = lane & 31, hh = lane >> 5, colg = 32 * tile + r;
    int qs, ib, imin, imax;
    if (grp == 0) { qs = colg >> 6; ib = colg & 63; imin = 32 * (tile & 1); imax = imin + 31; } else { qs = colg >> 3; ib = colg & 7; imin = 0; imax = 7; }
    const int dlo = imin - nb + 1, cnt = imax - imin + nb, mid = dlo + (cnt >> 1);
    const int d0 = half == 0 ? dlo : mid, d1 = half == 0 ? mid : dlo + cnt;
    const int par = r & 1;
    const int aoff = par * HY_TRCOPY + (L + 8 * hh - r - 32 * d0 - par) * 2;
    const int boff = (qs * ZSEQ + (nb + ib - d0) * 40 + 8 * hh) * 2;
    const float bias0 = hb[c] + bf2f(((const bf16_t*)fil)[((size_t)1 * 512 + c) * L]), bias1 = hb[512 + c] + bf2f(((const bf16_t*)fil)[((size_t)3 * 512 + c) * L]);
    bf16_t* yb = (bf16_t*)(F.ws + WS_YB);
#pragma unroll 1
    for (int o = 0; o < 2; ++o) {
        if (grp == 0) PROF_BEGIN(6);
        f32x16 acc;
#pragma unroll
        for (int e = 0; e < 16; ++e) acc[e] = 0.f;
        const LAS unsigned char* Ap = lds + HY_TR + o * HY_TRORD + aoff; const LAS unsigned char* Bp = lds + (o == 0 ? HY_ZP1 : HY_ZP2) + boff;
        f32x16 acc2;
#pragma unroll
        for (int e = 0; e < 16; ++e) acc2[e] = 0.f;
        u32x4 xa[4][2], ya[4][2]; bf16x8 xb[4][2], yb2[4][2];
#define HY_LD4(A, B) do { _Pragma("unroll") for (int u_ = 0; u_ < 4; ++u_) { const LAS unsigned* ap_ = (const LAS unsigned*)(Ap - 64 * u_); \
            A[u_][0] = (u32x4){ap_[0], ap_[1], ap_[2], ap_[3]}; A[u_][1] = (u32x4){ap_[8], ap_[9], ap_[10], ap_[11]}; \
            B[u_][0] = *(const LAS bf16x8*)(Bp - 80 * u_); B[u_][1] = *(const LAS bf16x8*)(Bp - 80 * u_ + 32); } Ap -= 256; Bp -= 320; } while (0)
#define HY_MM4(A, B) do { _Pragma("unroll") for (int u_ = 0; u_ < 4; ++u_) { acc = __builtin_amdgcn_mfma_f32_32x32x16_bf16(__builtin_bit_cast(bf16x8, A[u_][0]), B[u_][0], acc, 0, 0, 0); \
            acc2 = __builtin_amdgcn_mfma_f32_32x32x16_bf16(__builtin_bit_cast(bf16x8, A[u_][1]), B[u_][1], acc2, 0, 0, 0); } } while (0)
        const int ng = (d1 - d0) >> 2, nrem = (d1 - d0) & 3;
        HY_LD4(xa, xb);
#pragma unroll 1
        for (int g = 0;;) {
            __builtin_amdgcn_sched_barrier(0); if (g + 1 < ng) HY_LD4(ya, yb2); __builtin_amdgcn_sched_barrier(0); HY_MM4(xa, xb);
            if (++g >= ng) break;
            __builtin_amdgcn_sched_barrier(0); if (g + 1 < ng) HY_LD4(xa, xb); __builtin_amdgcn_sched_barrier(0); HY_MM4(ya, yb2);
            if (++g >= ng) break;
        }
#pragma unroll 1
        for (int rr = 0; rr < nrem; ++rr) { const LAS unsigned* ap_ = (const LAS unsigned*)Ap;
            const u32x4 q0 = (u32x4){ap_[0], ap_[1], ap_[2], ap_[3]}, q1 = (u32x4){ap_[8], ap_[9], ap_[10], ap_[11]};
            acc = __builtin_amdgcn_mfma_f32_32x32x16_bf16(__builtin_bit_cast(bf16x8, q0), *(const LAS bf16x8*)Bp, acc, 0, 0, 0);
            acc2 = __builtin_amdgcn_mfma_f32_32x32x16_bf16(__builtin_bit_cast(bf16x8, q1), *(const LAS bf16x8*)(Bp + 32), acc2, 0, 0, 0);
            Ap -= 64; Bp -= 80; }
#undef HY_LD4
#undef HY_MM4
#pragma unroll
        for (int e = 0; e < 16; ++e) acc[e] += acc2[e];
        if (grp == 0) { PROF_END(6); PROF_BEGIN(7); }
        LAS float* red = (LAS float*)(lds + HY_RED);
        if (half == 1) {
#pragma unroll
            for (int e = 0; e < 16; ++e) red[(tile * 16 + e) * 64 + lane] = acc[e]; }
        __syncthreads();
        if (half == 0) {
#pragma unroll
            for (int e = 0; e < 16; ++e) acc[e] += red[(tile * 16 + e) * 64 + lane];
#pragma unroll
            for (int g = 0; g < 4; ++g) { const int a4 = 8 * g + 4 * hh, p = qs * L + 32 * ib + a4, zo = (qs * ZSEQ + (nb + ib) * 40 + a4) * 2;
                const u32x2 gx = *(const LAS u32x2*)(lds + (o == 0 ? HY_X1 : HY_X2) + p * 2), zz = *(const LAS u32x2*)(lds + (o == 0 ? HY_ZP1 : HY_ZP2) + zo);
                const float gv[4] = {bflo(gx.x), bfhi(gx.x), bflo(gx.y), bfhi(gx.y)}, zv[4] = {bflo(zz.x), bfhi(zz.x), bflo(zz.y), bfhi(zz.y)};
                float y[4];
#pragma unroll
                for (int e = 0; e < 4; ++e) y[e] = gv[e] * (acc[4 * g + e] + (o == 0 ? bias0 : bias1) * zv[e]);
                if (o == 0) *(LAS u32x2*)(lds + HY_ZP2 + zo) = (u32x2){pk2(y[0], y[1]), pk2(y[2], y[3])};
                else {
#pragma unroll
                    for (int e = 0; e < 4; ++e) yb[(size_t)(row0 + p + e) * 512 + c] = (bf16_t)f2bf(y[e]); } }
        }
        __syncthreads();
        if (grp == 0) PROF_END(7);
    }
    PROF_END(3); PROF_FLUSH();
}

__device__ __forceinline__ int kpos32(int k) { return (k & ~31) | (((k >> 2) & 3) << 3) | (((k >> 4) & 1) << 2) | (k & 3); }
__device__ __forceinline__ size_t chunk_lin(int s, int n) { return (size_t)(s < 32 ? s * 4 + n : 128 + (s - 32) * 32 + n); }
constexpr int D1_GRP_BYTES = 61440;
__device__ __forceinline__ void d1_task(Frame& F, int l, int s, int h, int n) {
    int tid_ = F.tid; asm volatile("" : "+v"(tid_));
    const int tid = tid_, lane = tid & 63, wave = __builtin_amdgcn_readfirstlane(tid >> 6), lw = wave & 3, lt = tid & 255;
    LAS unsigned char* base = F.lds + (wave >> 2) * D1_GRP_BYTES;
    LAS bf16_t* qb = (LAS bf16_t*)base;
    LAS bf16_t* kb = qb + 64 * 72;
    LAS bf16_t* vb = kb + 64 * 72;
    LAS float* ATf = (LAS float*)(vb + 64 * 72);
    LAS float* ATb = ATf + 4096;
    LAS float* sm = ATb + 4096;
    LAS float* betaf = sm, *betab = sm + 64, *gcf = sm + 128, *gcb = sm + 192;
    const int L = seq_len(s), row0 = seq_start(s) + n * 64, tpos0 = n * 64;
    const bf16_t* qkv = (const bf16_t*)(F.ws + WS_QKV);
    const float* cw = F.in[I_CONVQKV] + (size_t)l * 3 * QKVW;
    const size_t cl = chunk_lin(s, n);
    PROF_DECL; PROF_BEGIN(40);
    float braw = 0.f, araw = 0.f, al = 0.f, dtb = 0.f;
    if (lw < 2) { const float* ba = (const float*)(F.ws + WS_BA) + (size_t)(row0 + lane) * 32; braw = ba[lw * 8 + h]; araw = ba[16 + lw * 8 + h];
        al = F.in[I_ALOG][l * 16 + lw * 8 + h]; dtb = F.in[I_DTB][l * 16 + lw * 8 + h]; }
    __syncthreads();
#pragma unroll 1
    for (int th2 = 0; th2 < 2 * NREP(14); ++th2) { const int th = th2 & 1;
        const int t = (lt >> 3) + 32 * th, sub = lt & 7, tp = tpos0 + t;
        const float m0 = tp > 0 ? 1.f : 0.f, m2 = tp < L - 1 ? 1.f : 0.f;
#pragma unroll
        for (int part = 0; part < 3; ++part) {
            const int ch = part * 512 + h * 64 + sub * 8;
            const bf16_t* src = qkv + (size_t)(row0 + t) * QKVW + ch;
            const u32x4 r1 = *(const u32x4*)src, r0 = *(const u32x4*)(tp > 0 ? src - QKVW : src), r2 = *(const u32x4*)(tp < L - 1 ? src + QKVW : src);
            const f32x4 w0a = *(const f32x4*)(cw + ch), w0b = *(const f32x4*)(cw + ch + 4), w1a = *(const f32x4*)(cw + QKVW + ch), w1b = *(const f32x4*)(cw + QKVW + ch + 4),
                        w2a = *(const f32x4*)(cw + 2 * QKVW + ch), w2b = *(const f32x4*)(cw + 2 * QKVW + ch + 4);
            const unsigned a0[4] = {r0.x, r0.y, r0.z, r0.w}, a1[4] = {r1.x, r1.y, r1.z, r1.w}, a2[4] = {r2.x, r2.y, r2.z, r2.w};
            const float w0[8] = {w0a[0], w0a[1], w0a[2], w0a[3], w0b[0], w0b[1], w0b[2], w0b[3]}, w1[8] = {w1a[0], w1a[1], w1a[2], w1a[3], w1b[0], w1b[1], w1b[2], w1b[3]},
                        w2[8] = {w2a[0], w2a[1], w2a[2], w2a[3], w2b[0], w2b[1], w2b[2], w2b[3]};
            float v[8]; float ss = 0.f;
#pragma unroll
            for (int e = 0; e < 8; ++e) { const float x0 = (e & 1) ? bfhi(a0[e >> 1]) : bflo(a0[e >> 1]), x1 = (e & 1) ? bfhi(a1[e >> 1]) : bflo(a1[e >> 1]), x2 = (e & 1) ? bfhi(a2[e >> 1]) : bflo(a2[e >> 1]);
                float a = x1 * w1[e] + m0 * x0 * w0[e] + m2 * x2 * w2[e]; a = a / (1.f + __expf(-a)); v[e] = a; ss += a * a; }
            if (part < 2) { ss += __shfl_xor(ss, 1); ss += __shfl_xor(ss, 2); ss += __shfl_xor(ss, 4);
                const float rs = (part == 0 ? 0.125f : 1.0f) / sqrtf(ss + EPS);
#pragma unroll
                for (int e = 0; e < 8; ++e) v[e] *= rs; }
            const u32x4 pk = (u32x4){pk2(v[0], v[1]), pk2(v[2], v[3]), pk2(v[4], v[5]), pk2(v[6], v[7])};
            *(LAS u32x4*)((part == 0 ? qb : (part == 1 ? kb : vb)) + t * 72 + sub * 8) = pk;
            if (part == 0) { bf16_t* qo = (bf16_t*)(F.ws + WS_QN) + (size_t)(row0 + t) * 512 + h * 64;
                *(u32x2*)(qo + kpos32(sub * 8)) = (u32x2){pk.x, pk.y}; *(u32x2*)(qo + kpos32(sub * 8 + 4)) = (u32x2){pk.z, pk.w}; }
        }
    }
    if (lw < 2) { const int dir = lw, t = lane;
        const float xx = araw + dtb; const float sp = xx > 20.f ? xx : log1pf(expf(xx));
        float a = -expf(al) * sp;
#pragma unroll
        for (int o = 1; o < 64; o <<= 1) { const float y = dir == 0 ? __shfl_up(a, o) : __shfl_down(a, o); if (dir == 0 ? (lane >= o) : (lane + o < 64)) a += y; }
        (dir == 0 ? betaf : betab)[t] = 1.f / (1.f + expf(-braw)); (dir == 0 ? gcf : gcb)[t] = a;
        ((float*)(F.ws + WS_GC))[((size_t)(dir * 8 + h) * 192 + cl) * 64 + t] = a; }
    __syncthreads();
    PROF_END(40); PROF_BEGIN(41);
    const size_t offF = ((size_t)(0 * 8 + h) * 192 + cl) * 4096, offB = ((size_t)(1 * 8 + h) * 192 + cl) * 4096;
    {
        const int ti = lw >> 1, tj = lw & 1, r = lane & 31, hh = lane >> 5, col = 32 * tj + r;
#pragma unroll 1
        for (int prod2 = 0; prod2 < 2 * NREP(15); ++prod2) { const int prod = prod2 & 1;
            const LAS bf16_t* Am = kb + (32 * ti + r) * 72 + 8 * hh; const LAS bf16_t* Bm = (prod == 0 ? kb : qb) + (32 * tj + r) * 72 + 8 * hh;
            f32x16 acc;
#pragma unroll
            for (int e = 0; e < 16; ++e) acc[e] = 0.f;
#pragma unroll
            for (int ks = 0; ks < 4; ++ks) acc = __builtin_amdgcn_mfma_f32_32x32x16_bf16(*(const LAS bf16x8*)(Am + 16 * ks), *(const LAS bf16x8*)(Bm + 16 * ks), acc, 0, 0, 0);
            if (prod == 0) {
                const int j = col; const float gfj = gcf[j], gbj = gcb[j];
#pragma unroll
                for (int g = 0; g < 4; ++g) { const int i4 = 32 * ti + 8 * g + 4 * hh; float ff[4], fb[4];
#pragma unroll
                    for (int e = 0; e < 4; ++e) { const int i = i4 + e; const float v = acc[4 * g + e];
                        ff[e] = i > j ? betaf[i] * v * __expf(gcf[i] - gfj) : 0.f; fb[e] = i < j ? betab[i] * v * __expf(gcb[i] - gbj) : 0.f; }
                    *(LAS f32x4*)(ATf + j * 64 + i4) = (f32x4){ff[0], ff[1], ff[2], ff[3]};
                    *(LAS f32x4*)(ATb + (63 - j) * 64 + (60 - i4)) = (f32x4){fb[3], fb[2], fb[1], fb[0]}; }
            } else {
                const int i = col; const float gfi = gcf[i], gbi = gcb[i]; bf16_t* QKo = (bf16_t*)(F.ws + WS_QK);
#pragma unroll
                for (int g = 0; g < 4; ++g) { const int j4 = 32 * ti + 8 * g + 4 * hh; float ff[4], fb[4];
#pragma unroll
                    for (int e = 0; e < 4; ++e) { const int j = j4 + e; const float v = acc[4 * g + e];
                        ff[e] = i >= j ? v * __expf(gfi - gcf[j]) : 0.f; fb[e] = i <= j ? v * __expf(gbi - gcb[j]) : 0.f; }
                    const int pj = kpos32(j4);
                    *(u32x2*)(QKo + offF + (size_t)i * 64 + pj) = (u32x2){pk2(ff[0], ff[1]), pk2(ff[2], ff[3])};
                    *(u32x2*)(QKo + offB + (size_t)i * 64 + pj) = (u32x2){pk2(fb[0], fb[1]), pk2(fb[2], fb[3])}; }
            }
        }
    }
    { const int d = lt >> 2, cg = lt & 3; bf16_t* kt = (bf16_t*)(F.ws + WS_KN) + ((size_t)h * 192 + cl) * 4096 + d * 64;
#pragma unroll
      for (int g = 0; g < 4; ++g) { const int c = 16 * cg + 4 * g;
          const unsigned w0 = (unsigned)kb[(c + 0) * 72 + d] | ((unsigned)kb[(c + 1) * 72 + d] << 16), w1 = (unsigned)kb[(c + 2) * 72 + d] | ((unsigned)kb[(c + 3) * 72 + d] << 16);
          *(u32x2*)(kt + kpos32(c)) = (u32x2){w0, w1}; } }
    __syncthreads();
    PROF_END(41); PROF_BEGIN(42);
#pragma unroll 1
    for (int srep = 0; srep < NREP(16); ++srep) {
        const int c = lane;
        int dmask = (lw >> 1) * 63, isw = lw & 1;
        asm volatile("" : "+v"(dmask), "+v"(isw));
        const bool bdir = dmask != 0, bw = isw != 0;
        const LAS float* AT = ATf + (bdir ? 4096 : 0) + c;
        const LAS float* bet = betaf + (bdir ? 64 : 0); const LAS float* gcc = gcf + (bdir ? 64 : 0);
        const LAS bf16_t* srcm = (bw ? kb : vb) + c;
        float x[64];
#pragma unroll
        for (int p = 0; p < 64; ++p) { const int t = p ^ dmask; const float be = bet[t]; const float eg = __expf(gcc[t]);
            x[p] = bf2f(srcm[t * 72]) * (bw ? be * eg : be); }
        float arow = AT[0];
#pragma unroll
        for (int j = 0; j < 63; ++j) { const float anext = AT[(j < 62 ? j + 1 : j) * 64]; const float xj = x[j];
#pragma unroll
            for (int i = j + 1; i < 64; ++i) { const float a = __builtin_bit_cast(float, __builtin_amdgcn_readlane(__builtin_bit_cast(int, arow), i)); x[i] -= a * xj; }
            arow = anext; }
        __builtin_amdgcn_sched_barrier(0);
        int dmask2 = dmask; asm volatile("" : "+v"(dmask2));
        const size_t offD = bdir ? offB : offF;
        if (!bw) {
            bf16_t* dst = (bf16_t*)(F.ws + WS_U) + offD + (size_t)c * 64;
#pragma unroll
            for (int g = 0; g < 8; ++g) { unsigned w[4];
#pragma unroll
                for (int k = 0; k < 4; ++k) { const float a = x[8 * g + 2 * k], b = x[8 * g + 2 * k + 1]; w[k] = pk2(bdir ? b : a, bdir ? a : b); }
                const u32x4 o = bdir ? (u32x4){w[3], w[2], w[1], w[0]} : (u32x4){w[0], w[1], w[2], w[3]};
                *(u32x4*)(dst + (bdir ? 56 - 8 * g : 8 * g)) = o; }
        } else {
            bf16_t* dst = (bf16_t*)(F.ws + WS_WW) + offD + kpos32(c);
#pragma unroll
            for (int p = 0; p < 64; ++p) dst[(p ^ dmask2) * 64] = (bf16_t)f2bf(-x[p]);
        }
    }
    PROF_END(42); PROF_FLUSH();
}

__device__ __forceinline__ bf16x8 pack8(const f32x4 a, const f32x4 b) {
    u32x4 w; w.x = pg8::cvt_pk_bf16(a[0], a[1]); w.y = pg8::cvt_pk_bf16(a[2], a[3]); w.z = pg8::cvt_pk_bf16(b[0], b[1]); w.w = pg8::cvt_pk_bf16(b[2], b[3]);
    return __builtin_bit_cast(bf16x8, w);
}
__device__ __forceinline__ void d2_wave_task(Frame& F, int l, int s, int h, int dir, int sl) {
    PROF_DECL; PROF_BEGIN(50);
    int lane_ = F.lane; asm volatile("" : "+v"(lane_));
    const int lane = lane_, r16 = lane & 15, q = lane >> 4, e0 = sl * 16;
    const int nch = s < 32 ? 4 : 32;
    LAS float* lo = (LAS float*)(F.lds + F.wave * 4608);
    f32x4 S[4];
#pragma unroll
    for (int t = 0; t < 4; ++t)
#pragma unroll
        for (int rg = 0; rg < 4; ++rg) { const int d = 16 * t + 4 * q + rg;
            S[t][rg] = s >= 32 ? F.in[I_STATE][((((size_t)(s - 32) * 2 + l) * 2 + dir) * 8 + h) * 4096 + d * 64 + e0 + r16] : 0.f; }
    const bf16_t* Wg = (const bf16_t*)(F.ws + WS_WW); const bf16_t* QKg = (const bf16_t*)(F.ws + WS_QK); const bf16_t* Ug = (const bf16_t*)(F.ws + WS_U);
    const bf16_t* QNg = (const bf16_t*)(F.ws + WS_QN); const bf16_t* KTg = (const bf16_t*)(F.ws + WS_KN); const float* GCg = (const float*)(F.ws + WS_GC);
    bf16_t* Og = (bf16_t*)(F.ws + (dir == 0 ? WS_OF : WS_OB));
    const int fo = r16 * 64 + 8 * q;
#pragma unroll 1
    for (int step = 0; step < nch; ++step) {
        const int n = dir == 0 ? step : nch - 1 - step; const size_t cl = chunk_lin(s, n);
        const size_t off = ((size_t)(dir * 8 + h) * 192 + cl) * 4096; const int tok0 = seq_start(s) + n * 64;
        const bf16_t* Wp = Wg + off + fo; const bf16_t* QKp = QKg + off + fo; const bf16_t* KTp = KTg + ((size_t)h * 192 + cl) * 4096 + fo;
        const bf16_t* Qp = QNg + (size_t)(tok0 + r16) * 512 + h * 64 + 8 * q; const bf16_t* Up = Ug + off + (size_t)(e0 + r16) * 64 + 4 * q;
        const float* gcp = GCg + ((size_t)(dir * 8 + h) * 192 + cl) * 64;
        bf16x8 Wf[4][2], Qf[4][2], QKf[4][2], KTf[4][2]; u32x2 Uv[4]; f32x4 gcv[4];
#pragma unroll
        for (int t = 0; t < 4; ++t) { Uv[t] = *(const u32x2*)(Up + 16 * t); gcv[t] = *(const f32x4*)(gcp + 16 * t + 4 * q);
#pragma unroll
            for (int ks = 0; ks < 2; ++ks) { Wf[t][ks] = *(const bf16x8*)(Wp + t * 1024 + 32 * ks); Qf[t][ks] = *(const bf16x8*)(Qp + (size_t)t * 16 * 512 + 32 * ks);
                QKf[t][ks] = *(const bf16x8*)(QKp + t * 1024 + 32 * ks); KTf[t][ks] = *(const bf16x8*)(KTp + t * 1024 + 32 * ks); } }
        const float gl = gcp[dir == 0 ? 63 : 0];
        bf16x8 Sb[2] = {pack8(S[0], S[1]), pack8(S[2], S[3])};
        f32x4 VN[4], O[4];
#pragma unroll
        for (int t = 0; t < 4; ++t) { VN[t] = (f32x4){bflo(Uv[t].x), bfhi(Uv[t].x), bflo(Uv[t].y), bfhi(Uv[t].y)}; O[t] = (f32x4){0.f, 0.f, 0.f, 0.f};
#pragma unroll
            for (int ks = 0; ks < 2; ++ks) { VN[t] = __builtin_amdgcn_mfma_f32_16x16x32_bf16(Wf[t][ks], Sb[ks], VN[t], 0, 0, 0); O[t] = __builtin_amdgcn_mfma_f32_16x16x32_bf16(Qf[t][ks], Sb[ks], O[t], 0, 0, 0); } }
        f32x4 VS[4];
#pragma unroll
        for (int t = 0; t < 4; ++t)
#pragma unroll
            for (int rg = 0; rg < 4; ++rg) { O[t][rg] *= __expf(gcv[t][rg]); VS[t][rg] = VN[t][rg] * __expf(gl - gcv[t][rg]); }
        const bf16x8 VNb[2] = {pack8(VN[0], VN[1]), pack8(VN[2], VN[3])}, VSb[2] = {pack8(VS[0], VS[1]), pack8(VS[2], VS[3])};
        const float egl = __expf(gl);
#pragma unroll
        for (int t = 0; t < 4; ++t) { S[t] = S[t] * egl;
#pragma unroll
            for (int ks = 0; ks < 2; ++ks) { O[t] = __builtin_amdgcn_mfma_f32_16x16x32_bf16(QKf[t][ks], VNb[ks], O[t], 0, 0, 0); S[t] = __builtin_amdgcn_mfma_f32_16x16x32_bf16(KTf[t][ks], VSb[ks], S[t], 0, 0, 0); } }
#pragma unroll
        for (int t = 0; t < 4; ++t)
#pragma unroll
            for (int rg = 0; rg < 4; ++rg) lo[(16 * t + 4 * q + rg) * 17 + r16] = O[t][rg];
        asm volatile("s_waitcnt lgkmcnt(0)" ::: "memory");
        { float ov[16];
#pragma unroll
          for (int e = 0; e < 16; ++e) ov[e] = lo[lane * 17 + e];
          bf16_t* op = Og + (size_t)(tok0 + lane) * 512 + h * 64 + e0;
          *(u32x4*)op = (u32x4){pk2(ov[0], ov[1]), pk2(ov[2], ov[3]), pk2(ov[4], ov[5]), pk2(ov[6], ov[7])};
          *(u32x4*)(op + 8) = (u32x4){pk2(ov[8], ov[9]), pk2(ov[10], ov[11]), pk2(ov[12], ov[13]), pk2(ov[14], ov[15])}; }
        asm volatile("s_waitcnt lgkmcnt(0)" ::: "memory");
    }
    if (s < 32) { float* so = F.out + (size_t)NTOK * DM + ((((size_t)s * 2 + l) * 2 + dir) * 8 + h) * 4096;
#pragma unroll
        for (int t = 0; t < 4; ++t)
#pragma unroll
            for (int rg = 0; rg < 4; ++rg) so[(16 * t + 4 * q + rg) * 64 + e0 + r16] = S[t][rg]; }
    PROF_END(50); PROF_FLUSH();
}

__device__ __forceinline__ void phase_combine(Frame& F, int l) {
    const bf16_t* of = (const bf16_t*)(F.ws + WS_OF); const bf16_t* ob = (const bf16_t*)(F.ws + WS_OB); const bf16_t* z = (const bf16_t*)(F.ws + WS_Z);
    bf16_t* ya = (bf16_t*)(F.ws + WS_YA); const float* na = F.in[I_NORMA] + l * 64;
    for (int i = F.bid * NTHR + F.tid; i < NTOK * 64; i += F.G * NTHR) {
        const size_t off = (size_t)i * 8; const int e0 = (i & 7) * 8;
        const u32x4 a = *(const u32x4*)(of + off), b = *(const u32x4*)(ob + off), zz = *(const u32x4*)(z + off);
        float o[8]; const unsigned aw[4] = {a.x, a.y, a.z, a.w}, bw[4] = {b.x, b.y, b.z, b.w}, zw[4] = {zz.x, zz.y, zz.z, zz.w};
        float ss = 0.f;
#pragma unroll
        for (int j = 0; j < 4; ++j) { o[2 * j] = bflo(aw[j]) + bflo(bw[j]); o[2 * j + 1] = bfhi(aw[j]) + bfhi(bw[j]); ss += o[2 * j] * o[2 * j] + o[2 * j + 1] * o[2 * j + 1]; }
        ss += __shfl_xor(ss, 1); ss += __shfl_xor(ss, 2); ss += __shfl_xor(ss, 4);
        const float rs = 1.0f / sqrtf(ss * (1.f / 64.f) + EPS);
        unsigned w[4];
#pragma unroll
        for (int j = 0; j < 4; ++j) { const float z0 = bflo(zw[j]), z1 = bfhi(zw[j]);
            w[j] = pk2(o[2 * j] * rs * na[e0 + 2 * j] * siluf_(z0), o[2 * j + 1] * rs * na[e0 + 2 * j + 1] * siluf_(z1)); }
        *(u32x4*)(ya + off) = (u32x4){w[0], w[1], w[2], w[3]};
    }
}

constexpr int N_PHASES = 26;
__global__ void __launch_bounds__(NTHR, 2) mk_fwd(Args args) {
    extern __shared__ __attribute__((aligned(16))) unsigned char lds_raw[];
    Frame F;
    F.lds = (LAS unsigned char*)lds_raw; F.in = args.in; F.out = args.out; F.ws = args.ws; F.ctl = (unsigned*)(args.ws + WS_CTL);
    F.tid = threadIdx.x; F.lane = F.tid & 63; F.wave = __builtin_amdgcn_readfirstlane(F.tid >> 6); F.G = gridDim.x; F.bid = blockIdx.x;
    for (int u = F.tid; u < (LDS_BYTES - LDSCTL_OFF) / 4; u += NTHR) ((LAS unsigned*)(F.lds + LDSCTL_OFF))[u] = 0u;
    __syncthreads();
    XcdBarrier bar; bar.bar = F.ctl + CW_BAR; bar.x = 0; bar.st = nullptr;
    if (!MK_PER_PHASE) bar = xcd_barrier_post(F.ctl + CW_BAR, (volatile LAS unsigned*)(F.lds + MISC_OFF) + 8);
    const int lo = args.ph_lo, hi = args.ph_hi;
    PROF_DECL;
    using namespace pg8;
#define IN(k) (lo <= (k) && (k) < hi)
#define SEAM(k) do { if (IN(k) && IN((k) + 1)) { if (!MK_PER_PHASE) xcd_barrier(bar); } } while (0)
#define PHASE_FRAME() Frame P = F; P.ws = opq(P.ws); P.out = opq(P.out); P.ctl = opq(P.ctl); asm volatile("" : "+v"(P.tid)); P.lane = P.tid & 63; P.wave = __builtin_amdgcn_readfirstlane(P.tid >> 6); \
    unsigned char* ws = P.ws; LAS unsigned char* ring = P.lds; (void)ws; (void)ring

    PROF_BEGIN(100);
    if (IN(0)) for (int rep = 0; rep < NREP(13); ++rep) { PHASE_FRAME(); PROF_BEGIN(120); prep_x_tables(P); __syncthreads(); PROF_END(120); PROF_BEGIN(121); prep_mod(P); __syncthreads(); PROF_END(121); PROF_BEGIN(122); prep_weights(P, 0); __syncthreads(); PROF_END(122); PROF_BEGIN(124); prep_filters(P, 0); __syncthreads(); PROF_END(124); }
    SEAM(0);
    PROF_END(100);
#pragma unroll 1
    for (int l = 0; l < 2; ++l) {
        const int pb = 1 + 12 * l;
#define MODL ((const float*)(ws + WS_MOD) + (size_t)l * 3 * 6144)
        PROF_BEGIN(101);
        if (IN(pb + 0)) { PHASE_FRAME(); if (l == 1) { PROF_BEGIN(130); prep_weights(P, 1); __syncthreads(); PROF_END(130); PROF_BEGIN(131); prep_filters(P, 1); __syncthreads(); PROF_END(131); }
            for (int rep = 0; rep < NREP(0); ++rep) phase_norm(P, P.in[I_N1G] + l * DM, MODL, 0, 1024, (bf16_t*)(ws + WS_H)); }
        SEAM(pb + 0);
        PROF_END(101);
        PROF_BEGIN(102);
        if (IN(pb + 1)) for (int rep = 0; rep < NREP(1); ++rep) { PHASE_FRAME();
            { Gemm g{1024, 2048, 2048}; Sched2D S{(const char*)(ws + WS_H), (const char*)(ws + W_N), (size_t)256 * 2048, (size_t)256 * 2048, 48, 9, P.G, P.bid, 0, 0};
              EpiInN E{(bf16_t*)(ws + WS_QKV), (bf16_t*)(ws + WS_Z), (float*)(ws + WS_BA)};
              gemm_phase<EpiInN, Sched2D, true, true>(ring, g, S, E); }
            { Gemm g{1024, 2048, 2048}; Sched2D S{(const char*)(ws + W_S), (const char*)(ws + WS_H), (size_t)256 * 2048, (size_t)256 * 2048, 10, 48, P.G, P.bid, 0, 0};
              EpiInS E{(bf16_t*)(ws + WS_HYT), (bf16_t*)(ws + WS_XCSL), (bf16_t*)(ws + WS_XCSC)};
              gemm_phase<EpiInS, Sched2D, true, true>(ring, g, S, E); }
        }
        SEAM(pb + 1);
        PROF_END(102);
        PROF_BEGIN(103);
        if (IN(pb + 2)) {
            { PHASE_FRAME(); Gemm g{2048, 8192, 8192}; SchedFourL S{(const char*)(ws + WS_TABL), (const char*)(ws + WS_XCSL), P.bid};
              EpiScaleBf16 E{(bf16_t*)(ws + WS_YF), 512, 1.0f};
              gemm_phase<EpiScaleBf16, SchedFourL, true, true>(ring, g, S, E); }
            { PHASE_FRAME(); Gemm g{512, 1024, 1024}; SchedFourC S{(const char*)(ws + WS_TABC), (const char*)(ws + WS_XCSC), P.bid - 64};
              EpiScaleBf16 E{(bf16_t*)(ws + WS_YC), 512, 1.0f / sqrtf(64.0f * 256.0f)};
              gemm_phase<EpiScaleBf16, SchedFourC, true, true>(ring, g, S, E); }
            for (int rep = 0; rep < NREP(2); ++rep) { PHASE_FRAME(); __syncthreads();
              const int xq = (int)(xb_xcc_id() & 7u), qid = 16 + (2 * l + rep) * 8 + xq;
              for (int t = q_next(P, qid); t < 192; t = q_next(P, qid)) {
                if (t < 64) hyena_task(P, l, 64 * xq + t, 0);
                else { const int tt = t - 64; hyena_task(P, l, 64 * xq + (tt >> 1), 1 + (tt & 1)); }
              } }
        }
        SEAM(pb + 2);
        PROF_END(103);
        PROF_BEGIN(104);
        if (IN(pb + 3)) for (int rep = 0; rep < NREP(3); ++rep) { PHASE_FRAME();
            for (int t0 = 2 * P.bid; t0 < 1536; t0 += 2 * P.G) { const int t = t0 + (P.wave >> 2);
                int s, h, n;
                if (t < 1024) { s = t >> 5; h = (t >> 2) & 7; n = t & 3; } else { const int tt = t - 1024; s = 32 + (tt >> 8); h = (tt >> 5) & 7; n = tt & 31; }
                d1_task(P, l, s, h, n);
            }
        }
        SEAM(pb + 3);
        PROF_END(104);
        PROF_BEGIN(105);
        if (IN(pb + 4)) for (int rep = 0; rep < NREP(4); ++rep) { PHASE_FRAME();
            const int gw = P.wave * P.G + P.bid, NW = NWAVES * P.G;
            if (gw < 128) { d2_wave_task(P, l, 32 + (gw >> 6), (gw >> 3) & 7, (gw >> 2) & 1, gw & 3); }
            else for (int tt = gw - 128; tt < 2048; tt += NW - 128) d2_wave_task(P, l, tt >> 6, (tt >> 3) & 7, (tt >> 2) & 1, tt & 3);
        }
        SEAM(pb + 4);
        PROF_END(105);
        PROF_BEGIN(106);
        if (IN(pb + 5)) { PHASE_FRAME();
            { const u32x4* p0 = (const u32x4*)(ws + WS_YF); const u32x4* p1 = p0 + 4096 * 512 / 8; bf16_t* yc = (bf16_t*)(ws + WS_YC) + (size_t)NCTX * 512; const float sc = 1.0f / sqrtf(64.0f * 2048.0f);
              for (int i = P.bid * NTHR + P.tid; i < 4096 * 512 / 8; i += P.G * NTHR) { const u32x4 a = p0[i], b = p1[i];
                  *(u32x4*)(yc + (size_t)i * 8) = (u32x4){pk2((bflo(a.x) + bflo(b.x)) * sc, (bfhi(a.x) + bfhi(b.x)) * sc), pk2((bflo(a.y) + bflo(b.y)) * sc, (bfhi(a.y) + bfhi(b.y)) * sc),
                                                          pk2((bflo(a.z) + bflo(b.z)) * sc, (bfhi(a.z) + bfhi(b.z)) * sc), pk2((bflo(a.w) + bflo(b.w)) * sc, (bfhi(a.w) + bfhi(b.w)) * sc)}; } }
            phase_combine(P, l); phase_norm(P, P.in[I_N1G] + l * DM, MODL, 0, 1024, (bf16_t*)(ws + WS_H)); }
        SEAM(pb + 5);
        PROF_END(106);
        PROF_BEGIN(107);
        if (IN(pb + 6)) for (int rep = 0; rep < NREP(6); ++rep) { PHASE_FRAME(); Gemm g{1024, 2048, 2048}; Sched2D S{(const char*)(ws + WS_H), (const char*)(ws + W_G), (size_t)256 * 2048, (size_t)256 * 2048, 48, 12, P.G, P.bid, 0, 0};
            EpiGate E{(bf16_t*)(ws + WS_GATE)};
            gemm_phase<EpiGate, Sched2D, true, true>(ring, g, S, E); }
        SEAM(pb + 6);
        PROF_END(107);
        PROF_BEGIN(108);
        if (IN(pb + 7)) {
            static_assert(WS_YB == WS_YA + 12 * MiB && WS_YC == WS_YB + 12 * MiB, "y buffers 12 MiB apart");
#pragma unroll 1
            for (int br = 0; br < 3; ++br) { PHASE_FRAME(); Gemm g{512, 1024, 1024};
                Sched2D S{(const char*)(ws + WS_YA + (size_t)br * 12 * MiB), (const char*)(ws + W_P + (size_t)br * MiB), (size_t)256 * 1024, (size_t)256 * 1024, 48, 4, P.G, P.bid, 0, 0};
                EpiMergeAcc E{(bf16_t*)(ws + WS_MRG), (const bf16_t*)(ws + WS_GATE), br * 1024, br == 0 ? 1 : 0};
                gemm_phase<EpiMergeAcc, Sched2D, true, true>(ring, g, S, E); }
        }
        SEAM(pb + 7);
        PROF_END(108);
        PROF_BEGIN(109);
        if (IN(pb + 8)) { PHASE_FRAME(); Gemm g{1024, 2048, 6144}; Sched2D S{(const char*)(ws + WS_MRG), (const char*)(ws + W_O3), (size_t)256 * 2048, (size_t)256 * 6144, 48, 4, P.G, P.bid, 0, 0};
            EpiResid E{P.out, MODL + 2048};
            gemm_phase<EpiResid, Sched2D, false, true>(ring, g, S, E); }
        SEAM(pb + 8);
        PROF_END(109);
        PROF_BEGIN(110);
        if (IN(pb + 9)) { PHASE_FRAME(); phase_norm(P, P.in[I_N2G] + l * DM, MODL, 3072, 4096, (bf16_t*)(ws + WS_H)); }
        SEAM(pb + 9);
        PROF_END(110);
        PROF_BEGIN(111);
        if (IN(pb + 10)) for (int rep = 0; rep < NREP(10); ++rep) { PHASE_FRAME(); Gemm g{1024, 2048, 2048}; Sched2D S{(const char*)(ws + WS_H), (const char*)(ws + W_GU), (size_t)256 * 2048, (size_t)256 * 2048, 48, 22, P.G, P.bid, 0, 0};
            EpiGU E{(bf16_t*)(ws + WS_ACT)};
            gemm_phase<EpiGU, Sched2D, true, true>(ring, g, S, E); }
        SEAM(pb + 10);
        PROF_END(111);
        PROF_BEGIN(112);
        if (IN(pb + 11)) { PHASE_FRAME(); Gemm g{DFF, DFF * 2, DFF * 2}; Sched2D S{(const char*)(ws + WS_ACT), (const char*)(ws + W_DN), (size_t)256 * DFF * 2, (size_t)256 * DFF * 2, 48, 4, P.G, P.bid, 0, 0};
            EpiResid E{P.out, MODL + 5120};
            gemm_phase<EpiResid, Sched2D, false, true>(ring, g, S, E); }
        SEAM(pb + 11);
        PROF_END(112);
    }
    PROF_BEGIN(113);
    if (IN(25)) { PHASE_FRAME(); phase_final(P); }
    PROF_END(113); PROF_FLUSH();
    if (PROBE_ID != 0) { __syncthreads();
        if (blockIdx.x == PROBE_BLK && threadIdx.x == 0) { const unsigned tot = *(volatile LAS unsigned*)(F.lds + MISC_OFF + 96); unsigned long long want = (unsigned long long)tot * PROBE_AMP; if (want > 3000000ull) want = 3000000ull;
            const unsigned long long t0 = __builtin_amdgcn_s_memrealtime(); while (__builtin_amdgcn_s_memrealtime() - t0 < want) __builtin_amdgcn_s_sleep(16); }
        __syncthreads(); }
#undef IN
#undef SEAM
}

extern "C" void kernel_launch(void* const* d_in, const int* in_sizes, int n_in, void* d_out, int out_size, void* d_ws, size_t ws_size, hipStream_t stream) {
    static int grid = 0;
    if (grid == 0) {
        if (n_in != N_IN || out_size != NTOK * DM + 32 * 2 * 2 * 8 * 4096 || ws_size < WS_END) { fprintf(stderr, "kernel_launch: unexpected shapes (n_in %d out %d ws %zu); nothing launched\n", n_in, out_size, ws_size); grid = -1; return; }
        int dev = 0, cus = 0, per_cu = 0;
        if (hipGetDevice(&dev) != hipSuccess || hipDeviceGetAttribute(&cus, hipDeviceAttributeMultiprocessorCount, dev) != hipSuccess) { grid = -1; return; }
        if (hipFuncSetAttribute((const void*)mk_fwd, hipFuncAttributeMaxDynamicSharedMemorySize, LDS_BYTES) != hipSuccess) { fprintf(stderr, "kernel_launch: hipFuncSetAttribute failed\n"); grid = -1; return; }
        if (hipOccupancyMaxActiveBlocksPerMultiprocessor(&per_cu, (const void*)mk_fwd, NTHR, LDS_BYTES) != hipSuccess || per_cu < 1) { fprintf(stderr, "kernel_launch: occupancy query says %d blocks per CU; nothing launched\n", per_cu); (void)hipGetLastError(); grid = -1; return; }
        grid = cus;
    }
    if (grid < 0) return;
    if (hipMemsetAsync((char*)d_ws + WS_CTL, 0, CTL_ZERO_BYTES, stream) != hipSuccess) return;
    Args a{};
    for (int i = 0; i < N_IN; ++i) a.in[i] = (const float*)d_in[i];
    a.out = (float*)d_out; a.ws = (unsigned char*)d_ws;
#if MK_PER_PHASE
    for (int p = 0; p < N_PHASES; ++p) { a.ph_lo = p; a.ph_hi = p + 1; a.li = 0; hipLaunchKernelGGL(mk_fwd, dim3(grid), dim3(NTHR), LDS_BYTES, stream, a); }
#else
    a.ph_lo = 0; a.ph_hi = N_PHASES; a.li = 0;
    hipLaunchKernelGGL(mk_fwd, dim3(grid), dim3(NTHR), LDS_BYTES, stream, a);
#endif
}
```

```cpp
#include <hip/hip_runtime.h>
#include <cstdio>
#include <cstdint>

#ifndef MK_PER_PHASE
#define MK_PER_PHASE 0
#endif

#ifndef REPMASK
#define REPMASK 0
#endif
#define NREP(k) (((REPMASK >> (k)) & 1) ? 2 : 1)
#ifndef PROBE_ID
#define PROBE_ID 0
#endif
#define PROBE_AMP 10
#ifndef PROBE_BLK
#define PROBE_BLK 150
#endif
#ifndef PROBE_BLK
#define PROBE_BLK 200
#endif
#define PROF_COUNT(id) do { if (PROBE_ID == (id) && blockIdx.x == PROBE_BLK && threadIdx.x == 0) { *PROF_WORD(0) = *PROF_WORD(0) + 1000u; } } while (0)
#ifndef PROBE_BLK
#define PROBE_BLK 200
#endif
#define PROF_COUNT(id) do { if (PROBE_ID == (id) && blockIdx.x == PROBE_BLK && threadIdx.x == 0) { *PROF_WORD(0) = *PROF_WORD(0) + 1000u; } } while (0)
#define PROF_WORD(i) ((volatile __attribute__((address_space(3))) unsigned*)(F.lds + MISC_OFF + 96 + 4 * (i)))
#define PROF_BEGIN(id) do { if (PROBE_ID == (id) && blockIdx.x == PROBE_BLK && threadIdx.x == 0) { *PROF_WORD(1) = (unsigned)__builtin_amdgcn_s_memrealtime(); } } while (0)
#define PROF_END(id) do { if (PROBE_ID == (id) && blockIdx.x == PROBE_BLK && threadIdx.x == 0) { asm volatile("s_waitcnt vmcnt(0) lgkmcnt(0)" ::: "memory"); *PROF_WORD(0) = *PROF_WORD(0) + ((unsigned)__builtin_amdgcn_s_memrealtime() - *PROF_WORD(1)); } } while (0)
#define LAS __attribute__((address_space(3)))
#define GAS __attribute__((address_space(1)))
typedef unsigned short bf16_t;
typedef short bf16x8 __attribute__((ext_vector_type(8)));
typedef float f32x4 __attribute__((ext_vector_type(4)));
typedef float f32x2 __attribute__((ext_vector_type(2)));
typedef unsigned u32x4 __attribute__((ext_vector_type(4)));
typedef unsigned u32x2 __attribute__((ext_vector_type(2)));

constexpr int DM = 1024, NTOK = 12288, NCTX = 8192, LCTX = 256, LLAT = 2048, BCTX = 32, BLAT = 2;
constexpr int HA = 8, QKVW = 1536, DFF = 2816, DIN = 7200;
constexpr int OFF_Z = 1536, OFF_B = 2048, OFF_HY = 2080, OFF_FN = 3616, OFF_GATE = 4128;
constexpr float EPS = 1e-6f;
enum { I_XP = 0, I_XS, I_STATE, I_C, I_CCTX, I_WMOD, I_BMOD, I_N1G, I_N2G, I_WIN, I_CONVQKV, I_ALOG, I_DTB, I_NORMA, I_CONVHY,
       I_HW1, I_HB1, I_HFREQ, I_HW2, I_HB2, I_HW3, I_HBIAS, I_WPA, I_WPB, I_WPC, I_WO, I_WGU, I_WDOWN, I_NORMF, N_IN };

constexpr size_t MiB = 1u << 20;
constexpr size_t WS_CTL = 0, CTL_ZERO_BYTES = 256 * 1024;
constexpr size_t WS_MOD = 1 * MiB;
constexpr size_t WS_B0 = 1 * MiB + 512 * 1024;
constexpr size_t WS_TABC = 2 * MiB;
constexpr size_t WS_FILC = 3 * MiB;
constexpr size_t WS_FILL = 5 * MiB;
constexpr size_t WS_YF = 13 * MiB;
constexpr size_t WS_TABL = 21 * MiB;
constexpr size_t WS_W = 37 * MiB;
constexpr size_t W_N = WS_W;
constexpr size_t W_S = W_N + 2304 * 1024 * 2;
constexpr size_t W_G = W_S + 2560 * 1024 * 2;
constexpr size_t W_P = W_G + 3072 * 1024 * 2;
constexpr size_t W_O3 = W_P + 3 * 1024 * 512 * 2;
constexpr size_t W_GU = W_O3 + 1024 * 3072 * 2;
constexpr size_t W_DN = W_GU + 5632 * 1024 * 2;
constexpr size_t W_END = W_DN + 1024 * 2816 * 2;
static_assert(W_END <= 78 * MiB, "weights region");
constexpr size_t WS_A0 = 78 * MiB;
constexpr size_t WS_QKV = WS_A0, WS_OF = WS_A0, WS_OB = WS_A0 + 12 * MiB, WS_MRG = WS_A0;
constexpr size_t WS_Z = 116 * MiB, WS_YA = WS_Z;
constexpr size_t WS_BA = 114 * MiB;
constexpr size_t WS_YB = 128 * MiB, WS_YC = 140 * MiB;
constexpr size_t WS_A5 = 152 * MiB;
constexpr size_t WS_H = WS_A5;
constexpr size_t WS_HYT = WS_A5 + 24 * MiB;
constexpr size_t WS_XCS = WS_A5 + 60 * MiB;
constexpr size_t WS_XCSL = WS_XCS, WS_XCSC = WS_XCS + 8 * MiB;
constexpr size_t WS_QN = WS_A5, WS_KN = WS_A5 + 12 * MiB;
constexpr size_t WS_U = WS_A5 + 24 * MiB;
constexpr size_t WS_WW = WS_A5 + 48 * MiB;
constexpr size_t WS_QK = WS_A5 + 72 * MiB;
constexpr size_t WS_GC = WS_A5 + 96 * MiB;
constexpr size_t WS_GATE = WS_A5 + 24 * MiB;
constexpr size_t WS_ACT = WS_A5 + 24 * MiB;
constexpr size_t WS_END = 256 * MiB;
static_assert(WS_GC + 2 * 8 * 192 * 64 * 4 <= WS_END && WS_GATE + (size_t)NTOK * 3072 * 2 <= WS_END, "ws map");
constexpr int CW_BAR = 4096;
constexpr int CW_Q = 16384;

constexpr int RING_BYTES = 131072, LDSCTL_OFF = RING_BYTES, MISC_OFF = LDSCTL_OFF + 320, LDS_BYTES = 147456;
constexpr int NWAVES = 8, NTHR = 512;

#define RLX_AGENT __ATOMIC_RELAXED, __HIP_MEMORY_SCOPE_AGENT
#define LDS_WAIT() asm volatile("s_waitcnt lgkmcnt(0)" ::: "memory")
__device__ __forceinline__ unsigned f2bf(float f) { unsigned u = __builtin_bit_cast(unsigned, f); return (u + 0x7fffu + ((u >> 16) & 1u)) >> 16; }
__device__ __forceinline__ unsigned pk2(float lo, float hi) { return f2bf(lo) | (f2bf(hi) << 16); }
__device__ __forceinline__ float bf2f(unsigned short b) { return __builtin_bit_cast(float, (unsigned)b << 16); }
__device__ __forceinline__ float bflo(unsigned w) { return __builtin_bit_cast(float, w << 16); }
__device__ __forceinline__ float bfhi(unsigned w) { return __builtin_bit_cast(float, w & 0xffff0000u); }
__device__ __forceinline__ float sin_rev(float r) { return __builtin_amdgcn_sinf(r - rintf(r)); }
__device__ __forceinline__ float cos_rev(float r) { return __builtin_amdgcn_cosf(r - rintf(r)); }
__device__ __forceinline__ float sin_rad(float x) { return sin_rev(x * 0.15915494309189535f); }
__device__ __forceinline__ float cos_rad(float x) { return cos_rev(x * 0.15915494309189535f); }
__device__ __forceinline__ float sigmoidf_(float x) { return 1.f / (1.f + __expf(-x)); }
__device__ __forceinline__ float siluf_(float x) { return x / (1.f + __expf(-x)); }
__device__ __forceinline__ float wave_sum(float v) {
#pragma unroll
    for (int o = 1; o < 64; o <<= 1) v += __shfl_xor(v, o);
    return v;
}
template <class T> __device__ __forceinline__ T* opq(T* p) {
    unsigned lo = (unsigned)(uintptr_t)p, hi = (unsigned)((uintptr_t)p >> 32); asm volatile("" : "+v"(lo), "+v"(hi));
    lo = __builtin_amdgcn_readfirstlane(lo); hi = __builtin_amdgcn_readfirstlane(hi); return (T*)(((uintptr_t)hi << 32) | (uintptr_t)lo);
}
__device__ __forceinline__ float dpp_f(float x, int ctrl_tag) {
    const int v = __builtin_bit_cast(int, x); int r;
    if (ctrl_tag == 0) r = __builtin_amdgcn_update_dpp(0, v, 0xB1, 0xF, 0xF, true);
    else if (ctrl_tag == 1) r = __builtin_amdgcn_update_dpp(0, v, 0x4E, 0xF, 0xF, true);
    else r = __builtin_amdgcn_update_dpp(0, v, 0x141, 0xF, 0xF, true);
    return __builtin_bit_cast(float, r);
}
__device__ __forceinline__ float sum8(float s) { s += dpp_f(s, 0); s += dpp_f(s, 1); s += dpp_f(s, 2); return s; }
__device__ __forceinline__ float lane_read(float x, int srclane) { return __builtin_bit_cast(float, __builtin_amdgcn_ds_bpermute(srclane << 2, __builtin_bit_cast(int, x))); }
__device__ __forceinline__ int seq_start(int s) { return s < 32 ? s * 256 : NCTX + (s - 32) * 2048; }
__device__ __forceinline__ int seq_len(int s) { return s < 32 ? 256 : 2048; }
__device__ __forceinline__ int mod_idx(int row) { return row < NCTX ? 0 : 1 + ((row - NCTX) >> 11); }

namespace pg8 {
constexpr int BM = 256, BK = 64, HALF = 128, HTB = HALF * BK * 2, STAGE_BYTES = 8 * HTB, NXCD = 8, WGM = 8;
__host__ __device__ __forceinline__ int lds_byte(int r, int c) { const int st = (r >> 4) * 2 + (c >> 5), rr = r & 15, cc = c & 31, ob = rr * 64 + cc * 2; return st * 1024 + (ob ^ (((ob >> 9) & 1) << 5)); }
__host__ __device__ __forceinline__ void stage_rc(int b, int& R, int& C) { const int st = b / 1024, sb = b % 1024, swz = sb ^ (((sb >> 9) & 1) << 5); R = (st >> 1) * 16 + swz / 64; C = (st & 1) * 32 + (swz % 64) / 2; }
__host__ __device__ __forceinline__ int perm32(int rho) { const int n = rho >> 4, i = rho & 15; return 8 * (i >> 2) + 4 * n + (i & 3); }

struct Unit { const char* a; const char* b; int r0, c0; };
struct Gemm { int K, lda, ldb; };

__device__ __forceinline__ bool static_order(long L, int nM, int nN, int& pm, int& pn) {
    const int nwg = nM * nN; if (L >= nwg) return false;
    int wgid = (int)L; { const int q = nwg / NXCD, r = nwg % NXCD, xcd = wgid % NXCD, off = wgid / NXCD; wgid = (xcd < r ? xcd * (q + 1) : r * (q + 1) + (xcd - r) * q) + off; }
    const int nig = WGM * nN, gid = wgid / nig, fm = gid * WGM, gsz = (nM - fm) < WGM ? (nM - fm) : WGM;
    pm = fm + ((wgid % nig) % gsz); pn = (wgid % nig) / gsz; return true;
}
__device__ __forceinline__ unsigned cvt_pk_bf16(float lo, float hi) { unsigned r; asm volatile("v_cvt_pk_bf16_f32 %0, %1, %2" : "=v"(r) : "v"(lo), "v"(hi)); return r; }

template <class Epi, class Sched, bool ALIGN_EPI, bool SP2>
__device__ __forceinline__ void gemm_phase(LAS unsigned char* lds, const Gemm g, const Sched& S, const Epi& E) {
    int tid_ = threadIdx.x; asm volatile("" : "+v"(tid_));
    const int tid = tid_, wid = __builtin_amdgcn_readfirstlane(tid >> 6), lane = tid & 63, wr = wid >> 2, wc = wid & 3, fr = lane & 15, fq = lane >> 4;
    const int K = g.K, nt = K / BK;
    unsigned voffA[2], voffB[2];
#pragma unroll
    for (int i = 0; i < 2; ++i) { int R, C; stage_rc(tid * 16 + i * 8192, R, C); const int Rb = Epi::PERM ? ((R & ~31) + perm32(R & 31)) : R;
        voffA[i] = (unsigned)(R * g.lda + C * 2); voffB[i] = (unsigned)(Rb * g.ldb + C * 2); }
    const size_t kstep = (size_t)(BK * 2);
    const size_t hstepA = (size_t)HALF * g.lda, hstepB = (size_t)HALF * g.ldb;
    const unsigned ldsw = (unsigned)wid * 1024u;
    const int aoff = lds_byte(wr * 64 + fr, fq * 8), boff = lds_byte(wc * 32 + fr, fq * 8);
#define PG8_SA(b, h) (((b) * 2 + (h)) * HTB)
#define PG8_SB(b, h) ((4 + (b) * 2 + (h)) * HTB)
#define PG8_STAGE(bufoff, gbase, voff) do { _Pragma("unroll") for (int _i = 0; _i < 2; ++_i) \
        __builtin_amdgcn_global_load_lds((const unsigned*)((const char*)(gbase) + (voff)[_i]), (LAS unsigned*)(lds + (bufoff) + ldsw + _i * 8192), 16, 0, 0); } while (0)
#define PG8_LDA(dst, b, h) do { _Pragma("unroll") for (int m = 0; m < 4; ++m) _Pragma("unroll") for (int k = 0; k < 2; ++k) dst[m][k] = *(const LAS bf16x8*)(lds + PG8_SA(b, h) + aoff + m * 2048 + k * 1024); } while (0)
#define PG8_LDB(dst, b, h) do { _Pragma("unroll") for (int n = 0; n < 2; ++n) _Pragma("unroll") for (int k = 0; k < 2; ++k) dst[n][k] = *(const LAS bf16x8*)(lds + PG8_SB(b, h) + boff + n * 2048 + k * 1024); } while (0)
#define PG8_MMA(ai, bj, At, Bt) do { __builtin_amdgcn_s_setprio(1); _Pragma("unroll") for (int m = 0; m < 4; ++m) _Pragma("unroll") for (int n = 0; n < 2; ++n) _Pragma("unroll") for (int k = 0; k < 2; ++k) \
        acc[ai][bj][m][n] = __builtin_amdgcn_mfma_f32_16x16x32_bf16(Bt[n][k], At[m][k], acc[ai][bj][m][n], 0, 0, 0); __builtin_amdgcn_s_setprio(0); } while (0)
#define PG8_WAIT_V(n) asm volatile("s_waitcnt vmcnt(" #n ")" ::: "memory")
#define PG8_WAIT_L(n) asm volatile("s_waitcnt lgkmcnt(" #n ")" ::: "memory")
#define PG8_BAR __builtin_amdgcn_s_barrier()
#define PG8_SCHED __builtin_amdgcn_sched_barrier(0)
    Unit cur, nxt; int ui = 0;
    if (!S.next(0, cur)) return;
    f32x4 acc[2][2][4][2];
#pragma unroll
    for (int a = 0; a < 2; ++a)
#pragma unroll
        for (int b = 0; b < 2; ++b)
#pragma unroll
            for (int m = 0; m < 4; ++m)
#pragma unroll
                for (int n = 0; n < 2; ++n) acc[a][b][m][n] = (f32x4){0.f, 0.f, 0.f, 0.f};
    bf16x8 At[4][2], B0[2][2], B1[2][2];
    const char* cA = cur.a; const char* cB = cur.b;
    if constexpr (SP2) {
        PG8_STAGE(PG8_SB(0, 0), cB, voffB); PG8_STAGE(PG8_SB(0, 1), cB + hstepB, voffB); PG8_STAGE(PG8_SA(0, 0), cA, voffA); PG8_STAGE(PG8_SA(0, 1), cA + hstepA, voffA);
        if (wr == 1) PG8_BAR;
        PG8_WAIT_V(2); PG8_BAR;
        PG8_STAGE(PG8_SB(1, 0), cB + kstep, voffB); PG8_STAGE(PG8_SA(1, 0), cA + kstep, voffA); PG8_STAGE(PG8_SB(1, 1), cB + hstepB + kstep, voffB);
        PG8_WAIT_V(6); PG8_BAR;
    } else {
        PG8_STAGE(PG8_SB(0, 0), cB, voffB); PG8_STAGE(PG8_SA(0, 0), cA, voffA); PG8_STAGE(PG8_SB(0, 1), cB + hstepB, voffB); PG8_STAGE(PG8_SA(0, 1), cA + hstepA, voffA);
        if (wr == 1) PG8_BAR;
        PG8_WAIT_V(4); PG8_BAR;
        PG8_STAGE(PG8_SB(1, 0), cB + kstep, voffB); PG8_STAGE(PG8_SA(1, 0), cA + kstep, voffA); PG8_STAGE(PG8_SB(1, 1), cB + hstepB + kstep, voffB);
        PG8_WAIT_V(6); PG8_BAR;
    }
    for (;;) {
        const bool has_next = S.next(ui + 1, nxt);
        const char* nA = has_next ? nxt.a : cA; const char* nB = has_next ? nxt.b : cB;
        for (int t = 0; t < nt; t += 2) {
            const bool last = (t == nt - 2);
            const char* a1 = cA + (size_t)(t + 1) * kstep;
            const char* a2 = last ? nA : cA + (size_t)(t + 2) * kstep; const char* b2 = last ? nB : cB + (size_t)(t + 2) * kstep;
            const char* a3 = a2 + kstep; const char* b3 = b2 + kstep;
            if constexpr (SP2) {
            PG8_LDB(B0, 0, 0); PG8_LDB(B1, 0, 1); PG8_SCHED; PG8_LDA(At, 0, 0); PG8_STAGE(PG8_SA(1, 1), a1 + hstepA, voffA);
            PG8_WAIT_V(8); PG8_WAIT_L(0); PG8_BAR; PG8_MMA(0, 0, At, B0); PG8_MMA(0, 1, At, B1); PG8_BAR; PG8_SCHED;
            PG8_LDA(At, 0, 1); PG8_STAGE(PG8_SB(0, 0), b2, voffB); PG8_STAGE(PG8_SB(0, 1), b2 + hstepB, voffB); PG8_STAGE(PG8_SA(0, 0), a2, voffA);
            PG8_WAIT_V(8); PG8_WAIT_L(0); PG8_BAR; PG8_MMA(1, 0, At, B0); PG8_MMA(1, 1, At, B1); PG8_BAR; PG8_SCHED;
            PG8_LDB(B0, 1, 0); PG8_LDB(B1, 1, 1); PG8_SCHED; PG8_LDA(At, 1, 0); PG8_STAGE(PG8_SA(0, 1), a2 + hstepA, voffA);
            PG8_WAIT_V(8); PG8_WAIT_L(0); PG8_BAR; PG8_MMA(0, 0, At, B0); PG8_MMA(0, 1, At, B1); PG8_BAR; PG8_SCHED;
            PG8_LDA(At, 1, 1); PG8_STAGE(PG8_SB(1, 0), b3, voffB); PG8_STAGE(PG8_SB(1, 1), b3 + hstepB, voffB); PG8_STAGE(PG8_SA(1, 0), a3, voffA);
            PG8_WAIT_V(8); PG8_WAIT_L(0); PG8_BAR; PG8_MMA(1, 0, At, B0); PG8_MMA(1, 1, At, B1); PG8_BAR; PG8_SCHED;
            } else {
            PG8_LDB(B0, 0, 0); PG8_SCHED; PG8_LDA(At, 0, 0); PG8_STAGE(PG8_SA(1, 1), a1 + hstepA, voffA);
            PG8_WAIT_L(8); PG8_BAR; PG8_WAIT_L(0); PG8_MMA(0, 0, At, B0); PG8_BAR; PG8_SCHED;
            PG8_LDB(B1, 0, 1); PG8_STAGE(PG8_SB(0, 0), b2, voffB);
            PG8_BAR; PG8_WAIT_L(0); PG8_MMA(0, 1, At, B1); PG8_BAR;
            PG8_LDA(At, 0, 1); PG8_STAGE(PG8_SA(0, 0), a2, voffA);
            PG8_BAR; PG8_WAIT_L(0); PG8_MMA(1, 0, At, B0); PG8_BAR; PG8_SCHED;
            PG8_STAGE(PG8_SB(0, 1), b2 + hstepB, voffB);
            PG8_WAIT_V(6); PG8_BAR; PG8_MMA(1, 1, At, B1); PG8_BAR;
            PG8_LDB(B0, 1, 0); PG8_SCHED; PG8_LDA(At, 1, 0); PG8_STAGE(PG8_SA(0, 1), a2 + hstepA, voffA);
            PG8_WAIT_L(8); PG8_BAR; PG8_WAIT_L(0); PG8_MMA(0, 0, At, B0); PG8_BAR; PG8_SCHED;
            PG8_LDB(B1, 1, 1); PG8_STAGE(PG8_SB(1, 0), b3, voffB);
            PG8_BAR; PG8_WAIT_L(0); PG8_MMA(0, 1, At, B1); PG8_BAR;
            PG8_LDA(At, 1, 1); PG8_STAGE(PG8_SA(1, 0), a3, voffA);
            PG8_BAR; PG8_WAIT_L(0); PG8_MMA(1, 0, At, B0); PG8_BAR; PG8_SCHED;
            PG8_STAGE(PG8_SB(1, 1), b3 + hstepB, voffB);
            PG8_WAIT_V(6); PG8_BAR; PG8_MMA(1, 1, At, B1); PG8_BAR;
            }
        }
        if constexpr (ALIGN_EPI) { if (wr == 0) PG8_BAR; }
        E(acc, cur, wr, wc, fr, fq);
        if (!has_next) break;
#pragma unroll
        for (int a = 0; a < 2; ++a)
#pragma unroll
            for (int b = 0; b < 2; ++b)
#pragma unroll
                for (int m = 0; m < 4; ++m)
#pragma unroll
                    for (int n = 0; n < 2; ++n) acc[a][b][m][n] = (f32x4){0.f, 0.f, 0.f, 0.f};
        cur = nxt; cA = nA; cB = nB; ++ui;
        if constexpr (ALIGN_EPI) { if (wr == 1) PG8_BAR; }
    }
    PG8_WAIT_V(0);
    if constexpr (!ALIGN_EPI) { if (wr == 0) PG8_BAR; }
    PG8_BAR;
#undef PG8_SA
#undef PG8_SB
#undef PG8_STAGE
#undef PG8_LDA
#undef PG8_LDB
#undef PG8_MMA
#undef PG8_WAIT_V
#undef PG8_WAIT_L
#undef PG8_BAR
#undef PG8_SCHED
}

struct Sched2D {
    const char* A; const char* B; size_t atile, btile; int nM, nN, G, c, r_base, c_base;
    __device__ __forceinline__ bool next(int i, Unit& u) const {
        if (c < 0) return false;
        int pm, pn; if (!static_order((long)i * G + c, nM, nN, pm, pn)) return false;
        u.a = A + (size_t)pm * atile; u.b = B + (size_t)pn * btile; u.r0 = r_base + pm * 256; u.c0 = c_base + pn * 256; return true;
    }
};
struct SchedMerge {
    const char *y0, *w0; int G, c;
    __device__ __forceinline__ bool next(int i, Unit& u) const {
        int pm, pn; if (!static_order((long)i * G + c, 48, 12, pm, pn)) return false;
        const int br = pn >> 2; const char* y = y0 + (size_t)br * (12u << 20); const char* w = w0 + (size_t)br * (1u << 20);
        u.a = y + (size_t)pm * 256 * 512 * 2; u.b = w + (size_t)(pn & 3) * 256 * 512 * 2; u.r0 = pm * 256; u.c0 = pn * 256; return true;
    }
};
struct SchedFourL {
    const char* tab; const char* xcs; int c;
    __device__ __forceinline__ bool next(int i, Unit& u) const {
        if (i > 0 || c < 0 || c >= 64) return false;
        const int ks = c >> 5, b = (c >> 4) & 1, pm = (c & 15) >> 1, pn = c & 1;
        u.a = tab + (size_t)pm * 256 * 4096 * 2 + (size_t)ks * 2048 * 2; u.b = xcs + ((size_t)b * 512 + pn * 256) * 4096 * 2 + (size_t)ks * 2048 * 2; u.r0 = ks * 4096 + b * 2048 + pm * 256; u.c0 = pn * 256; return true;
    }
};
struct SchedFourC {
    const char* tab; const char* xcs; int c;
    __device__ __forceinline__ bool next(int i, Unit& u) const {
        if (i > 0 || c < 0 || c >= 64) return false;
        const int b = c >> 1, pn = c & 1;
        u.a = tab; u.b = xcs + ((size_t)b * 512 + pn * 256) * 512 * 2; u.r0 = b * 256; u.c0 = pn * 256; return true;
    }
};

typedef f32x4 Acc[2][2][4][2];
struct EpiInN {
    static constexpr bool PERM = true;
    bf16_t* qkv; bf16_t* z; float* ba;
    __device__ __forceinline__ void operator()(const Acc& acc, const Unit& u, int wr, int wc, int fr, int fq) const {
        const int colt = u.c0;
#pragma unroll
        for (int ai = 0; ai < 2; ++ai)
#pragma unroll
            for (int m = 0; m < 4; ++m) { const int row = u.r0 + ai * HALF + wr * 64 + m * 16 + fr;
#pragma unroll
                for (int bj = 0; bj < 2; ++bj) { const int col = colt + bj * HALF + wc * 32 + 8 * fq; const f32x4 v0 = acc[ai][bj][m][0], v1 = acc[ai][bj][m][1];
                    if (colt < 2048) { u32x4 w; w.x = cvt_pk_bf16(v0[0], v0[1]); w.y = cvt_pk_bf16(v0[2], v0[3]); w.z = cvt_pk_bf16(v1[0], v1[1]); w.w = cvt_pk_bf16(v1[2], v1[3]);
                        bf16_t* p = colt < 1536 ? qkv + (size_t)row * 1536 + col : z + (size_t)row * 512 + (col - 1536);
                        *(u32x4*)p = w; }
                    else if (col - 2048 < 32) { float* p = ba + (size_t)row * 32 + (col - 2048); *(f32x4*)p = v0; *(f32x4*)(p + 4) = v1; } } }
    }
};
struct EpiInS {
    static constexpr bool PERM = true;
    bf16_t* hyt; bf16_t* xcsl; bf16_t* xcsc;
    __device__ __forceinline__ void operator()(const Acc& acc, const Unit& u, int wr, int wc, int fr, int fq) const {
#pragma unroll
        for (int ai = 0; ai < 2; ++ai)
#pragma unroll
            for (int m = 0; m < 4; ++m) { const int ch = u.r0 + ai * HALF + wr * 64 + m * 16 + fr;
#pragma unroll
                for (int bj = 0; bj < 2; ++bj) { const int tok = u.c0 + bj * HALF + wc * 32 + 8 * fq; const f32x4 v0 = acc[ai][bj][m][0], v1 = acc[ai][bj][m][1];
                    u32x4 w; w.x = cvt_pk_bf16(v0[0], v0[1]); w.y = cvt_pk_bf16(v0[2], v0[3]); w.z = cvt_pk_bf16(v1[0], v1[1]); w.w = cvt_pk_bf16(v1[2], v1[3]);
                    bf16_t* p;
                    if (ch < 1536) p = hyt + (size_t)ch * NTOK + tok;
                    else { const int cc = ch - 1536, which = cc >> 9, n = cc & 511;
                        if (tok < NCTX) { const int b = tok >> 8, t = tok & 255; p = xcsc + ((size_t)(b * 512 + n) * 512 + which * 256 + t); }
                        else { const int tt = tok - NCTX, b = tt >> 11, t = tt & 2047; p = xcsl + ((size_t)(b * 512 + n) * 4096 + which * 2048 + t); } }
                    *(u32x4*)p = w; } }
    }
};
struct EpiScaleBf16 {
    static constexpr bool PERM = true;
    bf16_t* O; int ldc; float scale;
    __device__ __forceinline__ void operator()(const Acc& acc, const Unit& u, int wr, int wc, int fr, int fq) const {
#pragma unroll
        for (int ai = 0; ai < 2; ++ai)
#pragma unroll
            for (int m = 0; m < 4; ++m) { const int row = u.r0 + ai * HALF + wr * 64 + m * 16 + fr;
#pragma unroll
                for (int bj = 0; bj < 2; ++bj) { const int col = u.c0 + bj * HALF + wc * 32 + 8 * fq; const f32x4 v0 = acc[ai][bj][m][0] * scale, v1 = acc[ai][bj][m][1] * scale;
                    u32x4 w; w.x = cvt_pk_bf16(v0[0], v0[1]); w.y = cvt_pk_bf16(v0[2], v0[3]); w.z = cvt_pk_bf16(v1[0], v1[1]); w.w = cvt_pk_bf16(v1[2], v1[3]);
                    *(u32x4*)(O + (size_t)row * ldc + col) = w; } }
    }
};
struct EpiAtomicF32 {
    static constexpr bool PERM = false;
    float* C; int ldc;
    __device__ __forceinline__ void operator()(const Acc& acc, const Unit& u, int wr, int wc, int fr, int fq) const {
#pragma unroll
        for (int ai = 0; ai < 2; ++ai)
#pragma unroll
            for (int m = 0; m < 4; ++m) { float* rowp = C + (size_t)(u.r0 + ai * HALF + wr * 64 + m * 16 + fr) * ldc + u.c0 + wc * 32 + 4 * fq;
#pragma unroll
                for (int bj = 0; bj < 2; ++bj)
#pragma unroll
                    for (int n = 0; n < 2; ++n)
#pragma unroll
                        for (int e = 0; e < 4; ++e) unsafeAtomicAdd(rowp + bj * HALF + n * 16 + e, acc[ai][bj][m][n][e]); }
    }
};
struct EpiGate {
    static constexpr bool PERM = true;
    bf16_t* O;
    __device__ __forceinline__ void operator()(const Acc& acc, const Unit& u, int wr, int wc, int fr, int fq) const {
#pragma unroll
        for (int ai = 0; ai < 2; ++ai)
#pragma unroll
            for (int m = 0; m < 4; ++m) { const int row = u.r0 + ai * HALF + wr * 64 + m * 16 + fr;
#pragma unroll
                for (int bj = 0; bj < 2; ++bj) { const int col = u.c0 + bj * HALF + wc * 32 + 8 * fq; const f32x4 v0 = acc[ai][bj][m][0], v1 = acc[ai][bj][m][1];
                    u32x4 w; w.x = cvt_pk_bf16(sigmoidf_(v0[0]), sigmoidf_(v0[1])); w.y = cvt_pk_bf16(sigmoidf_(v0[2]), sigmoidf_(v0[3]));
                    w.z = cvt_pk_bf16(sigmoidf_(v1[0]), sigmoidf_(v1[1])); w.w = cvt_pk_bf16(sigmoidf_(v1[2]), sigmoidf_(v1[3]));
                    *(u32x4*)(O + (size_t)row * 3072 + col) = w; } }
    }
};
struct EpiMerge {
    static constexpr bool PERM = true;
    bf16_t* O;
    __device__ __forceinline__ void operator()(const Acc& acc, const Unit& u, int wr, int wc, int fr, int fq) const {
#pragma unroll
        for (int ai = 0; ai < 2; ++ai)
#pragma unroll
            for (int m = 0; m < 4; ++m) { const int row = u.r0 + ai * HALF + wr * 64 + m * 16 + fr;
#pragma unroll
                for (int bj = 0; bj < 2; ++bj) { const int col = u.c0 + bj * HALF + wc * 32 + 8 * fq; const f32x4 v0 = acc[ai][bj][m][0], v1 = acc[ai][bj][m][1];
                    bf16_t* p = O + (size_t)row * 3072 + col; const u32x4 gg = *(const u32x4*)p;
                    u32x4 w; w.x = cvt_pk_bf16(v0[0] * bflo(gg.x), v0[1] * bfhi(gg.x)); w.y = cvt_pk_bf16(v0[2] * bflo(gg.y), v0[3] * bfhi(gg.y));
                    w.z = cvt_pk_bf16(v1[0] * bflo(gg.z), v1[1] * bfhi(gg.z)); w.w = cvt_pk_bf16(v1[2] * bflo(gg.w), v1[3] * bfhi(gg.w));
                    *(u32x4*)p = w; } }
    }
};
struct EpiMergeAcc {
    static constexpr bool PERM = true;
    bf16_t* M; const bf16_t* G; int gcol0; int first;
    __device__ __forceinline__ void operator()(const Acc& acc, const Unit& u, int wr, int wc, int fr, int fq) const {
#pragma unroll
        for (int ai = 0; ai < 2; ++ai)
#pragma unroll
            for (int m = 0; m < 4; ++m) { const int row = u.r0 + ai * HALF + wr * 64 + m * 16 + fr;
#pragma unroll
                for (int bj = 0; bj < 2; ++bj) { const int col = u.c0 + bj * HALF + wc * 32 + 8 * fq; const f32x4 v0 = acc[ai][bj][m][0], v1 = acc[ai][bj][m][1];
                    const u32x4 gg = *(const u32x4*)(G + (size_t)row * 3072 + gcol0 + col); bf16_t* p = M + (size_t)row * 1024 + col;
                    float o[8] = {v0[0] * bflo(gg.x), v0[1] * bfhi(gg.x), v0[2] * bflo(gg.y), v0[3] * bfhi(gg.y), v1[0] * bflo(gg.z), v1[1] * bfhi(gg.z), v1[2] * bflo(gg.w), v1[3] * bfhi(gg.w)};
                    if (!first) { const u32x4 mm = *(const u32x4*)p; o[0] += bflo(mm.x); o[1] += bfhi(mm.x); o[2] += bflo(mm.y); o[3] += bfhi(mm.y); o[4] += bflo(mm.z); o[5] += bfhi(mm.z); o[6] += bflo(mm.w); o[7] += bfhi(mm.w); }
                    u32x4 w; w.x = cvt_pk_bf16(o[0], o[1]); w.y = cvt_pk_bf16(o[2], o[3]); w.z = cvt_pk_bf16(o[4], o[5]); w.w = cvt_pk_bf16(o[6], o[7]);
                    *(u32x4*)p = w; } }
    }
};
struct EpiResid {
    static constexpr bool PERM = false;
    float* X; const float* gate;
    __device__ __forceinline__ void operator()(const Acc& acc, const Unit& u, int wr, int wc, int fr, int fq) const {
        const float* gp = gate + (size_t)mod_idx(u.r0) * 6144;
#pragma unroll
        for (int bj = 0; bj < 2; ++bj)
#pragma unroll
            for (int n = 0; n < 2; ++n) { const int col = u.c0 + bj * HALF + wc * 32 + 16 * n + 4 * fq; const f32x4 gv = *(const f32x4*)(gp + col);
#pragma unroll
                for (int ai = 0; ai < 2; ++ai)
#pragma unroll
                    for (int m = 0; m < 4; ++m) { const int row = u.r0 + ai * HALF + wr * 64 + m * 16 + fr; float* p = X + (size_t)row * DM + col;
                        const f32x4 x = *(const f32x4*)p; *(f32x4*)p = x + gv * acc[ai][bj][m][n]; } }
    }
};
struct EpiGU {
    static constexpr bool PERM = true;
    bf16_t* O;
    __device__ __forceinline__ void operator()(const Acc& acc, const Unit& u, int wr, int wc, int fr, int fq) const {
        const int col = (u.c0 >> 1) + wc * 32 + 8 * fq;
#pragma unroll
        for (int ai = 0; ai < 2; ++ai)
#pragma unroll
            for (int m = 0; m < 4; ++m) { const int row = u.r0 + ai * HALF + wr * 64 + m * 16 + fr;
                const f32x4 g0 = acc[ai][0][m][0], g1 = acc[ai][0][m][1], u0 = acc[ai][1][m][0], u1 = acc[ai][1][m][1];
                u32x4 w; w.x = cvt_pk_bf16(siluf_(g0[0]) * u0[0], siluf_(g0[1]) * u0[1]); w.y = cvt_pk_bf16(siluf_(g0[2]) * u0[2], siluf_(g0[3]) * u0[3]);
                w.z = cvt_pk_bf16(siluf_(g1[0]) * u1[0], siluf_(g1[1]) * u1[1]); w.w = cvt_pk_bf16(siluf_(g1[2]) * u1[2], siluf_(g1[3]) * u1[3]);
                *(u32x4*)(O + (size_t)row * DFF + col) = w; }
    }
};
}

#define XB_TMO      128
#define XB_XCNT(j)  (256  + 64 * (j))
#define XB_XSUB(j)  (1280 + 64 * (j))
#define XB_XGEN(j)  (2304 + 64 * (j))
#define XB_TOP      3328
#define XB_TOPGEN   3392
#define XCD_BAR_WORDS 3456
#define XB_SPIN_CAP (1u << 18)
__device__ __forceinline__ unsigned xb_ld(unsigned* p)              { return __hip_atomic_load(p, __ATOMIC_RELAXED, __HIP_MEMORY_SCOPE_AGENT); }
__device__ __forceinline__ unsigned xb_add(unsigned* p, unsigned v) { return __hip_atomic_fetch_add(p, v, __ATOMIC_RELAXED, __HIP_MEMORY_SCOPE_AGENT); }
__device__ __forceinline__ unsigned xb_xcc_id() { return (unsigned)__builtin_amdgcn_s_getreg((3 << 11) | 20) & 0xFu; }
#define XB_SPIN(cond, bar) do { unsigned _sp = 0; while (cond) { __builtin_amdgcn_s_sleep(1); \
    if ((++_sp & 255u) == 0u) { if (xb_ld(&(bar)[XB_TMO])) break; if (_sp > XB_SPIN_CAP) { atomicAdd(&(bar)[XB_TMO], 1u); break; } } } } while (0)
struct XcdBarrier { unsigned* bar; unsigned x; volatile LAS unsigned* st; };
__device__ __forceinline__ XcdBarrier xcd_barrier_post(unsigned* bar, volatile LAS unsigned* st) {
    XcdBarrier b; b.bar = bar; b.x = xb_xcc_id(); b.st = st;
    if (threadIdx.x == 0) (void)xb_add(&bar[XB_XCNT(b.x)], 1u);
    return b;
}
__device__ __forceinline__ void xcd_barrier_complete(unsigned* bar, unsigned x, unsigned& nloc, unsigned& nx) {
    const unsigned G = gridDim.x * gridDim.y * gridDim.z;
    unsigned sum, cnt, mine, sp = 0u;
    for (;;) {
        sum = 0u; cnt = 0u; mine = 0u;
#pragma unroll 1
        for (unsigned j = 0; j < 16; ++j) { const unsigned c = xb_ld(&bar[XB_XCNT(j)]); sum += c; cnt += (c > 0u) ? 1u : 0u; mine = (j == x) ? c : mine; }
        if (sum == G) break;
        __builtin_amdgcn_s_sleep(1);
        if ((++sp & 255u) == 0u) { if (xb_ld(&bar[XB_TMO])) break; if (sp > XB_SPIN_CAP) { atomicAdd(&bar[XB_TMO], 1u); break; } }
    }
    nloc = mine > 0u ? mine : 1u; nx = cnt > 0u ? cnt : 1u;
}
__device__ __forceinline__ void xcd_barrier(const XcdBarrier& b) {
    asm volatile("s_waitcnt vmcnt(0)" ::: "memory");
    __syncthreads();
    if (threadIdx.x == 0) {
        unsigned* bar = opq(b.bar);
        __builtin_amdgcn_s_waitcnt(0);
        unsigned nloc = b.st[0], nx = b.st[1];
        if (nloc == 0u) { xcd_barrier_complete(bar, b.x, nloc, nx); b.st[0] = nloc; b.st[1] = nx; }
        const unsigned old = xb_add(&bar[XB_XSUB(b.x)], 1u);
        const unsigned gen = old / nloc;
        if (old + 1u == (gen + 1u) * nloc) {
            __builtin_amdgcn_fence(__ATOMIC_RELEASE, "agent");
            asm volatile("s_waitcnt vmcnt(0)" ::: "memory");
            const unsigned og = xb_add(&bar[XB_TOP], 1u);
            const unsigned tg = og / nx;
            if (og + 1u == (tg + 1u) * nx) xb_add(&bar[XB_TOPGEN], 1u);
            else XB_SPIN(xb_ld(&bar[XB_TOPGEN]) == tg, bar);
            __builtin_amdgcn_fence(__ATOMIC_ACQUIRE, "agent");
            xb_add(&bar[XB_XGEN(b.x)], 1u);
            asm volatile("s_waitcnt vmcnt(0)" ::: "memory");
        } else {
            XB_SPIN(xb_ld(&bar[XB_XGEN(b.x)]) == gen, bar);
            __builtin_amdgcn_fence(__ATOMIC_ACQUIRE, "agent");
            asm volatile("s_waitcnt vmcnt(0)" ::: "memory");
        }
    }
    __syncthreads();
}

struct Args { const float* in[N_IN]; float* out; unsigned char* ws; int ph_lo, ph_hi, li, pad; };
struct Frame {
    LAS unsigned char* lds; const float* const* in; float* out; unsigned char* ws; unsigned* ctl;
    int tid, lane, wave, G, bid;
};
#define PROF_DECL do {} while (0)
#define PROF_FLUSH() do {} while (0)
__device__ __forceinline__ int q_next(Frame& F, int qid) {
    volatile LAS int* slot = (volatile LAS int*)(F.lds + MISC_OFF + 64);
    __syncthreads();
    if (F.tid == 0) *slot = (int)__hip_atomic_fetch_add(F.ctl + CW_Q + 64 * qid, 1u, RLX_AGENT);
    __syncthreads();
    return *slot;
}

__device__ __forceinline__ void transpose_item(const float* W, int ld_src, int col0, bf16_t* WT, int ld_dst, int dst_k0, int row0, int k0, LAS float* scr, int lane) {
    float tv[32];
#pragma unroll
    for (int i = 0; i < 32; ++i) tv[i] = W[(size_t)(k0 + 2 * i + (lane >> 5)) * ld_src + col0 + (lane & 31)];
#pragma unroll
    for (int i = 0; i < 32; ++i) scr[(2 * i + (lane >> 5)) * 33 + (lane & 31)] = tv[i];
    LDS_WAIT(); asm volatile("" ::: "memory");
    const int c = lane & 7;
#pragma unroll
    for (int j = 0; j < 4; ++j) { const int n = (lane >> 3) + 8 * j; const LAS float* s = scr + (8 * c) * 33 + n;
        u32x4 o; o.x = pk2(s[0 * 33], s[1 * 33]); o.y = pk2(s[2 * 33], s[3 * 33]); o.z = pk2(s[4 * 33], s[5 * 33]); o.w = pk2(s[6 * 33], s[7 * 33]);
        *(u32x4*)(WT + (size_t)(row0 + n) * ld_dst + dst_k0 + k0 + 8 * c) = o; }
    LDS_WAIT(); asm volatile("" ::: "memory");
}
__device__ __forceinline__ void prep_weights(Frame& F, int l) {
    LAS float* scr = (LAS float*)(F.lds + F.wave * 16384);
    const int gw = F.bid * NWAVES + F.wave, NGW = F.G * NWAVES;
    const float* w_in = F.in[I_WIN] + (size_t)l * DM * DIN;
    unsigned char* ws = F.ws;
    constexpr int NI_QKVZBA = 16 * (2080 / 32), NI_HY = 16 * 48, NI_G = 16 * 96, NI_P = 8 * 32, NI_O = 16 * 32, NI_GU = 16 * 176, NI_DN = 44 * 32;
    constexpr int NITEMS = NI_QKVZBA + NI_HY + NI_G + 3 * NI_P + 3 * NI_O + NI_GU + NI_DN;
#pragma unroll 1
    for (int it = gw; it < NITEMS; it += NGW) {
        int r = it;
        const float* src; int ld_src, col0, ld_dst, dst_k0, row0, k0; bf16_t* dst;
        if (r < NI_QKVZBA) { const int nb = r % 65, kb = r / 65; src = w_in; ld_src = DIN; col0 = nb * 32; dst = (bf16_t*)(ws + W_N); ld_dst = 1024; dst_k0 = 0; row0 = nb * 32; k0 = kb * 64; }
        else if ((r -= NI_QKVZBA) < NI_HY) { const int nb = r % 48, kb = r / 48; src = w_in; ld_src = DIN; col0 = OFF_HY + nb * 32; dst = (bf16_t*)(ws + W_S); ld_dst = 1024; dst_k0 = 0; row0 = nb * 32; k0 = kb * 64; }
        else if ((r -= NI_HY) < NI_G) { const int nb = r % 96, kb = r / 96; src = w_in; ld_src = DIN; col0 = OFF_GATE + nb * 32; dst = (bf16_t*)(ws + W_G); ld_dst = 1024; dst_k0 = 0; row0 = nb * 32; k0 = kb * 64; }
        else if ((r -= NI_G) < 3 * NI_P) { const int j = r / NI_P, q = r % NI_P, nb = q % 32, kb = q / 32; src = (j == 0 ? F.in[I_WPA] : (j == 1 ? F.in[I_WPB] : F.in[I_WPC])) + (size_t)l * 512 * 1024;
            ld_src = 1024; col0 = nb * 32; dst = (bf16_t*)(ws + W_P) + (size_t)j * 1024 * 512; ld_dst = 512; dst_k0 = 0; row0 = nb * 32; k0 = kb * 64; }
        else if ((r -= 3 * NI_P) < 3 * NI_O) { const int j = r / NI_O, q = r % NI_O, nb = q % 32, kb = q / 32; src = F.in[I_WO] + (size_t)l * 1024 * 1024;
            ld_src = 1024; col0 = nb * 32; dst = (bf16_t*)(ws + W_O3); ld_dst = 3072; dst_k0 = j * 1024; row0 = nb * 32; k0 = kb * 64; }
        else if ((r -= 3 * NI_O) < NI_GU) { const int nb = r % 176, kb = r / 176; const int n0 = nb * 32, up = n0 >= DFF ? 1 : 0, nn = n0 - up * DFF;
            src = F.in[I_WGU] + (size_t)l * 1024 * 5632; ld_src = 5632; col0 = n0; dst = (bf16_t*)(ws + W_GU); ld_dst = 1024; dst_k0 = 0; row0 = 256 * (nn / 128) + 128 * up + (nn % 128); k0 = kb * 64; }
        else { r -= NI_GU; const int nb = r % 32, kb = r / 32; src = F.in[I_WDOWN] + (size_t)l * DFF * 1024; ld_src = 1024; col0 = nb * 32; dst = (bf16_t*)(ws + W_DN); ld_dst = DFF; dst_k0 = 0; row0 = nb * 32; k0 = kb * 64; }
        transpose_item(src, ld_src, col0, dst, ld_dst, dst_k0, row0, k0, scr, F.lane);
    }
    { u32x4* z = (u32x4*)(ws + W_N + (size_t)2080 * 1024 * 2); const int n16 = 224 * 1024 * 2 / 16;
      for (int i = F.bid * NTHR + F.tid; i < n16; i += F.G * NTHR) z[i] = (u32x4){0u, 0u, 0u, 0u}; }
    __syncthreads();
    {
        LAS float* tile = (LAS float*)F.lds;
        LAS float* ctab = tile + 64 * 65;
        if (F.tid < 64) { ctab[F.tid] = cos_rev((float)F.tid / 64.0f); ctab[64 + F.tid] = sin_rev((float)F.tid / 64.0f); }
        for (int task = F.bid; task < 128; task += F.G) {
            const int kb = task >> 3, g = task & 7;
            __syncthreads();
            for (int i = F.tid; i < 4096; i += NTHR) { const int kk = i >> 6, cc = i & 63; tile[kk * 65 + cc] = w_in[(size_t)(kb * 64 + kk) * DIN + OFF_FN + g * 64 + cc]; }
            __syncthreads();
            const int kk = F.tid & 63, cq = F.tid >> 6;
#pragma unroll 1
            for (int j = 0; j < 8; ++j) { const int c = cq * 8 + j; float ac = 0.f, as = 0.f;
#pragma unroll 4
                for (int cp = 0; cp < 64; ++cp) { const float w = tile[kk * 65 + cp]; const int idx = (c * cp) & 63; ac += w * ctab[idx]; as += w * ctab[64 + idx]; }
                bf16_t* d = (bf16_t*)(ws + W_S);
                d[(size_t)(1536 + g * 64 + c) * 1024 + kb * 64 + kk] = (bf16_t)f2bf(ac);
                d[(size_t)(2048 + g * 64 + c) * 1024 + kb * 64 + kk] = (bf16_t)f2bf(as); }
        }
        __syncthreads();
    }
}
typedef float f32x16 __attribute__((ext_vector_type(16)));
__device__ __forceinline__ void prep_filters(Frame& F, int l) {
    LAS bf16_t* h2b = (LAS bf16_t*)F.lds;
    LAS bf16_t* w3t = h2b + 64 * 72;
    LAS float* zp = (LAS float*)w3t;
    LAS float* h1 = zp + 64 * 33;
    LAS float* w1s = h1 + 64 * 64;
    LAS float* w2s = w1s + 33 * 64;
    const float* w1 = F.in[I_HW1] + l * 33 * 64; const float* b1 = F.in[I_HB1] + l * 64; const float* fq = F.in[I_HFREQ] + l * 64;
    const float* w2 = F.in[I_HW2] + l * 64 * 64; const float* b2 = F.in[I_HB2] + l * 64; const float* w3 = F.in[I_HW3] + (size_t)l * 64 * 2048;
    for (int task4 = F.G - 1 - F.bid; task4 < 144; task4 += F.G) {
        const int task = task4 >> 2, qsel = task4 & 3;
        const int L = task < 32 ? LLAT : LCTX, t0 = (task < 32 ? task : task - 32) * 64;
        bf16_t* fil = (bf16_t*)(F.ws + (task < 32 ? WS_FILL : WS_FILC));
        float wcol[64];
#pragma unroll
        for (int k = 0; k < 64; ++k) wcol[k] = w3[(size_t)k * 2048 + qsel * 512 + F.tid];
        unsigned wpk[32];
#pragma unroll
        for (int k = 0; k < 32; ++k) wpk[k] = pk2(wcol[2 * k], wcol[2 * k + 1]);
        __syncthreads();
        for (int i = F.tid; i < 33 * 64; i += NTHR) w1s[i] = w1[i];
        for (int i = F.tid; i < 64 * 64; i += NTHR) w2s[i] = w2[i];
        for (int i = F.tid; i < 64 * 33; i += NTHR) { const int tt = i / 33, e = i % 33; const int ti = t0 + tt;
            float v;
            if (e == 0) v = (float)ti / (float)(L - 1);
            else { const int b = (e - 1) & 15; const float fr = 1e-4f + (15.0f - 1e-4f) * (float)b / 15.0f; const float rv = fr * ((float)ti / (float)L);
                   v = e <= 16 ? cos_rev(rv) : -sin_rev(rv); }
            zp[i] = v; }
        __syncthreads();
        for (int i = F.tid; i < 4096; i += NTHR) { const int tt = i >> 6, j = i & 63; float a = b1[j];
            for (int e = 0; e < 33; ++e) a += zp[tt * 33 + e] * w1s[e * 64 + j];
            h1[i] = sin_rad(fq[j] * a); }
        __syncthreads();
        for (int i = F.tid; i < 4096; i += NTHR) { const int tt = i >> 6, j = i & 63; float a = b2[j];
            for (int k = 0; k < 64; ++k) a += h1[tt * 64 + k] * w2s[k * 64 + j];
            h2b[tt * 72 + j] = (bf16_t)f2bf(sin_rad(fq[j] * a)); }
        __syncthreads();
#pragma unroll
        for (int m = 0; m < 8; ++m) *(LAS u32x4*)(w3t + F.tid * 72 + 8 * m) = (u32x4){wpk[4 * m], wpk[4 * m + 1], wpk[4 * m + 2], wpk[4 * m + 3]};
        __syncthreads();
        const int r = F.lane & 31, hh = F.lane >> 5;
        const float dmin = 4.605170185988091f / 1.5f, dmax = 4.605170185988091f / 0.3f;
#pragma unroll 1
        for (int tile = 0; tile < 4; ++tile) { const int ct = 2 * F.wave + (tile & 1), rt = tile >> 1;
            const LAS bf16_t* Am = h2b + (32 * rt + r) * 72 + 8 * hh; const LAS bf16_t* Bm = w3t + (32 * ct + r) * 72 + 8 * hh;
            f32x16 acc;
#pragma unroll
            for (int e = 0; e < 16; ++e) acc[e] = 0.f;
#pragma unroll
            for (int ks = 0; ks < 4; ++ks) acc = __builtin_amdgcn_mfma_f32_32x32x16_bf16(*(const LAS bf16x8*)(Am + 16 * ks), *(const LAS bf16x8*)(Bm + 16 * ks), acc, 0, 0, 0);
            const int c = 32 * ct + r, n = qsel * 512 + c; const float delta = dmin + (dmax - dmin) * (float)c / 511.0f;
            bf16_t* dst = fil + (size_t)n * L + t0;
#pragma unroll
            for (int g = 0; g < 4; ++g) { const int tt4 = 32 * rt + 8 * g + 4 * hh; float v[4];
#pragma unroll
                for (int e = 0; e < 4; ++e) { const float tl = (float)(t0 + tt4 + e) / (float)(L - 1); v[e] = acc[4 * g + e] * expf(-tl * delta); }
                *(u32x2*)(dst + tt4) = (u32x2){pk2(v[0], v[1]), pk2(v[2], v[3])}; } }
    }
    __syncthreads();
}
__device__ __forceinline__ void prep_mod(Frame& F) {
    LAS float* sc = (LAS float*)F.lds;
    LAS float* red = sc + 3 * 1024;
    __syncthreads();
    for (int i = F.tid; i < 3 * 1024; i += NTHR) { const int mi = i >> 10, k = i & 1023; const float v = mi == 0 ? F.in[I_CCTX][k] : F.in[I_C][(mi - 1) * 1024 + k]; sc[i] = v / (1.f + expf(-v)); }
    __syncthreads();
    float* mod = (float*)(F.ws + WS_MOD);
    for (int task = F.bid; task < 192; task += F.G) {
        const int l = task / 96, j = task % 96, n = j * 64 + F.lane;
        const float* w = F.in[I_WMOD] + (size_t)l * 1024 * 6144 + n;
        float a0 = 0.f, a1 = 0.f, a2 = 0.f;
        const int kb = F.wave * 128;
#pragma unroll 32
        for (int k = 0; k < 128; ++k) { const float wv = w[(size_t)(kb + k) * 6144]; a0 += sc[kb + k] * wv; a1 += sc[1024 + kb + k] * wv; a2 += sc[2048 + kb + k] * wv; }
        red[(F.wave * 3 + 0) * 64 + F.lane] = a0; red[(F.wave * 3 + 1) * 64 + F.lane] = a1; red[(F.wave * 3 + 2) * 64 + F.lane] = a2;
        __syncthreads();
        if (F.tid < 192) { const int mi = F.tid >> 6, ln = F.tid & 63; float s = F.in[I_BMOD][l * 6144 + j * 64 + ln];
            for (int w8 = 0; w8 < 8; ++w8) s += red[(w8 * 3 + mi) * 64 + ln];
            mod[((size_t)l * 3 + mi) * 6144 + j * 64 + ln] = s; }
        __syncthreads();
    }
}
__device__ __forceinline__ void prep_x_tables(Frame& F) {
    const int gt = F.bid * NTHR + F.tid, NG = F.G * NTHR;
    for (int i = gt; i < NTOK * DM / 4; i += NG) {
        const int row = i >> 8, c4 = (i & 255) * 4;
        f32x4 v;
        if (row < NCTX) v = *(const f32x4*)(F.in[I_XP] + (size_t)row * DM + c4);
        else { const int tt = row - NCTX, t = tt & 2047; v = *(const f32x4*)(F.in[I_XS] + (size_t)tt * DM + c4);
            const int seg = c4 >> 8; const float pos = (seg < 2) ? (float)(t >> 6) : (float)(t & 63);
#pragma unroll
            for (int u = 0; u < 4; ++u) { const int ii = (c4 + u) & 255; const float om = expf(-9.210340371976184f * (float)ii / 256.0f); const float a = pos * om;
                v[u] += (seg & 1) ? cos_rad(a) : sin_rad(a); } }
        *(f32x4*)(F.out + (size_t)row * DM + c4) = v;
    }
    for (int i = gt; i < 2048 * 4096 / 8; i += NG) { const int tp = i >> 9, k0 = (i & 511) * 8; unsigned w[4];
#pragma unroll
        for (int u = 0; u < 4; ++u) { float v[2];
#pragma unroll
            for (int e = 0; e < 2; ++e) { const int k = k0 + 2 * u + e; const int m = (tp * (k & 2047)) & 2047; const float x = (float)m / 2048.0f; v[e] = k < 2048 ? cos_rev(x) : -sin_rev(x); }
            w[u] = pk2(v[0], v[1]); }
        *(u32x4*)((bf16_t*)(F.ws + WS_TABL) + (size_t)tp * 4096 + k0) = (u32x4){w[0], w[1], w[2], w[3]}; }
    for (int i = gt; i < 256 * 512 / 8; i += NG) { const int tp = i >> 6, k0 = (i & 63) * 8; unsigned w[4];
#pragma unroll
        for (int u = 0; u < 4; ++u) { float v[2];
#pragma unroll
            for (int e = 0; e < 2; ++e) { const int k = k0 + 2 * u + e; const int m = (tp * (k & 255)) & 255; const float x = (float)m / 256.0f; v[e] = k < 256 ? cos_rev(x) : -sin_rev(x); }
            w[u] = pk2(v[0], v[1]); }
        *(u32x4*)((bf16_t*)(F.ws + WS_TABC) + (size_t)tp * 512 + k0) = (u32x4){w[0], w[1], w[2], w[3]}; }
}

__device__ __forceinline__ void phase_norm(Frame& F, const float* g, const float* modl, int sh_off, int sc_off, bf16_t* H) {
    const int gw = F.bid * NWAVES + F.wave, NGW = F.G * NWAVES;
    for (int row0 = gw; row0 < NTOK; row0 += 2 * NGW) {
        const int row1 = row0 + NGW < NTOK ? row0 + NGW : row0;
        const f32x4* xr0 = (const f32x4*)(F.out + (size_t)row0 * DM) + F.lane; const f32x4* xr1 = (const f32x4*)(F.out + (size_t)row1 * DM) + F.lane;
        f32x4 v0[4], v1[4]; float s0 = 0.f, s1 = 0.f;
#pragma unroll
        for (int j = 0; j < 4; ++j) { v0[j] = xr0[64 * j]; v1[j] = xr1[64 * j]; }
#pragma unroll
        for (int j = 0; j < 4; ++j) { s0 += (v0[j].x * v0[j].x + v0[j].y * v0[j].y) + (v0[j].z * v0[j].z + v0[j].w * v0[j].w); s1 += (v1[j].x * v1[j].x + v1[j].y * v1[j].y) + (v1[j].z * v1[j].z + v1[j].w * v1[j].w); }
        const float rstd0 = 1.0f / sqrtf(wave_sum(s0) * (1.f / DM) + EPS), rstd1 = 1.0f / sqrtf(wave_sum(s1) * (1.f / DM) + EPS);
        const float* mp0 = modl + (size_t)mod_idx(row0) * 6144; const float* mp1 = modl + (size_t)mod_idx(row1) * 6144;
        u32x2* o0 = (u32x2*)(H + (size_t)row0 * DM) + F.lane; u32x2* o1 = (u32x2*)(H + (size_t)row1 * DM) + F.lane;
#pragma unroll
        for (int j = 0; j < 4; ++j) { const int c = 4 * F.lane + 256 * j; const f32x4 gg = *(const f32x4*)(g + c);
            const f32x4 y0 = (v0[j] * rstd0) * gg * (*(const f32x4*)(mp0 + sc_off + c) + 1.0f) + *(const f32x4*)(mp0 + sh_off + c);
            const f32x4 y1 = (v1[j] * rstd1) * gg * (*(const f32x4*)(mp1 + sc_off + c) + 1.0f) + *(const f32x4*)(mp1 + sh_off + c);
            o0[64 * j] = (u32x2){pk2(y0.x, y0.y), pk2(y0.z, y0.w)};
            if (row1 != row0) o1[64 * j] = (u32x2){pk2(y1.x, y1.y), pk2(y1.z, y1.w)}; }
    }
}
__device__ __forceinline__ void phase_final(Frame& F) {
    const int gw = F.bid * NWAVES + F.wave, NGW = F.G * NWAVES; const float* g = F.in[I_NORMF];
    for (int row = gw; row < NTOK; row += NGW) {
        f32x4* xr = (f32x4*)(F.out + (size_t)row * DM) + F.lane;
        f32x4 v[4]; float s = 0.f;
#pragma unroll
        for (int j = 0; j < 4; ++j) { v[j] = xr[64 * j]; s += (v[j].x * v[j].x + v[j].y * v[j].y) + (v[j].z * v[j].z + v[j].w * v[j].w); }
        const float rstd = 1.0f / sqrtf(wave_sum(s) * (1.f / DM) + EPS);
#pragma unroll
        for (int j = 0; j < 4; ++j) { const int c = 4 * F.lane + 256 * j; const f32x4 gg = *(const f32x4*)(g + c); xr[64 * j] = (v[j] * rstd) * gg; }
    }
}

constexpr int HY_X1 = 0, HY_X2 = 8192, HY_ZP1 = 16384, HY_ZP2 = 47104, HY_TR = 77824, HY_TRCOPY = 8256, HY_TRORD = 16512, HY_RED = 110848;
static_assert(HY_RED + 16384 <= RING_BYTES, "hyena LDS map");
__device__ __forceinline__ void hyena_task(Frame& F, int l, int c, int grp) {
    int tid_ = F.tid; asm volatile("" : "+v"(tid_));
    const int tid = tid_, lane = tid & 63, wave = __builtin_amdgcn_readfirstlane(tid >> 6);
    const int L = grp == 0 ? LLAT : LCTX, nb = L >> 5, ZSEQ = (3 * L / 32) * 40, row0 = grp == 0 ? NCTX : (grp - 1) * 4096;
    LAS unsigned char* lds = F.lds;
    const bf16_t* hyt = (const bf16_t*)(F.ws + WS_HYT);
    const float* cw = F.in[I_CONVHY] + (size_t)l * 3 * 1536;
    const float* fil = (const float*)(F.ws + (grp == 0 ? WS_FILL : WS_FILC));
    const float* hb = F.in[I_HBIAS] + (size_t)l * 2 * 512;
    PROF_DECL;
    __syncthreads();
    if (grp == 0) PROF_COUNT(4); else PROF_COUNT(5);
    PROF_BEGIN(1);
    {
        const int p = 8 * tid, t = p & (L - 1), qs = p / L;
#pragma unroll
        for (int st = 0; st < 3; ++st) { const int ch = st * 512 + c; const bf16_t* src = hyt + (size_t)ch * NTOK + row0 + p;
            const u32x4 rv = *(const u32x4*)src; const float xm_ = bf2f(src[t > 0 ? -1 : 0]), xp_ = bf2f(src[t + 8 < L ? 8 : 0]); const float xm = t > 0 ? xm_ : 0.f, xp = t + 8 < L ? xp_ : 0.f;
            const float w0 = cw[ch], w1 = cw[1536 + ch], w2 = cw[2 * 1536 + ch];
            const float x[10] = {xm, bflo(rv.x), bfhi(rv.x), bflo(rv.y), bfhi(rv.y), bflo(rv.z), bfhi(rv.z), bflo(rv.w), bfhi(rv.w), xp};
            float o[8];
#pragma unroll
            for (int e = 0; e < 8; ++e) o[e] = w0 * x[e] + w1 * x[e + 1] + w2 * x[e + 2];
            const u32x4 pk = (u32x4){pk2(o[0], o[1]), pk2(o[2], o[3]), pk2(o[4], o[5]), pk2(o[6], o[7])};
            if (st < 2) *(LAS u32x4*)(lds + (st == 0 ? HY_X1 : HY_X2) + p * 2) = pk;
            else *(LAS u32x4*)(lds + HY_ZP1 + (qs * ZSEQ + (nb + (t >> 5)) * 40 + (t & 31)) * 2) = pk; }
        const int npad = (4096 / L) * 2 * nb;
        for (int i2 = tid; i2 < 2 * npad * 5; i2 += NTHR) { const int img = i2 / (npad * 5), rem = i2 % (npad * 5), pbk = rem / 5, piece = rem % 5;
            const int qs2 = pbk / (2 * nb), bb = pbk % (2 * nb), blk = bb < nb ? bb : bb + nb;
            *(LAS u32x4*)(lds + (img == 0 ? HY_ZP1 : HY_ZP2) + (qs2 * ZSEQ + blk * 40) * 2 + piece * 16) = (u32x4){0u, 0u, 0u, 0u}; }
    }
    PROF_END(1); PROF_BEGIN(2);
    { const bf16_t* fb16 = (const bf16_t*)fil; const int npc = L / 8;
      for (int i2 = tid; i2 < 4 * npc; i2 += NTHR) { const int jd = i2 / npc, k = i2 % npc, o = jd >> 1, dirn = jd & 1;
          const u32x4 v = *(const u32x4*)(fb16 + ((size_t)jd * 512 + c) * L + 8 * k);
          LAS unsigned char* c0 = lds + HY_TR + o * HY_TRORD; LAS unsigned char* c1 = c0 + HY_TRCOPY;
          const unsigned e0 = v.x & 0xffffu, e1 = v.x >> 16, e2 = v.y & 0xffffu, e3 = v.y >> 16, e4 = v.z & 0xffffu, e5 = v.z >> 16, e6 = v.w & 0xffffu, e7 = v.w >> 16;
          if (dirn == 0) {
              const int p1 = L - 8 * k - 8;
              *(LAS u32x4*)(c1 + p1 * 2) = (u32x4){e7 | (e6 << 16), e5 | (e4 << 16), e3 | (e2 << 16), e1 | (e0 << 16)};
              const int p0 = L - 8 * k - 7;
              *(LAS unsigned short*)(c0 + p0 * 2) = (unsigned short)e7;
              *(LAS unsigned*)(c0 + (p0 + 1) * 2) = e6 | (e5 << 16); *(LAS unsigned*)(c0 + (p0 + 3) * 2) = e4 | (e3 << 16); *(LAS unsigned*)(c0 + (p0 + 5) * 2) = e2 | (e1 << 16);
              *(LAS unsigned short*)(c0 + (p0 + 7) * 2) = (unsigned short)e0;
          } else {
              const int q0 = L + 8 * k;
              if (k > 0) *(LAS u32x4*)(c0 + q0 * 2) = v;
              else { *(LAS unsigned short*)(c0 + (q0 + 1) * 2) = (unsigned short)e1; *(LAS unsigned*)(c0 + (q0 + 2) * 2) = v.y; *(LAS unsigned*)(c0 + (q0 + 4) * 2) = v.z; *(LAS unsigned*)(c0 + (q0 + 6) * 2) = v.w; }
              const int q1 = q0 - 1;
              if (k > 0) *(LAS unsigned short*)(c1 + q1 * 2) = (unsigned short)e0;
              *(LAS unsigned*)(c1 + (q1 + 1) * 2) = e1 | (e2 << 16); *(LAS unsigned*)(c1 + (q1 + 3) * 2) = e3 | (e4 << 16); *(LAS unsigned*)(c1 + (q1 + 5) * 2) = e5 | (e6 << 16);
              *(LAS unsigned short*)(c1 + (q1 + 7) * 2) = (unsigned short)e7;
          } } }
    __syncthreads();
    PROF_END(2); PROF_BEGIN(3);
    const int tile = wave & 3, half = wave >> 2, r = lane & 31, hh = lane >> 5, colg = 32 * tile + r;
    int qs, ib, imin, imax;
    if (grp == 0) { qs = colg >> 6; ib = colg & 63; imin = 32 * (tile & 1); imax = imin + 31; } else { qs = colg >> 3; ib = colg & 7; imin = 0; imax = 7; }
    const int dlo = imin - nb + 1, cnt = imax - imin + nb, mid = dlo + (cnt >> 1);
    const int d0 = half == 0 ? dlo : mid, d1 = half == 0 ? mid : dlo + cnt;
    const int par = r & 1;
    const int aoff = par * HY_TRCOPY + (L + 8 * hh - r - 32 * d0 - par) * 2;
    const int boff = (qs * ZSEQ + (nb + ib - d0) * 40 + 8 * hh) * 2;
    const float bias0 = hb[c] + bf2f(((const bf16_t*)fil)[((size_t)1 * 512 + c) * L]), bias1 = hb[512 + c] + bf2f(((const bf16_t*)fil)[((size_t)3 * 512 + c) * L]);
    bf16_t* yb = (bf16_t*)(F.ws + WS_YB);
#pragma unroll 1
    for (int o = 0; o < 2; ++o) {
        if (grp == 0) PROF_BEGIN(6);
        f32x16 acc;
#pragma unroll
        for (int e = 0; e < 16; ++e) acc[e] = 0.f;
        const LAS unsigned char* Ap = lds + HY_TR + o * HY_TRORD + aoff; const LAS unsigned char* Bp = lds + (o == 0 ? HY_ZP1 : HY_ZP2) + boff;
        f32x16 acc2;
#pragma unroll
        for (int e = 0; e < 16; ++e) acc2[e] = 0.f;
        u32x4 xa[4][2], ya[4][2]; bf16x8 xb[4][2], yb2[4][2];
#define HY_LD4(A, B) do { _Pragma("unroll") for (int u_ = 0; u_ < 4; ++u_) { const LAS unsigned* ap_ = (const LAS unsigned*)(Ap - 64 * u_); \
            A[u_][0] = (u32x4){ap_[0], ap_[1], ap_[2], ap_[3]}; A[u_][1] = (u32x4){ap_[8], ap_[9], ap_[10], ap_[11]}; \
            B[u_][0] = *(const LAS bf16x8*)(Bp - 80 * u_); B[u_][1] = *(const LAS bf16x8*)(Bp - 80 * u_ + 32); } Ap -= 256; Bp -= 320; } while (0)
#define HY_MM4(A, B) do { _Pragma("unroll") for (int u_ = 0; u_ < 4; ++u_) { acc = __builtin_amdgcn_mfma_f32_32x32x16_bf16(__builtin_bit_cast(bf16x8, A[u_][0]), B[u_][0], acc, 0, 0, 0); \
            acc2 = __builtin_amdgcn_mfma_f32_32x32x16_bf16(__builtin_bit_cast(bf16x8, A[u_][1]), B[u_][1], acc2, 0, 0, 0); } } while (0)
        const int ng = (d1 - d0) >> 2, nrem = (d1 - d0) & 3;
        HY_LD4(xa, xb);
#pragma unroll 1
        for (int g = 0;;) {
            __builtin_amdgcn_sched_barrier(0); if (g + 1 < ng) HY_LD4(ya, yb2); __builtin_amdgcn_sched_barrier(0); HY_MM4(xa, xb);
            if (++g >= ng) break;
            __builtin_amdgcn_sched_barrier(0); if (g + 1 < ng) HY_LD4(xa, xb); __builtin_amdgcn_sched_barrier(0); HY_MM4(ya, yb2);
            if (++g >= ng) break;
        }
#pragma unroll 1
        for (int rr = 0; rr < nrem; ++rr) { const LAS unsigned* ap_ = (const LAS unsigned*)Ap;
            const u32x4 q0 = (u32x4){ap_[0], ap_[1], ap_[2], ap_[3]}, q1 = (u32x4){ap_[8], ap_[9], ap_[10], ap_[11]};
            acc = __builtin_amdgcn_mfma_f32_32x32x16_bf16(__builtin_bit_cast(bf16x8, q0), *(const LAS bf16x8*)Bp, acc, 0, 0, 0);
            acc2 = __builtin_amdgcn_mfma_f32_32x32x16_bf16(__builtin_bit_cast(bf16x8, q1), *(const LAS bf16x8*)(Bp + 32), acc2, 0, 0, 0);
            Ap -= 64; Bp -= 80; }
#undef HY_LD4
#undef HY_MM4
#pragma unroll
        for (int e = 0; e < 16; ++e) acc[e] += acc2[e];
        if (grp == 0) { PROF_END(6); PROF_BEGIN(7); }
        LAS float* red = (LAS float*)(lds + HY_RED);
        if (half == 1) {
#pragma unroll
            for (int e = 0; e < 16; ++e) red[(tile * 16 + e) * 64 + lane] = acc[e]; }
        __syncthreads();
        if (half == 0) {
#pragma unroll
            for (int e = 0; e < 16; ++e) acc[e] += red[(tile * 16 + e) * 64 + lane];
#pragma unroll
            for (int g = 0; g < 4; ++g) { const int a4 = 8 * g + 4 * hh, p = qs * L + 32 * ib + a4, zo = (qs * ZSEQ + (nb + ib) * 40 + a4) * 2;
                const u32x2 gx = *(const LAS u32x2*)(lds + (o == 0 ? HY_X1 : HY_X2) + p * 2), zz = *(const LAS u32x2*)(lds + (o == 0 ? HY_ZP1 : HY_ZP2) + zo);
                const float gv[4] = {bflo(gx.x), bfhi(gx.x), bflo(gx.y), bfhi(gx.y)}, zv[4] = {bflo(zz.x), bfhi(zz.x), bflo(zz.y), bfhi(zz.y)};
                float y[4];
#pragma unroll
                for (int e = 0; e < 4; ++e) y[e] = gv[e] * (acc[4 * g + e] + (o == 0 ? bias0 : bias1) * zv[e]);
                if (o == 0) *(LAS u32x2*)(lds + HY_ZP2 + zo) = (u32x2){pk2(y[0], y[1]), pk2(y[2], y[3])};
                else {
#pragma unroll
                    for (int e = 0; e < 4; ++e) yb[(size_t)(row0 + p + e) * 512 + c] = (bf16_t)f2bf(y[e]); } }
        }
        __syncthreads();
        if (grp == 0) PROF_END(7);
    }
    PROF_END(3); PROF_FLUSH();
}

__device__ __forceinline__ int kpos32(int k) { return (k & ~31) | (((k >> 2) & 3) << 3) | (((k >> 4) & 1) << 2) | (k & 3); }
__device__ __forceinline__ size_t chunk_lin(int s, int n) { return (size_t)(s < 32 ? s * 4 + n : 128 + (s - 32) * 32 + n); }
constexpr int D1_GRP_BYTES = 61440;
__device__ __forceinline__ void d1_task(Frame& F, int l, int s, int h, int n) {
    int tid_ = F.tid; asm volatile("" : "+v"(tid_));
    const int tid = tid_, lane = tid & 63, wave = __builtin_amdgcn_readfirstlane(tid >> 6), lw = wave & 3, lt = tid & 255;
    LAS unsigned char* base = F.lds + (wave >> 2) * D1_GRP_BYTES;
    LAS bf16_t* qb = (LAS bf16_t*)base;
    LAS bf16_t* kb = qb + 64 * 72;
    LAS bf16_t* vb = kb + 64 * 72;
    LAS float* ATf = (LAS float*)(vb + 64 * 72);
    LAS float* ATb = ATf + 4096;
    LAS float* sm = ATb + 4096;
    LAS float* betaf = sm, *betab = sm + 64, *gcf = sm + 128, *gcb = sm + 192;
    const int L = seq_len(s), row0 = seq_start(s) + n * 64, tpos0 = n * 64;
    const bf16_t* qkv = (const bf16_t*)(F.ws + WS_QKV);
    const float* cw = F.in[I_CONVQKV] + (size_t)l * 3 * QKVW;
    const size_t cl = chunk_lin(s, n);
    PROF_DECL; PROF_BEGIN(40);
    float braw = 0.f, araw = 0.f, al = 0.f, dtb = 0.f;
    if (lw < 2) { const float* ba = (const float*)(F.ws + WS_BA) + (size_t)(row0 + lane) * 32; braw = ba[lw * 8 + h]; araw = ba[16 + lw * 8 + h];
        al = F.in[I_ALOG][l * 16 + lw * 8 + h]; dtb = F.in[I_DTB][l * 16 + lw * 8 + h]; }
    __syncthreads();
    {
        const int sub = lt & 7;
        u32x4 rr[2][3][3]; f32x4 ww[3][3][2];
#pragma unroll
        for (int part = 0; part < 3; ++part) { const int ch = part * 512 + h * 64 + sub * 8;
#pragma unroll
            for (int i = 0; i < 3; ++i) { ww[part][i][0] = *(const f32x4*)(cw + i * QKVW + ch); ww[part][i][1] = *(const f32x4*)(cw + i * QKVW + ch + 4); }
#pragma unroll
            for (int th = 0; th < 2; ++th) { const int t = (lt >> 3) + 32 * th, tp = tpos0 + t; const bf16_t* src = qkv + (size_t)(row0 + t) * QKVW + ch;
                rr[th][part][1] = *(const u32x4*)src; rr[th][part][0] = *(const u32x4*)(tp > 0 ? src - QKVW : src); rr[th][part][2] = *(const u32x4*)(tp < L - 1 ? src + QKVW : src); } }
#pragma unroll
        for (int th2 = 0; th2 < 2 * NREP(14); ++th2) { const int th = th2 & 1;
            const int t = (lt >> 3) + 32 * th, tp = tpos0 + t;
            const float m0 = tp > 0 ? 1.f : 0.f, m2 = tp < L - 1 ? 1.f : 0.f;
#pragma unroll
            for (int part = 0; part < 3; ++part) {
                const u32x4 r0 = rr[th][part][0], r1 = rr[th][part][1], r2 = rr[th][part][2];
                const unsigned a0[4] = {r0.x, r0.y, r0.z, r0.w}, a1[4] = {r1.x, r1.y, r1.z, r1.w}, a2[4] = {r2.x, r2.y, r2.z, r2.w};
                float v[8]; float ss = 0.f;
#pragma unroll
                for (int e = 0; e < 8; ++e) { const float x0 = (e & 1) ? bfhi(a0[e >> 1]) : bflo(a0[e >> 1]), x1 = (e & 1) ? bfhi(a1[e >> 1]) : bflo(a1[e >> 1]), x2 = (e & 1) ? bfhi(a2[e >> 1]) : bflo(a2[e >> 1]);
                    float a = x1 * ww[part][1][e >> 2][e & 3] + m0 * x0 * ww[part][0][e >> 2][e & 3] + m2 * x2 * ww[part][2][e >> 2][e & 3]; a = a / (1.f + __expf(-a)); v[e] = a; ss += a * a; }
                if (part < 2) { ss = sum8(ss);
                    const float rs = (part == 0 ? 0.125f : 1.0f) / sqrtf(ss + EPS);
#pragma unroll
                    for (int e = 0; e < 8; ++e) v[e] *= rs; }
                const u32x4 pk = (u32x4){pk2(v[0], v[1]), pk2(v[2], v[3]), pk2(v[4], v[5]), pk2(v[6], v[7])};
                *(LAS u32x4*)((part == 0 ? qb : (part == 1 ? kb : vb)) + t * 72 + sub * 8) = pk;
                if (part == 0) { bf16_t* qo = (bf16_t*)(F.ws + WS_QN) + (size_t)(row0 + t) * 512 + h * 64;
                    *(u32x2*)(qo + kpos32(sub * 8)) = (u32x2){pk.x, pk.y}; *(u32x2*)(qo + kpos32(sub * 8 + 4)) = (u32x2){pk.z, pk.w}; }
            }
        }
    }
    if (lw < 2) { const int dir = lw, t = lane;
        const float xx = araw + dtb; const float sp = xx > 20.f ? xx : log1pf(expf(xx));
        float a = -expf(al) * sp;
#pragma unroll
        for (int o = 1; o < 64; o <<= 1) { const float y = lane_read(a, dir == 0 ? ((lane - o) & 63) : ((lane + o) & 63)); if (dir == 0 ? (lane >= o) : (lane + o < 64)) a += y; }
        (dir == 0 ? betaf : betab)[t] = 1.f / (1.f + expf(-braw)); (dir == 0 ? gcf : gcb)[t] = a;
        ((float*)(F.ws + WS_GC))[((size_t)(dir * 8 + h) * 192 + cl) * 64 + t] = a; }
    __syncthreads();
    PROF_END(40); PROF_BEGIN(41);
    const size_t offF = ((size_t)(0 * 8 + h) * 192 + cl) * 4096, offB = ((size_t)(1 * 8 + h) * 192 + cl) * 4096;
    {
        const int ti = lw >> 1, tj = lw & 1, r = lane & 31, hh = lane >> 5, col = 32 * tj + r;
#pragma unroll 1
        for (int prod2 = 0; prod2 < 2 * NREP(15); ++prod2) { const int prod = prod2 & 1;
            const LAS bf16_t* Am = kb + (32 * ti + r) * 72 + 8 * hh; const LAS bf16_t* Bm = (prod == 0 ? kb : qb) + (32 * tj + r) * 72 + 8 * hh;
            f32x16 acc;
#pragma unroll
            for (int e = 0; e < 16; ++e) acc[e] = 0.f;
#pragma unroll
            for (int ks = 0; ks < 4; ++ks) acc = __builtin_amdgcn_mfma_f32_32x32x16_bf16(*(const LAS bf16x8*)(Am + 16 * ks), *(const LAS bf16x8*)(Bm + 16 * ks), acc, 0, 0, 0);
            if (prod == 0) {
                const int j = col; const float gfj = gcf[j], gbj = gcb[j];
#pragma unroll
                for (int g = 0; g < 4; ++g) { const int i4 = 32 * ti + 8 * g + 4 * hh; float ff[4], fb[4];
#pragma unroll
                    for (int e = 0; e < 4; ++e) { const int i = i4 + e; const float v = acc[4 * g + e];
                        ff[e] = i > j ? betaf[i] * v * __expf(gcf[i] - gfj) : 0.f; fb[e] = i < j ? betab[i] * v * __expf(gcb[i] - gbj) : 0.f; }
                    *(LAS f32x4*)(ATf + j * 64 + i4) = (f32x4){ff[0], ff[1], ff[2], ff[3]};
                    *(LAS f32x4*)(ATb + (63 - j) * 64 + (60 - i4)) = (f32x4){fb[3], fb[2], fb[1], fb[0]}; }
            } else {
                const int i = col; const float gfi = gcf[i], gbi = gcb[i]; bf16_t* QKo = (bf16_t*)(F.ws + WS_QK);
#pragma unroll
                for (int g = 0; g < 4; ++g) { const int j4 = 32 * ti + 8 * g + 4 * hh; float ff[4], fb[4];
#pragma unroll
                    for (int e = 0; e < 4; ++e) { const int j = j4 + e; const float v = acc[4 * g + e];
                        ff[e] = i >= j ? v * __expf(gfi - gcf[j]) : 0.f; fb[e] = i <= j ? v * __expf(gbi - gcb[j]) : 0.f; }
                    const int pj = kpos32(j4);
                    *(u32x2*)(QKo + offF + (size_t)i * 64 + pj) = (u32x2){pk2(ff[0], ff[1]), pk2(ff[2], ff[3])};
                    *(u32x2*)(QKo + offB + (size_t)i * 64 + pj) = (u32x2){pk2(fb[0], fb[1]), pk2(fb[2], fb[3])}; }
            }
        }
    }
    { const int d = lt >> 2, cg = lt & 3; bf16_t* kt = (bf16_t*)(F.ws + WS_KN) + ((size_t)h * 192 + cl) * 4096 + d * 64;
#pragma unroll
      for (int g = 0; g < 4; ++g) { const int c = 16 * cg + 4 * g;
          const unsigned w0 = (unsigned)kb[(c + 0) * 72 + d] | ((unsigned)kb[(c + 1) * 72 + d] << 16), w1 = (unsigned)kb[(c + 2) * 72 + d] | ((unsigned)kb[(c + 3) * 72 + d] << 16);
          *(u32x2*)(kt + kpos32(c)) = (u32x2){w0, w1}; } }
    __syncthreads();
    PROF_END(41); PROF_BEGIN(42);
#pragma unroll 1
    for (int srep = 0; srep < NREP(16); ++srep) {
        const int c = lane;
        int dmask = (lw >> 1) * 63, isw = lw & 1;
        asm volatile("" : "+v"(dmask), "+v"(isw));
        const bool bdir = dmask != 0, bw = isw != 0;
        int vzero; asm volatile("v_mov_b32 %0, 0" : "=v"(vzero));
        const LAS float* AT = ATf + (bdir ? 4096 : 0) + vzero;
        const LAS float* bet = betaf + (bdir ? 64 : 0); const LAS float* gcc = gcf + (bdir ? 64 : 0);
        const LAS bf16_t* srcm = (bw ? kb : vb) + c;
        float x[64];
#pragma unroll
        for (int p = 0; p < 64; ++p) { const int t = p ^ dmask; const float be = bet[t]; const float eg = __expf(gcc[t]);
            x[p] = bf2f(srcm[t * 72]) * (bw ? be * eg : be);
            if ((p & 7) == 7) __builtin_amdgcn_sched_barrier(0); }
#define SOLVE_LD(R, j) do { _Pragma("unroll") for (int i4_ = ((j) + 1) & ~3; i4_ < 64; i4_ += 4) R[i4_ >> 2] = *(const LAS f32x4*)(AT + (j) * 64 + i4_); } while (0)
#define SOLVE_FM(R, j) do { const float xj_ = x[j]; _Pragma("unroll") for (int i_ = (j) + 1; i_ < 64; ++i_) x[i_] -= R[i_ >> 2][i_ & 3] * xj_; } while (0)
        {
#pragma unroll
          for (int j = 0; j < 32; ++j) { const float xj = x[j]; f32x4 rh[8];
              __builtin_amdgcn_sched_barrier(0);
#pragma unroll
              for (int i4 = (j + 1) & ~3; i4 < 32; i4 += 4) rh[i4 >> 2] = *(const LAS f32x4*)(AT + j * 64 + i4);
#pragma unroll
              for (int i = j + 1; i < 32; ++i) x[i] -= rh[i >> 2][i & 3] * xj;
              __builtin_amdgcn_sched_barrier(0);
#pragma unroll
              for (int i4 = 32; i4 < 64; i4 += 4) rh[(i4 - 32) >> 2] = *(const LAS f32x4*)(AT + j * 64 + i4);
#pragma unroll
              for (int i = 32; i < 64; ++i) x[i] -= rh[(i - 32) >> 2][i & 3] * xj; } }
        { f32x4 ra[16], rb[16];
          SOLVE_LD(ra, 32);
#pragma unroll
          for (int j = 32; j < 56; j += 2) {
            __builtin_amdgcn_sched_barrier(0); SOLVE_LD(rb, j + 1); __builtin_amdgcn_sched_barrier(0); SOLVE_FM(ra, j);
            __builtin_amdgcn_sched_barrier(0); if (j + 2 < 56) SOLVE_LD(ra, j + 2); __builtin_amdgcn_sched_barrier(0); SOLVE_FM(rb, j + 1); } }
        { f32x4 rt[7][2];
#pragma unroll
          for (int j = 56; j < 63; ++j)
#pragma unroll
              for (int i4 = (j + 1) & ~3; i4 < 64; i4 += 4) rt[j - 56][(i4 - 56) >> 2] = *(const LAS f32x4*)(AT + j * 64 + i4);
          __builtin_amdgcn_sched_barrier(0);
#pragma unroll
          for (int j = 56; j < 63; ++j) { const float xj = x[j];
#pragma unroll
              for (int i = j + 1; i < 64; ++i) x[i] -= rt[j - 56][(i - 56) >> 2][i & 3] * xj; } }
#undef SOLVE_LD
#undef SOLVE_FM
        __builtin_amdgcn_sched_barrier(0);
        int dmask2 = dmask; asm volatile("" : "+v"(dmask2), "+v"(x[63]));
        const size_t offD = bdir ? offB : offF;
        if (!bw) {
            bf16_t* dst = (bf16_t*)(F.ws + WS_U) + offD + (size_t)c * 64;
#pragma unroll
            for (int g = 0; g < 8; ++g) { unsigned w[4];
#pragma unroll
                for (int k = 0; k < 4; ++k) { const float a = x[8 * g + 2 * k], b = x[8 * g + 2 * k + 1]; w[k] = pk2(bdir ? b : a, bdir ? a : b); }
                const u32x4 o = bdir ? (u32x4){w[3], w[2], w[1], w[0]} : (u32x4){w[0], w[1], w[2], w[3]};
                *(u32x4*)(dst + (bdir ? 56 - 8 * g : 8 * g)) = o; }
        } else {
            bf16_t* dst = (bf16_t*)(F.ws + WS_WW) + offD + kpos32(c);
#pragma unroll
            for (int p = 0; p < 64; ++p) dst[(p ^ dmask2) * 64] = (bf16_t)f2bf(-x[p]);
        }
    }
    PROF_END(42); PROF_FLUSH();
}

__device__ __forceinline__ bf16x8 pack8(const f32x4 a, const f32x4 b) {
    u32x4 w; w.x = pg8::cvt_pk_bf16(a[0], a[1]); w.y = pg8::cvt_pk_bf16(a[2], a[3]); w.z = pg8::cvt_pk_bf16(b[0], b[1]); w.w = pg8::cvt_pk_bf16(b[2], b[3]);
    return __builtin_bit_cast(bf16x8, w);
}
__device__ __forceinline__ void d2_wave_task(Frame& F, int l, int s, int h, int dir, int sl) {
    PROF_DECL; PROF_BEGIN(50);
    int lane_ = F.lane; asm volatile("" : "+v"(lane_));
    const int lane = lane_, r16 = lane & 15, q = lane >> 4, e0 = sl * 16;
    const int nch = s < 32 ? 4 : 32;
    LAS float* lo = (LAS float*)(F.lds + F.wave * 4608);
    f32x4 S[4];
#pragma unroll
    for (int t = 0; t < 4; ++t)
#pragma unroll
        for (int rg = 0; rg < 4; ++rg) { const int d = 16 * t + 4 * q + rg;
            S[t][rg] = s >= 32 ? F.in[I_STATE][((((size_t)(s - 32) * 2 + l) * 2 + dir) * 8 + h) * 4096 + d * 64 + e0 + r16] : 0.f; }
    const bf16_t* Wg = (const bf16_t*)(F.ws + WS_WW); const bf16_t* QKg = (const bf16_t*)(F.ws + WS_QK); const bf16_t* Ug = (const bf16_t*)(F.ws + WS_U);
    const bf16_t* QNg = (const bf16_t*)(F.ws + WS_QN); const bf16_t* KTg = (const bf16_t*)(F.ws + WS_KN); const float* GCg = (const float*)(F.ws + WS_GC);
    bf16_t* Og = (bf16_t*)(F.ws + (dir == 0 ? WS_OF : WS_OB));
    const int fo = r16 * 64 + 8 * q;
#pragma unroll 1
    for (int step = 0; step < nch; ++step) {
        const int n = dir == 0 ? step : nch - 1 - step; const size_t cl = chunk_lin(s, n);
        const size_t off = ((size_t)(dir * 8 + h) * 192 + cl) * 4096; const int tok0 = seq_start(s) + n * 64;
        const bf16_t* Wp = Wg + off + fo; const bf16_t* QKp = QKg + off + fo; const bf16_t* KTp = KTg + ((size_t)h * 192 + cl) * 4096 + fo;
        const bf16_t* Qp = QNg + (size_t)(tok0 + r16) * 512 + h * 64 + 8 * q; const bf16_t* Up = Ug + off + (size_t)(e0 + r16) * 64 + 4 * q;
        const float* gcp = GCg + ((size_t)(dir * 8 + h) * 192 + cl) * 64;
        bf16x8 Wf[4][2], Qf[4][2], QKf[4][2], KTf[4][2]; u32x2 Uv[4]; f32x4 gcv[4];
#pragma unroll
        for (int t = 0; t < 4; ++t) { Uv[t] = *(const u32x2*)(Up + 16 * t); gcv[t] = *(const f32x4*)(gcp + 16 * t + 4 * q);
#pragma unroll
            for (int ks = 0; ks < 2; ++ks) { Wf[t][ks] = *(const bf16x8*)(Wp + t * 1024 + 32 * ks); Qf[t][ks] = *(const bf16x8*)(Qp + (size_t)t * 16 * 512 + 32 * ks);
                QKf[t][ks] = *(const bf16x8*)(QKp + t * 1024 + 32 * ks); KTf[t][ks] = *(const bf16x8*)(KTp + t * 1024 + 32 * ks); } }
        const float gl = gcp[dir == 0 ? 63 : 0];
        bf16x8 Sb[2] = {pack8(S[0], S[1]), pack8(S[2], S[3])};
        f32x4 VN[4], O[4];
#pragma unroll
        for (int t = 0; t < 4; ++t) { VN[t] = (f32x4){bflo(Uv[t].x), bfhi(Uv[t].x), bflo(Uv[t].y), bfhi(Uv[t].y)}; O[t] = (f32x4){0.f, 0.f, 0.f, 0.f};
#pragma unroll
            for (int ks = 0; ks < 2; ++ks) { VN[t] = __builtin_amdgcn_mfma_f32_16x16x32_bf16(Wf[t][ks], Sb[ks], VN[t], 0, 0, 0); O[t] = __builtin_amdgcn_mfma_f32_16x16x32_bf16(Qf[t][ks], Sb[ks], O[t], 0, 0, 0); } }
        f32x4 VS[4];
#pragma unroll
        for (int t = 0; t < 4; ++t)
#pragma unroll
            for (int rg = 0; rg < 4; ++rg) { O[t][rg] *= __expf(gcv[t][rg]); VS[t][rg] = VN[t][rg] * __expf(gl - gcv[t][rg]); }
        const bf16x8 VNb[2] = {pack8(VN[0], VN[1]), pack8(VN[2], VN[3])}, VSb[2] = {pack8(VS[0], VS[1]), pack8(VS[2], VS[3])};
        const float egl = __expf(gl);
#pragma unroll
        for (int t = 0; t < 4; ++t) { S[t] = S[t] * egl;
#pragma unroll
            for (int ks = 0; ks < 2; ++ks) { O[t] = __builtin_amdgcn_mfma_f32_16x16x32_bf16(QKf[t][ks], VNb[ks], O[t], 0, 0, 0); S[t] = __builtin_amdgcn_mfma_f32_16x16x32_bf16(KTf[t][ks], VSb[ks], S[t], 0, 0, 0); } }
#pragma unroll
        for (int t = 0; t < 4; ++t)
#pragma unroll
            for (int rg = 0; rg < 4; ++rg) lo[(16 * t + 4 * q + rg) * 17 + r16] = O[t][rg];
        asm volatile("s_waitcnt lgkmcnt(0)" ::: "memory");
        { float ov[16];
#pragma unroll
          for (int e = 0; e < 16; ++e) ov[e] = lo[lane * 17 + e];
          bf16_t* op = Og + (size_t)(tok0 + lane) * 512 + h * 64 + e0;
          *(u32x4*)op = (u32x4){pk2(ov[0], ov[1]), pk2(ov[2], ov[3]), pk2(ov[4], ov[5]), pk2(ov[6], ov[7])};
          *(u32x4*)(op + 8) = (u32x4){pk2(ov[8], ov[9]), pk2(ov[10], ov[11]), pk2(ov[12], ov[13]), pk2(ov[14], ov[15])}; }
        asm volatile("s_waitcnt lgkmcnt(0)" ::: "memory");
    }
    if (s < 32) { float* so = F.out + (size_t)NTOK * DM + ((((size_t)s * 2 + l) * 2 + dir) * 8 + h) * 4096;
#pragma unroll
        for (int t = 0; t < 4; ++t)
#pragma unroll
            for (int rg = 0; rg < 4; ++rg) so[(16 * t + 4 * q + rg) * 64 + e0 + r16] = S[t][rg]; }
    PROF_END(50); PROF_FLUSH();
}

__device__ __forceinline__ void phase_combine(Frame& F, int l) {
    const bf16_t* of = (const bf16_t*)(F.ws + WS_OF); const bf16_t* ob = (const bf16_t*)(F.ws + WS_OB); const bf16_t* z = (const bf16_t*)(F.ws + WS_Z);
    bf16_t* ya = (bf16_t*)(F.ws + WS_YA); const float* na = F.in[I_NORMA] + l * 64;
    for (int i = F.bid * NTHR + F.tid; i < NTOK * 64; i += F.G * NTHR) {
        const size_t off = (size_t)i * 8; const int e0 = (i & 7) * 8;
        const u32x4 a = *(const u32x4*)(of + off), b = *(const u32x4*)(ob + off), zz = *(const u32x4*)(z + off);
        float o[8]; const unsigned aw[4] = {a.x, a.y, a.z, a.w}, bw[4] = {b.x, b.y, b.z, b.w}, zw[4] = {zz.x, zz.y, zz.z, zz.w};
        float ss = 0.f;
#pragma unroll
        for (int j = 0; j < 4; ++j) { o[2 * j] = bflo(aw[j]) + bflo(bw[j]); o[2 * j + 1] = bfhi(aw[j]) + bfhi(bw[j]); ss += o[2 * j] * o[2 * j] + o[2 * j + 1] * o[2 * j + 1]; }
        ss += __shfl_xor(ss, 1); ss += __shfl_xor(ss, 2); ss += __shfl_xor(ss, 4);
        const float rs = 1.0f / sqrtf(ss * (1.f / 64.f) + EPS);
        unsigned w[4];
#pragma unroll
        for (int j = 0; j < 4; ++j) { const float z0 = bflo(zw[j]), z1 = bfhi(zw[j]);
            w[j] = pk2(o[2 * j] * rs * na[e0 + 2 * j] * siluf_(z0), o[2 * j + 1] * rs * na[e0 + 2 * j + 1] * siluf_(z1)); }
        *(u32x4*)(ya + off) = (u32x4){w[0], w[1], w[2], w[3]};
    }
}

constexpr int N_PHASES = 26;
__global__ void __launch_bounds__(NTHR, 2) mk_fwd(Args args) {
    extern __shared__ __attribute__((aligned(16))) unsigned char lds_raw[];
    Frame F;
    F.lds = (LAS unsigned char*)lds_raw; F.in = args.in; F.out = args.out; F.ws = args.ws; F.ctl = (unsigned*)(args.ws + WS_CTL);
    F.tid = threadIdx.x; F.lane = F.tid & 63; F.wave = __builtin_amdgcn_readfirstlane(F.tid >> 6); F.G = gridDim.x; F.bid = blockIdx.x;
    for (int u = F.tid; u < (LDS_BYTES - LDSCTL_OFF) / 4; u += NTHR) ((LAS unsigned*)(F.lds + LDSCTL_OFF))[u] = 0u;
    __syncthreads();
    XcdBarrier bar; bar.bar = F.ctl + CW_BAR; bar.x = 0; bar.st = nullptr;
    if (!MK_PER_PHASE) bar = xcd_barrier_post(F.ctl + CW_BAR, (volatile LAS unsigned*)(F.lds + MISC_OFF) + 8);
    const int lo = args.ph_lo, hi = args.ph_hi;
    PROF_DECL;
    using namespace pg8;
#define IN(k) (lo <= (k) && (k) < hi)
#define SEAM(k) do { if (IN(k) && IN((k) + 1)) { if (!MK_PER_PHASE) xcd_barrier(bar); } } while (0)
#define PHASE_FRAME() Frame P = F; P.ws = opq(P.ws); P.out = opq(P.out); P.ctl = opq(P.ctl); asm volatile("" : "+v"(P.tid)); P.lane = P.tid & 63; P.wave = __builtin_amdgcn_readfirstlane(P.tid >> 6); \
    unsigned char* ws = P.ws; LAS unsigned char* ring = P.lds; (void)ws; (void)ring

    PROF_BEGIN(100);
    if (IN(0)) for (int rep = 0; rep < NREP(13); ++rep) { PHASE_FRAME(); PROF_BEGIN(120); prep_x_tables(P); __syncthreads(); PROF_END(120); PROF_BEGIN(121); prep_mod(P); __syncthreads(); PROF_END(121); PROF_BEGIN(122); prep_weights(P, 0); __syncthreads(); PROF_END(122); PROF_BEGIN(124); prep_filters(P, 0); __syncthreads(); PROF_END(124); }
    SEAM(0);
    PROF_END(100);
#pragma unroll 1
    for (int l = 0; l < 2; ++l) {
        const int pb = 1 + 12 * l;
#define MODL ((const float*)(ws + WS_MOD) + (size_t)l * 3 * 6144)
        PROF_BEGIN(101);
        if (IN(pb + 0)) { PHASE_FRAME(); if (l == 1) { PROF_BEGIN(130); prep_weights(P, 1); __syncthreads(); PROF_END(130); PROF_BEGIN(131); prep_filters(P, 1); __syncthreads(); PROF_END(131); }
            for (int rep = 0; rep < NREP(0); ++rep) phase_norm(P, P.in[I_N1G] + l * DM, MODL, 0, 1024, (bf16_t*)(ws + WS_H)); }
        SEAM(pb + 0);
        PROF_END(101);
        PROF_BEGIN(102);
        if (IN(pb + 1)) for (int rep = 0; rep < NREP(1); ++rep) { PHASE_FRAME();
            { Gemm g{1024, 2048, 2048}; Sched2D S{(const char*)(ws + WS_H), (const char*)(ws + W_N), (size_t)256 * 2048, (size_t)256 * 2048, 48, 9, P.G, P.bid, 0, 0};
              EpiInN E{(bf16_t*)(ws + WS_QKV), (bf16_t*)(ws + WS_Z), (float*)(ws + WS_BA)};
              gemm_phase<EpiInN, Sched2D, true, true>(ring, g, S, E); }
            { Gemm g{1024, 2048, 2048}; Sched2D S{(const char*)(ws + W_S), (const char*)(ws + WS_H), (size_t)256 * 2048, (size_t)256 * 2048, 10, 48, P.G, P.bid, 0, 0};
              EpiInS E{(bf16_t*)(ws + WS_HYT), (bf16_t*)(ws + WS_XCSL), (bf16_t*)(ws + WS_XCSC)};
              gemm_phase<EpiInS, Sched2D, true, true>(ring, g, S, E); }
        }
        SEAM(pb + 1);
        PROF_END(102);
        PROF_BEGIN(103);
        if (IN(pb + 2)) {
            { PHASE_FRAME(); Gemm g{2048, 8192, 8192}; SchedFourL S{(const char*)(ws + WS_TABL), (const char*)(ws + WS_XCSL), P.bid};
              EpiScaleBf16 E{(bf16_t*)(ws + WS_YF), 512, 1.0f};
              gemm_phase<EpiScaleBf16, SchedFourL, true, true>(ring, g, S, E); }
            { PHASE_FRAME(); Gemm g{512, 1024, 1024}; SchedFourC S{(const char*)(ws + WS_TABC), (const char*)(ws + WS_XCSC), P.bid - 64};
              EpiScaleBf16 E{(bf16_t*)(ws + WS_YC), 512, 1.0f / sqrtf(64.0f * 256.0f)};
              gemm_phase<EpiScaleBf16, SchedFourC, true, true>(ring, g, S, E); }
            for (int rep = 0; rep < NREP(2); ++rep) { PHASE_FRAME(); __syncthreads();
              const int xq = P.bid & 7, qid = 16 + (2 * l + rep) * 8 + xq;
              for (int t = q_next(P, qid); t < 192; t = q_next(P, qid)) {
                if (t < 64) hyena_task(P, l, 64 * xq + t, 0);
                else { const int tt = t - 64; hyena_task(P, l, 64 * xq + (tt >> 1), 1 + (tt & 1)); }
              } }
        }
        SEAM(pb + 2);
        PROF_END(103);
        PROF_BEGIN(104);
        if (IN(pb + 3)) for (int rep = 0; rep < NREP(3); ++rep) { PHASE_FRAME();
            for (int t0 = 2 * P.bid; t0 < 1536; t0 += 2 * P.G) { const int t = t0 + (P.wave >> 2);
                int s, h, n;
                if (t < 1024) { s = t >> 5; h = (t >> 2) & 7; n = t & 3; } else { const int tt = t - 1024; s = 32 + (tt >> 8); h = (tt >> 5) & 7; n = tt & 31; }
                d1_task(P, l, s, h, n);
            }
        }
        SEAM(pb + 3);
        PROF_END(104);
        PROF_BEGIN(105);
        if (IN(pb + 4)) for (int rep = 0; rep < NREP(4); ++rep) { PHASE_FRAME();
            const int gw = P.wave * P.G + P.bid, NW = NWAVES * P.G;
            if (gw < 128) { d2_wave_task(P, l, 32 + (gw >> 6), (gw >> 3) & 7, (gw >> 2) & 1, gw & 3); }
            else for (int tt = gw - 128; tt < 2048; tt += NW - 128) d2_wave_task(P, l, tt >> 6, (tt >> 3) & 7, (tt >> 2) & 1, tt & 3);
        }
        SEAM(pb + 4);
        PROF_END(105);
        PROF_BEGIN(106);
        if (IN(pb + 5)) { PHASE_FRAME();
            { const u32x4* p0 = (const u32x4*)(ws + WS_YF); const u32x4* p1 = p0 + 4096 * 512 / 8; bf16_t* yc = (bf16_t*)(ws + WS_YC) + (size_t)NCTX * 512; const float sc = 1.0f / sqrtf(64.0f * 2048.0f);
              for (int i = P.bid * NTHR + P.tid; i < 4096 * 512 / 8; i += P.G * NTHR) { const u32x4 a = p0[i], b = p1[i];
                  *(u32x4*)(yc + (size_t)i * 8) = (u32x4){pk2((bflo(a.x) + bflo(b.x)) * sc, (bfhi(a.x) + bfhi(b.x)) * sc), pk2((bflo(a.y) + bflo(b.y)) * sc, (bfhi(a.y) + bfhi(b.y)) * sc),
                                                          pk2((bflo(a.z) + bflo(b.z)) * sc, (bfhi(a.z) + bfhi(b.z)) * sc), pk2((bflo(a.w) + bflo(b.w)) * sc, (bfhi(a.w) + bfhi(b.w)) * sc)}; } }
            phase_combine(P, l); phase_norm(P, P.in[I_N1G] + l * DM, MODL, 0, 1024, (bf16_t*)(ws + WS_H)); }
        SEAM(pb + 5);
        PROF_END(106);
        PROF_BEGIN(107);
        if (IN(pb + 6)) for (int rep = 0; rep < NREP(6); ++rep) { PHASE_FRAME(); Gemm g{1024, 2048, 2048}; Sched2D S{(const char*)(ws + WS_H), (const char*)(ws + W_G), (size_t)256 * 2048, (size_t)256 * 2048, 48, 12, P.G, P.bid, 0, 0};
            EpiGate E{(bf16_t*)(ws + WS_GATE)};
            gemm_phase<EpiGate, Sched2D, true, true>(ring, g, S, E); }
        SEAM(pb + 6);
        PROF_END(107);
        PROF_BEGIN(108);
        if (IN(pb + 7)) {
            static_assert(WS_YB == WS_YA + 12 * MiB && WS_YC == WS_YB + 12 * MiB, "y buffers 12 MiB apart");
#pragma unroll 1
            for (int br = 0; br < 3; ++br) { PHASE_FRAME(); Gemm g{512, 1024, 1024};
                Sched2D S{(const char*)(ws + WS_YA + (size_t)br * 12 * MiB), (const char*)(ws + W_P + (size_t)br * MiB), (size_t)256 * 1024, (size_t)256 * 1024, 48, 4, P.G, P.bid, 0, 0};
                EpiMergeAcc E{(bf16_t*)(ws + WS_MRG), (const bf16_t*)(ws + WS_GATE), br * 1024, br == 0 ? 1 : 0};
                gemm_phase<EpiMergeAcc, Sched2D, true, true>(ring, g, S, E); }
        }
        SEAM(pb + 7);
        PROF_END(108);
        PROF_BEGIN(109);
        if (IN(pb + 8)) { PHASE_FRAME(); Gemm g{1024, 2048, 6144}; Sched2D S{(const char*)(ws + WS_MRG), (const char*)(ws + W_O3), (size_t)256 * 2048, (size_t)256 * 6144, 48, 4, P.G, P.bid, 0, 0};
            EpiResid E{P.out, MODL + 2048};
            gemm_phase<EpiResid, Sched2D, false, true>(ring, g, S, E); }
        SEAM(pb + 8);
        PROF_END(109);
        PROF_BEGIN(110);
        if (IN(pb + 9)) { PHASE_FRAME(); phase_norm(P, P.in[I_N2G] + l * DM, MODL, 3072, 4096, (bf16_t*)(ws + WS_H)); }
        SEAM(pb + 9);
        PROF_END(110);
        PROF_BEGIN(111);
        if (IN(pb + 10)) for (int rep = 0; rep < NREP(10); ++rep) { PHASE_FRAME(); Gemm g{1024, 2048, 2048}; Sched2D S{(const char*)(ws + WS_H), (const char*)(ws + W_GU), (size_t)256 * 2048, (size_t)256 * 2048, 48, 22, P.G, P.bid, 0, 0};
            EpiGU E{(bf16_t*)(ws + WS_ACT)};
            gemm_phase<EpiGU, Sched2D, true, true>(ring, g, S, E); }
        SEAM(pb + 10);
        PROF_END(111);
        PROF_BEGIN(112);
        if (IN(pb + 11)) { PHASE_FRAME(); Gemm g{DFF, DFF * 2, DFF * 2}; Sched2D S{(const char*)(ws + WS_ACT), (const char*)(ws + W_DN), (size_t)256 * DFF * 2, (size_t)256 * DFF * 2, 48, 4, P.G, P.bid, 0, 0};
            EpiResid E{P.out, MODL + 5120};
            gemm_phase<EpiResid, Sched2D, false, true>(ring, g, S, E); }
        SEAM(pb + 11);
        PROF_END(112);
    }
    PROF_BEGIN(113);
    if (IN(25)) { PHASE_FRAME(); phase_final(P); }
    PROF_END(113); PROF_FLUSH();
    if (PROBE_ID != 0) { __syncthreads();
        if (blockIdx.x == PROBE_BLK && threadIdx.x == 0) { const unsigned tot = *(volatile LAS unsigned*)(F.lds + MISC_OFF + 96); unsigned long long want = (unsigned long long)tot * PROBE_AMP; if (want > 3000000ull) want = 3000000ull;
            const unsigned long long t0 = __builtin_amdgcn_s_memrealtime(); while (__builtin_amdgcn_s_memrealtime() - t0 < want) __builtin_amdgcn_s_sleep(16); }
        __syncthreads(); }
#undef IN
#undef SEAM
}

extern "C" void kernel_launch(void* const* d_in, const int* in_sizes, int n_in, void* d_out, int out_size, void* d_ws, size_t ws_size, hipStream_t stream) {
    static int grid = 0;
    if (grid == 0) {
        if (n_in != N_IN || out_size != NTOK * DM + 32 * 2 * 2 * 8 * 4096 || ws_size < WS_END) { fprintf(stderr, "kernel_launch: unexpected shapes (n_in %d out %d ws %zu); nothing launched\n", n_in, out_size, ws_size); grid = -1; return; }
        int dev = 0, cus = 0, per_cu = 0;
        if (hipGetDevice(&dev) != hipSuccess || hipDeviceGetAttribute(&cus, hipDeviceAttributeMultiprocessorCount, dev) != hipSuccess) { grid = -1; return; }
        if (hipFuncSetAttribute((const void*)mk_fwd, hipFuncAttributeMaxDynamicSharedMemorySize, LDS_BYTES) != hipSuccess) { fprintf(stderr, "kernel_launch: hipFuncSetAttribute failed\n"); grid = -1; return; }
        if (hipOccupancyMaxActiveBlocksPerMultiprocessor(&per_cu, (const void*)mk_fwd, NTHR, LDS_BYTES) != hipSuccess || per_cu < 1) { fprintf(stderr, "kernel_launch: occupancy query says %d blocks per CU; nothing launched\n", per_cu); (void)hipGetLastError(); grid = -1; return; }
        grid = cus;
    }
    if (grid < 0) return;
    if (hipMemsetAsync((char*)d_ws + WS_CTL, 0, CTL_ZERO_BYTES, stream) != hipSuccess) return;
    Args a{};
    for (int i = 0; i < N_IN; ++i) a.in[i] = (const float*)d_in[i];
    a.out = (float*)d_out; a.ws = (unsigned char*)d_ws;
#if MK_PER_PHASE
    for (int p = 0; p < N_PHASES; ++p) { a.ph_lo = p; a.ph_hi = p + 1; a.li = 0; hipLaunchKernelGGL(mk_fwd, dim3(grid), dim3(NTHR), LDS_BYTES, stream, a); }
#else
    a.ph_lo = 0; a.ph_hi = N_PHASES; a.li = 0;
    hipLaunchKernelGGL(mk_fwd, dim3(grid), dim3(NTHR), LDS_BYTES, stream, a);
#endif
}
```

```cpp
#include <hip/hip_runtime.h>
#include <cstdio>
#include <cstdint>

#ifndef MK_PER_PHASE
#define MK_PER_PHASE 0
#endif

#ifndef REPMASK
#define REPMASK 0
#endif
#define NREP(k) (((REPMASK >> (k)) & 1) ? 2 : 1)
#ifndef PROBE_ID
#define PROBE_ID 0
#endif
#define PROBE_AMP 10
#ifndef PROBE_BLK
#define PROBE_BLK 150
#endif
#ifndef PROBE_BLK
#define PROBE_BLK 200
#endif
#define PROF_COUNT(id) do { if (PROBE_ID == (id) && blockIdx.x == PROBE_BLK && threadIdx.x == 0) { *PROF_WORD(0) = *PROF_WORD(0) + 1000u; } } while (0)
#ifndef PROBE_BLK
#define PROBE_BLK 200
#endif
#define PROF_COUNT(id) do { if (PROBE_ID == (id) && blockIdx.x == PROBE_BLK && threadIdx.x == 0) { *PROF_WORD(0) = *PROF_WORD(0) + 1000u; } } while (0)
#define PROF_WORD(i) ((volatile __attribute__((address_space(3))) unsigned*)(F.lds + MISC_OFF + 96 + 4 * (i)))
#define PROF_BEGIN(id) do { if (PROBE_ID == (id) && blockIdx.x == PROBE_BLK && threadIdx.x == 0) { *PROF_WORD(1) = (unsigned)__builtin_amdgcn_s_memrealtime(); } } while (0)
#define PROF_END(id) do { if (PROBE_ID == (id) && blockIdx.x == PROBE_BLK && threadIdx.x == 0) { asm volatile("s_waitcnt vmcnt(0) lgkmcnt(0)" ::: "memory"); *PROF_WORD(0) = *PROF_WORD(0) + ((unsigned)__builtin_amdgcn_s_memrealtime() - *PROF_WORD(1)); } } while (0)
#define LAS __attribute__((address_space(3)))
#define GAS __attribute__((address_space(1)))
typedef unsigned short bf16_t;
typedef short bf16x8 __attribute__((ext_vector_type(8)));
typedef float f32x4 __attribute__((ext_vector_type(4)));
typedef float f32x2 __attribute__((ext_vector_type(2)));
typedef unsigned u32x4 __attribute__((ext_vector_type(4)));
typedef unsigned u32x2 __attribute__((ext_vector_type(2)));

constexpr int DM = 1024, NTOK = 12288, NCTX = 8192, LCTX = 256, LLAT = 2048, BCTX = 32, BLAT = 2;
constexpr int HA = 8, QKVW = 1536, DFF = 2816, DIN = 7200;
constexpr int OFF_Z = 1536, OFF_B = 2048, OFF_HY = 2080, OFF_FN = 3616, OFF_GATE = 4128;
constexpr float EPS = 1e-6f;
enum { I_XP = 0, I_XS, I_STATE, I_C, I_CCTX, I_WMOD, I_BMOD, I_N1G, I_N2G, I_WIN, I_CONVQKV, I_ALOG, I_DTB, I_NORMA, I_CONVHY,
       I_HW1, I_HB1, I_HFREQ, I_HW2, I_HB2, I_HW3, I_HBIAS, I_WPA, I_WPB, I_WPC, I_WO, I_WGU, I_WDOWN, I_NORMF, N_IN };

constexpr size_t MiB = 1u << 20;
constexpr size_t WS_CTL = 0, CTL_ZERO_BYTES = 256 * 1024;
constexpr size_t WS_MOD = 1 * MiB;
constexpr size_t WS_B0 = 1 * MiB + 512 * 1024;
constexpr size_t WS_TABC = 2 * MiB;
constexpr size_t WS_FILC = 3 * MiB;
constexpr size_t WS_FILL = 5 * MiB;
constexpr size_t WS_YF = 13 * MiB;
constexpr size_t WS_TABL = 21 * MiB;
constexpr size_t WS_W = 37 * MiB;
constexpr size_t W_N = WS_W;
constexpr size_t W_S = W_N + 2304 * 1024 * 2;
constexpr size_t W_G = W_S + 2560 * 1024 * 2;
constexpr size_t W_P = W_G + 3072 * 1024 * 2;
constexpr size_t W_O3 = W_P + 3 * 1024 * 512 * 2;
constexpr size_t W_GU = W_O3 + 1024 * 3072 * 2;
constexpr size_t W_DN = W_GU + 5632 * 1024 * 2;
constexpr size_t W_END = W_DN + 1024 * 2816 * 2;
static_assert(W_END <= 78 * MiB, "weights region");
constexpr size_t WS_A0 = 78 * MiB;
constexpr size_t WS_QKV = WS_A0, WS_OF = WS_A0, WS_OB = WS_A0 + 12 * MiB, WS_MRG = WS_A0;
constexpr size_t WS_Z = 116 * MiB, WS_YA = WS_Z;
constexpr size_t WS_BA = 114 * MiB;
constexpr size_t WS_YB = 128 * MiB, WS_YC = 140 * MiB;
constexpr size_t WS_A5 = 152 * MiB;
constexpr size_t WS_H = WS_A5;
constexpr size_t WS_HYT = WS_A5 + 24 * MiB;
constexpr size_t WS_XCS = WS_A5 + 60 * MiB;
constexpr size_t WS_XCSL = WS_XCS, WS_XCSC = WS_XCS + 8 * MiB;
constexpr size_t WS_QN = WS_A5, WS_KN = WS_A5 + 12 * MiB;
constexpr size_t WS_U = WS_A5 + 24 * MiB;
constexpr size_t WS_WW = WS_A5 + 48 * MiB;
constexpr size_t WS_QK = WS_A5 + 72 * MiB;
constexpr size_t WS_GC = WS_A5 + 96 * MiB;
constexpr size_t WS_GATE = WS_A5 + 24 * MiB;
constexpr size_t WS_ACT = WS_A5 + 24 * MiB;
constexpr size_t WS_END = 256 * MiB;
static_assert(WS_GC + 2 * 8 * 192 * 64 * 4 <= WS_END && WS_GATE + (size_t)NTOK * 3072 * 2 <= WS_END, "ws map");
constexpr int CW_BAR = 4096;
constexpr int CW_Q = 16384;

constexpr int RING_BYTES = 131072, LDSCTL_OFF = RING_BYTES, MISC_OFF = LDSCTL_OFF + 320, LDS_BYTES = 147456;
constexpr int NWAVES = 8, NTHR = 512;

#define RLX_AGENT __ATOMIC_RELAXED, __HIP_MEMORY_SCOPE_AGENT
#define LDS_WAIT() asm volatile("s_waitcnt lgkmcnt(0)" ::: "memory")
__device__ __forceinline__ unsigned f2bf(float f) { unsigned u = __builtin_bit_cast(unsigned, f); return (u + 0x7fffu + ((u >> 16) & 1u)) >> 16; }
__device__ __forceinline__ unsigned pk2(float lo, float hi) { return f2bf(lo) | (f2bf(hi) << 16); }
__device__ __forceinline__ float bf2f(unsigned short b) { return __builtin_bit_cast(float, (unsigned)b << 16); }
__device__ __forceinline__ float bflo(unsigned w) { return __builtin_bit_cast(float, w << 16); }
__device__ __forceinline__ float bfhi(unsigned w) { return __builtin_bit_cast(float, w & 0xffff0000u); }
__device__ __forceinline__ float sin_rev(float r) { return __builtin_amdgcn_sinf(r - rintf(r)); }
__device__ __forceinline__ float cos_rev(float r) { return __builtin_amdgcn_cosf(r - rintf(r)); }
__device__ __forceinline__ float sin_rad(float x) { return sin_rev(x * 0.15915494309189535f); }
__device__ __forceinline__ float cos_rad(float x) { return cos_rev(x * 0.15915494309189535f); }
__device__ __forceinline__ float sigmoidf_(float x) { return 1.f / (1.f + __expf(-x)); }
__device__ __forceinline__ float siluf_(float x) { return x / (1.f + __expf(-x)); }
__device__ __forceinline__ float wave_sum(float v) {
#pragma unroll
    for (int o = 1; o < 64; o <<= 1) v += __shfl_xor(v, o);
    return v;
}
template <class T> __device__ __forceinline__ T* opq(T* p) {
    unsigned lo = (unsigned)(uintptr_t)p, hi = (unsigned)((uintptr_t)p >> 32); asm volatile("" : "+v"(lo), "+v"(hi));
    lo = __builtin_amdgcn_readfirstlane(lo); hi = __builtin_amdgcn_readfirstlane(hi);
    return (T*)(GAS T*)(((uintptr_t)hi << 32) | (uintptr_t)lo);
}
__device__ __forceinline__ float dpp_f(float x, int ctrl_tag) {
    const int v = __builtin_bit_cast(int, x); int r;
    if (ctrl_tag == 0) r = __builtin_amdgcn_update_dpp(0, v, 0xB1, 0xF, 0xF, true);
    else if (ctrl_tag == 1) r = __builtin_amdgcn_update_dpp(0, v, 0x4E, 0xF, 0xF, true);
    else r = __builtin_amdgcn_update_dpp(0, v, 0x141, 0xF, 0xF, true);
    return __builtin_bit_cast(float, r);
}
__device__ __forceinline__ float sum8(float s) { s += dpp_f(s, 0); s += dpp_f(s, 1); s += dpp_f(s, 2); return s; }
__device__ __forceinline__ float lane_read(float x, int srclane) { return __builtin_bit_cast(float, __builtin_amdgcn_ds_bpermute(srclane << 2, __builtin_bit_cast(int, x))); }
__device__ __forceinline__ int seq_start(int s) { return s < 32 ? s * 256 : NCTX + (s - 32) * 2048; }
__device__ __forceinline__ int seq_len(int s) { return s < 32 ? 256 : 2048; }
__device__ __forceinline__ int mod_idx(int row) { return row < NCTX ? 0 : 1 + ((row - NCTX) >> 11); }

namespace pg8 {
constexpr int BM = 256, BK = 64, HALF = 128, HTB = HALF * BK * 2, STAGE_BYTES = 8 * HTB, NXCD = 8, WGM = 8;
__host__ __device__ __forceinline__ int lds_byte(int r, int c) { const int st = (r >> 4) * 2 + (c >> 5), rr = r & 15, cc = c & 31, ob = rr * 64 + cc * 2; return st * 1024 + (ob ^ (((ob >> 9) & 1) << 5)); }
__host__ __device__ __forceinline__ void stage_rc(int b, int& R, int& C) { const int st = b / 1024, sb = b % 1024, swz = sb ^ (((sb >> 9) & 1) << 5); R = (st >> 1) * 16 + swz / 64; C = (st & 1) * 32 + (swz % 64) / 2; }
__host__ __device__ __forceinline__ int perm32(int rho) { const int n = rho >> 4, i = rho & 15; return 8 * (i >> 2) + 4 * n + (i & 3); }

struct Unit { const char* a; const char* b; int r0, c0; };
struct Gemm { int K, lda, ldb; };

__device__ __forceinline__ bool static_order(long L, int nM, int nN, int& pm, int& pn) {
    const int nwg = nM * nN; if (L >= nwg) return false;
    int wgid = (int)L; { const int q = nwg / NXCD, r = nwg % NXCD, xcd = wgid % NXCD, off = wgid / NXCD; wgid = (xcd < r ? xcd * (q + 1) : r * (q + 1) + (xcd - r) * q) + off; }
    const int nig = WGM * nN, gid = wgid / nig, fm = gid * WGM, gsz = (nM - fm) < WGM ? (nM - fm) : WGM;
    pm = fm + ((wgid % nig) % gsz); pn = (wgid % nig) / gsz; return true;
}
__device__ __forceinline__ unsigned cvt_pk_bf16(float lo, float hi) { unsigned r; asm volatile("v_cvt_pk_bf16_f32 %0, %1, %2" : "=v"(r) : "v"(lo), "v"(hi)); return r; }

template <class Epi, class Sched, bool ALIGN_EPI, bool SP2>
__device__ __forceinline__ void gemm_phase(LAS unsigned char* lds, const Gemm g, const Sched& S, const Epi& E) {
    int tid_ = threadIdx.x; asm volatile("" : "+v"(tid_));
    const int tid = tid_, wid = __builtin_amdgcn_readfirstlane(tid >> 6), lane = tid & 63, wr = wid >> 2, wc = wid & 3, fr = lane & 15, fq = lane >> 4;
    const int K = g.K, nt = K / BK;
    unsigned voffA[2], voffB[2];
#pragma unroll
    for (int i = 0; i < 2; ++i) { int R, C; stage_rc(tid * 16 + i * 8192, R, C); const int Rb = Epi::PERM ? ((R & ~31) + perm32(R & 31)) : R;
        voffA[i] = (unsigned)(R * g.lda + C * 2); voffB[i] = (unsigned)(Rb * g.ldb + C * 2); }
    const size_t kstep = (size_t)(BK * 2);
    const size_t hstepA = (size_t)HALF * g.lda, hstepB = (size_t)HALF * g.ldb;
    const unsigned ldsw = (unsigned)wid * 1024u;
    const int aoff = lds_byte(wr * 64 + fr, fq * 8), boff = lds_byte(wc * 32 + fr, fq * 8);
#define PG8_SA(b, h) (((b) * 2 + (h)) * HTB)
#define PG8_SB(b, h) ((4 + (b) * 2 + (h)) * HTB)
#define PG8_STAGE(bufoff, gbase, voff) do { _Pragma("unroll") for (int _i = 0; _i < 2; ++_i) \
        __builtin_amdgcn_global_load_lds((const unsigned*)((const char*)(gbase) + (voff)[_i]), (LAS unsigned*)(lds + (bufoff) + ldsw + _i * 8192), 16, 0, 0); } while (0)
#define PG8_LDA(dst, b, h) do { _Pragma("unroll") for (int m = 0; m < 4; ++m) _Pragma("unroll") for (int k = 0; k < 2; ++k) dst[m][k] = *(const LAS bf16x8*)(lds + PG8_SA(b, h) + aoff + m * 2048 + k * 1024); } while (0)
#define PG8_LDB(dst, b, h) do { _Pragma("unroll") for (int n = 0; n < 2; ++n) _Pragma("unroll") for (int k = 0; k < 2; ++k) dst[n][k] = *(const LAS bf16x8*)(lds + PG8_SB(b, h) + boff + n * 2048 + k * 1024); } while (0)
#define PG8_MMA(ai, bj, At, Bt) do { __builtin_amdgcn_s_setprio(1); _Pragma("unroll") for (int m = 0; m < 4; ++m) _Pragma("unroll") for (int n = 0; n < 2; ++n) _Pragma("unroll") for (int k = 0; k < 2; ++k) \
        acc[ai][bj][m][n] = __builtin_amdgcn_mfma_f32_16x16x32_bf16(Bt[n][k], At[m][k], acc[ai][bj][m][n], 0, 0, 0); __builtin_amdgcn_s_setprio(0); } while (0)
#define PG8_WAIT_V(n) asm volatile("s_waitcnt vmcnt(" #n ")" ::: "memory")
#define PG8_WAIT_L(n) asm volatile("s_waitcnt lgkmcnt(" #n ")" ::: "memory")
#define PG8_BAR __builtin_amdgcn_s_barrier()
#define PG8_SCHED __builtin_amdgcn_sched_barrier(0)
    Unit cur, nxt; int ui = 0;
    if (!S.next(0, cur)) return;
    f32x4 acc[2][2][4][2];
#pragma unroll
    for (int a = 0; a < 2; ++a)
#pragma unroll
        for (int b = 0; b < 2; ++b)
#pragma unroll
            for (int m = 0; m < 4; ++m)
#pragma unroll
                for (int n = 0; n < 2; ++n) acc[a][b][m][n] = (f32x4){0.f, 0.f, 0.f, 0.f};
    bf16x8 At[4][2], B0[2][2], B1[2][2];
    const char* cA = cur.a; const char* cB = cur.b;
    if constexpr (SP2) {
        PG8_STAGE(PG8_SB(0, 0), cB, voffB); PG8_STAGE(PG8_SB(0, 1), cB + hstepB, voffB); PG8_STAGE(PG8_SA(0, 0), cA, voffA); PG8_STAGE(PG8_SA(0, 1), cA + hstepA, voffA);
        if (wr == 1) PG8_BAR;
        PG8_WAIT_V(2); PG8_BAR;
        PG8_STAGE(PG8_SB(1, 0), cB + kstep, voffB); PG8_STAGE(PG8_SA(1, 0), cA + kstep, voffA); PG8_STAGE(PG8_SB(1, 1), cB + hstepB + kstep, voffB);
        PG8_WAIT_V(6); PG8_BAR;
    } else {
        PG8_STAGE(PG8_SB(0, 0), cB, voffB); PG8_STAGE(PG8_SA(0, 0), cA, voffA); PG8_STAGE(PG8_SB(0, 1), cB + hstepB, voffB); PG8_STAGE(PG8_SA(0, 1), cA + hstepA, voffA);
        if (wr == 1) PG8_BAR;
        PG8_WAIT_V(4); PG8_BAR;
        PG8_STAGE(PG8_SB(1, 0), cB + kstep, voffB); PG8_STAGE(PG8_SA(1, 0), cA + kstep, voffA); PG8_STAGE(PG8_SB(1, 1), cB + hstepB + kstep, voffB);
        PG8_WAIT_V(6); PG8_BAR;
    }
    for (;;) {
        const bool has_next = S.next(ui + 1, nxt);
        const char* nA = has_next ? nxt.a : cA; const char* nB = has_next ? nxt.b : cB;
        for (int t = 0; t < nt; t += 2) {
            const bool last = (t == nt - 2);
            const char* a1 = cA + (size_t)(t + 1) * kstep;
            const char* a2 = last ? nA : cA + (size_t)(t + 2) * kstep; const char* b2 = last ? nB : cB + (size_t)(t + 2) * kstep;
            const char* a3 = a2 + kstep; const char* b3 = b2 + kstep;
            if constexpr (SP2) {
            PG8_LDB(B0, 0, 0); PG8_LDB(B1, 0, 1); PG8_SCHED; PG8_LDA(At, 0, 0); PG8_STAGE(PG8_SA(1, 1), a1 + hstepA, voffA);
            PG8_WAIT_V(8); PG8_WAIT_L(0); PG8_BAR; PG8_MMA(0, 0, At, B0); PG8_MMA(0, 1, At, B1); PG8_BAR; PG8_SCHED;
            PG8_LDA(At, 0, 1); PG8_STAGE(PG8_SB(0, 0), b2, voffB); PG8_STAGE(PG8_SB(0, 1), b2 + hstepB, voffB); PG8_STAGE(PG8_SA(0, 0), a2, voffA);
            PG8_WAIT_V(8); PG8_WAIT_L(0); PG8_BAR; PG8_MMA(1, 0, At, B0); PG8_MMA(1, 1, At, B1); PG8_BAR; PG8_SCHED;
            PG8_LDB(B0, 1, 0); PG8_LDB(B1, 1, 1); PG8_SCHED; PG8_LDA(At, 1, 0); PG8_STAGE(PG8_SA(0, 1), a2 + hstepA, voffA);
            PG8_WAIT_V(8); PG8_WAIT_L(0); PG8_BAR; PG8_MMA(0, 0, At, B0); PG8_MMA(0, 1, At, B1); PG8_BAR; PG8_SCHED;
            PG8_LDA(At, 1, 1); PG8_STAGE(PG8_SB(1, 0), b3, voffB); PG8_STAGE(PG8_SB(1, 1), b3 + hstepB, voffB); PG8_STAGE(PG8_SA(1, 0), a3, voffA);
            PG8_WAIT_V(8); PG8_WAIT_L(0); PG8_BAR; PG8_MMA(1, 0, At, B0); PG8_MMA(1, 1, At, B1); PG8_BAR; PG8_SCHED;
            } else {
            PG8_LDB(B0, 0, 0); PG8_SCHED; PG8_LDA(At, 0, 0); PG8_STAGE(PG8_SA(1, 1), a1 + hstepA, voffA);
            PG8_WAIT_L(8); PG8_BAR; PG8_WAIT_L(0); PG8_MMA(0, 0, At, B0); PG8_BAR; PG8_SCHED;
            PG8_LDB(B1, 0, 1); PG8_STAGE(PG8_SB(0, 0), b2, voffB);
            PG8_BAR; PG8_WAIT_L(0); PG8_MMA(0, 1, At, B1); PG8_BAR;
            PG8_LDA(At, 0, 1); PG8_STAGE(PG8_SA(0, 0), a2, voffA);
            PG8_BAR; PG8_WAIT_L(0); PG8_MMA(1, 0, At, B0); PG8_BAR; PG8_SCHED;
            PG8_STAGE(PG8_SB(0, 1), b2 + hstepB, voffB);
            PG8_WAIT_V(6); PG8_BAR; PG8_MMA(1, 1, At, B1); PG8_BAR;
            PG8_LDB(B0, 1, 0); PG8_SCHED; PG8_LDA(At, 1, 0); PG8_STAGE(PG8_SA(0, 1), a2 + hstepA, voffA);
            PG8_WAIT_L(8); PG8_BAR; PG8_WAIT_L(0); PG8_MMA(0, 0, At, B0); PG8_BAR; PG8_SCHED;
            PG8_LDB(B1, 1, 1); PG8_STAGE(PG8_SB(1, 0), b3, voffB);
            PG8_BAR; PG8_WAIT_L(0); PG8_MMA(0, 1, At, B1); PG8_BAR;
            PG8_LDA(At, 1, 1); PG8_STAGE(PG8_SA(1, 0), a3, voffA);
            PG8_BAR; PG8_WAIT_L(0); PG8_MMA(1, 0, At, B0); PG8_BAR; PG8_SCHED;
            PG8_STAGE(PG8_SB(1, 1), b3 + hstepB, voffB);
            PG8_WAIT_V(6); PG8_BAR; PG8_MMA(1, 1, At, B1); PG8_BAR;
            }
        }
        if constexpr (ALIGN_EPI) { if (wr == 0) PG8_BAR; }
        E(acc, cur, wr, wc, fr, fq);
        if (!has_next) break;
#pragma unroll
        for (int a = 0; a < 2; ++a)
#pragma unroll
            for (int b = 0; b < 2; ++b)
#pragma unroll
                for (int m = 0; m < 4; ++m)
#pragma unroll
                    for (int n = 0; n < 2; ++n) acc[a][b][m][n] = (f32x4){0.f, 0.f, 0.f, 0.f};
        cur = nxt; cA = nA; cB = nB; ++ui;
        if constexpr (ALIGN_EPI) { if (wr == 1) PG8_BAR; }
    }
    PG8_WAIT_V(0);
    if constexpr (!ALIGN_EPI) { if (wr == 0) PG8_BAR; }
    PG8_BAR;
#undef PG8_SA
#undef PG8_SB
#undef PG8_STAGE
#undef PG8_LDA
#undef PG8_LDB
#undef PG8_MMA
#undef PG8_WAIT_V
#undef PG8_WAIT_L
#undef PG8_BAR
#undef PG8_SCHED
}

struct Sched2D {
    const char* A; const char* B; size_t atile, btile; int nM, nN, G, c, r_base, c_base;
    __device__ __forceinline__ bool next(int i, Unit& u) const {
        if (c < 0) return false;
        int pm, pn; if (!static_order((long)i * G + c, nM, nN, pm, pn)) return false;
        u.a = A + (size_t)pm * atile; u.b = B + (size_t)pn * btile; u.r0 = r_base + pm * 256; u.c0 = c_base + pn * 256; return true;
    }
};
struct SchedMerge {
    const char *y0, *w0; int G, c;
    __device__ __forceinline__ bool next(int i, Unit& u) const {
        int pm, pn; if (!static_order((long)i * G + c, 48, 12, pm, pn)) return false;
        const int br = pn >> 2; const char* y = y0 + (size_t)br * (12u << 20); const char* w = w0 + (size_t)br * (1u << 20);
        u.a = y + (size_t)pm * 256 * 512 * 2; u.b = w + (size_t)(pn & 3) * 256 * 512 * 2; u.r0 = pm * 256; u.c0 = pn * 256; return true;
    }
};
struct SchedFourL {
    const char* tab; const char* xcs; int c;
    __device__ __forceinline__ bool next(int i, Unit& u) const {
        if (i > 0 || c < 0 || c >= 64) return false;
        const int ks = c >> 5, b = (c >> 4) & 1, pm = (c & 15) >> 1, pn = c & 1;
        u.a = tab + (size_t)pm * 256 * 4096 * 2 + (size_t)ks * 2048 * 2; u.b = xcs + ((size_t)b * 512 + pn * 256) * 4096 * 2 + (size_t)ks * 2048 * 2; u.r0 = ks * 4096 + b * 2048 + pm * 256; u.c0 = pn * 256; return true;
    }
};
struct SchedFourC {
    const char* tab; const char* xcs; int c;
    __device__ __forceinline__ bool next(int i, Unit& u) const {
        if (i > 0 || c < 0 || c >= 64) return false;
        const int b = c >> 1, pn = c & 1;
        u.a = tab; u.b = xcs + ((size_t)b * 512 + pn * 256) * 512 * 2; u.r0 = b * 256; u.c0 = pn * 256; return true;
    }
};

typedef f32x4 Acc[2][2][4][2];
struct EpiInN {
    static constexpr bool PERM = true;
    bf16_t* qkv; bf16_t* z; float* ba;
    __device__ __forceinline__ void operator()(const Acc& acc, const Unit& u, int wr, int wc, int fr, int fq) const {
        const int colt = u.c0;
#pragma unroll
        for (int ai = 0; ai < 2; ++ai)
#pragma unroll
            for (int m = 0; m < 4; ++m) { const int row = u.r0 + ai * HALF + wr * 64 + m * 16 + fr;
#pragma unroll
                for (int bj = 0; bj < 2; ++bj) { const int col = colt + bj * HALF + wc * 32 + 8 * fq; const f32x4 v0 = acc[ai][bj][m][0], v1 = acc[ai][bj][m][1];
                    if (colt < 2048) { u32x4 w; w.x = cvt_pk_bf16(v0[0], v0[1]); w.y = cvt_pk_bf16(v0[2], v0[3]); w.z = cvt_pk_bf16(v1[0], v1[1]); w.w = cvt_pk_bf16(v1[2], v1[3]);
                        bf16_t* p = colt < 1536 ? qkv + (size_t)row * 1536 + col : z + (size_t)row * 512 + (col - 1536);
                        *(u32x4*)p = w; }
                    else if (col - 2048 < 32) { float* p = ba + (size_t)row * 32 + (col - 2048); *(f32x4*)p = v0; *(f32x4*)(p + 4) = v1; } } }
    }
};
struct EpiInS {
    static constexpr bool PERM = true;
    bf16_t* hyt; bf16_t* xcsl; bf16_t* xcsc;
    __device__ __forceinline__ void operator()(const Acc& acc, const Unit& u, int wr, int wc, int fr, int fq) const {
#pragma unroll
        for (int ai = 0; ai < 2; ++ai)
#pragma unroll
            for (int m = 0; m < 4; ++m) { const int ch = u.r0 + ai * HALF + wr * 64 + m * 16 + fr;
#pragma unroll
                for (int bj = 0; bj < 2; ++bj) { const int tok = u.c0 + bj * HALF + wc * 32 + 8 * fq; const f32x4 v0 = acc[ai][bj][m][0], v1 = acc[ai][bj][m][1];
                    u32x4 w; w.x = cvt_pk_bf16(v0[0], v0[1]); w.y = cvt_pk_bf16(v0[2], v0[3]); w.z = cvt_pk_bf16(v1[0], v1[1]); w.w = cvt_pk_bf16(v1[2], v1[3]);
                    bf16_t* p;
                    if (ch < 1536) p = hyt + (size_t)ch * NTOK + tok;
                    else { const int cc = ch - 1536, which = cc >> 9, n = cc & 511;
                        if (tok < NCTX) { const int b = tok >> 8, t = tok & 255; p = xcsc + ((size_t)(b * 512 + n) * 512 + which * 256 + t); }
                        else { const int tt = tok - NCTX, b = tt >> 11, t = tt & 2047; p = xcsl + ((size_t)(b * 512 + n) * 4096 + which * 2048 + t); } }
                    *(u32x4*)p = w; } }
    }
};
struct EpiScaleBf16 {
    static constexpr bool PERM = true;
    bf16_t* O; int ldc; float scale;
    __device__ __forceinline__ void operator()(const Acc& acc, const Unit& u, int wr, int wc, int fr, int fq) const {
#pragma unroll
        for (int ai = 0; ai < 2; ++ai)
#pragma unroll
            for (int m = 0; m < 4; ++m) { const int row = u.r0 + ai * HALF + wr * 64 + m * 16 + fr;
#pragma unroll
                for (int bj = 0; bj < 2; ++bj) { const int col = u.c0 + bj * HALF + wc * 32 + 8 * fq; const f32x4 v0 = acc[ai][bj][m][0] * scale, v1 = acc[ai][bj][m][1] * scale;
                    u32x4 w; w.x = cvt_pk_bf16(v0[0], v0[1]); w.y = cvt_pk_bf16(v0[2], v0[3]); w.z = cvt_pk_bf16(v1[0], v1[1]); w.w = cvt_pk_bf16(v1[2], v1[3]);
                    *(u32x4*)(O + (size_t)row * ldc + col) = w; } }
    }
};
struct EpiAtomicF32 {
    static constexpr bool PERM = false;
    float* C; int ldc;
    __device__ __forceinline__ void operator()(const Acc& acc, const Unit& u, int wr, int wc, int fr, int fq) const {
#pragma unroll
        for (int ai = 0; ai < 2; ++ai)
#pragma unroll
            for (int m = 0; m < 4; ++m) { float* rowp = C + (size_t)(u.r0 + ai * HALF + wr * 64 + m * 16 + fr) * ldc + u.c0 + wc * 32 + 4 * fq;
#pragma unroll
                for (int bj = 0; bj < 2; ++bj)
#pragma unroll
                    for (int n = 0; n < 2; ++n)
#pragma unroll
                        for (int e = 0; e < 4; ++e) unsafeAtomicAdd(rowp + bj * HALF + n * 16 + e, acc[ai][bj][m][n][e]); }
    }
};
struct EpiGate {
    static constexpr bool PERM = true;
    bf16_t* O;
    __device__ __forceinline__ void operator()(const Acc& acc, const Unit& u, int wr, int wc, int fr, int fq) const {
#pragma unroll
        for (int ai = 0; ai < 2; ++ai)
#pragma unroll
            for (int m = 0; m < 4; ++m) { const int row = u.r0 + ai * HALF + wr * 64 + m * 16 + fr;
#pragma unroll
                for (int bj = 0; bj < 2; ++bj) { const int col = u.c0 + bj * HALF + wc * 32 + 8 * fq; const f32x4 v0 = acc[ai][bj][m][0], v1 = acc[ai][bj][m][1];
                    u32x4 w; w.x = cvt_pk_bf16(sigmoidf_(v0[0]), sigmoidf_(v0[1])); w.y = cvt_pk_bf16(sigmoidf_(v0[2]), sigmoidf_(v0[3]));
                    w.z = cvt_pk_bf16(sigmoidf_(v1[0]), sigmoidf_(v1[1])); w.w = cvt_pk_bf16(sigmoidf_(v1[2]), sigmoidf_(v1[3]));
                    *(u32x4*)(O + (size_t)row * 3072 + col) = w; } }
    }
};
struct EpiMerge {
    static constexpr bool PERM = true;
    bf16_t* O;
    __device__ __forceinline__ void operator()(const Acc& acc, const Unit& u, int wr, int wc, int fr, int fq) const {
#pragma unroll
        for (int ai = 0; ai < 2; ++ai)
#pragma unroll
            for (int m = 0; m < 4; ++m) { const int row = u.r0 + ai * HALF + wr * 64 + m * 16 + fr;
#pragma unroll
                for (int bj = 0; bj < 2; ++bj) { const int col = u.c0 + bj * HALF + wc * 32 + 8 * fq; const f32x4 v0 = acc[ai][bj][m][0], v1 = acc[ai][bj][m][1];
                    bf16_t* p = O + (size_t)row * 3072 + col; const u32x4 gg = *(const u32x4*)p;
                    u32x4 w; w.x = cvt_pk_bf16(v0[0] * bflo(gg.x), v0[1] * bfhi(gg.x)); w.y = cvt_pk_bf16(v0[2] * bflo(gg.y), v0[3] * bfhi(gg.y));
                    w.z = cvt_pk_bf16(v1[0] * bflo(gg.z), v1[1] * bfhi(gg.z)); w.w = cvt_pk_bf16(v1[2] * bflo(gg.w), v1[3] * bfhi(gg.w));
                    *(u32x4*)p = w; } }
    }
};
struct EpiMergeAcc {
    static constexpr bool PERM = true;
    bf16_t* M; const bf16_t* G; int gcol0; int first;
    __device__ __forceinline__ void operator()(const Acc& acc, const Unit& u, int wr, int wc, int fr, int fq) const {
#pragma unroll
        for (int ai = 0; ai < 2; ++ai)
#pragma unroll
            for (int m = 0; m < 4; ++m) { const int row = u.r0 + ai * HALF + wr * 64 + m * 16 + fr;
#pragma unroll
                for (int bj = 0; bj < 2; ++bj) { const int col = u.c0 + bj * HALF + wc * 32 + 8 * fq; const f32x4 v0 = acc[ai][bj][m][0], v1 = acc[ai][bj][m][1];
                    const u32x4 gg = *(const u32x4*)(G + (size_t)row * 3072 + gcol0 + col); bf16_t* p = M + (size_t)row * 1024 + col;
                    float o[8] = {v0[0] * bflo(gg.x), v0[1] * bfhi(gg.x), v0[2] * bflo(gg.y), v0[3] * bfhi(gg.y), v1[0] * bflo(gg.z), v1[1] * bfhi(gg.z), v1[2] * bflo(gg.w), v1[3] * bfhi(gg.w)};
                    if (!first) { const u32x4 mm = *(const u32x4*)p; o[0] += bflo(mm.x); o[1] += bfhi(mm.x); o[2] += bflo(mm.y); o[3] += bfhi(mm.y); o[4] += bflo(mm.z); o[5] += bfhi(mm.z); o[6] += bflo(mm.w); o[7] += bfhi(mm.w); }
                    u32x4 w; w.x = cvt_pk_bf16(o[0], o[1]); w.y = cvt_pk_bf16(o[2], o[3]); w.z = cvt_pk_bf16(o[4], o[5]); w.w = cvt_pk_bf16(o[6], o[7]);
                    *(u32x4*)p = w; } }
    }
};
struct EpiResid {
    static constexpr bool PERM = false;
    float* X; const float* gate;
    __device__ __forceinline__ void operator()(const Acc& acc, const Unit& u, int wr, int wc, int fr, int fq) const {
        const float* gp = gate + (size_t)mod_idx(u.r0) * 6144;
#pragma unroll
        for (int bj = 0; bj < 2; ++bj)
#pragma unroll
            for (int n = 0; n < 2; ++n) { const int col = u.c0 + bj * HALF + wc * 32 + 16 * n + 4 * fq; const f32x4 gv = *(const f32x4*)(gp + col);
#pragma unroll
                for (int ai = 0; ai < 2; ++ai)
#pragma unroll
                    for (int m = 0; m < 4; ++m) { const int row = u.r0 + ai * HALF + wr * 64 + m * 16 + fr; float* p = X + (size_t)row * DM + col;
                        const f32x4 x = *(const f32x4*)p; *(f32x4*)p = x + gv * acc[ai][bj][m][n]; } }
    }
};
struct EpiGU {
    static constexpr bool PERM = true;
    bf16_t* O;
    __device__ __forceinline__ void operator()(const Acc& acc, const Unit& u, int wr, int wc, int fr, int fq) const {
        const int col = (u.c0 >> 1) + wc * 32 + 8 * fq;
#pragma unroll
        for (int ai = 0; ai < 2; ++ai)
#pragma unroll
            for (int m = 0; m < 4; ++m) { const int row = u.r0 + ai * HALF + wr * 64 + m * 16 + fr;
                const f32x4 g0 = acc[ai][0][m][0], g1 = acc[ai][0][m][1], u0 = acc[ai][1][m][0], u1 = acc[ai][1][m][1];
                u32x4 w; w.x = cvt_pk_bf16(siluf_(g0[0]) * u0[0], siluf_(g0[1]) * u0[1]); w.y = cvt_pk_bf16(siluf_(g0[2]) * u0[2], siluf_(g0[3]) * u0[3]);
                w.z = cvt_pk_bf16(siluf_(g1[0]) * u1[0], siluf_(g1[1]) * u1[1]); w.w = cvt_pk_bf16(siluf_(g1[2]) * u1[2], siluf_(g1[3]) * u1[3]);
                *(u32x4*)(O + (size_t)row * DFF + col) = w; }
    }
};
}

#define XB_TMO      128
#define XB_XCNT(j)  (256  + 64 * (j))
#define XB_XSUB(j)  (1280 + 64 * (j))
#define XB_XGEN(j)  (2304 + 64 * (j))
#define XB_TOP      3328
#define XB_TOPGEN   3392
#define XCD_BAR_WORDS 3456
#define XB_SPIN_CAP (1u << 18)
__device__ __forceinline__ unsigned xb_ld(unsigned* p)              { return __hip_atomic_load(p, __ATOMIC_RELAXED, __HIP_MEMORY_SCOPE_AGENT); }
__device__ __forceinline__ unsigned xb_add(unsigned* p, unsigned v) { return __hip_atomic_fetch_add(p, v, __ATOMIC_RELAXED, __HIP_MEMORY_SCOPE_AGENT); }
__device__ __forceinline__ unsigned xb_xcc_id() { return (unsigned)__builtin_amdgcn_s_getreg((3 << 11) | 20) & 0xFu; }
#define XB_SPIN(cond, bar) do { unsigned _sp = 0; while (cond) { __builtin_amdgcn_s_sleep(1); \
    if ((++_sp & 255u) == 0u) { if (xb_ld(&(bar)[XB_TMO])) break; if (_sp > XB_SPIN_CAP) { atomicAdd(&(bar)[XB_TMO], 1u); break; } } } } while (0)
struct XcdBarrier { unsigned* bar; unsigned x; volatile LAS unsigned* st; };
__device__ __forceinline__ XcdBarrier xcd_barrier_post(unsigned* bar, volatile LAS unsigned* st) {
    XcdBarrier b; b.bar = bar; b.x = xb_xcc_id(); b.st = st;
    if (threadIdx.x == 0) (void)xb_add(&bar[XB_XCNT(b.x)], 1u);
    return b;
}
__device__ __forceinline__ void xcd_barrier_complete(unsigned* bar, unsigned x, unsigned& nloc, unsigned& nx) {
    const unsigned G = gridDim.x * gridDim.y * gridDim.z;
    unsigned sum, cnt, mine, sp = 0u;
    for (;;) {
        sum = 0u; cnt = 0u; mine = 0u;
#pragma unroll 1
        for (unsigned j = 0; j < 16; ++j) { const unsigned c = xb_ld(&bar[XB_XCNT(j)]); sum += c; cnt += (c > 0u) ? 1u : 0u; mine = (j == x) ? c : mine; }
        if (sum == G) break;
        __builtin_amdgcn_s_sleep(1);
        if ((++sp & 255u) == 0u) { if (xb_ld(&bar[XB_TMO])) break; if (sp > XB_SPIN_CAP) { atomicAdd(&bar[XB_TMO], 1u); break; } }
    }
    nloc = mine > 0u ? mine : 1u; nx = cnt > 0u ? cnt : 1u;
}
__device__ __forceinline__ void xcd_barrier(const XcdBarrier& b) {
    asm volatile("s_waitcnt vmcnt(0)" ::: "memory");
    __syncthreads();
    if (threadIdx.x == 0) {
        unsigned* bar = opq(b.bar);
        __builtin_amdgcn_s_waitcnt(0);
        unsigned nloc = b.st[0], nx = b.st[1];
        if (nloc == 0u) { xcd_barrier_complete(bar, b.x, nloc, nx); b.st[0] = nloc; b.st[1] = nx; }
        const unsigned old = xb_add(&bar[XB_XSUB(b.x)], 1u);
        const unsigned gen = old / nloc;
        if (old + 1u == (gen + 1u) * nloc) {
            __builtin_amdgcn_fence(__ATOMIC_RELEASE, "agent");
            asm volatile("s_waitcnt vmcnt(0)" ::: "memory");
            const unsigned og = xb_add(&bar[XB_TOP], 1u);
            const unsigned tg = og / nx;
            if (og + 1u == (tg + 1u) * nx) xb_add(&bar[XB_TOPGEN], 1u);
            else XB_SPIN(xb_ld(&bar[XB_TOPGEN]) == tg, bar);
            __builtin_amdgcn_fence(__ATOMIC_ACQUIRE, "agent");
            xb_add(&bar[XB_XGEN(b.x)], 1u);
            asm volatile("s_waitcnt vmcnt(0)" ::: "memory");
        } else {
            XB_SPIN(xb_ld(&bar[XB_XGEN(b.x)]) == gen, bar);
            __builtin_amdgcn_fence(__ATOMIC_ACQUIRE, "agent");
            asm volatile("s_waitcnt vmcnt(0)" ::: "memory");
        }
    }
    __syncthreads();
}

struct Args { const float* in[N_IN]; float* out; unsigned char* ws; int ph_lo, ph_hi, li, pad; };
struct Frame {
    LAS unsigned char* lds; const float* const* in; float* out; unsigned char* ws; unsigned* ctl;
    int tid, lane, wave, G, bid;
};
#define PROF_DECL do {} while (0)
#define PROF_FLUSH() do {} while (0)
__device__ __forceinline__ int q_next(Frame& F, int qid) {
    volatile LAS int* slot = (volatile LAS int*)(F.lds + MISC_OFF + 64);
    __syncthreads();
    if (F.tid == 0) *slot = (int)__hip_atomic_fetch_add(F.ctl + CW_Q + 64 * qid, 1u, RLX_AGENT);
    __syncthreads();
    return *slot;
}

__device__ __forceinline__ void transpose_item(const float* W, int ld_src, int col0, bf16_t* WT, int ld_dst, int dst_k0, int row0, int k0, LAS float* scr, int lane) {
    float tv[32];
#pragma unroll
    for (int i = 0; i < 32; ++i) tv[i] = W[(size_t)(k0 + 2 * i + (lane >> 5)) * ld_src + col0 + (lane & 31)];
#pragma unroll
    for (int i = 0; i < 32; ++i) scr[(2 * i + (lane >> 5)) * 33 + (lane & 31)] = tv[i];
    LDS_WAIT(); asm volatile("" ::: "memory");
    const int c = lane & 7;
#pragma unroll
    for (int j = 0; j < 4; ++j) { const int n = (lane >> 3) + 8 * j; const LAS float* s = scr + (8 * c) * 33 + n;
        u32x4 o; o.x = pk2(s[0 * 33], s[1 * 33]); o.y = pk2(s[2 * 33], s[3 * 33]); o.z = pk2(s[4 * 33], s[5 * 33]); o.w = pk2(s[6 * 33], s[7 * 33]);
        *(u32x4*)(WT + (size_t)(row0 + n) * ld_dst + dst_k0 + k0 + 8 * c) = o; }
    LDS_WAIT(); asm volatile("" ::: "memory");
}
__device__ __forceinline__ void prep_weights(Frame& F, int l) {
    LAS float* scr = (LAS float*)(F.lds + F.wave * 16384);
    const int gw = F.bid * NWAVES + F.wave, NGW = F.G * NWAVES;
    const float* w_in = F.in[I_WIN] + (size_t)l * DM * DIN;
    unsigned char* ws = F.ws;
    constexpr int NI_QKVZBA = 16 * (2080 / 32), NI_HY = 16 * 48, NI_G = 16 * 96, NI_P = 8 * 32, NI_O = 16 * 32, NI_GU = 16 * 176, NI_DN = 44 * 32;
    constexpr int NITEMS = NI_QKVZBA + NI_HY + NI_G + 3 * NI_P + 3 * NI_O + NI_GU + NI_DN;
#pragma unroll 1
    for (int it = gw; it < NITEMS; it += NGW) {
        int r = it;
        const float* src; int ld_src, col0, ld_dst, dst_k0, row0, k0; bf16_t* dst;
        if (r < NI_QKVZBA) { const int nb = r % 65, kb = r / 65; src = w_in; ld_src = DIN; col0 = nb * 32; dst = (bf16_t*)(ws + W_N); ld_dst = 1024; dst_k0 = 0; row0 = nb * 32; k0 = kb * 64; }
        else if ((r -= NI_QKVZBA) < NI_HY) { const int nb = r % 48, kb = r / 48; src = w_in; ld_src = DIN; col0 = OFF_HY + nb * 32; dst = (bf16_t*)(ws + W_S); ld_dst = 1024; dst_k0 = 0; row0 = nb * 32; k0 = kb * 64; }
        else if ((r -= NI_HY) < NI_G) { const int nb = r % 96, kb = r / 96; src = w_in; ld_src = DIN; col0 = OFF_GATE + nb * 32; dst = (bf16_t*)(ws + W_G); ld_dst = 1024; dst_k0 = 0; row0 = nb * 32; k0 = kb * 64; }
        else if ((r -= NI_G) < 3 * NI_P) { const int j = r / NI_P, q = r % NI_P, nb = q % 32, kb = q / 32; src = (j == 0 ? F.in[I_WPA] : (j == 1 ? F.in[I_WPB] : F.in[I_WPC])) + (size_t)l * 512 * 1024;
            ld_src = 1024; col0 = nb * 32; dst = (bf16_t*)(ws + W_P) + (size_t)j * 1024 * 512; ld_dst = 512; dst_k0 = 0; row0 = nb * 32; k0 = kb * 64; }
        else if ((r -= 3 * NI_P) < 3 * NI_O) { const int j = r / NI_O, q = r % NI_O, nb = q % 32, kb = q / 32; src = F.in[I_WO] + (size_t)l * 1024 * 1024;
            ld_src = 1024; col0 = nb * 32; dst = (bf16_t*)(ws + W_O3); ld_dst = 3072; dst_k0 = j * 1024; row0 = nb * 32; k0 = kb * 64; }
        else if ((r -= 3 * NI_O) < NI_GU) { const int nb = r % 176, kb = r / 176; const int n0 = nb * 32, up = n0 >= DFF ? 1 : 0, nn = n0 - up * DFF;
            src = F.in[I_WGU] + (size_t)l * 1024 * 5632; ld_src = 5632; col0 = n0; dst = (bf16_t*)(ws + W_GU); ld_dst = 1024; dst_k0 = 0; row0 = 256 * (nn / 128) + 128 * up + (nn % 128); k0 = kb * 64; }
        else { r -= NI_GU; const int nb = r % 32, kb = r / 32; src = F.in[I_WDOWN] + (size_t)l * DFF * 1024; ld_src = 1024; col0 = nb * 32; dst = (bf16_t*)(ws + W_DN); ld_dst = DFF; dst_k0 = 0; row0 = nb * 32; k0 = kb * 64; }
        transpose_item(src, ld_src, col0, dst, ld_dst, dst_k0, row0, k0, scr, F.lane);
    }
    { u32x4* z = (u32x4*)(ws + W_N + (size_t)2080 * 1024 * 2); const int n16 = 224 * 1024 * 2 / 16;
      for (int i = F.bid * NTHR + F.tid; i < n16; i += F.G * NTHR) z[i] = (u32x4){0u, 0u, 0u, 0u}; }
    __syncthreads();
    {
        LAS float* tile = (LAS float*)F.lds;
        LAS float* ctab = tile + 64 * 65;
        if (F.tid < 64) { ctab[F.tid] = cos_rev((float)F.tid / 64.0f); ctab[64 + F.tid] = sin_rev((float)F.tid / 64.0f); }
        for (int task = F.bid; task < 128; task += F.G) {
            const int kb = task >> 3, g = task & 7;
            __syncthreads();
            for (int i = F.tid; i < 4096; i += NTHR) { const int kk = i >> 6, cc = i & 63; tile[kk * 65 + cc] = w_in[(size_t)(kb * 64 + kk) * DIN + OFF_FN + g * 64 + cc]; }
            __syncthreads();
            const int kk = F.tid & 63, cq = F.tid >> 6;
#pragma unroll 1
            for (int j = 0; j < 8; ++j) { const int c = cq * 8 + j; float ac = 0.f, as = 0.f;
#pragma unroll 4
                for (int cp = 0; cp < 64; ++cp) { const float w = tile[kk * 65 + cp]; const int idx = (c * cp) & 63; ac += w * ctab[idx]; as += w * ctab[64 + idx]; }
                bf16_t* d = (bf16_t*)(ws + W_S);
                d[(size_t)(1536 + g * 64 + c) * 1024 + kb * 64 + kk] = (bf16_t)f2bf(ac);
                d[(size_t)(2048 + g * 64 + c) * 1024 + kb * 64 + kk] = (bf16_t)f2bf(as); }
        }
        __syncthreads();
    }
}
typedef float f32x16 __attribute__((ext_vector_type(16)));
__device__ __forceinline__ void prep_filters(Frame& F, int l) {
    LAS bf16_t* h2b = (LAS bf16_t*)F.lds;
    LAS bf16_t* w3t = h2b + 64 * 72;
    LAS float* zp = (LAS float*)w3t;
    LAS float* h1 = zp + 64 * 33;
    LAS float* w1s = h1 + 64 * 64;
    LAS float* w2s = w1s + 33 * 64;
    const float* w1 = F.in[I_HW1] + l * 33 * 64; const float* b1 = F.in[I_HB1] + l * 64; const float* fq = F.in[I_HFREQ] + l * 64;
    const float* w2 = F.in[I_HW2] + l * 64 * 64; const float* b2 = F.in[I_HB2] + l * 64; const float* w3 = F.in[I_HW3] + (size_t)l * 64 * 2048;
    for (int task4 = F.G - 1 - F.bid; task4 < 144; task4 += F.G) {
        const int task = task4 >> 2, qsel = task4 & 3;
        const int L = task < 32 ? LLAT : LCTX, t0 = (task < 32 ? task : task - 32) * 64;
        bf16_t* fil = (bf16_t*)(F.ws + (task < 32 ? WS_FILL : WS_FILC));
        float wcol[64];
#pragma unroll
        for (int k = 0; k < 64; ++k) wcol[k] = w3[(size_t)k * 2048 + qsel * 512 + F.tid];
        unsigned wpk[32];
#pragma unroll
        for (int k = 0; k < 32; ++k) wpk[k] = pk2(wcol[2 * k], wcol[2 * k + 1]);
        __syncthreads();
        for (int i = F.tid; i < 33 * 64; i += NTHR) w1s[i] = w1[i];
        for (int i = F.tid; i < 64 * 64; i += NTHR) w2s[i] = w2[i];
        for (int i = F.tid; i < 64 * 33; i += NTHR) { const int tt = i / 33, e = i % 33; const int ti = t0 + tt;
            float v;
            if (e == 0) v = (float)ti / (float)(L - 1);
            else { const int b = (e - 1) & 15; const float fr = 1e-4f + (15.0f - 1e-4f) * (float)b / 15.0f; const float rv = fr * ((float)ti / (float)L);
                   v = e <= 16 ? cos_rev(rv) : -sin_rev(rv); }
            zp[i] = v; }
        __syncthreads();
        for (int i = F.tid; i < 4096; i += NTHR) { const int tt = i >> 6, j = i & 63; float a = b1[j];
            for (int e = 0; e < 33; ++e) a += zp[tt * 33 + e] * w1s[e * 64 + j];
            h1[i] = sin_rad(fq[j] * a); }
        __syncthreads();
        for (int i = F.tid; i < 4096; i += NTHR) { const int tt = i >> 6, j = i & 63; float a = b2[j];
            for (int k = 0; k < 64; ++k) a += h1[tt * 64 + k] * w2s[k * 64 + j];
            h2b[tt * 72 + j] = (bf16_t)f2bf(sin_rad(fq[j] * a)); }
        __syncthreads();
#pragma unroll
        for (int m = 0; m < 8; ++m) *(LAS u32x4*)(w3t + F.tid * 72 + 8 * m) = (u32x4){wpk[4 * m], wpk[4 * m + 1], wpk[4 * m + 2], wpk[4 * m + 3]};
        __syncthreads();
        const int r = F.lane & 31, hh = F.lane >> 5;
        const float dmin = 4.605170185988091f / 1.5f, dmax = 4.605170185988091f / 0.3f;
#pragma unroll 1
        for (int tile = 0; tile < 4; ++tile) { const int ct = 2 * F.wave + (tile & 1), rt = tile >> 1;
            const LAS bf16_t* Am = h2b + (32 * rt + r) * 72 + 8 * hh; const LAS bf16_t* Bm = w3t + (32 * ct + r) * 72 + 8 * hh;
            f32x16 acc;
#pragma unroll
            for (int e = 0; e < 16; ++e) acc[e] = 0.f;
#pragma unroll
            for (int ks = 0; ks < 4; ++ks) acc = __builtin_amdgcn_mfma_f32_32x32x16_bf16(*(const LAS bf16x8*)(Am + 16 * ks), *(const LAS bf16x8*)(Bm + 16 * ks), acc, 0, 0, 0);
            const int c = 32 * ct + r, n = qsel * 512 + c; const float delta = dmin + (dmax - dmin) * (float)c / 511.0f;
            bf16_t* dst = fil + (size_t)n * L + t0;
#pragma unroll
            for (int g = 0; g < 4; ++g) { const int tt4 = 32 * rt + 8 * g + 4 * hh; float v[4];
#pragma unroll
                for (int e = 0; e < 4; ++e) { const float tl = (float)(t0 + tt4 + e) / (float)(L - 1); v[e] = acc[4 * g + e] * expf(-tl * delta); }
                *(u32x2*)(dst + tt4) = (u32x2){pk2(v[0], v[1]), pk2(v[2], v[3])}; } }
    }
    __syncthreads();
}
__device__ __forceinline__ void prep_mod(Frame& F) {
    LAS float* sc = (LAS float*)F.lds;
    LAS float* red = sc + 3 * 1024;
    __syncthreads();
    for (int i = F.tid; i < 3 * 1024; i += NTHR) { const int mi = i >> 10, k = i & 1023; const float v = mi == 0 ? F.in[I_CCTX][k] : F.in[I_C][(mi - 1) * 1024 + k]; sc[i] = v / (1.f + expf(-v)); }
    __syncthreads();
    float* mod = (float*)(F.ws + WS_MOD);
    for (int task = F.bid; task < 192; task += F.G) {
        const int l = task / 96, j = task % 96, n = j * 64 + F.lane;
        const float* w = F.in[I_WMOD] + (size_t)l * 1024 * 6144 + n;
        float a0 = 0.f, a1 = 0.f, a2 = 0.f;
        const int kb = F.wave * 128;
#pragma unroll 32
        for (int k = 0; k < 128; ++k) { const float wv = w[(size_t)(kb + k) * 6144]; a0 += sc[kb + k] * wv; a1 += sc[1024 + kb + k] * wv; a2 += sc[2048 + kb + k] * wv; }
        red[(F.wave * 3 + 0) * 64 + F.lane] = a0; red[(F.wave * 3 + 1) * 64 + F.lane] = a1; red[(F.wave * 3 + 2) * 64 + F.lane] = a2;
        __syncthreads();
        if (F.tid < 192) { const int mi = F.tid >> 6, ln = F.tid & 63; float s = F.in[I_BMOD][l * 6144 + j * 64 + ln];
            for (int w8 = 0; w8 < 8; ++w8) s += red[(w8 * 3 + mi) * 64 + ln];
            mod[((size_t)l * 3 + mi) * 6144 + j * 64 + ln] = s; }
        __syncthreads();
    }
}
__device__ __forceinline__ void prep_x_tables(Frame& F) {
    const int gt = F.bid * NTHR + F.tid, NG = F.G * NTHR;
    for (int i = gt; i < NTOK * DM / 4; i += NG) {
        const int row = i >> 8, c4 = (i & 255) * 4;
        f32x4 v;
        if (row < NCTX) v = *(const f32x4*)(F.in[I_XP] + (size_t)row * DM + c4);
        else { const int tt = row - NCTX, t = tt & 2047; v = *(const f32x4*)(F.in[I_XS] + (size_t)tt * DM + c4);
            const int seg = c4 >> 8; const float pos = (seg < 2) ? (float)(t >> 6) : (float)(t & 63);
#pragma unroll
            for (int u = 0; u < 4; ++u) { const int ii = (c4 + u) & 255; const float om = expf(-9.210340371976184f * (float)ii / 256.0f); const float a = pos * om;
                v[u] += (seg & 1) ? cos_rad(a) : sin_rad(a); } }
        *(f32x4*)(F.out + (size_t)row * DM + c4) = v;
    }
    for (int i = gt; i < 2048 * 4096 / 8; i += NG) { const int tp = i >> 9, k0 = (i & 511) * 8; unsigned w[4];
#pragma unroll
        for (int u = 0; u < 4; ++u) { float v[2];
#pragma unroll
            for (int e = 0; e < 2; ++e) { const int k = k0 + 2 * u + e; const int m = (tp * (k & 2047)) & 2047; const float x = (float)m / 2048.0f; v[e] = k < 2048 ? cos_rev(x) : -sin_rev(x); }
            w[u] = pk2(v[0], v[1]); }
        *(u32x4*)((bf16_t*)(F.ws + WS_TABL) + (size_t)tp * 4096 + k0) = (u32x4){w[0], w[1], w[2], w[3]}; }
    for (int i = gt; i < 256 * 512 / 8; i += NG) { const int tp = i >> 6, k0 = (i & 63) * 8; unsigned w[4];
#pragma unroll
        for (int u = 0; u < 4; ++u) { float v[2];
#pragma unroll
            for (int e = 0; e < 2; ++e) { const int k = k0 + 2 * u + e; const int m = (tp * (k & 255)) & 255; const float x = (float)m / 256.0f; v[e] = k < 256 ? cos_rev(x) : -sin_rev(x); }
            w[u] = pk2(v[0], v[1]); }
        *(u32x4*)((bf16_t*)(F.ws + WS_TABC) + (size_t)tp * 512 + k0) = (u32x4){w[0], w[1], w[2], w[3]}; }
}

__device__ __forceinline__ void phase_norm(Frame& F, const float* g, const float* modl, int sh_off, int sc_off, bf16_t* H) {
    const int gw = F.bid * NWAVES + F.wave, NGW = F.G * NWAVES;
    for (int row0 = gw; row0 < NTOK; row0 += 2 * NGW) {
        const int row1 = row0 + NGW < NTOK ? row0 + NGW : row0;
        const f32x4* xr0 = (const f32x4*)(F.out + (size_t)row0 * DM) + F.lane; const f32x4* xr1 = (const f32x4*)(F.out + (size_t)row1 * DM) + F.lane;
        f32x4 v0[4], v1[4]; float s0 = 0.f, s1 = 0.f;
#pragma unroll
        for (int j = 0; j < 4; ++j) { v0[j] = xr0[64 * j]; v1[j] = xr1[64 * j]; }
#pragma unroll
        for (int j = 0; j < 4; ++j) { s0 += (v0[j].x * v0[j].x + v0[j].y * v0[j].y) + (v0[j].z * v0[j].z + v0[j].w * v0[j].w); s1 += (v1[j].x * v1[j].x + v1[j].y * v1[j].y) + (v1[j].z * v1[j].z + v1[j].w * v1[j].w); }
        const float rstd0 = 1.0f / sqrtf(wave_sum(s0) * (1.f / DM) + EPS), rstd1 = 1.0f / sqrtf(wave_sum(s1) * (1.f / DM) + EPS);
        const float* mp0 = modl + (size_t)mod_idx(row0) * 6144; const float* mp1 = modl + (size_t)mod_idx(row1) * 6144;
        u32x2* o0 = (u32x2*)(H + (size_t)row0 * DM) + F.lane; u32x2* o1 = (u32x2*)(H + (size_t)row1 * DM) + F.lane;
#pragma unroll
        for (int j = 0; j < 4; ++j) { const int c = 4 * F.lane + 256 * j; const f32x4 gg = *(const f32x4*)(g + c);
            const f32x4 y0 = (v0[j] * rstd0) * gg * (*(const f32x4*)(mp0 + sc_off + c) + 1.0f) + *(const f32x4*)(mp0 + sh_off + c);
            const f32x4 y1 = (v1[j] * rstd1) * gg * (*(const f32x4*)(mp1 + sc_off + c) + 1.0f) + *(const f32x4*)(mp1 + sh_off + c);
            o0[64 * j] = (u32x2){pk2(y0.x, y0.y), pk2(y0.z, y0.w)};
            if (row1 != row0) o1[64 * j] = (u32x2){pk2(y1.x, y1.y), pk2(y1.z, y1.w)}; }
    }
}
__device__ __forceinline__ void phase_final(Frame& F) {
    const int gw = F.bid * NWAVES + F.wave, NGW = F.G * NWAVES; const float* g = F.in[I_NORMF];
    for (int row = gw; row < NTOK; row += NGW) {
        f32x4* xr = (f32x4*)(F.out + (size_t)row * DM) + F.lane;
        f32x4 v[4]; float s = 0.f;
#pragma unroll
        for (int j = 0; j < 4; ++j) { v[j] = xr[64 * j]; s += (v[j].x * v[j].x + v[j].y * v[j].y) + (v[j].z * v[j].z + v[j].w * v[j].w); }
        const float rstd = 1.0f / sqrtf(wave_sum(s) * (1.f / DM) + EPS);
#pragma unroll
        for (int j = 0; j < 4; ++j) { const int c = 4 * F.lane + 256 * j; const f32x4 gg = *(const f32x4*)(g + c); xr[64 * j] = (v[j] * rstd) * gg; }
    }
}

constexpr int HY_X1 = 0, HY_X2 = 8192, HY_ZP1 = 16384, HY_ZP2 = 47104, HY_TR = 77824, HY_TRCOPY = 8256, HY_TRORD = 16512, HY_RED = 110848;
static_assert(HY_RED + 16384 <= RING_BYTES, "hyena LDS map");
__device__ __forceinline__ void hyena_task(Frame& F, int l, int c, int grp) {
    int tid_ = F.tid; asm volatile("" : "+v"(tid_));
    const int tid = tid_, lane = tid & 63, wave = __builtin_amdgcn_readfirstlane(tid >> 6);
    const int L = grp == 0 ? LLAT : LCTX, nb = L >> 5, ZSEQ = (3 * L / 32) * 40, row0 = grp == 0 ? NCTX : (grp - 1) * 4096;
    LAS unsigned char* lds = F.lds;
    const bf16_t* hyt = (const bf16_t*)(F.ws + WS_HYT);
    const float* cw = F.in[I_CONVHY] + (size_t)l * 3 * 1536;
    const float* fil = (const float*)(F.ws + (grp == 0 ? WS_FILL : WS_FILC));
    const float* hb = F.in[I_HBIAS] + (size_t)l * 2 * 512;
    PROF_DECL;
    __syncthreads();
    if (grp == 0) PROF_COUNT(4); else PROF_COUNT(5);
    PROF_BEGIN(1);
    {
        const int p = 8 * tid, t = p & (L - 1), qs = p / L;
#pragma unroll
        for (int st = 0; st < 3; ++st) { const int ch = st * 512 + c; const bf16_t* src = hyt + (size_t)ch * NTOK + row0 + p;
            const u32x4 rv = *(const u32x4*)src; const float xm_ = bf2f(src[t > 0 ? -1 : 0]), xp_ = bf2f(src[t + 8 < L ? 8 : 0]); const float xm = t > 0 ? xm_ : 0.f, xp = t + 8 < L ? xp_ : 0.f;
            const float w0 = cw[ch], w1 = cw[1536 + ch], w2 = cw[2 * 1536 + ch];
            const float x[10] = {xm, bflo(rv.x), bfhi(rv.x), bflo(rv.y), bfhi(rv.y), bflo(rv.z), bfhi(rv.z), bflo(rv.w), bfhi(rv.w), xp};
            float o[8];
#pragma unroll
            for (int e = 0; e < 8; ++e) o[e] = w0 * x[e] + w1 * x[e + 1] + w2 * x[e + 2];
            const u32x4 pk = (u32x4){pk2(o[0], o[1]), pk2(o[2], o[3]), pk2(o[4], o[5]), pk2(o[6], o[7])};
            if (st < 2) *(LAS u32x4*)(lds + (st == 0 ? HY_X1 : HY_X2) + p * 2) = pk;
            else *(LAS u32x4*)(lds + HY_ZP1 + (qs * ZSEQ + (nb + (t >> 5)) * 40 + (t & 31)) * 2) = pk; }
        const int npad = (4096 / L) * 2 * nb;
        for (int i2 = tid; i2 < 2 * npad * 5; i2 += NTHR) { const int img = i2 / (npad * 5), rem = i2 % (npad * 5), pbk = rem / 5, piece = rem % 5;
            const int qs2 = pbk / (2 * nb), bb = pbk % (2 * nb), blk = bb < nb ? bb : bb + nb;
            *(LAS u32x4*)(lds + (img == 0 ? HY_ZP1 : HY_ZP2) + (qs2 * ZSEQ + blk * 40) * 2 + piece * 16) = (u32x4){0u, 0u, 0u, 0u}; }
    }
    PROF_END(1); PROF_BEGIN(2);
    { const bf16_t* fb16 = (const bf16_t*)fil; const int npc = L / 8;
      for (int i2 = tid; i2 < 4 * npc; i2 += NTHR) { const int jd = i2 / npc, k = i2 % npc, o = jd >> 1, dirn = jd & 1;
          const u32x4 v = *(const u32x4*)(fb16 + ((size_t)jd * 512 + c) * L + 8 * k);
          LAS unsigned char* c0 = lds + HY_TR + o * HY_TRORD; LAS unsigned char* c1 = c0 + HY_TRCOPY;
          const unsigned e0 = v.x & 0xffffu, e1 = v.x >> 16, e2 = v.y & 0xffffu, e3 = v.y >> 16, e4 = v.z & 0xffffu, e5 = v.z >> 16, e6 = v.w & 0xffffu, e7 = v.w >> 16;
          if (dirn == 0) {
              const int p1 = L - 8 * k - 8;
              *(LAS u32x4*)(c1 + p1 * 2) = (u32x4){e7 | (e6 << 16), e5 | (e4 << 16), e3 | (e2 << 16), e1 | (e0 << 16)};
              const int p0 = L - 8 * k - 7;
              *(LAS unsigned short*)(c0 + p0 * 2) = (unsigned short)e7;
              *(LAS unsigned*)(c0 + (p0 + 1) * 2) = e6 | (e5 << 16); *(LAS unsigned*)(c0 + (p0 + 3) * 2) = e4 | (e3 << 16); *(LAS unsigned*)(c0 + (p0 + 5) * 2) = e2 | (e1 << 16);
              *(LAS unsigned short*)(c0 + (p0 + 7) * 2) = (unsigned short)e0;
          } else {
              const int q0 = L + 8 * k;
              if (k > 0) *(LAS u32x4*)(c0 + q0 * 2) = v;
              else { *(LAS unsigned short*)(c0 + (q0 + 1) * 2) = (unsigned short)e1; *(LAS unsigned*)(c0 + (q0 + 2) * 2) = v.y; *(LAS unsigned*)(c0 + (q0 + 4) * 2) = v.z; *(LAS unsigned*)(c0 + (q0 + 6) * 2) = v.w; }
              const int q1 = q0 - 1;
              if (k > 0) *(LAS unsigned short*)(c1 + q1 * 2) = (unsigned short)e0;
              *(LAS unsigned*)(c1 + (q1 + 1) * 2) = e1 | (e2 << 16); *(LAS unsigned*)(c1 + (q1 + 3) * 2) = e3 | (e4 << 16); *(LAS unsigned*)(c1 + (q1 + 5) * 2) = e5 | (e6 << 16);
              *(LAS unsigned short*)(c1 + (q1 + 7) * 2) = (unsigned short)e7;
          } } }
    __syncthreads();
    PROF_END(2); PROF_BEGIN(3);
    const int tile = wave & 3, half = wave >> 2, r = lane & 31, hh = lane >> 5, colg = 32 * tile + r;
    int qs, ib, imin, imax;
    if (grp == 0) { qs = colg >> 6; ib = colg & 63; imin = 32 * (tile & 1); imax = imin + 31; } else { qs = colg >> 3; ib = colg & 7; imin = 0; imax = 7; }
    const int dlo = imin - nb + 1, cnt = imax - imin + nb, mid = dlo + (cnt >> 1);
    const int d0 = half == 0 ? dlo : mid, d1 = half == 0 ? mid : dlo + cnt;
    const int par = r & 1;
    const int aoff = par * HY_TRCOPY + (L + 8 * hh - r - 32 * d0 - par) * 2;
    const int boff = (qs * ZSEQ + (nb + ib - d0) * 40 + 8 * hh) * 2;
    const float bias0 = hb[c] + bf2f(((const bf16_t*)fil)[((size_t)1 * 512 + c) * L]), bias1 = hb[512 + c] + bf2f(((const bf16_t*)fil)[((size_t)3 * 512 + c) * L]);
    bf16_t* yb = (bf16_t*)(F.ws + WS_YB);
#pragma unroll 1
    for (int o = 0; o < 2; ++o) {
        if (grp == 0) PROF_BEGIN(6);
        f32x16 acc;
#pragma unroll
        for (int e = 0; e < 16; ++e) acc[e] = 0.f;
        const LAS unsigned char* Ap = lds + HY_TR + o * HY_TRORD + aoff; const LAS unsigned char* Bp = lds + (o == 0 ? HY_ZP1 : HY_ZP2) + boff;
        f32x16 acc2;
#pragma unroll
        for (int e = 0; e < 16; ++e) acc2[e] = 0.f;
        u32x4 xa[4][2], ya[4][2]; bf16x8 xb[4][2], yb2[4][2];
#define HY_LD4(A, B) do { _Pragma("unroll") for (int u_ = 0; u_ < 4; ++u_) { const LAS unsigned* ap_ = (const LAS unsigned*)(Ap - 64 * u_); \
            A[u_][0] = (u32x4){ap_[0], ap_[1], ap_[2], ap_[3]}; A[u_][1] = (u32x4){ap_[8], ap_[9], ap_[10], ap_[11]}; \
            B[u_][0] = *(const LAS bf16x8*)(Bp - 80 * u_); B[u_][1] = *(const LAS bf16x8*)(Bp - 80 * u_ + 32); } Ap -= 256; Bp -= 320; } while (0)
#define HY_MM4(A, B) do { _Pragma("unroll") for (int u_ = 0; u_ < 4; ++u_) { acc = __builtin_amdgcn_mfma_f32_32x32x16_bf16(__builtin_bit_cast(bf16x8, A[u_][0]), B[u_][0], acc, 0, 0, 0); \
            acc2 = __builtin_amdgcn_mfma_f32_32x32x16_bf16(__builtin_bit_cast(bf16x8, A[u_][1]), B[u_][1], acc2, 0, 0, 0); } } while (0)
        const int ng = (d1 - d0) >> 2, nrem = (d1 - d0) & 3;
        HY_LD4(xa, xb);
#pragma unroll 1
        for (int g = 0;;) {
            __builtin_amdgcn_sched_barrier(0); if (g + 1 < ng) HY_LD4(ya, yb2); __builtin_amdgcn_sched_barrier(0); HY_MM4(xa, xb);
            if (++g >= ng) break;
            __builtin_amdgcn_sched_barrier(0); if (g + 1 < ng) HY_LD4(xa, xb); __builtin_amdgcn_sched_barrier(0); HY_MM4(ya, yb2);
            if (++g >= ng) break;
        }
#pragma unroll 1
        for (int rr = 0; rr < nrem; ++rr) { const LAS unsigned* ap_ = (const LAS unsigned*)Ap;
            const u32x4 q0 = (u32x4){ap_[0], ap_[1], ap_[2], ap_[3]}, q1 = (u32x4){ap_[8], ap_[9], ap_[10], ap_[11]};
            acc = __builtin_amdgcn_mfma_f32_32x32x16_bf16(__builtin_bit_cast(bf16x8, q0), *(const LAS bf16x8*)Bp, acc, 0, 0, 0);
            acc2 = __builtin_amdgcn_mfma_f32_32x32x16_bf16(__builtin_bit_cast(bf16x8, q1), *(const LAS bf16x8*)(Bp + 32), acc2, 0, 0, 0);
            Ap -= 64; Bp -= 80; }
#undef HY_LD4
#undef HY_MM4
#pragma unroll
        for (int e = 0; e < 16; ++e) acc[e] += acc2[e];
        if (grp == 0) { PROF_END(6); PROF_BEGIN(7); }
        LAS float* red = (LAS float*)(lds + HY_RED);
        if (half == 1) {
#pragma unroll
            for (int e = 0; e < 16; ++e) red[(tile * 16 + e) * 64 + lane] = acc[e]; }
        __syncthreads();
        if (half == 0) {
#pragma unroll
            for (int e = 0; e < 16; ++e) acc[e] += red[(tile * 16 + e) * 64 + lane];
#pragma unroll
            for (int g = 0; g < 4; ++g) { const int a4 = 8 * g + 4 * hh, p = qs * L + 32 * ib + a4, zo = (qs * ZSEQ + (nb + ib) * 40 + a4) * 2;
                const u32x2 gx = *(const LAS u32x2*)(lds + (o == 0 ? HY_X1 : HY_X2) + p * 2), zz = *(const LAS u32x2*)(lds + (o == 0 ? HY_ZP1 : HY_ZP2) + zo);
                const float gv[4] = {bflo(gx.x), bfhi(gx.x), bflo(gx.y), bfhi(gx.y)}, zv[4] = {bflo(zz.x), bfhi(zz.x), bflo(zz.y), bfhi(zz.y)};
                float y[4];
#pragma unroll
                for (int e = 0; e < 4; ++e) y[e] = gv[e] * (acc[4 * g + e] + (o == 0 ? bias0 : bias1) * zv[e]);
                if (o == 0) *(LAS u32x2*)(lds + HY_ZP2 + zo) = (u32x2){pk2(y[0], y[1]), pk2(y[2], y[3])};
                else {
#pragma unroll
                    for (int e = 0; e < 4; ++e) yb[(size_t)(row0 + p + e) * 512 + c] = (bf16_t)f2bf(y[e]); } }
        }
        __syncthreads();
        if (grp == 0) PROF_END(7);
    }
    PROF_END(3); PROF_FLUSH();
}

__device__ __forceinline__ int kpos32(int k) { return (k & ~31) | (((k >> 2) & 3) << 3) | (((k >> 4) & 1) << 2) | (k & 3); }
__device__ __forceinline__ size_t chunk_lin(int s, int n) { return (size_t)(s < 32 ? s * 4 + n : 128 + (s - 32) * 32 + n); }
constexpr int D1_GRP_BYTES = 61440;
__device__ __forceinline__ void d1_task(Frame& F, int l, int s, int h, int n) {
    int tid_ = F.tid; asm volatile("" : "+v"(tid_));
    const int tid = tid_, lane = tid & 63, wave = __builtin_amdgcn_readfirstlane(tid >> 6), lw = wave & 3, lt = tid & 255;
    LAS unsigned char* base = F.lds + (wave >> 2) * D1_GRP_BYTES;
    LAS bf16_t* qb = (LAS bf16_t*)base;
    LAS bf16_t* kb = qb + 64 * 72;
    LAS bf16_t* vb = kb + 64 * 72;
    LAS float* ATf = (LAS float*)(vb + 64 * 72);
    LAS float* ATb = ATf + 4096;
    LAS float* sm = ATb + 4096;
    LAS float* betaf = sm, *betab = sm + 64, *gcf = sm + 128, *gcb = sm + 192;
    const int L = seq_len(s), row0 = seq_start(s) + n * 64, tpos0 = n * 64;
    const bf16_t* qkv = (const bf16_t*)(F.ws + WS_QKV);
    const float* cw = F.in[I_CONVQKV] + (size_t)l * 3 * QKVW;
    const size_t cl = chunk_lin(s, n);
    PROF_DECL; PROF_BEGIN(40);
    float braw = 0.f, araw = 0.f, al = 0.f, dtb = 0.f;
    if (lw < 2) { const float* ba = (const float*)(F.ws + WS_BA) + (size_t)(row0 + lane) * 32; braw = ba[lw * 8 + h]; araw = ba[16 + lw * 8 + h];
        al = F.in[I_ALOG][l * 16 + lw * 8 + h]; dtb = F.in[I_DTB][l * 16 + lw * 8 + h]; }
    __syncthreads();
    {
        const int sub = lt & 7;
        u32x4 rr[2][3][3]; f32x4 ww[3][3][2];
#pragma unroll
        for (int part = 0; part < 3; ++part) { const int ch = part * 512 + h * 64 + sub * 8;
#pragma unroll
            for (int i = 0; i < 3; ++i) { ww[part][i][0] = *(const f32x4*)(cw + i * QKVW + ch); ww[part][i][1] = *(const f32x4*)(cw + i * QKVW + ch + 4); }
#pragma unroll
            for (int th = 0; th < 2; ++th) { const int t = (lt >> 3) + 32 * th, tp = tpos0 + t; const bf16_t* src = qkv + (size_t)(row0 + t) * QKVW + ch;
                rr[th][part][1] = *(const u32x4*)src; rr[th][part][0] = *(const u32x4*)(tp > 0 ? src - QKVW : src); rr[th][part][2] = *(const u32x4*)(tp < L - 1 ? src + QKVW : src); } }
#pragma unroll
        for (int th2 = 0; th2 < 2 * NREP(14); ++th2) { const int th = th2 & 1;
            const int t = (lt >> 3) + 32 * th, tp = tpos0 + t;
            const float m0 = tp > 0 ? 1.f : 0.f, m2 = tp < L - 1 ? 1.f : 0.f;
#pragma unroll
            for (int part = 0; part < 3; ++part) {
                const u32x4 r0 = rr[th][part][0], r1 = rr[th][part][1], r2 = rr[th][part][2];
                const unsigned a0[4] = {r0.x, r0.y, r0.z, r0.w}, a1[4] = {r1.x, r1.y, r1.z, r1.w}, a2[4] = {r2.x, r2.y, r2.z, r2.w};
                float v[8]; float ss = 0.f;
#pragma unroll
                for (int e = 0; e < 8; ++e) { const float x0 = (e & 1) ? bfhi(a0[e >> 1]) : bflo(a0[e >> 1]), x1 = (e & 1) ? bfhi(a1[e >> 1]) : bflo(a1[e >> 1]), x2 = (e & 1) ? bfhi(a2[e >> 1]) : bflo(a2[e >> 1]);
                    float a = x1 * ww[part][1][e >> 2][e & 3] + m0 * x0 * ww[part][0][e >> 2][e & 3] + m2 * x2 * ww[part][2][e >> 2][e & 3]; a = a / (1.f + __expf(-a)); v[e] = a; ss += a * a; }
                if (part < 2) { ss = sum8(ss);
                    const float rs = (part == 0 ? 0.125f : 1.0f) / sqrtf(ss + EPS);
#pragma unroll
                    for (int e = 0; e < 8; ++e) v[e] *= rs; }
                const u32x4 pk = (u32x4){pk2(v[0], v[1]), pk2(v[2], v[3]), pk2(v[4], v[5]), pk2(v[6], v[7])};
                *(LAS u32x4*)((part == 0 ? qb : (part == 1 ? kb : vb)) + t * 72 + sub * 8) = pk;
                if (part == 0) { bf16_t* qo = (bf16_t*)(F.ws + WS_QN) + (size_t)(row0 + t) * 512 + h * 64;
                    *(u32x2*)(qo + kpos32(sub * 8)) = (u32x2){pk.x, pk.y}; *(u32x2*)(qo + kpos32(sub * 8 + 4)) = (u32x2){pk.z, pk.w}; }
            }
        }
    }
    if (lw < 2) { const int dir = lw, t = lane;
        const float xx = araw + dtb; const float sp = xx > 20.f ? xx : log1pf(expf(xx));
        float a = -expf(al) * sp;
#pragma unroll
        for (int o = 1; o < 64; o <<= 1) { const float y = lane_read(a, dir == 0 ? ((lane - o) & 63) : ((lane + o) & 63)); if (dir == 0 ? (lane >= o) : (lane + o < 64)) a += y; }
        (dir == 0 ? betaf : betab)[t] = 1.f / (1.f + expf(-braw)); (dir == 0 ? gcf : gcb)[t] = a;
        ((float*)(F.ws + WS_GC))[((size_t)(dir * 8 + h) * 192 + cl) * 64 + t] = a; }
    __syncthreads();
    PROF_END(40); PROF_BEGIN(41);
    const size_t offF = ((size_t)(0 * 8 + h) * 192 + cl) * 4096, offB = ((size_t)(1 * 8 + h) * 192 + cl) * 4096;
    {
        const int ti = lw >> 1, tj = lw & 1, r = lane & 31, hh = lane >> 5, col = 32 * tj + r;
#pragma unroll 1
        for (int prod2 = 0; prod2 < 2 * NREP(15); ++prod2) { const int prod = prod2 & 1;
            const LAS bf16_t* Am = kb + (32 * ti + r) * 72 + 8 * hh; const LAS bf16_t* Bm = (prod == 0 ? kb : qb) + (32 * tj + r) * 72 + 8 * hh;
            f32x16 acc;
#pragma unroll
            for (int e = 0; e < 16; ++e) acc[e] = 0.f;
#pragma unroll
            for (int ks = 0; ks < 4; ++ks) acc = __builtin_amdgcn_mfma_f32_32x32x16_bf16(*(const LAS bf16x8*)(Am + 16 * ks), *(const LAS bf16x8*)(Bm + 16 * ks), acc, 0, 0, 0);
            if (prod == 0) {
                const int j = col; const float gfj = gcf[j], gbj = gcb[j];
#pragma unroll
                for (int g = 0; g < 4; ++g) { const int i4 = 32 * ti + 8 * g + 4 * hh; float ff[4], fb[4];
#pragma unroll
                    for (int e = 0; e < 4; ++e) { const int i = i4 + e; const float v = acc[4 * g + e];
                        ff[e] = i > j ? betaf[i] * v * __expf(gcf[i] - gfj) : 0.f; fb[e] = i < j ? betab[i] * v * __expf(gcb[i] - gbj) : 0.f; }
                    *(LAS f32x4*)(ATf + j * 64 + i4) = (f32x4){ff[0], ff[1], ff[2], ff[3]};
                    *(LAS f32x4*)(ATb + (63 - j) * 64 + (60 - i4)) = (f32x4){fb[3], fb[2], fb[1], fb[0]}; }
            } else {
                const int i = col; const float gfi = gcf[i], gbi = gcb[i]; bf16_t* QKo = (bf16_t*)(F.ws + WS_QK);
#pragma unroll
                for (int g = 0; g < 4; ++g) { const int j4 = 32 * ti + 8 * g + 4 * hh; float ff[4], fb[4];
#pragma unroll
                    for (int e = 0; e < 4; ++e) { const int j = j4 + e; const float v = acc[4 * g + e];
                        ff[e] = i >= j ? v * __expf(gfi - gcf[j]) : 0.f; fb[e] = i <= j ? v * __expf(gbi - gcb[j]) : 0.f; }
                    const int pj = kpos32(j4);
                    *(u32x2*)(QKo + offF + (size_t)i * 64 + pj) = (u32x2){pk2(ff[0], ff[1]), pk2(ff[2], ff[3])};
                    *(u32x2*)(QKo + offB + (size_t)i * 64 + pj) = (u32x2){pk2(fb[0], fb[1]), pk2(fb[2], fb[3])}; }
            }
        }
    }
    { const int d = lt >> 2, cg = lt & 3; bf16_t* kt = (bf16_t*)(F.ws + WS_KN) + ((size_t)h * 192 + cl) * 4096 + d * 64;
#pragma unroll
      for (int g = 0; g < 4; ++g) { const int c = 16 * cg + 4 * g;
          const unsigned w0 = (unsigned)kb[(c + 0) * 72 + d] | ((unsigned)kb[(c + 1) * 72 + d] << 16), w1 = (unsigned)kb[(c + 2) * 72 + d] | ((unsigned)kb[(c + 3) * 72 + d] << 16);
          *(u32x2*)(kt + kpos32(c)) = (u32x2){w0, w1}; } }
    __syncthreads();
    PROF_END(41); PROF_BEGIN(42);
#pragma unroll 1
    for (int srep = 0; srep < NREP(16); ++srep) {
        const int c = lane;
        int dmask = (lw >> 1) * 63, isw = lw & 1;
        asm volatile("" : "+v"(dmask), "+v"(isw));
        const bool bdir = dmask != 0, bw = isw != 0;
        int vzero; asm volatile("v_mov_b32 %0, 0" : "=v"(vzero));
        const LAS float* AT = ATf + (bdir ? 4096 : 0) + vzero;
        const LAS float* bet = betaf + (bdir ? 64 : 0); const LAS float* gcc = gcf + (bdir ? 64 : 0);
        const LAS bf16_t* srcm = (bw ? kb : vb) + c;
        float x[64];
#pragma unroll
        for (int p = 0; p < 64; ++p) { const int t = p ^ dmask; const float be = bet[t]; const float eg = __expf(gcc[t]);
            x[p] = bf2f(srcm[t * 72]) * (bw ? be * eg : be);
            if ((p & 7) == 7) __builtin_amdgcn_sched_barrier(0); }
#define SOLVE_LD(R, j) do { _Pragma("unroll") for (int i4_ = ((j) + 1) & ~3; i4_ < 64; i4_ += 4) R[i4_ >> 2] = *(const LAS f32x4*)(AT + (j) * 64 + i4_); } while (0)
#define SOLVE_FM(R, j) do { const float xj_ = x[j]; _Pragma("unroll") for (int i_ = (j) + 1; i_ < 64; ++i_) x[i_] -= R[i_ >> 2][i_ & 3] * xj_; } while (0)
        {
#pragma unroll
          for (int j = 0; j < 32; ++j) { const float xj = x[j]; f32x4 rh[8];
              __builtin_amdgcn_sched_barrier(0);
#pragma unroll
              for (int i4 = (j + 1) & ~3; i4 < 32; i4 += 4) rh[i4 >> 2] = *(const LAS f32x4*)(AT + j * 64 + i4);
#pragma unroll
              for (int i = j + 1; i < 32; ++i) x[i] -= rh[i >> 2][i & 3] * xj;
              __builtin_amdgcn_sched_barrier(0);
#pragma unroll
              for (int i4 = 32; i4 < 64; i4 += 4) rh[(i4 - 32) >> 2] = *(const LAS f32x4*)(AT + j * 64 + i4);
#pragma unroll
              for (int i = 32; i < 64; ++i) x[i] -= rh[(i - 32) >> 2][i & 3] * xj; } }
        { f32x4 ra[16], rb[16];
          SOLVE_LD(ra, 32);
#pragma unroll
          for (int j = 32; j < 56; j += 2) {
            __builtin_amdgcn_sched_barrier(0); SOLVE_LD(rb, j + 1); __builtin_amdgcn_sched_barrier(0); SOLVE_FM(ra, j);
            __builtin_amdgcn_sched_barrier(0); if (j + 2 < 56) SOLVE_LD(ra, j + 2); __builtin_amdgcn_sched_barrier(0); SOLVE_FM(rb, j + 1); } }
        { f32x4 rt[7][2];
#pragma unroll
          for (int j = 56; j < 63; ++j)
#pragma unroll
              for (int i4 = (j + 1) & ~3; i4 < 64; i4 += 4) rt[j - 56][(i4 - 56) >> 2] = *(const LAS f32x4*)(AT + j * 64 + i4);
          __builtin_amdgcn_sched_barrier(0);
#pragma unroll
          for (int j = 56; j < 63; ++j) { const float xj = x[j];
#pragma unroll
              for (int i = j + 1; i < 64; ++i) x[i] -= rt[j - 56][(i - 56) >> 2][i & 3] * xj; } }
#undef SOLVE_LD
#undef SOLVE_FM
        __builtin_amdgcn_sched_barrier(0);
        int dmask2 = dmask; asm volatile("" : "+v"(dmask2), "+v"(x[63]));
        const size_t offD = bdir ? offB : offF;
        if (!bw) {
            bf16_t* dst = (bf16_t*)(F.ws + WS_U) + offD + (size_t)c * 64;
#pragma unroll
            for (int g = 0; g < 8; ++g) { unsigned w[4];
#pragma unroll
                for (int k = 0; k < 4; ++k) { const float a = x[8 * g + 2 * k], b = x[8 * g + 2 * k + 1]; w[k] = pk2(bdir ? b : a, bdir ? a : b); }
                const u32x4 o = bdir ? (u32x4){w[3], w[2], w[1], w[0]} : (u32x4){w[0], w[1], w[2], w[3]};
                *(u32x4*)(dst + (bdir ? 56 - 8 * g : 8 * g)) = o; }
        } else {
            bf16_t* dst = (bf16_t*)(F.ws + WS_WW) + offD + kpos32(c);
#pragma unroll
            for (int p = 0; p < 64; ++p) dst[(p ^ dmask2) * 64] = (bf16_t)f2bf(-x[p]);
        }
    }
    PROF_END(42); PROF_FLUSH();
}

__device__ __forceinline__ bf16x8 pack8(const f32x4 a, const f32x4 b) {
    u32x4 w; w.x = pg8::cvt_pk_bf16(a[0], a[1]); w.y = pg8::cvt_pk_bf16(a[2], a[3]); w.z = pg8::cvt_pk_bf16(b[0], b[1]); w.w = pg8::cvt_pk_bf16(b[2], b[3]);
    return __builtin_bit_cast(bf16x8, w);
}
__device__ __forceinline__ void d2_wave_task(Frame& F, int l, int s, int h, int dir, int sl) {
    PROF_DECL; PROF_BEGIN(50);
    int lane_ = F.lane; asm volatile("" : "+v"(lane_));
    const int lane = lane_, r16 = lane & 15, q = lane >> 4, e0 = sl * 16;
    const int nch = s < 32 ? 4 : 32;
    LAS float* lo = (LAS float*)(F.lds + F.wave * 4608);
    f32x4 S[4];
#pragma unroll
    for (int t = 0; t < 4; ++t)
#pragma unroll
        for (int rg = 0; rg < 4; ++rg) { const int d = 16 * t + 4 * q + rg;
            S[t][rg] = s >= 32 ? F.in[I_STATE][((((size_t)(s - 32) * 2 + l) * 2 + dir) * 8 + h) * 4096 + d * 64 + e0 + r16] : 0.f; }
    const bf16_t* Wg = (const bf16_t*)(F.ws + WS_WW); const bf16_t* QKg = (const bf16_t*)(F.ws + WS_QK); const bf16_t* Ug = (const bf16_t*)(F.ws + WS_U);
    const bf16_t* QNg = (const bf16_t*)(F.ws + WS_QN); const bf16_t* KTg = (const bf16_t*)(F.ws + WS_KN); const float* GCg = (const float*)(F.ws + WS_GC);
    bf16_t* Og = (bf16_t*)(F.ws + (dir == 0 ? WS_OF : WS_OB));
    const int fo = r16 * 64 + 8 * q;
#pragma unroll 1
    for (int step = 0; step < nch; ++step) {
        const int n = dir == 0 ? step : nch - 1 - step; const size_t cl = chunk_lin(s, n);
        const size_t off = ((size_t)(dir * 8 + h) * 192 + cl) * 4096; const int tok0 = seq_start(s) + n * 64;
        const bf16_t* Wp = Wg + off + fo; const bf16_t* QKp = QKg + off + fo; const bf16_t* KTp = KTg + ((size_t)h * 192 + cl) * 4096 + fo;
        const bf16_t* Qp = QNg + (size_t)(tok0 + r16) * 512 + h * 64 + 8 * q; const bf16_t* Up = Ug + off + (size_t)(e0 + r16) * 64 + 4 * q;
        const float* gcp = GCg + ((size_t)(dir * 8 + h) * 192 + cl) * 64;
        bf16x8 Wf[4][2], Qf[4][2], QKf[4][2], KTf[4][2]; u32x2 Uv[4]; f32x4 gcv[4];
#pragma unroll
        for (int t = 0; t < 4; ++t) { Uv[t] = *(const u32x2*)(Up + 16 * t); gcv[t] = *(const f32x4*)(gcp + 16 * t + 4 * q);
#pragma unroll
            for (int ks = 0; ks < 2; ++ks) { Wf[t][ks] = *(const bf16x8*)(Wp + t * 1024 + 32 * ks); Qf[t][ks] = *(const bf16x8*)(Qp + (size_t)t * 16 * 512 + 32 * ks);
                QKf[t][ks] = *(const bf16x8*)(QKp + t * 1024 + 32 * ks); KTf[t][ks] = *(const bf16x8*)(KTp + t * 1024 + 32 * ks); } }
        const float gl = gcp[dir == 0 ? 63 : 0];
        bf16x8 Sb[2] = {pack8(S[0], S[1]), pack8(S[2], S[3])};
        f32x4 VN[4], O[4];
#pragma unroll
        for (int t = 0; t < 4; ++t) { VN[t] = (f32x4){bflo(Uv[t].x), bfhi(Uv[t].x), bflo(Uv[t].y), bfhi(Uv[t].y)}; O[t] = (f32x4){0.f, 0.f, 0.f, 0.f};
#pragma unroll
            for (int ks = 0; ks < 2; ++ks) { VN[t] = __builtin_amdgcn_mfma_f32_16x16x32_bf16(Wf[t][ks], Sb[ks], VN[t], 0, 0, 0); O[t] = __builtin_amdgcn_mfma_f32_16x16x32_bf16(Qf[t][ks], Sb[ks], O[t], 0, 0, 0); } }
        f32x4 VS[4];
#pragma unroll
        for (int t = 0; t < 4; ++t)
#pragma unroll
            for (int rg = 0; rg < 4; ++rg) { O[t][rg] *= __expf(gcv[t][rg]); VS[t][rg] = VN[t][rg] * __expf(gl - gcv[t][rg]); }
        const bf16x8 VNb[2] = {pack8(VN[0], VN[1]), pack8(VN[2], VN[3])}, VSb[2] = {pack8(VS[0], VS[1]), pack8(VS[2], VS[3])};
        const float egl = __expf(gl);
#pragma unroll
        for (int t = 0; t < 4; ++t) { S[t] = S[t] * egl;
#pragma unroll
            for (int ks = 0; ks < 2; ++ks) { O[t] = __builtin_amdgcn_mfma_f32_16x16x32_bf16(QKf[t][ks], VNb[ks], O[t], 0, 0, 0); S[t] = __builtin_amdgcn_mfma_f32_16x16x32_bf16(KTf[t][ks], VSb[ks], S[t], 0, 0, 0); } }
#pragma unroll
        for (int t = 0; t < 4; ++t)
#pragma unroll
            for (int rg = 0; rg < 4; ++rg) lo[(16 * t + 4 * q + rg) * 17 + r16] = O[t][rg];
        asm volatile("s_waitcnt lgkmcnt(0)" ::: "memory");
        { float ov[16];
#pragma unroll
          for (int e = 0; e < 16; ++e) ov[e] = lo[lane * 17 + e];
          bf16_t* op = Og + (size_t)(tok0 + lane) * 512 + h * 64 + e0;
          *(u32x4*)op = (u32x4){pk2(ov[0], ov[1]), pk2(ov[2], ov[3]), pk2(ov[4], ov[5]), pk2(ov[6], ov[7])};
          *(u32x4*)(op + 8) = (u32x4){pk2(ov[8], ov[9]), pk2(ov[10], ov[11]), pk2(ov[12], ov[13]), pk2(ov[14], ov[15])}; }
        asm volatile("s_waitcnt lgkmcnt(0)" ::: "memory");
    }
    if (s < 32) { float* so = F.out + (size_t)NTOK * DM + ((((size_t)s * 2 + l) * 2 + dir) * 8 + h) * 4096;
#pragma unroll
        for (int t = 0; t < 4; ++t)
#pragma unroll
            for (int rg = 0; rg < 4; ++rg) so[(16 * t + 4 * q + rg) * 64 + e0 + r16] = S[t][rg]; }
    PROF_END(50); PROF_FLUSH();
}

__device__ __forceinline__ void phase_combine(Frame& F, int l) {
    const bf16_t* of = (const bf16_t*)(F.ws + WS_OF); const bf16_t* ob = (const bf16_t*)(F.ws + WS_OB); const bf16_t* z = (const bf16_t*)(F.ws + WS_Z);
    bf16_t* ya = (bf16_t*)(F.ws + WS_YA); const float* na = F.in[I_NORMA] + l * 64;
    for (int i = F.bid * NTHR + F.tid; i < NTOK * 64; i += F.G * NTHR) {
        const size_t off = (size_t)i * 8; const int e0 = (i & 7) * 8;
        const u32x4 a = *(const u32x4*)(of + off), b = *(const u32x4*)(ob + off), zz = *(const u32x4*)(z + off);
        float o[8]; const unsigned aw[4] = {a.x, a.y, a.z, a.w}, bw[4] = {b.x, b.y, b.z, b.w}, zw[4] = {zz.x, zz.y, zz.z, zz.w};
        float ss = 0.f;
#pragma unroll
        for (int j = 0; j < 4; ++j) { o[2 * j] = bflo(aw[j]) + bflo(bw[j]); o[2 * j + 1] = bfhi(aw[j]) + bfhi(bw[j]); ss += o[2 * j] * o[2 * j] + o[2 * j + 1] * o[2 * j + 1]; }
        ss += __shfl_xor(ss, 1); ss += __shfl_xor(ss, 2); ss += __shfl_xor(ss, 4);
        const float rs = 1.0f / sqrtf(ss * (1.f / 64.f) + EPS);
        unsigned w[4];
#pragma unroll
        for (int j = 0; j < 4; ++j) { const float z0 = bflo(zw[j]), z1 = bfhi(zw[j]);
            w[j] = pk2(o[2 * j] * rs * na[e0 + 2 * j] * siluf_(z0), o[2 * j + 1] * rs * na[e0 + 2 * j + 1] * siluf_(z1)); }
        *(u32x4*)(ya + off) = (u32x4){w[0], w[1], w[2], w[3]};
    }
}

constexpr int N_PHASES = 26;
__global__ void __launch_bounds__(NTHR, 2) mk_fwd(Args args) {
    extern __shared__ __attribute__((aligned(16))) unsigned char lds_raw[];
    Frame F;
    F.lds = (LAS unsigned char*)lds_raw; F.in = args.in; F.out = args.out; F.ws = args.ws; F.ctl = (unsigned*)(args.ws + WS_CTL);
    F.tid = threadIdx.x; F.lane = F.tid & 63; F.wave = __builtin_amdgcn_readfirstlane(F.tid >> 6); F.G = gridDim.x; F.bid = blockIdx.x;
    for (int u = F.tid; u < (LDS_BYTES - LDSCTL_OFF) / 4; u += NTHR) ((LAS unsigned*)(F.lds + LDSCTL_OFF))[u] = 0u;
    __syncthreads();
    XcdBarrier bar; bar.bar = F.ctl + CW_BAR; bar.x = 0; bar.st = nullptr;
    if (!MK_PER_PHASE) bar = xcd_barrier_post(F.ctl + CW_BAR, (volatile LAS unsigned*)(F.lds + MISC_OFF) + 8);
    const int lo = args.ph_lo, hi = args.ph_hi;
    PROF_DECL;
    using namespace pg8;
#define IN(k) (lo <= (k) && (k) < hi)
#define SEAM(k) do { if (IN(k) && IN((k) + 1)) { if (!MK_PER_PHASE) xcd_barrier(bar); } } while (0)
#define PHASE_FRAME() Frame P = F; P.ws = opq(P.ws); P.out = opq(P.out); P.ctl = opq(P.ctl); asm volatile("" : "+v"(P.tid)); P.lane = P.tid & 63; P.wave = __builtin_amdgcn_readfirstlane(P.tid >> 6); \
    unsigned char* ws = P.ws; LAS unsigned char* ring = P.lds; (void)ws; (void)ring

    PROF_BEGIN(100);
    if (IN(0)) for (int rep = 0; rep < NREP(13); ++rep) { PHASE_FRAME(); PROF_BEGIN(120); prep_x_tables(P); __syncthreads(); PROF_END(120); PROF_BEGIN(121); prep_mod(P); __syncthreads(); PROF_END(121); PROF_BEGIN(122); prep_weights(P, 0); __syncthreads(); PROF_END(122); PROF_BEGIN(124); prep_filters(P, 0); __syncthreads(); PROF_END(124); }
    SEAM(0);
    PROF_END(100);
#pragma unroll 1
    for (int l = 0; l < 2; ++l) {
        const int pb = 1 + 12 * l;
#define MODL ((const float*)(ws + WS_MOD) + (size_t)l * 3 * 6144)
        PROF_BEGIN(101);
        if (IN(pb + 0)) { PHASE_FRAME(); if (l == 1) { PROF_BEGIN(130); prep_weights(P, 1); __syncthreads(); PROF_END(130); PROF_BEGIN(131); prep_filters(P, 1); __syncthreads(); PROF_END(131); }
            for (int rep = 0; rep < NREP(0); ++rep) phase_norm(P, P.in[I_N1G] + l * DM, MODL, 0, 1024, (bf16_t*)(ws + WS_H)); }
        SEAM(pb + 0);
        PROF_END(101);
        PROF_BEGIN(102);
        if (IN(pb + 1)) for (int rep = 0; rep < NREP(1); ++rep) { PHASE_FRAME();
            { Gemm g{1024, 2048, 2048}; Sched2D S{(const char*)(ws + WS_H), (const char*)(ws + W_N), (size_t)256 * 2048, (size_t)256 * 2048, 48, 9, P.G, P.bid, 0, 0};
              EpiInN E{(bf16_t*)(ws + WS_QKV), (bf16_t*)(ws + WS_Z), (float*)(ws + WS_BA)};
              gemm_phase<EpiInN, Sched2D, true, true>(ring, g, S, E); }
            { Gemm g{1024, 2048, 2048}; Sched2D S{(const char*)(ws + W_S), (const char*)(ws + WS_H), (size_t)256 * 2048, (size_t)256 * 2048, 10, 48, P.G, P.bid, 0, 0};
              EpiInS E{(bf16_t*)(ws + WS_HYT), (bf16_t*)(ws + WS_XCSL), (bf16_t*)(ws + WS_XCSC)};
              gemm_phase<EpiInS, Sched2D, true, true>(ring, g, S, E); }
        }
        SEAM(pb + 1);
        PROF_END(102);
        PROF_BEGIN(103);
        if (IN(pb + 2)) {
            { PHASE_FRAME(); Gemm g{2048, 8192, 8192}; SchedFourL S{(const char*)(ws + WS_TABL), (const char*)(ws + WS_XCSL), P.bid};
              EpiScaleBf16 E{(bf16_t*)(ws + WS_YF), 512, 1.0f};
              gemm_phase<EpiScaleBf16, SchedFourL, true, true>(ring, g, S, E); }
            { PHASE_FRAME(); Gemm g{512, 1024, 1024}; SchedFourC S{(const char*)(ws + WS_TABC), (const char*)(ws + WS_XCSC), P.bid - 64};
              EpiScaleBf16 E{(bf16_t*)(ws + WS_YC), 512, 1.0f / sqrtf(64.0f * 256.0f)};
              gemm_phase<EpiScaleBf16, SchedFourC, true, true>(ring, g, S, E); }
            for (int rep = 0; rep < NREP(2); ++rep) { PHASE_FRAME(); __syncthreads();
              const int xq = P.bid & 7, qid = 16 + (2 * l + rep) * 8 + xq;
              for (int t = q_next(P, qid); t < 192; t = q_next(P, qid)) {
                if (t < 64) hyena_task(P, l, 64 * xq + t, 0);
                else { const int tt = t - 64; hyena_task(P, l, 64 * xq + (tt >> 1), 1 + (tt & 1)); }
              } }
        }
        SEAM(pb + 2);
        PROF_END(103);
        PROF_BEGIN(104);
        if (IN(pb + 3)) for (int rep = 0; rep < NREP(3); ++rep) { PHASE_FRAME();
            for (int t0 = 2 * P.bid; t0 < 1536; t0 += 2 * P.G) { const int t = t0 + (P.wave >> 2);
                int s, h, n;
                if (t < 1024) { s = t >> 5; h = (t >> 2) & 7; n = t & 3; } else { const int tt = t - 1024; s = 32 + (tt >> 8); h = (tt >> 5) & 7; n = tt & 31; }
                d1_task(P, l, s, h, n);
            }
        }
        SEAM(pb + 3);
        PROF_END(104);
        PROF_BEGIN(105);
        if (IN(pb + 4)) for (int rep = 0; rep < NREP(4); ++rep) { PHASE_FRAME();
            const int gw = P.wave * P.G + P.bid, NW = NWAVES * P.G;
            if (gw < 128) { d2_wave_task(P, l, 32 + (gw >> 6), (gw >> 3) & 7, (gw >> 2) & 1, gw & 3); }
            else for (int tt = gw - 128; tt < 2048; tt += NW - 128) d2_wave_task(P, l, tt >> 6, (tt >> 3) & 7, (tt >> 2) & 1, tt & 3);
        }
        SEAM(pb + 4);
        PROF_END(105);
        PROF_BEGIN(106);
        if (IN(pb + 5)) { PHASE_FRAME();
            { const u32x4* p0 = (const u32x4*)(ws + WS_YF); const u32x4* p1 = p0 + 4096 * 512 / 8; bf16_t* yc = (bf16_t*)(ws + WS_YC) + (size_t)NCTX * 512; const float sc = 1.0f / sqrtf(64.0f * 2048.0f);
              for (int i = P.bid * NTHR + P.tid; i < 4096 * 512 / 8; i += P.G * NTHR) { const u32x4 a = p0[i], b = p1[i];
                  *(u32x4*)(yc + (size_t)i * 8) = (u32x4){pk2((bflo(a.x) + bflo(b.x)) * sc, (bfhi(a.x) + bfhi(b.x)) * sc), pk2((bflo(a.y) + bflo(b.y)) * sc, (bfhi(a.y) + bfhi(b.y)) * sc),
                                                          pk2((bflo(a.z) + bflo(b.z)) * sc, (bfhi(a.z) + bfhi(b.z)) * sc), pk2((bflo(a.w) + bflo(b.w)) * sc, (bfhi(a.w) + bfhi(b.w)) * sc)}; } }
            phase_combine(P, l); phase_norm(P, P.in[I_N1G] + l * DM, MODL, 0, 1024, (bf16_t*)(ws + WS_H)); }
        SEAM(pb + 5);
        PROF_END(106);
        PROF_BEGIN(107);
        if (IN(pb + 6)) for (int rep = 0; rep < NREP(6); ++rep) { PHASE_FRAME(); Gemm g{1024, 2048, 2048}; Sched2D S{(const char*)(ws + WS_H), (const char*)(ws + W_G), (size_t)256 * 2048, (size_t)256 * 2048, 48, 12, P.G, P.bid, 0, 0};
            EpiGate E{(bf16_t*)(ws + WS_GATE)};
            gemm_phase<EpiGate, Sched2D, true, true>(ring, g, S, E); }
        SEAM(pb + 6);
        PROF_END(107);
        PROF_BEGIN(108);
        if (IN(pb + 7)) {
            static_assert(WS_YB == WS_YA + 12 * MiB && WS_YC == WS_YB + 12 * MiB, "y buffers 12 MiB apart");
#pragma unroll 1
            for (int br = 0; br < 3; ++br) { PHASE_FRAME(); Gemm g{512, 1024, 1024};
                Sched2D S{(const char*)(ws + WS_YA + (size_t)br * 12 * MiB), (const char*)(ws + W_P + (size_t)br * MiB), (size_t)256 * 1024, (size_t)256 * 1024, 48, 4, P.G, P.bid, 0, 0};
                EpiMergeAcc E{(bf16_t*)(ws + WS_MRG), (const bf16_t*)(ws + WS_GATE), br * 1024, br == 0 ? 1 : 0};
                gemm_phase<EpiMergeAcc, Sched2D, true, true>(ring, g, S, E); }
        }
        SEAM(pb + 7);
        PROF_END(108);
        PROF_BEGIN(109);
        if (IN(pb + 8)) { PHASE_FRAME(); Gemm g{1024, 2048, 6144}; Sched2D S{(const char*)(ws + WS_MRG), (const char*)(ws + W_O3), (size_t)256 * 2048, (size_t)256 * 6144, 48, 4, P.G, P.bid, 0, 0};
            EpiResid E{P.out, MODL + 2048};
            gemm_phase<EpiResid, Sched2D, false, true>(ring, g, S, E); }
        SEAM(pb + 8);
        PROF_END(109);
        PROF_BEGIN(110);
        if (IN(pb + 9)) { PHASE_FRAME(); phase_norm(P, P.in[I_N2G] + l * DM, MODL, 3072, 4096, (bf16_t*)(ws + WS_H)); }
        SEAM(pb + 9);
        PROF_END(110);
        PROF_BEGIN(111);
        if (IN(pb + 10)) for (int rep = 0; rep < NREP(10); ++rep) { PHASE_FRAME(); Gemm g{1024, 2048, 2048}; Sched2D S{(const char*)(ws + WS_H), (const char*)(ws + W_GU), (size_t)256 * 2048, (size_t)256 * 2048, 48, 22, P.G, P.bid, 0, 0};
            EpiGU E{(bf16_t*)(ws + WS_ACT)};
            gemm_phase<EpiGU, Sched2D, true, true>(ring, g, S, E); }
        SEAM(pb + 10);
        PROF_END(111);
        PROF_BEGIN(112);
        if (IN(pb + 11)) { PHASE_FRAME(); Gemm g{DFF, DFF * 2, DFF * 2}; Sched2D S{(const char*)(ws + WS_ACT), (const char*)(ws + W_DN), (size_t)256 * DFF * 2, (size_t)256 * DFF * 2, 48, 4, P.G, P.bid, 0, 0};
            EpiResid E{P.out, MODL + 5120};
            gemm_phase<EpiResid, Sched2D, false, true>(ring, g, S, E); }
        SEAM(pb + 11);
        PROF_END(112);
    }
    PROF_BEGIN(113);
    if (IN(25)) { PHASE_FRAME(); phase_final(P); }
    PROF_END(113); PROF_FLUSH();
    if (PROBE_ID != 0) { __syncthreads();
        if (blockIdx.x == PROBE_BLK && threadIdx.x == 0) { const unsigned tot = *(volatile LAS unsigned*)(F.lds + MISC_OFF + 96); unsigned long long want = (unsigned long long)tot * PROBE_AMP; if (want > 3000000ull) want = 3000000ull;
            const unsigned long long t0 = __builtin_amdgcn_s_memrealtime(); while (__builtin_amdgcn_s_memrealtime() - t0 < want) __builtin_amdgcn_s_sleep(16); }
        __syncthreads(); }
#undef IN
#undef SEAM
}

extern "C" void kernel_launch(void* const* d_in, const int* in_sizes, int n_in, void* d_out, int out_size, void* d_ws, size_t ws_size, hipStream_t stream) {
    static int grid = 0;
    if (grid == 0) {
        if (n_in != N_IN || out_size != NTOK * DM + 32 * 2 * 2 * 8 * 4096 || ws_size < WS_END) { fprintf(stderr, "kernel_launch: unexpected shapes (n_in %d out %d ws %zu); nothing launched\n", n_in, out_size, ws_size); grid = -1; return; }
        int dev = 0, cus = 0, per_cu = 0;
        if (hipGetDevice(&dev) != hipSuccess || hipDeviceGetAttribute(&cus, hipDeviceAttributeMultiprocessorCount, dev) != hipSuccess) { grid = -1; return; }
        if (hipFuncSetAttribute((const void*)mk_fwd, hipFuncAttributeMaxDynamicSharedMemorySize, LDS_BYTES) != hipSuccess) { fprintf(stderr, "kernel_launch: hipFuncSetAttribute failed\n"); grid = -1; return; }
        if (hipOccupancyMaxActiveBlocksPerMultiprocessor(&per_cu, (const void*)mk_fwd, NTHR, LDS_BYTES) != hipSuccess || per_cu < 1) { fprintf(stderr, "kernel_launch: occupancy query says %d blocks per CU; nothing launched\n", per_cu); (void)hipGetLastError(); grid = -1; return; }
        grid = cus;
    }
    if (grid < 0) return;
    if (hipMemsetAsync((char*)d_ws + WS_CTL, 0, CTL_ZERO_BYTES, stream) != hipSuccess) return;
    Args a{};
    for (int i = 0; i < N_IN; ++i) a.in[i] = (const float*)d_in[i];
    a.out = (float*)d_out; a.ws = (unsigned char*)d_ws;
#if MK_PER_PHASE
    for (int p = 0; p < N_PHASES; ++p) { a.ph_lo = p; a.ph_hi = p + 1; a.li = 0; hipLaunchKernelGGL(mk_fwd, dim3(grid), dim3(NTHR), LDS_BYTES, stream, a); }
#else
    a.ph_lo = 0; a.ph_hi = N_PHASES; a.li = 0;
    hipLaunchKernelGGL(mk_fwd, dim3(grid), dim3(NTHR), LDS_BYTES, stream, a);
#endif
}
```

```cpp
#include <hip/hip_runtime.h>
#include <cstdio>
#include <cstdint>

#ifndef MK_PER_PHASE
#define MK_PER_PHASE 0
#endif

#ifndef REPMASK
#define REPMASK 0
#endif
#define NREP(k) (((REPMASK >> (k)) & 1) ? 2 : 1)
#ifndef PROBE_ID
#define PROBE_ID 0
#endif
#define PROBE_AMP 10
#ifndef PROBE_BLK
#define PROBE_BLK 150
#endif
#ifndef PROBE_BLK
#define PROBE_BLK 200
#endif
#define PROF_COUNT(id) do { if (PROBE_ID == (id) && blockIdx.x == PROBE_BLK && threadIdx.x == 0) { *PROF_WORD(0) = *PROF_WORD(0) + 1000u; } } while (0)
#ifndef PROBE_BLK
#define PROBE_BLK 200
#endif
#define PROF_COUNT(id) do { if (PROBE_ID == (id) && blockIdx.x == PROBE_BLK && threadIdx.x == 0) { *PROF_WORD(0) = *PROF_WORD(0) + 1000u; } } while (0)
#define PROF_WORD(i) ((volatile __attribute__((address_space(3))) unsigned*)(F.lds + MISC_OFF + 96 + 4 * (i)))
#define PROF_BEGIN(id) do { if (PROBE_ID == (id) && blockIdx.x == PROBE_BLK && threadIdx.x == 0) { *PROF_WORD(1) = (unsigned)__builtin_amdgcn_s_memrealtime(); } } while (0)
#define PROF_END(id) do { if (PROBE_ID == (id) && blockIdx.x == PROBE_BLK && threadIdx.x == 0) { asm volatile("s_waitcnt vmcnt(0) lgkmcnt(0)" ::: "memory"); *PROF_WORD(0) = *PROF_WORD(0) + ((unsigned)__builtin_amdgcn_s_memrealtime() - *PROF_WORD(1)); } } while (0)
#define LAS __attribute__((address_space(3)))
#define GAS __attribute__((address_space(1)))
typedef unsigned short bf16_t;
typedef short bf16x8 __attribute__((ext_vector_type(8)));
typedef float f32x4 __attribute__((ext_vector_type(4)));
typedef float f32x2 __attribute__((ext_vector_type(2)));
typedef unsigned u32x4 __attribute__((ext_vector_type(4)));
typedef unsigned u32x2 __attribute__((ext_vector_type(2)));

constexpr int DM = 1024, NTOK = 12288, NCTX = 8192, LCTX = 256, LLAT = 2048, BCTX = 32, BLAT = 2;
constexpr int HA = 8, QKVW = 1536, DFF = 2816, DIN = 7200;
constexpr int OFF_Z = 1536, OFF_B = 2048, OFF_HY = 2080, OFF_FN = 3616, OFF_GATE = 4128;
constexpr float EPS = 1e-6f;
enum { I_XP = 0, I_XS, I_STATE, I_C, I_CCTX, I_WMOD, I_BMOD, I_N1G, I_N2G, I_WIN, I_CONVQKV, I_ALOG, I_DTB, I_NORMA, I_CONVHY,
       I_HW1, I_HB1, I_HFREQ, I_HW2, I_HB2, I_HW3, I_HBIAS, I_WPA, I_WPB, I_WPC, I_WO, I_WGU, I_WDOWN, I_NORMF, N_IN };

constexpr size_t MiB = 1u << 20;
constexpr size_t WS_CTL = 0, CTL_ZERO_BYTES = 256 * 1024;
constexpr size_t WS_MOD = 1 * MiB;
constexpr size_t WS_B0 = 1 * MiB + 512 * 1024;
constexpr size_t WS_TABC = 2 * MiB;
constexpr size_t WS_FILC = 3 * MiB;
constexpr size_t WS_FILL = 5 * MiB;
constexpr size_t WS_YF = 13 * MiB;
constexpr size_t WS_TABL = 21 * MiB;
constexpr size_t WS_W = 37 * MiB;
constexpr size_t W_N = WS_W;
constexpr size_t W_S = W_N + 2304 * 1024 * 2;
constexpr size_t W_G = W_S + 2560 * 1024 * 2;
constexpr size_t W_P = W_G + 3072 * 1024 * 2;
constexpr size_t W_O3 = W_P + 3 * 1024 * 512 * 2;
constexpr size_t W_GU = W_O3 + 1024 * 3072 * 2;
constexpr size_t W_DN = W_GU + 5632 * 1024 * 2;
constexpr size_t W_END = W_DN + 1024 * 2816 * 2;
static_assert(W_END <= 78 * MiB, "weights region");
constexpr size_t WS_A0 = 78 * MiB;
constexpr size_t WS_QKV = WS_A0, WS_OF = WS_A0, WS_OB = WS_A0 + 12 * MiB, WS_MRG = WS_A0;
constexpr size_t WS_Z = 116 * MiB, WS_YA = WS_Z;
constexpr size_t WS_BA = 114 * MiB;
constexpr size_t WS_YB = 128 * MiB, WS_YC = 140 * MiB;
constexpr size_t WS_A5 = 152 * MiB;
constexpr size_t WS_H = WS_A5;
constexpr size_t WS_HYT = WS_A5 + 24 * MiB;
constexpr size_t WS_XCS = WS_A5 + 60 * MiB;
constexpr size_t WS_XCSL = WS_XCS, WS_XCSC = WS_XCS + 8 * MiB;
constexpr size_t WS_QN = WS_A5, WS_KN = WS_A5 + 12 * MiB;
constexpr size_t WS_U = WS_A5 + 24 * MiB;
constexpr size_t WS_WW = WS_A5 + 48 * MiB;
constexpr size_t WS_QK = WS_A5 + 72 * MiB;
constexpr size_t WS_GC = WS_A5 + 96 * MiB;
constexpr size_t WS_GATE = WS_A5 + 24 * MiB;
constexpr size_t WS_ACT = WS_A5 + 24 * MiB;
constexpr size_t WS_END = 256 * MiB;
static_assert(WS_GC + 2 * 8 * 192 * 64 * 4 <= WS_END && WS_GATE + (size_t)NTOK * 3072 * 2 <= WS_END, "ws map");
constexpr int CW_BAR = 4096;
constexpr int CW_Q = 16384;

constexpr int RING_BYTES = 131072, LDSCTL_OFF = RING_BYTES, MISC_OFF = LDSCTL_OFF + 320, LDS_BYTES = 147456;
constexpr int NWAVES = 8, NTHR = 512;

#define RLX_AGENT __ATOMIC_RELAXED, __HIP_MEMORY_SCOPE_AGENT
#define LDS_WAIT() asm volatile("s_waitcnt lgkmcnt(0)" ::: "memory")
__device__ __forceinline__ unsigned f2bf(float f) { unsigned u = __builtin_bit_cast(unsigned, f); return (u + 0x7fffu + ((u >> 16) & 1u)) >> 16; }
__device__ __forceinline__ unsigned pk2(float lo, float hi) { return f2bf(lo) | (f2bf(hi) << 16); }
__device__ __forceinline__ float bf2f(unsigned short b) { return __builtin_bit_cast(float, (unsigned)b << 16); }
__device__ __forceinline__ float bflo(unsigned w) { return __builtin_bit_cast(float, w << 16); }
__device__ __forceinline__ float bfhi(unsigned w) { return __builtin_bit_cast(float, w & 0xffff0000u); }
__device__ __forceinline__ float sin_rev(float r) { return __builtin_amdgcn_sinf(r - rintf(r)); }
__device__ __forceinline__ float cos_rev(float r) { return __builtin_amdgcn_cosf(r - rintf(r)); }
__device__ __forceinline__ float sin_rad(float x) { return sin_rev(x * 0.15915494309189535f); }
__device__ __forceinline__ float cos_rad(float x) { return cos_rev(x * 0.15915494309189535f); }
__device__ __forceinline__ float sigmoidf_(float x) { return 1.f / (1.f + __expf(-x)); }
__device__ __forceinline__ float siluf_(float x) { return x / (1.f + __expf(-x)); }
__device__ __forceinline__ float wave_sum(float v) {
#pragma unroll
    for (int o = 1; o < 64; o <<= 1) v += __shfl_xor(v, o);
    return v;
}
template <class T> __device__ __forceinline__ T* opq(T* p) {
    unsigned lo = (unsigned)(uintptr_t)p, hi = (unsigned)((uintptr_t)p >> 32); asm volatile("" : "+v"(lo), "+v"(hi));
    lo = __builtin_amdgcn_readfirstlane(lo); hi = __builtin_amdgcn_readfirstlane(hi);
    return (T*)(GAS T*)(((uintptr_t)hi << 32) | (uintptr_t)lo);
}
__device__ __forceinline__ float dpp_f(float x, int ctrl_tag) {
    const int v = __builtin_bit_cast(int, x); int r;
    if (ctrl_tag == 0) r = __builtin_amdgcn_update_dpp(0, v, 0xB1, 0xF, 0xF, true);
    else if (ctrl_tag == 1) r = __builtin_amdgcn_update_dpp(0, v, 0x4E, 0xF, 0xF, true);
    else r = __builtin_amdgcn_update_dpp(0, v, 0x141, 0xF, 0xF, true);
    return __builtin_bit_cast(float, r);
}
__device__ __forceinline__ float sum8(float s) { s += dpp_f(s, 0); s += dpp_f(s, 1); s += dpp_f(s, 2); return s; }
__device__ __forceinline__ float lane_read(float x, int srclane) { return __builtin_bit_cast(float, __builtin_amdgcn_ds_bpermute(srclane << 2, __builtin_bit_cast(int, x))); }
__device__ __forceinline__ int seq_start(int s) { return s < 32 ? s * 256 : NCTX + (s - 32) * 2048; }
__device__ __forceinline__ int seq_len(int s) { return s < 32 ? 256 : 2048; }
__device__ __forceinline__ int mod_idx(int row) { return row < NCTX ? 0 : 1 + ((row - NCTX) >> 11); }

namespace pg8 {
constexpr int BM = 256, BK = 64, HALF = 128, HTB = HALF * BK * 2, STAGE_BYTES = 8 * HTB, NXCD = 8, WGM = 8;
__host__ __device__ __forceinline__ int lds_byte(int r, int c) { const int st = (r >> 4) * 2 + (c >> 5), rr = r & 15, cc = c & 31, ob = rr * 64 + cc * 2; return st * 1024 + (ob ^ (((ob >> 9) & 1) << 5)); }
__host__ __device__ __forceinline__ void stage_rc(int b, int& R, int& C) { const int st = b / 1024, sb = b % 1024, swz = sb ^ (((sb >> 9) & 1) << 5); R = (st >> 1) * 16 + swz / 64; C = (st & 1) * 32 + (swz % 64) / 2; }
__host__ __device__ __forceinline__ int perm32(int rho) { const int n = rho >> 4, i = rho & 15; return 8 * (i >> 2) + 4 * n + (i & 3); }

struct Unit { const char* a; const char* b; int r0, c0; };
struct Gemm { int K, lda, ldb; };

__device__ __forceinline__ bool static_order(long L, int nM, int nN, int& pm, int& pn) {
    const int nwg = nM * nN; if (L >= nwg) return false;
    int wgid = (int)L; { const int q = nwg / NXCD, r = nwg % NXCD, xcd = wgid % NXCD, off = wgid / NXCD; wgid = (xcd < r ? xcd * (q + 1) : r * (q + 1) + (xcd - r) * q) + off; }
    const int nig = WGM * nN, gid = wgid / nig, fm = gid * WGM, gsz = (nM - fm) < WGM ? (nM - fm) : WGM;
    pm = fm + ((wgid % nig) % gsz); pn = (wgid % nig) / gsz; return true;
}
__device__ __forceinline__ unsigned cvt_pk_bf16(float lo, float hi) { unsigned r; asm volatile("v_cvt_pk_bf16_f32 %0, %1, %2" : "=v"(r) : "v"(lo), "v"(hi)); return r; }

template <class Epi, class Sched, bool ALIGN_EPI, bool SP2>
__device__ __forceinline__ void gemm_phase(LAS unsigned char* lds, const Gemm g, const Sched& S, const Epi& E) {
    int tid_ = threadIdx.x; asm volatile("" : "+v"(tid_));
    const int tid = tid_, wid = __builtin_amdgcn_readfirstlane(tid >> 6), lane = tid & 63, wr = wid >> 2, wc = wid & 3, fr = lane & 15, fq = lane >> 4;
    const int K = g.K, nt = K / BK;
    unsigned voffA[2], voffB[2];
#pragma unroll
    for (int i = 0; i < 2; ++i) { int R, C; stage_rc(tid * 16 + i * 8192, R, C); const int Rb = Epi::PERM ? ((R & ~31) + perm32(R & 31)) : R;
        voffA[i] = (unsigned)(R * g.lda + C * 2); voffB[i] = (unsigned)(Rb * g.ldb + C * 2); }
    const size_t kstep = (size_t)(BK * 2);
    const size_t hstepA = (size_t)HALF * g.lda, hstepB = (size_t)HALF * g.ldb;
    const unsigned ldsw = (unsigned)wid * 1024u;
    const int aoff = lds_byte(wr * 64 + fr, fq * 8), boff = lds_byte(wc * 32 + fr, fq * 8);
#define PG8_SA(b, h) (((b) * 2 + (h)) * HTB)
#define PG8_SB(b, h) ((4 + (b) * 2 + (h)) * HTB)
#define PG8_STAGE(bufoff, gbase, voff) do { _Pragma("unroll") for (int _i = 0; _i < 2; ++_i) \
        __builtin_amdgcn_global_load_lds((const unsigned*)((const char*)(gbase) + (voff)[_i]), (LAS unsigned*)(lds + (bufoff) + ldsw + _i * 8192), 16, 0, 0); } while (0)
#define PG8_LDA(dst, b, h) do { _Pragma("unroll") for (int m = 0; m < 4; ++m) _Pragma("unroll") for (int k = 0; k < 2; ++k) dst[m][k] = *(const LAS bf16x8*)(lds + PG8_SA(b, h) + aoff + m * 2048 + k * 1024); } while (0)
#define PG8_LDB(dst, b, h) do { _Pragma("unroll") for (int n = 0; n < 2; ++n) _Pragma("unroll") for (int k = 0; k < 2; ++k) dst[n][k] = *(const LAS bf16x8*)(lds + PG8_SB(b, h) + boff + n * 2048 + k * 1024); } while (0)
#define PG8_MMA(ai, bj, At, Bt) do { __builtin_amdgcn_s_setprio(1); _Pragma("unroll") for (int m = 0; m < 4; ++m) _Pragma("unroll") for (int n = 0; n < 2; ++n) _Pragma("unroll") for (int k = 0; k < 2; ++k) \
        acc[ai][bj][m][n] = __builtin_amdgcn_mfma_f32_16x16x32_bf16(Bt[n][k], At[m][k], acc[ai][bj][m][n], 0, 0, 0); __builtin_amdgcn_s_setprio(0); } while (0)
#define PG8_WAIT_V(n) asm volatile("s_waitcnt vmcnt(" #n ")" ::: "memory")
#define PG8_WAIT_L(n) asm volatile("s_waitcnt lgkmcnt(" #n ")" ::: "memory")
#define PG8_BAR __builtin_amdgcn_s_barrier()
#define PG8_SCHED __builtin_amdgcn_sched_barrier(0)
    Unit cur, nxt; int ui = 0;
    if (!S.next(0, cur)) return;
    f32x4 acc[2][2][4][2];
#pragma unroll
    for (int a = 0; a < 2; ++a)
#pragma unroll
        for (int b = 0; b < 2; ++b)
#pragma unroll
            for (int m = 0; m < 4; ++m)
#pragma unroll
                for (int n = 0; n < 2; ++n) acc[a][b][m][n] = (f32x4){0.f, 0.f, 0.f, 0.f};
    bf16x8 At[4][2], B0[2][2], B1[2][2];
    const char* cA = cur.a; const char* cB = cur.b;
    if constexpr (SP2) {
        PG8_STAGE(PG8_SB(0, 0), cB, voffB); PG8_STAGE(PG8_SB(0, 1), cB + hstepB, voffB); PG8_STAGE(PG8_SA(0, 0), cA, voffA); PG8_STAGE(PG8_SA(0, 1), cA + hstepA, voffA);
        if (wr == 1) PG8_BAR;
        PG8_WAIT_V(2); PG8_BAR;
        PG8_STAGE(PG8_SB(1, 0), cB + kstep, voffB); PG8_STAGE(PG8_SA(1, 0), cA + kstep, voffA); PG8_STAGE(PG8_SB(1, 1), cB + hstepB + kstep, voffB);
        PG8_WAIT_V(6); PG8_BAR;
    } else {
        PG8_STAGE(PG8_SB(0, 0), cB, voffB); PG8_STAGE(PG8_SA(0, 0), cA, voffA); PG8_STAGE(PG8_SB(0, 1), cB + hstepB, voffB); PG8_STAGE(PG8_SA(0, 1), cA + hstepA, voffA);
        if (wr == 1) PG8_BAR;
        PG8_WAIT_V(4); PG8_BAR;
        PG8_STAGE(PG8_SB(1, 0), cB + kstep, voffB); PG8_STAGE(PG8_SA(1, 0), cA + kstep, voffA); PG8_STAGE(PG8_SB(1, 1), cB + hstepB + kstep, voffB);
        PG8_WAIT_V(6); PG8_BAR;
    }
    for (;;) {
        const bool has_next = S.next(ui + 1, nxt);
        const char* nA = has_next ? nxt.a : cA; const char* nB = has_next ? nxt.b : cB;
        for (int t = 0; t < nt; t += 2) {
            const bool last = (t == nt - 2);
            const char* a1 = cA + (size_t)(t + 1) * kstep;
            const char* a2 = last ? nA : cA + (size_t)(t + 2) * kstep; const char* b2 = last ? nB : cB + (size_t)(t + 2) * kstep;
            const char* a3 = a2 + kstep; const char* b3 = b2 + kstep;
            if constexpr (SP2) {
            PG8_LDB(B0, 0, 0); PG8_LDB(B1, 0, 1); PG8_SCHED; PG8_LDA(At, 0, 0); PG8_STAGE(PG8_SA(1, 1), a1 + hstepA, voffA);
            PG8_WAIT_V(8); PG8_WAIT_L(0); PG8_BAR; PG8_MMA(0, 0, At, B0); PG8_MMA(0, 1, At, B1); PG8_BAR; PG8_SCHED;
            PG8_LDA(At, 0, 1); PG8_STAGE(PG8_SB(0, 0), b2, voffB); PG8_STAGE(PG8_SB(0, 1), b2 + hstepB, voffB); PG8_STAGE(PG8_SA(0, 0), a2, voffA);
            PG8_WAIT_V(8); PG8_WAIT_L(0); PG8_BAR; PG8_MMA(1, 0, At, B0); PG8_MMA(1, 1, At, B1); PG8_BAR; PG8_SCHED;
            PG8_LDB(B0, 1, 0); PG8_LDB(B1, 1, 1); PG8_SCHED; PG8_LDA(At, 1, 0); PG8_STAGE(PG8_SA(0, 1), a2 + hstepA, voffA);
            PG8_WAIT_V(8); PG8_WAIT_L(0); PG8_BAR; PG8_MMA(0, 0, At, B0); PG8_MMA(0, 1, At, B1); PG8_BAR; PG8_SCHED;
            PG8_LDA(At, 1, 1); PG8_STAGE(PG8_SB(1, 0), b3, voffB); PG8_STAGE(PG8_SB(1, 1), b3 + hstepB, voffB); PG8_STAGE(PG8_SA(1, 0), a3, voffA);
            PG8_WAIT_V(8); PG8_WAIT_L(0); PG8_BAR; PG8_MMA(1, 0, At, B0); PG8_MMA(1, 1, At, B1); PG8_BAR; PG8_SCHED;
            } else {
            PG8_LDB(B0, 0, 0); PG8_SCHED; PG8_LDA(At, 0, 0); PG8_STAGE(PG8_SA(1, 1), a1 + hstepA, voffA);
            PG8_WAIT_L(8); PG8_BAR; PG8_WAIT_L(0); PG8_MMA(0, 0, At, B0); PG8_BAR; PG8_SCHED;
            PG8_LDB(B1, 0, 1); PG8_STAGE(PG8_SB(0, 0), b2, voffB);
            PG8_BAR; PG8_WAIT_L(0); PG8_MMA(0, 1, At, B1); PG8_BAR;
            PG8_LDA(At, 0, 1); PG8_STAGE(PG8_SA(0, 0), a2, voffA);
            PG8_BAR; PG8_WAIT_L(0); PG8_MMA(1, 0, At, B0); PG8_BAR; PG8_SCHED;
            PG8_STAGE(PG8_SB(0, 1), b2 + hstepB, voffB);
            PG8_WAIT_V(6); PG8_BAR; PG8_MMA(1, 1, At, B1); PG8_BAR;
            PG8_LDB(B0, 1, 0); PG8_SCHED; PG8_LDA(At, 1, 0); PG8_STAGE(PG8_SA(0, 1), a2 + hstepA, voffA);
            PG8_WAIT_L(8); PG8_BAR; PG8_WAIT_L(0); PG8_MMA(0, 0, At, B0); PG8_BAR; PG8_SCHED;
            PG8_LDB(B1, 1, 1); PG8_STAGE(PG8_SB(1, 0), b3, voffB);
            PG8_BAR; PG8_WAIT_L(0); PG8_MMA(0, 1, At, B1); PG8_BAR;
            PG8_LDA(At, 1, 1); PG8_STAGE(PG8_SA(1, 0), a3, voffA);
            PG8_BAR; PG8_WAIT_L(0); PG8_MMA(1, 0, At, B0); PG8_BAR; PG8_SCHED;
            PG8_STAGE(PG8_SB(1, 1), b3 + hstepB, voffB);
            PG8_WAIT_V(6); PG8_BAR; PG8_MMA(1, 1, At, B1); PG8_BAR;
            }
        }
        if constexpr (ALIGN_EPI) { if (wr == 0) PG8_BAR; }
        E(acc, cur, wr, wc, fr, fq);
        if (!has_next) break;
#pragma unroll
        for (int a = 0; a < 2; ++a)
#pragma unroll
            for (int b = 0; b < 2; ++b)
#pragma unroll
                for (int m = 0; m < 4; ++m)
#pragma unroll
                    for (int n = 0; n < 2; ++n) acc[a][b][m][n] = (f32x4){0.f, 0.f, 0.f, 0.f};
        cur = nxt; cA = nA; cB = nB; ++ui;
        if constexpr (ALIGN_EPI) { if (wr == 1) PG8_BAR; }
    }
    PG8_WAIT_V(0);
    if constexpr (!ALIGN_EPI) { if (wr == 0) PG8_BAR; }
    PG8_BAR;
#undef PG8_SA
#undef PG8_SB
#undef PG8_STAGE
#undef PG8_LDA
#undef PG8_LDB
#undef PG8_MMA
#undef PG8_WAIT_V
#undef PG8_WAIT_L
#undef PG8_BAR
#undef PG8_SCHED
}

struct Sched2D {
    const char* A; const char* B; size_t atile, btile; int nM, nN, G, c, r_base, c_base;
    __device__ __forceinline__ bool next(int i, Unit& u) const {
        if (c < 0) return false;
        int pm, pn; if (!static_order((long)i * G + c, nM, nN, pm, pn)) return false;
        u.a = A + (size_t)pm * atile; u.b = B + (size_t)pn * btile; u.r0 = r_base + pm * 256; u.c0 = c_base + pn * 256; return true;
    }
};
struct SchedMerge {
    const char *y0, *w0; int G, c;
    __device__ __forceinline__ bool next(int i, Unit& u) const {
        int pm, pn; if (!static_order((long)i * G + c, 48, 12, pm, pn)) return false;
        const int br = pn >> 2; const char* y = y0 + (size_t)br * (12u << 20); const char* w = w0 + (size_t)br * (1u << 20);
        u.a = y + (size_t)pm * 256 * 512 * 2; u.b = w + (size_t)(pn & 3) * 256 * 512 * 2; u.r0 = pm * 256; u.c0 = pn * 256; return true;
    }
};
struct SchedFourL {
    const char* tab; const char* xcs; int c;
    __device__ __forceinline__ bool next(int i, Unit& u) const {
        if (i > 0 || c < 0 || c >= 64) return false;
        const int ks = c >> 5, b = (c >> 4) & 1, pm = (c & 15) >> 1, pn = c & 1;
        u.a = tab + (size_t)pm * 256 * 4096 * 2 + (size_t)ks * 2048 * 2; u.b = xcs + ((size_t)b * 512 + pn * 256) * 4096 * 2 + (size_t)ks * 2048 * 2; u.r0 = ks * 4096 + b * 2048 + pm * 256; u.c0 = pn * 256; return true;
    }
};
struct SchedFourC {
    const char* tab; const char* xcs; int c;
    __device__ __forceinline__ bool next(int i, Unit& u) const {
        if (i > 0 || c < 0 || c >= 64) return false;
        const int b = c >> 1, pn = c & 1;
        u.a = tab; u.b = xcs + ((size_t)b * 512 + pn * 256) * 512 * 2; u.r0 = b * 256; u.c0 = pn * 256; return true;
    }
};

typedef f32x4 Acc[2][2][4][2];
struct EpiInN {
    static constexpr bool PERM = true;
    bf16_t* qkv; bf16_t* z; float* ba;
    __device__ __forceinline__ void operator()(const Acc& acc, const Unit& u, int wr, int wc, int fr, int fq) const {
        const int colt = u.c0;
#pragma unroll
        for (int ai = 0; ai < 2; ++ai)
#pragma unroll
            for (int m = 0; m < 4; ++m) { const int row = u.r0 + ai * HALF + wr * 64 + m * 16 + fr;
#pragma unroll
                for (int bj = 0; bj < 2; ++bj) { const int col = colt + bj * HALF + wc * 32 + 8 * fq; const f32x4 v0 = acc[ai][bj][m][0], v1 = acc[ai][bj][m][1];
                    if (colt < 2048) { u32x4 w; w.x = cvt_pk_bf16(v0[0], v0[1]); w.y = cvt_pk_bf16(v0[2], v0[3]); w.z = cvt_pk_bf16(v1[0], v1[1]); w.w = cvt_pk_bf16(v1[2], v1[3]);
                        bf16_t* p = colt < 1536 ? qkv + (size_t)row * 1536 + col : z + (size_t)row * 512 + (col - 1536);
                        *(u32x4*)p = w; }
                    else if (col - 2048 < 32) { float* p = ba + (size_t)row * 32 + (col - 2048); *(f32x4*)p = v0; *(f32x4*)(p + 4) = v1; } } }
    }
};
struct EpiInS {
    static constexpr bool PERM = true;
    bf16_t* hyt; bf16_t* xcsl; bf16_t* xcsc;
    __device__ __forceinline__ void operator()(const Acc& acc, const Unit& u, int wr, int wc, int fr, int fq) const {
#pragma unroll
        for (int ai = 0; ai < 2; ++ai)
#pragma unroll
            for (int m = 0; m < 4; ++m) { const int ch = u.r0 + ai * HALF + wr * 64 + m * 16 + fr;
#pragma unroll
                for (int bj = 0; bj < 2; ++bj) { const int tok = u.c0 + bj * HALF + wc * 32 + 8 * fq; const f32x4 v0 = acc[ai][bj][m][0], v1 = acc[ai][bj][m][1];
                    u32x4 w; w.x = cvt_pk_bf16(v0[0], v0[1]); w.y = cvt_pk_bf16(v0[2], v0[3]); w.z = cvt_pk_bf16(v1[0], v1[1]); w.w = cvt_pk_bf16(v1[2], v1[3]);
                    bf16_t* p;
                    if (ch < 1536) p = hyt + (size_t)ch * NTOK + tok;
                    else { const int cc = ch - 1536, which = cc >> 9, n = cc & 511;
                        if (tok < NCTX) { const int b = tok >> 8, t = tok & 255; p = xcsc + ((size_t)(b * 512 + n) * 512 + which * 256 + t); }
                        else { const int tt = tok - NCTX, b = tt >> 11, t = tt & 2047; p = xcsl + ((size_t)(b * 512 + n) * 4096 + which * 2048 + t); } }
                    *(u32x4*)p = w; } }
    }
};
struct EpiScaleBf16 {
    static constexpr bool PERM = true;
    bf16_t* O; int ldc; float scale;
    __device__ __forceinline__ void operator()(const Acc& acc, const Unit& u, int wr, int wc, int fr, int fq) const {
#pragma unroll
        for (int ai = 0; ai < 2; ++ai)
#pragma unroll
            for (int m = 0; m < 4; ++m) { const int row = u.r0 + ai * HALF + wr * 64 + m * 16 + fr;
#pragma unroll
                for (int bj = 0; bj < 2; ++bj) { const int col = u.c0 + bj * HALF + wc * 32 + 8 * fq; const f32x4 v0 = acc[ai][bj][m][0] * scale, v1 = acc[ai][bj][m][1] * scale;
                    u32x4 w; w.x = cvt_pk_bf16(v0[0], v0[1]); w.y = cvt_pk_bf16(v0[2], v0[3]); w.z = cvt_pk_bf16(v1[0], v1[1]); w.w = cvt_pk_bf16(v1[2], v1[3]);
                    *(u32x4*)(O + (size_t)row * ldc + col) = w; } }
    }
};
struct EpiAtomicF32 {
    static constexpr bool PERM = false;
    float* C; int ldc;
    __device__ __forceinline__ void operator()(const Acc& acc, const Unit& u, int wr, int wc, int fr, int fq) const {
#pragma unroll
        for (int ai = 0; ai < 2; ++ai)
#pragma unroll
            for (int m = 0; m < 4; ++m) { float* rowp = C + (size_t)(u.r0 + ai * HALF + wr * 64 + m * 16 + fr) * ldc + u.c0 + wc * 32 + 4 * fq;
#pragma unroll
                for (int bj = 0; bj < 2; ++bj)
#pragma unroll
                    for (int n = 0; n < 2; ++n)
#pragma unroll
                        for (int e = 0; e < 4; ++e) unsafeAtomicAdd(rowp + bj * HALF + n * 16 + e, acc[ai][bj][m][n][e]); }
    }
};
struct EpiGate {
    static constexpr bool PERM = true;
    bf16_t* O;
    __device__ __forceinline__ void operator()(const Acc& acc, const Unit& u, int wr, int wc, int fr, int fq) const {
#pragma unroll
        for (int ai = 0; ai < 2; ++ai)
#pragma unroll
            for (int m = 0; m < 4; ++m) { const int row = u.r0 + ai * HALF + wr * 64 + m * 16 + fr;
#pragma unroll
                for (int bj = 0; bj < 2; ++bj) { const int col = u.c0 + bj * HALF + wc * 32 + 8 * fq; const f32x4 v0 = acc[ai][bj][m][0], v1 = acc[ai][bj][m][1];
                    u32x4 w; w.x = cvt_pk_bf16(sigmoidf_(v0[0]), sigmoidf_(v0[1])); w.y = cvt_pk_bf16(sigmoidf_(v0[2]), sigmoidf_(v0[3]));
                    w.z = cvt_pk_bf16(sigmoidf_(v1[0]), sigmoidf_(v1[1])); w.w = cvt_pk_bf16(sigmoidf_(v1[2]), sigmoidf_(v1[3]));
                    *(u32x4*)(O + (size_t)row * 3072 + col) = w; } }
    }
};
struct EpiMerge {
    static constexpr bool PERM = true;
    bf16_t* O;
    __device__ __forceinline__ void operator()(const Acc& acc, const Unit& u, int wr, int wc, int fr, int fq) const {
#pragma unroll
        for (int ai = 0; ai < 2; ++ai)
#pragma unroll
            for (int m = 0; m < 4; ++m) { const int row = u.r0 + ai * HALF + wr * 64 + m * 16 + fr;
#pragma unroll
                for (int bj = 0; bj < 2; ++bj) { const int col = u.c0 + bj * HALF + wc * 32 + 8 * fq; const f32x4 v0 = acc[ai][bj][m][0], v1 = acc[ai][bj][m][1];
                    bf16_t* p = O + (size_t)row * 3072 + col; const u32x4 gg = *(const u32x4*)p;
                    u32x4 w; w.x = cvt_pk_bf16(v0[0] * bflo(gg.x), v0[1] * bfhi(gg.x)); w.y = cvt_pk_bf16(v0[2] * bflo(gg.y), v0[3] * bfhi(gg.y));
                    w.z = cvt_pk_bf16(v1[0] * bflo(gg.z), v1[1] * bfhi(gg.z)); w.w = cvt_pk_bf16(v1[2] * bflo(gg.w), v1[3] * bfhi(gg.w));
                    *(u32x4*)p = w; } }
    }
};
struct EpiMergeAcc {
    static constexpr bool PERM = true;
    bf16_t* M; const bf16_t* G; int gcol0; int first;
    __device__ __forceinline__ void operator()(const Acc& acc, const Unit& u, int wr, int wc, int fr, int fq) const {
#pragma unroll
        for (int ai = 0; ai < 2; ++ai)
#pragma unroll
            for (int m = 0; m < 4; ++m) { const int row = u.r0 + ai * HALF + wr * 64 + m * 16 + fr;
#pragma unroll
                for (int bj = 0; bj < 2; ++bj) { const int col = u.c0 + bj * HALF + wc * 32 + 8 * fq; const f32x4 v0 = acc[ai][bj][m][0], v1 = acc[ai][bj][m][1];
                    const u32x4 gg = *(const u32x4*)(G + (size_t)row * 3072 + gcol0 + col); bf16_t* p = M + (size_t)row * 1024 + col;
                    float o[8] = {v0[0] * bflo(gg.x), v0[1] * bfhi(gg.x), v0[2] * bflo(gg.y), v0[3] * bfhi(gg.y), v1[0] * bflo(gg.z), v1[1] * bfhi(gg.z), v1[2] * bflo(gg.w), v1[3] * bfhi(gg.w)};
                    if (!first) { const u32x4 mm = *(const u32x4*)p; o[0] += bflo(mm.x); o[1] += bfhi(mm.x); o[2] += bflo(mm.y); o[3] += bfhi(mm.y); o[4] += bflo(mm.z); o[5] += bfhi(mm.z); o[6] += bflo(mm.w); o[7] += bfhi(mm.w); }
                    u32x4 w; w.x = cvt_pk_bf16(o[0], o[1]); w.y = cvt_pk_bf16(o[2], o[3]); w.z = cvt_pk_bf16(o[4], o[5]); w.w = cvt_pk_bf16(o[6], o[7]);
                    *(u32x4*)p = w; } }
    }
};
struct EpiResid {
    static constexpr bool PERM = false;
    float* X; const float* gate;
    __device__ __forceinline__ void operator()(const Acc& acc, const Unit& u, int wr, int wc, int fr, int fq) const {
        const float* gp = gate + (size_t)mod_idx(u.r0) * 6144;
#pragma unroll
        for (int bj = 0; bj < 2; ++bj)
#pragma unroll
            for (int n = 0; n < 2; ++n) { const int col = u.c0 + bj * HALF + wc * 32 + 16 * n + 4 * fq; const f32x4 gv = *(const f32x4*)(gp + col);
#pragma unroll
                for (int ai = 0; ai < 2; ++ai)
#pragma unroll
                    for (int m = 0; m < 4; ++m) { const int row = u.r0 + ai * HALF + wr * 64 + m * 16 + fr; float* p = X + (size_t)row * DM + col;
                        const f32x4 x = *(const f32x4*)p; *(f32x4*)p = x + gv * acc[ai][bj][m][n]; } }
    }
};
struct EpiGU {
    static constexpr bool PERM = true;
    bf16_t* O;
    __device__ __forceinline__ void operator()(const Acc& acc, const Unit& u, int wr, int wc, int fr, int fq) const {
        const int col = (u.c0 >> 1) + wc * 32 + 8 * fq;
#pragma unroll
        for (int ai = 0; ai < 2; ++ai)
#pragma unroll
            for (int m = 0; m < 4; ++m) { const int row = u.r0 + ai * HALF + wr * 64 + m * 16 + fr;
                const f32x4 g0 = acc[ai][0][m][0], g1 = acc[ai][0][m][1], u0 = acc[ai][1][m][0], u1 = acc[ai][1][m][1];
                u32x4 w; w.x = cvt_pk_bf16(siluf_(g0[0]) * u0[0], siluf_(g0[1]) * u0[1]); w.y = cvt_pk_bf16(siluf_(g0[2]) * u0[2], siluf_(g0[3]) * u0[3]);
                w.z = cvt_pk_bf16(siluf_(g1[0]) * u1[0], siluf_(g1[1]) * u1[1]); w.w = cvt_pk_bf16(siluf_(g1[2]) * u1[2], siluf_(g1[3]) * u1[3]);
                *(u32x4*)(O + (size_t)row * DFF + col) = w; }
    }
};
}

#define XB_TMO      128
#define XB_XCNT(j)  (256  + 64 * (j))
#define XB_XSUB(j)  (1280 + 64 * (j))
#define XB_XGEN(j)  (2304 + 64 * (j))
#define XB_TOP      3328
#define XB_TOPGEN   3392
#define XCD_BAR_WORDS 3456
#define XB_SPIN_CAP (1u << 18)
__device__ __forceinline__ unsigned xb_ld(unsigned* p)              { return __hip_atomic_load(p, __ATOMIC_RELAXED, __HIP_MEMORY_SCOPE_AGENT); }
__device__ __forceinline__ unsigned xb_add(unsigned* p, unsigned v) { return __hip_atomic_fetch_add(p, v, __ATOMIC_RELAXED, __HIP_MEMORY_SCOPE_AGENT); }
__device__ __forceinline__ unsigned xb_xcc_id() { return (unsigned)__builtin_amdgcn_s_getreg((3 << 11) | 20) & 0xFu; }
#define XB_SPIN(cond, bar) do { unsigned _sp = 0; while (cond) { __builtin_amdgcn_s_sleep(1); \
    if ((++_sp & 255u) == 0u) { if (xb_ld(&(bar)[XB_TMO])) break; if (_sp > XB_SPIN_CAP) { atomicAdd(&(bar)[XB_TMO], 1u); break; } } } } while (0)
struct XcdBarrier { unsigned* bar; unsigned x; volatile LAS unsigned* st; };
__device__ __forceinline__ XcdBarrier xcd_barrier_post(unsigned* bar, volatile LAS unsigned* st) {
    XcdBarrier b; b.bar = bar; b.x = xb_xcc_id(); b.st = st;
    if (threadIdx.x == 0) (void)xb_add(&bar[XB_XCNT(b.x)], 1u);
    return b;
}
__device__ __forceinline__ void xcd_barrier_complete(unsigned* bar, unsigned x, unsigned& nloc, unsigned& nx) {
    const unsigned G = gridDim.x * gridDim.y * gridDim.z;
    unsigned sum, cnt, mine, sp = 0u;
    for (;;) {
        sum = 0u; cnt = 0u; mine = 0u;
#pragma unroll 1
        for (unsigned j = 0; j < 16; ++j) { const unsigned c = xb_ld(&bar[XB_XCNT(j)]); sum += c; cnt += (c > 0u) ? 1u : 0u; mine = (j == x) ? c : mine; }
        if (sum == G) break;
        __builtin_amdgcn_s_sleep(1);
        if ((++sp & 255u) == 0u) { if (xb_ld(&bar[XB_TMO])) break; if (sp > XB_SPIN_CAP) { atomicAdd(&bar[XB_TMO], 1u); break; } }
    }
    nloc = mine > 0u ? mine : 1u; nx = cnt > 0u ? cnt : 1u;
}
__device__ __forceinline__ void xcd_barrier(const XcdBarrier& b) {
    asm volatile("s_waitcnt vmcnt(0)" ::: "memory");
    __syncthreads();
    if (threadIdx.x == 0) {
        unsigned* bar = opq(b.bar);
        __builtin_amdgcn_s_waitcnt(0);
        unsigned nloc = b.st[0], nx = b.st[1];
        if (nloc == 0u) { xcd_barrier_complete(bar, b.x, nloc, nx); b.st[0] = nloc; b.st[1] = nx; }
        const unsigned old = xb_add(&bar[XB_XSUB(b.x)], 1u);
        const unsigned gen = old / nloc;
        if (old + 1u == (gen + 1u) * nloc) {
            __builtin_amdgcn_fence(__ATOMIC_RELEASE, "agent");
            asm volatile("s_waitcnt vmcnt(0)" ::: "memory");
            const unsigned og = xb_add(&bar[XB_TOP], 1u);
            const unsigned tg = og / nx;
            if (og + 1u == (tg + 1u) * nx) xb_add(&bar[XB_TOPGEN], 1u);
            else XB_SPIN(xb_ld(&bar[XB_TOPGEN]) == tg, bar);
            __builtin_amdgcn_fence(__ATOMIC_ACQUIRE, "agent");
            xb_add(&bar[XB_XGEN(b.x)], 1u);
            asm volatile("s_waitcnt vmcnt(0)" ::: "memory");
        } else {
            XB_SPIN(xb_ld(&bar[XB_XGEN(b.x)]) == gen, bar);
            __builtin_amdgcn_fence(__ATOMIC_ACQUIRE, "agent");
            asm volatile("s_waitcnt vmcnt(0)" ::: "memory");
        }
    }
    __syncthreads();
}

struct Args { const float* in[N_IN]; float* out; unsigned char* ws; int ph_lo, ph_hi, li, pad; };
struct Frame {
    LAS unsigned char* lds; const float* const* in; float* out; unsigned char* ws; unsigned* ctl;
    int tid, lane, wave, G, bid;
};
#define PROF_DECL do {} while (0)
#define PROF_FLUSH() do {} while (0)
__device__ __forceinline__ int q_next(Frame& F, int qid) {
    volatile LAS int* slot = (volatile LAS int*)(F.lds + MISC_OFF + 64);
    __syncthreads();
    if (F.tid == 0) *slot = (int)__hip_atomic_fetch_add(F.ctl + CW_Q + 64 * qid, 1u, RLX_AGENT);
    __syncthreads();
    return *slot;
}

__device__ __forceinline__ void transpose_item(const float* W, int ld_src, int col0, bf16_t* WT, int ld_dst, int dst_k0, int row0, int k0, LAS float* scr, int lane) {
    float tv[32];
#pragma unroll
    for (int i = 0; i < 32; ++i) tv[i] = W[(size_t)(k0 + 2 * i + (lane >> 5)) * ld_src + col0 + (lane & 31)];
#pragma unroll
    for (int i = 0; i < 32; ++i) scr[(2 * i + (lane >> 5)) * 33 + (lane & 31)] = tv[i];
    LDS_WAIT(); asm volatile("" ::: "memory");
    const int c = lane & 7;
#pragma unroll
    for (int j = 0; j < 4; ++j) { const int n = (lane >> 3) + 8 * j; const LAS float* s = scr + (8 * c) * 33 + n;
        u32x4 o; o.x = pk2(s[0 * 33], s[1 * 33]); o.y = pk2(s[2 * 33], s[3 * 33]); o.z = pk2(s[4 * 33], s[5 * 33]); o.w = pk2(s[6 * 33], s[7 * 33]);
        *(u32x4*)(WT + (size_t)(row0 + n) * ld_dst + dst_k0 + k0 + 8 * c) = o; }
    LDS_WAIT(); asm volatile("" ::: "memory");
}
struct TrItem { const float* src; bf16_t* dst; int ld_src, ld_dst; };
__device__ __forceinline__ int tr_part(int r) {
    constexpr int NI_QKVZBA = 16 * (2080 / 32), NI_HY = 16 * 48, NI_G = 16 * 96, NI_P = 8 * 32, NI_O = 16 * 32, NI_GU = 16 * 176;
    return r < NI_QKVZBA + NI_HY ? 0 : (r < NI_QKVZBA + NI_HY + NI_G ? 1 : (r < NI_QKVZBA + NI_HY + NI_G + 3 * NI_P ? 2 : (r < NI_QKVZBA + NI_HY + NI_G + 3 * NI_P + 3 * NI_O ? 3 : (r < NI_QKVZBA + NI_HY + NI_G + 3 * NI_P + 3 * NI_O + NI_GU ? 4 : 5))));
}
__device__ __forceinline__ TrItem tr_decode(Frame& F, int l, int r) {
    constexpr int NI_QKVZBA = 16 * (2080 / 32), NI_HY = 16 * 48, NI_G = 16 * 96, NI_P = 8 * 32, NI_O = 16 * 32, NI_GU = 16 * 176;
    const float* w_in = F.in[I_WIN] + (size_t)l * DM * DIN; unsigned char* ws = F.ws;
    const float* src; int ld_src, col0, ld_dst, dst_k0, row0, k0; bf16_t* dst;
    if (r < NI_QKVZBA) { const int nb = r % 65, kb = r / 65; src = w_in; ld_src = DIN; col0 = nb * 32; dst = (bf16_t*)(ws + W_N); ld_dst = 1024; dst_k0 = 0; row0 = nb * 32; k0 = kb * 64; }
    else if ((r -= NI_QKVZBA) < NI_HY) { const int nb = r % 48, kb = r / 48; src = w_in; ld_src = DIN; col0 = OFF_HY + nb * 32; dst = (bf16_t*)(ws + W_S); ld_dst = 1024; dst_k0 = 0; row0 = nb * 32; k0 = kb * 64; }
    else if ((r -= NI_HY) < NI_G) { const int nb = r % 96, kb = r / 96; src = w_in; ld_src = DIN; col0 = OFF_GATE + nb * 32; dst = (bf16_t*)(ws + W_G); ld_dst = 1024; dst_k0 = 0; row0 = nb * 32; k0 = kb * 64; }
    else if ((r -= NI_G) < 3 * NI_P) { const int j = r / NI_P, q = r % NI_P, nb = q % 32, kb = q / 32; src = (j == 0 ? F.in[I_WPA] : (j == 1 ? F.in[I_WPB] : F.in[I_WPC])) + (size_t)l * 512 * 1024;
        ld_src = 1024; col0 = nb * 32; dst = (bf16_t*)(ws + W_P) + (size_t)j * 1024 * 512; ld_dst = 512; dst_k0 = 0; row0 = nb * 32; k0 = kb * 64; }
    else if ((r -= 3 * NI_P) < 3 * NI_O) { const int j = r / NI_O, q = r % NI_O, nb = q % 32, kb = q / 32; src = F.in[I_WO] + (size_t)l * 1024 * 1024;
        ld_src = 1024; col0 = nb * 32; dst = (bf16_t*)(ws + W_O3); ld_dst = 3072; dst_k0 = j * 1024; row0 = nb * 32; k0 = kb * 64; }
    else if ((r -= 3 * NI_O) < NI_GU) { const int nb = r % 176, kb = r / 176; const int n0 = nb * 32, up = n0 >= DFF ? 1 : 0, nn = n0 - up * DFF;
        src = F.in[I_WGU] + (size_t)l * 1024 * 5632; ld_src = 5632; col0 = n0; dst = (bf16_t*)(ws + W_GU); ld_dst = 1024; dst_k0 = 0; row0 = 256 * (nn / 128) + 128 * up + (nn % 128); k0 = kb * 64; }
    else { r -= NI_GU; const int nb = r % 32, kb = r / 32; src = F.in[I_WDOWN] + (size_t)l * DFF * 1024; ld_src = 1024; col0 = nb * 32; dst = (bf16_t*)(ws + W_DN); ld_dst = DFF; dst_k0 = 0; row0 = nb * 32; k0 = kb * 64; }
    TrItem t; t.src = src + (size_t)k0 * ld_src + col0; t.dst = dst + (size_t)row0 * ld_dst + dst_k0 + k0; t.ld_src = ld_src; t.ld_dst = ld_dst; return t;
}
__device__ __forceinline__ void prep_weights(Frame& F, int l, int mask) {
    LAS float* scr = (LAS float*)(F.lds + F.wave * 16384);
    const int gw = F.bid * NWAVES + F.wave, NGW = F.G * NWAVES, lane = F.lane;
    unsigned char* ws = F.ws; const float* w_in = F.in[I_WIN] + (size_t)l * DM * DIN;
    constexpr int NITEMS = 16 * 65 + 16 * 48 + 16 * 96 + 3 * 8 * 32 + 3 * 16 * 32 + 16 * 176 + 44 * 32;
    int it = gw;
    while (it < NITEMS && !((mask >> tr_part(it)) & 1)) it += NGW;
    float tv[32]; TrItem cur{};
    if (it < NITEMS) { cur = tr_decode(F, l, it);
#pragma unroll
        for (int i = 0; i < 32; ++i) tv[i] = cur.src[(size_t)(2 * i + (lane >> 5)) * cur.ld_src + (lane & 31)]; }
#pragma unroll 1
    while (it < NITEMS) {
        int nx = it + NGW;
        while (nx < NITEMS && !((mask >> tr_part(nx)) & 1)) nx += NGW;
        float tn[32]; TrItem nxt = cur;
        if (nx < NITEMS) { nxt = tr_decode(F, l, nx);
#pragma unroll
            for (int i = 0; i < 32; ++i) tn[i] = nxt.src[(size_t)(2 * i + (lane >> 5)) * nxt.ld_src + (lane & 31)]; }
        else {
#pragma unroll
            for (int i = 0; i < 32; ++i) tn[i] = 0.f; }
#pragma unroll
        for (int i = 0; i < 32; ++i) scr[(2 * i + (lane >> 5)) * 33 + (lane & 31)] = tv[i];
        LDS_WAIT(); asm volatile("" ::: "memory");
        { const int c = lane & 7;
#pragma unroll
          for (int j = 0; j < 4; ++j) { const int n = (lane >> 3) + 8 * j; const LAS float* s = scr + (8 * c) * 33 + n;
              u32x4 o; o.x = pk2(s[0 * 33], s[1 * 33]); o.y = pk2(s[2 * 33], s[3 * 33]); o.z = pk2(s[4 * 33], s[5 * 33]); o.w = pk2(s[6 * 33], s[7 * 33]);
              *(u32x4*)(cur.dst + (size_t)n * cur.ld_dst + 8 * c) = o; } }
        LDS_WAIT(); asm volatile("" ::: "memory");
#pragma unroll
        for (int i = 0; i < 32; ++i) tv[i] = tn[i];
        cur = nxt; it = nx;
    }
    if (!(mask & 1)) return;
    { u32x4* z = (u32x4*)(ws + W_N + (size_t)2080 * 1024 * 2); const int n16 = 224 * 1024 * 2 / 16;
      for (int i = F.bid * NTHR + F.tid; i < n16; i += F.G * NTHR) z[i] = (u32x4){0u, 0u, 0u, 0u}; }
    __syncthreads();
    {
        LAS float* tile = (LAS float*)F.lds;
        LAS float* ctab = tile + 64 * 65;
        if (F.tid < 64) { ctab[F.tid] = cos_rev((float)F.tid / 64.0f); ctab[64 + F.tid] = sin_rev((float)F.tid / 64.0f); }
        for (int task = F.bid; task < 128; task += F.G) {
            const int kb = task >> 3, g = task & 7;
            __syncthreads();
            for (int i = F.tid; i < 4096; i += NTHR) { const int kk = i >> 6, cc = i & 63; tile[kk * 65 + cc] = w_in[(size_t)(kb * 64 + kk) * DIN + OFF_FN + g * 64 + cc]; }
            __syncthreads();
            const int kk = F.tid & 63, cq = F.tid >> 6;
#pragma unroll 1
            for (int j = 0; j < 8; ++j) { const int c = cq * 8 + j; float ac = 0.f, as = 0.f;
#pragma unroll 4
                for (int cp = 0; cp < 64; ++cp) { const float w = tile[kk * 65 + cp]; const int idx = (c * cp) & 63; ac += w * ctab[idx]; as += w * ctab[64 + idx]; }
                bf16_t* d = (bf16_t*)(ws + W_S);
                d[(size_t)(1536 + g * 64 + c) * 1024 + kb * 64 + kk] = (bf16_t)f2bf(ac);
                d[(size_t)(2048 + g * 64 + c) * 1024 + kb * 64 + kk] = (bf16_t)f2bf(as); }
        }
        __syncthreads();
    }
}
typedef float f32x16 __attribute__((ext_vector_type(16)));
__device__ __forceinline__ void prep_filters(Frame& F, int l) {
    LAS bf16_t* h2b = (LAS bf16_t*)F.lds;
    LAS bf16_t* w3t = h2b + 64 * 72;
    LAS float* zp = (LAS float*)w3t;
    LAS float* h1 = zp + 64 * 33;
    LAS float* w1s = h1 + 64 * 64;
    LAS float* w2s = w1s + 33 * 64;
    const float* w1 = F.in[I_HW1] + l * 33 * 64; const float* b1 = F.in[I_HB1] + l * 64; const float* fq = F.in[I_HFREQ] + l * 64;
    const float* w2 = F.in[I_HW2] + l * 64 * 64; const float* b2 = F.in[I_HB2] + l * 64; const float* w3 = F.in[I_HW3] + (size_t)l * 64 * 2048;
    for (int task4 = F.G - 1 - F.bid; task4 < 144; task4 += F.G) {
        const int task = task4 >> 2, qsel = task4 & 3;
        const int L = task < 32 ? LLAT : LCTX, t0 = (task < 32 ? task : task - 32) * 64;
        bf16_t* fil = (bf16_t*)(F.ws + (task < 32 ? WS_FILL : WS_FILC));
        float wcol[64];
#pragma unroll
        for (int k = 0; k < 64; ++k) wcol[k] = w3[(size_t)k * 2048 + qsel * 512 + F.tid];
        unsigned wpk[32];
#pragma unroll
        for (int k = 0; k < 32; ++k) wpk[k] = pk2(wcol[2 * k], wcol[2 * k + 1]);
        __syncthreads();
        for (int i = F.tid; i < 33 * 64; i += NTHR) w1s[i] = w1[i];
        for (int i = F.tid; i < 64 * 64; i += NTHR) w2s[i] = w2[i];
        for (int i = F.tid; i < 64 * 33; i += NTHR) { const int tt = i / 33, e = i % 33; const int ti = t0 + tt;
            float v;
            if (e == 0) v = (float)ti / (float)(L - 1);
            else { const int b = (e - 1) & 15; const float fr = 1e-4f + (15.0f - 1e-4f) * (float)b / 15.0f; const float rv = fr * ((float)ti / (float)L);
                   v = e <= 16 ? cos_rev(rv) : -sin_rev(rv); }
            zp[i] = v; }
        __syncthreads();
        for (int i = F.tid; i < 4096; i += NTHR) { const int tt = i >> 6, j = i & 63; float a = b1[j];
            for (int e = 0; e < 33; ++e) a += zp[tt * 33 + e] * w1s[e * 64 + j];
            h1[i] = sin_rad(fq[j] * a); }
        __syncthreads();
        for (int i = F.tid; i < 4096; i += NTHR) { const int tt = i >> 6, j = i & 63; float a = b2[j];
            for (int k = 0; k < 64; ++k) a += h1[tt * 64 + k] * w2s[k * 64 + j];
            h2b[tt * 72 + j] = (bf16_t)f2bf(sin_rad(fq[j] * a)); }
        __syncthreads();
#pragma unroll
        for (int m = 0; m < 8; ++m) *(LAS u32x4*)(w3t + F.tid * 72 + 8 * m) = (u32x4){wpk[4 * m], wpk[4 * m + 1], wpk[4 * m + 2], wpk[4 * m + 3]};
        __syncthreads();
        const int r = F.lane & 31, hh = F.lane >> 5;
        const float dmin = 4.605170185988091f / 1.5f, dmax = 4.605170185988091f / 0.3f;
#pragma unroll 1
        for (int tile = 0; tile < 4; ++tile) { const int ct = 2 * F.wave + (tile & 1), rt = tile >> 1;
            const LAS bf16_t* Am = h2b + (32 * rt + r) * 72 + 8 * hh; const LAS bf16_t* Bm = w3t + (32 * ct + r) * 72 + 8 * hh;
            f32x16 acc;
#pragma unroll
            for (int e = 0; e < 16; ++e) acc[e] = 0.f;
#pragma unroll
            for (int ks = 0; ks < 4; ++ks) acc = __builtin_amdgcn_mfma_f32_32x32x16_bf16(*(const LAS bf16x8*)(Am + 16 * ks), *(const LAS bf16x8*)(Bm + 16 * ks), acc, 0, 0, 0);
            const int c = 32 * ct + r, n = qsel * 512 + c; const float delta = dmin + (dmax - dmin) * (float)c / 511.0f;
            bf16_t* dst = fil + (size_t)n * L + t0;
#pragma unroll
            for (int g = 0; g < 4; ++g) { const int tt4 = 32 * rt + 8 * g + 4 * hh; float v[4];
#pragma unroll
                for (int e = 0; e < 4; ++e) { const float tl = (float)(t0 + tt4 + e) / (float)(L - 1); v[e] = acc[4 * g + e] * expf(-tl * delta); }
                *(u32x2*)(dst + tt4) = (u32x2){pk2(v[0], v[1]), pk2(v[2], v[3])}; } }
    }
    __syncthreads();
}
__device__ __forceinline__ void prep_mod(Frame& F) {
    LAS float* sc = (LAS float*)F.lds;
    LAS float* red = sc + 3 * 1024;
    __syncthreads();
    for (int i = F.tid; i < 3 * 1024; i += NTHR) { const int mi = i >> 10, k = i & 1023; const float v = mi == 0 ? F.in[I_CCTX][k] : F.in[I_C][(mi - 1) * 1024 + k]; sc[i] = v / (1.f + expf(-v)); }
    __syncthreads();
    float* mod = (float*)(F.ws + WS_MOD);
    for (int task = F.bid; task < 192; task += F.G) {
        const int l = task / 96, j = task % 96, n = j * 64 + F.lane;
        const float* w = F.in[I_WMOD] + (size_t)l * 1024 * 6144 + n;
        float a0 = 0.f, a1 = 0.f, a2 = 0.f;
        const int kb = F.wave * 128;
#pragma unroll 32
        for (int k = 0; k < 128; ++k) { const float wv = w[(size_t)(kb + k) * 6144]; a0 += sc[kb + k] * wv; a1 += sc[1024 + kb + k] * wv; a2 += sc[2048 + kb + k] * wv; }
        red[(F.wave * 3 + 0) * 64 + F.lane] = a0; red[(F.wave * 3 + 1) * 64 + F.lane] = a1; red[(F.wave * 3 + 2) * 64 + F.lane] = a2;
        __syncthreads();
        if (F.tid < 192) { const int mi = F.tid >> 6, ln = F.tid & 63; float s = F.in[I_BMOD][l * 6144 + j * 64 + ln];
            for (int w8 = 0; w8 < 8; ++w8) s += red[(w8 * 3 + mi) * 64 + ln];
            mod[((size_t)l * 3 + mi) * 6144 + j * 64 + ln] = s; }
        __syncthreads();
    }
}
__device__ __forceinline__ void prep_x_tables(Frame& F) {
    const int gt = F.bid * NTHR + F.tid, NG = F.G * NTHR;
    for (int i = gt; i < NTOK * DM / 4; i += NG) {
        const int row = i >> 8, c4 = (i & 255) * 4;
        f32x4 v;
        if (row < NCTX) v = *(const f32x4*)(F.in[I_XP] + (size_t)row * DM + c4);
        else { const int tt = row - NCTX, t = tt & 2047; v = *(const f32x4*)(F.in[I_XS] + (size_t)tt * DM + c4);
            const int seg = c4 >> 8; const float pos = (seg < 2) ? (float)(t >> 6) : (float)(t & 63);
#pragma unroll
            for (int u = 0; u < 4; ++u) { const int ii = (c4 + u) & 255; const float om = expf(-9.210340371976184f * (float)ii / 256.0f); const float a = pos * om;
                v[u] += (seg & 1) ? cos_rad(a) : sin_rad(a); } }
        *(f32x4*)(F.out + (size_t)row * DM + c4) = v;
    }
    for (int i = gt; i < 2048 * 4096 / 8; i += NG) { const int tp = i >> 9, k0 = (i & 511) * 8; unsigned w[4];
#pragma unroll
        for (int u = 0; u < 4; ++u) { float v[2];
#pragma unroll
            for (int e = 0; e < 2; ++e) { const int k = k0 + 2 * u + e; const int m = (tp * (k & 2047)) & 2047; const float x = (float)m / 2048.0f; v[e] = k < 2048 ? cos_rev(x) : -sin_rev(x); }
            w[u] = pk2(v[0], v[1]); }
        *(u32x4*)((bf16_t*)(F.ws + WS_TABL) + (size_t)tp * 4096 + k0) = (u32x4){w[0], w[1], w[2], w[3]}; }
    for (int i = gt; i < 256 * 512 / 8; i += NG) { const int tp = i >> 6, k0 = (i & 63) * 8; unsigned w[4];
#pragma unroll
        for (int u = 0; u < 4; ++u) { float v[2];
#pragma unroll
            for (int e = 0; e < 2; ++e) { const int k = k0 + 2 * u + e; const int m = (tp * (k & 255)) & 255; const float x = (float)m / 256.0f; v[e] = k < 256 ? cos_rev(x) : -sin_rev(x); }
            w[u] = pk2(v[0], v[1]); }
        *(u32x4*)((bf16_t*)(F.ws + WS_TABC) + (size_t)tp * 512 + k0) = (u32x4){w[0], w[1], w[2], w[3]}; }
}

__device__ __forceinline__ void phase_norm(Frame& F, const float* g, const float* modl, int sh_off, int sc_off, bf16_t* H) {
    const int gw = F.bid * NWAVES + F.wave, NGW = F.G * NWAVES;
    for (int row0 = gw; row0 < NTOK; row0 += 2 * NGW) {
        const int row1 = row0 + NGW < NTOK ? row0 + NGW : row0;
        const f32x4* xr0 = (const f32x4*)(F.out + (size_t)row0 * DM) + F.lane; const f32x4* xr1 = (const f32x4*)(F.out + (size_t)row1 * DM) + F.lane;
        f32x4 v0[4], v1[4]; float s0 = 0.f, s1 = 0.f;
#pragma unroll
        for (int j = 0; j < 4; ++j) { v0[j] = xr0[64 * j]; v1[j] = xr1[64 * j]; }
#pragma unroll
        for (int j = 0; j < 4; ++j) { s0 += (v0[j].x * v0[j].x + v0[j].y * v0[j].y) + (v0[j].z * v0[j].z + v0[j].w * v0[j].w); s1 += (v1[j].x * v1[j].x + v1[j].y * v1[j].y) + (v1[j].z * v1[j].z + v1[j].w * v1[j].w); }
        const float rstd0 = 1.0f / sqrtf(wave_sum(s0) * (1.f / DM) + EPS), rstd1 = 1.0f / sqrtf(wave_sum(s1) * (1.f / DM) + EPS);
        const float* mp0 = modl + (size_t)mod_idx(row0) * 6144; const float* mp1 = modl + (size_t)mod_idx(row1) * 6144;
        u32x2* o0 = (u32x2*)(H + (size_t)row0 * DM) + F.lane; u32x2* o1 = (u32x2*)(H + (size_t)row1 * DM) + F.lane;
#pragma unroll
        for (int j = 0; j < 4; ++j) { const int c = 4 * F.lane + 256 * j; const f32x4 gg = *(const f32x4*)(g + c);
            const f32x4 y0 = (v0[j] * rstd0) * gg * (*(const f32x4*)(mp0 + sc_off + c) + 1.0f) + *(const f32x4*)(mp0 + sh_off + c);
            const f32x4 y1 = (v1[j] * rstd1) * gg * (*(const f32x4*)(mp1 + sc_off + c) + 1.0f) + *(const f32x4*)(mp1 + sh_off + c);
            o0[64 * j] = (u32x2){pk2(y0.x, y0.y), pk2(y0.z, y0.w)};
            if (row1 != row0) o1[64 * j] = (u32x2){pk2(y1.x, y1.y), pk2(y1.z, y1.w)}; }
    }
}
__device__ __forceinline__ void phase_final(Frame& F) {
    const int gw = F.bid * NWAVES + F.wave, NGW = F.G * NWAVES; const float* g = F.in[I_NORMF];
    for (int row = gw; row < NTOK; row += NGW) {
        f32x4* xr = (f32x4*)(F.out + (size_t)row * DM) + F.lane;
        f32x4 v[4]; float s = 0.f;
#pragma unroll
        for (int j = 0; j < 4; ++j) { v[j] = xr[64 * j]; s += (v[j].x * v[j].x + v[j].y * v[j].y) + (v[j].z * v[j].z + v[j].w * v[j].w); }
        const float rstd = 1.0f / sqrtf(wave_sum(s) * (1.f / DM) + EPS);
#pragma unroll
        for (int j = 0; j < 4; ++j) { const int c = 4 * F.lane + 256 * j; const f32x4 gg = *(const f32x4*)(g + c); xr[64 * j] = (v[j] * rstd) * gg; }
    }
}

constexpr int HY_X1 = 0, HY_X2 = 8192, HY_ZP1 = 16384, HY_ZP2 = 47104, HY_TR = 77824, HY_TRCOPY = 8256, HY_TRORD = 16512, HY_RED = 110848;
static_assert(HY_RED + 16384 <= RING_BYTES, "hyena LDS map");
__device__ __forceinline__ void hyena_task(Frame& F, int l, int c, int grp) {
    int tid_ = F.tid; asm volatile("" : "+v"(tid_));
    const int tid = tid_, lane = tid & 63, wave = __builtin_amdgcn_readfirstlane(tid >> 6);
    const int L = grp == 0 ? LLAT : LCTX, nb = L >> 5, ZSEQ = (3 * L / 32) * 40, row0 = grp == 0 ? NCTX : (grp - 1) * 4096;
    LAS unsigned char* lds = F.lds;
    const bf16_t* hyt = (const bf16_t*)(F.ws + WS_HYT);
    const float* cw = F.in[I_CONVHY] + (size_t)l * 3 * 1536;
    const float* fil = (const float*)(F.ws + (grp == 0 ? WS_FILL : WS_FILC));
    const float* hb = F.in[I_HBIAS] + (size_t)l * 2 * 512;
    PROF_DECL;
    __syncthreads();
    if (grp == 0) PROF_COUNT(4); else PROF_COUNT(5);
    PROF_BEGIN(1);
    {
        const int p = 8 * tid, t = p & (L - 1), qs = p / L;
#pragma unroll
        for (int st = 0; st < 3; ++st) { const int ch = st * 512 + c; const bf16_t* src = hyt + (size_t)ch * NTOK + row0 + p;
            const u32x4 rv = *(const u32x4*)src; const float xm_ = bf2f(src[t > 0 ? -1 : 0]), xp_ = bf2f(src[t + 8 < L ? 8 : 0]); const float xm = t > 0 ? xm_ : 0.f, xp = t + 8 < L ? xp_ : 0.f;
            const float w0 = cw[ch], w1 = cw[1536 + ch], w2 = cw[2 * 1536 + ch];
            const float x[10] = {xm, bflo(rv.x), bfhi(rv.x), bflo(rv.y), bfhi(rv.y), bflo(rv.z), bfhi(rv.z), bflo(rv.w), bfhi(rv.w), xp};
            float o[8];
#pragma unroll
            for (int e = 0; e < 8; ++e) o[e] = w0 * x[e] + w1 * x[e + 1] + w2 * x[e + 2];
            const u32x4 pk = (u32x4){pk2(o[0], o[1]), pk2(o[2], o[3]), pk2(o[4], o[5]), pk2(o[6], o[7])};
            if (st < 2) *(LAS u32x4*)(lds + (st == 0 ? HY_X1 : HY_X2) + p * 2) = pk;
            else *(LAS u32x4*)(lds + HY_ZP1 + (qs * ZSEQ + (nb + (t >> 5)) * 40 + (t & 31)) * 2) = pk; }
        const int npad = (4096 / L) * 2 * nb;
        for (int i2 = tid; i2 < 2 * npad * 5; i2 += NTHR) { const int img = i2 / (npad * 5), rem = i2 % (npad * 5), pbk = rem / 5, piece = rem % 5;
            const int qs2 = pbk / (2 * nb), bb = pbk % (2 * nb), blk = bb < nb ? bb : bb + nb;
            *(LAS u32x4*)(lds + (img == 0 ? HY_ZP1 : HY_ZP2) + (qs2 * ZSEQ + blk * 40) * 2 + piece * 16) = (u32x4){0u, 0u, 0u, 0u}; }
    }
    PROF_END(1); PROF_BEGIN(2);
    { const bf16_t* fb16 = (const bf16_t*)fil; const int npc = L / 8;
      for (int i2 = tid; i2 < 4 * npc; i2 += NTHR) { const int jd = i2 / npc, k = i2 % npc, o = jd >> 1, dirn = jd & 1;
          const u32x4 v = *(const u32x4*)(fb16 + ((size_t)jd * 512 + c) * L + 8 * k);
          LAS unsigned char* c0 = lds + HY_TR + o * HY_TRORD; LAS unsigned char* c1 = c0 + HY_TRCOPY;
          const unsigned e0 = v.x & 0xffffu, e1 = v.x >> 16, e2 = v.y & 0xffffu, e3 = v.y >> 16, e4 = v.z & 0xffffu, e5 = v.z >> 16, e6 = v.w & 0xffffu, e7 = v.w >> 16;
          if (dirn == 0) {
              const int p1 = L - 8 * k - 8;
              *(LAS u32x4*)(c1 + p1 * 2) = (u32x4){e7 | (e6 << 16), e5 | (e4 << 16), e3 | (e2 << 16), e1 | (e0 << 16)};
              const int p0 = L - 8 * k - 7;
              *(LAS unsigned short*)(c0 + p0 * 2) = (unsigned short)e7;
              *(LAS unsigned*)(c0 + (p0 + 1) * 2) = e6 | (e5 << 16); *(LAS unsigned*)(c0 + (p0 + 3) * 2) = e4 | (e3 << 16); *(LAS unsigned*)(c0 + (p0 + 5) * 2) = e2 | (e1 << 16);
              *(LAS unsigned short*)(c0 + (p0 + 7) * 2) = (unsigned short)e0;
          } else {
              const int q0 = L + 8 * k;
              if (k > 0) *(LAS u32x4*)(c0 + q0 * 2) = v;
              else { *(LAS unsigned short*)(c0 + (q0 + 1) * 2) = (unsigned short)e1; *(LAS unsigned*)(c0 + (q0 + 2) * 2) = v.y; *(LAS unsigned*)(c0 + (q0 + 4) * 2) = v.z; *(LAS unsigned*)(c0 + (q0 + 6) * 2) = v.w; }
              const int q1 = q0 - 1;
              if (k > 0) *(LAS unsigned short*)(c1 + q1 * 2) = (unsigned short)e0;
              *(LAS unsigned*)(c1 + (q1 + 1) * 2) = e1 | (e2 << 16); *(LAS unsigned*)(c1 + (q1 + 3) * 2) = e3 | (e4 << 16); *(LAS unsigned*)(c1 + (q1 + 5) * 2) = e5 | (e6 << 16);
              *(LAS unsigned short*)(c1 + (q1 + 7) * 2) = (unsigned short)e7;
          } } }
    __syncthreads();
    PROF_END(2); PROF_BEGIN(3);
    const int tile = wave & 3, half = wave >> 2, r = lane & 31, hh = lane >> 5, colg = 32 * tile + r;
    int qs, ib, imin, imax;
    if (grp == 0) { qs = colg >> 6; ib = colg & 63; imin = 32 * (tile & 1); imax = imin + 31; } else { qs = colg >> 3; ib = colg & 7; imin = 0; imax = 7; }
    const int dlo = imin - nb + 1, cnt = imax - imin + nb, mid = dlo + (cnt >> 1);
    const int d0 = half == 0 ? dlo : mid, d1 = half == 0 ? mid : dlo + cnt;
    const int par = r & 1;
    const int aoff = par * HY_TRCOPY + (L + 8 * hh - r - 32 * d0 - par) * 2;
    const int boff = (qs * ZSEQ + (nb + ib - d0) * 40 + 8 * hh) * 2;
    const float bias0 = hb[c] + bf2f(((const bf16_t*)fil)[((size_t)1 * 512 + c) * L]), bias1 = hb[512 + c] + bf2f(((const bf16_t*)fil)[((size_t)3 * 512 + c) * L]);
    bf16_t* yb = (bf16_t*)(F.ws + WS_YB);
#pragma unroll 1
    for (int o = 0; o < 2; ++o) {
        if (grp == 0) PROF_BEGIN(6);
        f32x16 acc;
#pragma unroll
        for (int e = 0; e < 16; ++e) acc[e] = 0.f;
        const LAS unsigned char* Ap = lds + HY_TR + o * HY_TRORD + aoff; const LAS unsigned char* Bp = lds + (o == 0 ? HY_ZP1 : HY_ZP2) + boff;
        f32x16 acc2;
#pragma unroll
        for (int e = 0; e < 16; ++e) acc2[e] = 0.f;
        u32x4 xa[4][2], ya[4][2]; bf16x8 xb[4][2], yb2[4][2];
#define HY_LD4(A, B) do { _Pragma("unroll") for (int u_ = 0; u_ < 4; ++u_) { const LAS unsigned* ap_ = (const LAS unsigned*)(Ap - 64 * u_); \
            A[u_][0] = (u32x4){ap_[0], ap_[1], ap_[2], ap_[3]}; A[u_][1] = (u32x4){ap_[8], ap_[9], ap_[10], ap_[11]}; \
            B[u_][0] = *(const LAS bf16x8*)(Bp - 80 * u_); B[u_][1] = *(const LAS bf16x8*)(Bp - 80 * u_ + 32); } Ap -= 256; Bp -= 320; } while (0)
#define HY_MM4(A, B) do { _Pragma("unroll") for (int u_ = 0; u_ < 4; ++u_) { acc = __builtin_amdgcn_mfma_f32_32x32x16_bf16(__builtin_bit_cast(bf16x8, A[u_][0]), B[u_][0], acc, 0, 0, 0); \
            acc2 = __builtin_amdgcn_mfma_f32_32x32x16_bf16(__builtin_bit_cast(bf16x8, A[u_][1]), B[u_][1], acc2, 0, 0, 0); } } while (0)
        const int ng = (d1 - d0) >> 2, nrem = (d1 - d0) & 3;
        HY_LD4(xa, xb);
#pragma unroll 1
        for (int g = 0;;) {
            __builtin_amdgcn_sched_barrier(0); if (g + 1 < ng) HY_LD4(ya, yb2); __builtin_amdgcn_sched_barrier(0); HY_MM4(xa, xb);
            if (++g >= ng) break;
            __builtin_amdgcn_sched_barrier(0); if (g + 1 < ng) HY_LD4(xa, xb); __builtin_amdgcn_sched_barrier(0); HY_MM4(ya, yb2);
            if (++g >= ng) break;
        }
#pragma unroll 1
        for (int rr = 0; rr < nrem; ++rr) { const LAS unsigned* ap_ = (const LAS unsigned*)Ap;
            const u32x4 q0 = (u32x4){ap_[0], ap_[1], ap_[2], ap_[3]}, q1 = (u32x4){ap_[8], ap_[9], ap_[10], ap_[11]};
            acc = __builtin_amdgcn_mfma_f32_32x32x16_bf16(__builtin_bit_cast(bf16x8, q0), *(const LAS bf16x8*)Bp, acc, 0, 0, 0);
            acc2 = __builtin_amdgcn_mfma_f32_32x32x16_bf16(__builtin_bit_cast(bf16x8, q1), *(const LAS bf16x8*)(Bp + 32), acc2, 0, 0, 0);
            Ap -= 64; Bp -= 80; }
#undef HY_LD4
#undef HY_MM4
#pragma unroll
        for (int e = 0; e < 16; ++e) acc[e] += acc2[e];
        if (grp == 0) { PROF_END(6); PROF_BEGIN(7); }
        LAS float* red = (LAS float*)(lds + HY_RED);
        if (half == 1) {
#pragma unroll
            for (int e = 0; e < 16; ++e) red[(tile * 16 + e) * 64 + lane] = acc[e]; }
        __syncthreads();
        if (half == 0) {
#pragma unroll
            for (int e = 0; e < 16; ++e) acc[e] += red[(tile * 16 + e) * 64 + lane];
#pragma unroll
            for (int g = 0; g < 4; ++g) { const int a4 = 8 * g + 4 * hh, p = qs * L + 32 * ib + a4, zo = (qs * ZSEQ + (nb + ib) * 40 + a4) * 2;
                const u32x2 gx = *(const LAS u32x2*)(lds + (o == 0 ? HY_X1 : HY_X2) + p * 2), zz = *(const LAS u32x2*)(lds + (o == 0 ? HY_ZP1 : HY_ZP2) + zo);
                const float gv[4] = {bflo(gx.x), bfhi(gx.x), bflo(gx.y), bfhi(gx.y)}, zv[4] = {bflo(zz.x), bfhi(zz.x), bflo(zz.y), bfhi(zz.y)};
                float y[4];
#pragma unroll
                for (int e = 0; e < 4; ++e) y[e] = gv[e] * (acc[4 * g + e] + (o == 0 ? bias0 : bias1) * zv[e]);
                if (o == 0) *(LAS u32x2*)(lds + HY_ZP2 + zo) = (u32x2){pk2(y[0], y[1]), pk2(y[2], y[3])};
                else {
#pragma unroll
                    for (int e = 0; e < 4; ++e) yb[(size_t)(row0 + p + e) * 512 + c] = (bf16_t)f2bf(y[e]); } }
        }
        __syncthreads();
        if (grp == 0) PROF_END(7);
    }
    PROF_END(3); PROF_FLUSH();
}

__device__ __forceinline__ int kpos32(int k) { return (k & ~31) | (((k >> 2) & 3) << 3) | (((k >> 4) & 1) << 2) | (k & 3); }
__device__ __forceinline__ size_t chunk_lin(int s, int n) { return (size_t)(s < 32 ? s * 4 + n : 128 + (s - 32) * 32 + n); }
constexpr int D1_GRP_BYTES = 61440;
__device__ __forceinline__ void d1_task(Frame& F, int l, int s, int h, int n) {
    int tid_ = F.tid; asm volatile("" : "+v"(tid_));
    const int tid = tid_, lane = tid & 63, wave = __builtin_amdgcn_readfirstlane(tid >> 6), lw = wave & 3, lt = tid & 255;
    LAS unsigned char* base = F.lds + (wave >> 2) * D1_GRP_BYTES;
    LAS bf16_t* qb = (LAS bf16_t*)base;
    LAS bf16_t* kb = qb + 64 * 72;
    LAS bf16_t* vb = kb + 64 * 72;
    LAS float* ATf = (LAS float*)(vb + 64 * 72);
    LAS float* ATb = ATf + 4096;
    LAS float* sm = ATb + 4096;
    LAS float* betaf = sm, *betab = sm + 64, *gcf = sm + 128, *gcb = sm + 192;
    const int L = seq_len(s), row0 = seq_start(s) + n * 64, tpos0 = n * 64;
    const bf16_t* qkv = (const bf16_t*)(F.ws + WS_QKV);
    const float* cw = F.in[I_CONVQKV] + (size_t)l * 3 * QKVW;
    const size_t cl = chunk_lin(s, n);
    PROF_DECL; PROF_BEGIN(40);
    float braw = 0.f, araw = 0.f, al = 0.f, dtb = 0.f;
    if (lw < 2) { const float* ba = (const float*)(F.ws + WS_BA) + (size_t)(row0 + lane) * 32; braw = ba[lw * 8 + h]; araw = ba[16 + lw * 8 + h];
        al = F.in[I_ALOG][l * 16 + lw * 8 + h]; dtb = F.in[I_DTB][l * 16 + lw * 8 + h]; }
    __syncthreads();
    {
        const int sub = lt & 7;
        u32x4 rr[2][3][3]; f32x4 ww[3][3][2];
#pragma unroll
        for (int part = 0; part < 3; ++part) { const int ch = part * 512 + h * 64 + sub * 8;
#pragma unroll
            for (int i = 0; i < 3; ++i) { ww[part][i][0] = *(const f32x4*)(cw + i * QKVW + ch); ww[part][i][1] = *(const f32x4*)(cw + i * QKVW + ch + 4); }
#pragma unroll
            for (int th = 0; th < 2; ++th) { const int t = (lt >> 3) + 32 * th, tp = tpos0 + t; const bf16_t* src = qkv + (size_t)(row0 + t) * QKVW + ch;
                rr[th][part][1] = *(const u32x4*)src; rr[th][part][0] = *(const u32x4*)(tp > 0 ? src - QKVW : src); rr[th][part][2] = *(const u32x4*)(tp < L - 1 ? src + QKVW : src); } }
#pragma unroll
        for (int th2 = 0; th2 < 2 * NREP(14); ++th2) { const int th = th2 & 1;
            const int t = (lt >> 3) + 32 * th, tp = tpos0 + t;
            const float m0 = tp > 0 ? 1.f : 0.f, m2 = tp < L - 1 ? 1.f : 0.f;
#pragma unroll
            for (int part = 0; part < 3; ++part) {
                const u32x4 r0 = rr[th][part][0], r1 = rr[th][part][1], r2 = rr[th][part][2];
                const unsigned a0[4] = {r0.x, r0.y, r0.z, r0.w}, a1[4] = {r1.x, r1.y, r1.z, r1.w}, a2[4] = {r2.x, r2.y, r2.z, r2.w};
                float v[8]; float ss = 0.f;
#pragma unroll
                for (int e = 0; e < 8; ++e) { const float x0 = (e & 1) ? bfhi(a0[e >> 1]) : bflo(a0[e >> 1]), x1 = (e & 1) ? bfhi(a1[e >> 1]) : bflo(a1[e >> 1]), x2 = (e & 1) ? bfhi(a2[e >> 1]) : bflo(a2[e >> 1]);
                    float a = x1 * ww[part][1][e >> 2][e & 3] + m0 * x0 * ww[part][0][e >> 2][e & 3] + m2 * x2 * ww[part][2][e >> 2][e & 3]; a = a / (1.f + __expf(-a)); v[e] = a; ss += a * a; }
                if (part < 2) { ss = sum8(ss);
                    const float rs = (part == 0 ? 0.125f : 1.0f) / sqrtf(ss + EPS);
#pragma unroll
                    for (int e = 0; e < 8; ++e) v[e] *= rs; }
                const u32x4 pk = (u32x4){pk2(v[0], v[1]), pk2(v[2], v[3]), pk2(v[4], v[5]), pk2(v[6], v[7])};
                *(LAS u32x4*)((part == 0 ? qb : (part == 1 ? kb : vb)) + t * 72 + sub * 8) = pk;
                if (part == 0) { bf16_t* qo = (bf16_t*)(F.ws + WS_QN) + (size_t)(row0 + t) * 512 + h * 64;
                    *(u32x2*)(qo + kpos32(sub * 8)) = (u32x2){pk.x, pk.y}; *(u32x2*)(qo + kpos32(sub * 8 + 4)) = (u32x2){pk.z, pk.w}; }
            }
        }
    }
    if (lw < 2) { const int dir = lw, t = lane;
        const float xx = araw + dtb; const float sp = xx > 20.f ? xx : log1pf(expf(xx));
        float a = -expf(al) * sp;
#pragma unroll
        for (int o = 1; o < 64; o <<= 1) { const float y = lane_read(a, dir == 0 ? ((lane - o) & 63) : ((lane + o) & 63)); if (dir == 0 ? (lane >= o) : (lane + o < 64)) a += y; }
        (dir == 0 ? betaf : betab)[t] = 1.f / (1.f + expf(-braw)); (dir == 0 ? gcf : gcb)[t] = a;
        ((float*)(F.ws + WS_GC))[((size_t)(dir * 8 + h) * 192 + cl) * 64 + t] = a; }
    __syncthreads();
    PROF_END(40); PROF_BEGIN(41);
    const size_t offF = ((size_t)(0 * 8 + h) * 192 + cl) * 4096, offB = ((size_t)(1 * 8 + h) * 192 + cl) * 4096;
    {
        const int ti = lw >> 1, tj = lw & 1, r = lane & 31, hh = lane >> 5, col = 32 * tj + r;
#pragma unroll 1
        for (int prod2 = 0; prod2 < 2 * NREP(15); ++prod2) { const int prod = prod2 & 1;
            const LAS bf16_t* Am = kb + (32 * ti + r) * 72 + 8 * hh; const LAS bf16_t* Bm = (prod == 0 ? kb : qb) + (32 * tj + r) * 72 + 8 * hh;
            f32x16 acc;
#pragma unroll
            for (int e = 0; e < 16; ++e) acc[e] = 0.f;
#pragma unroll
            for (int ks = 0; ks < 4; ++ks) acc = __builtin_amdgcn_mfma_f32_32x32x16_bf16(*(const LAS bf16x8*)(Am + 16 * ks), *(const LAS bf16x8*)(Bm + 16 * ks), acc, 0, 0, 0);
            if (prod == 0) {
                const int j = col; const float gfj = gcf[j], gbj = gcb[j];
#pragma unroll
                for (int g = 0; g < 4; ++g) { const int i4 = 32 * ti + 8 * g + 4 * hh; float ff[4], fb[4];
#pragma unroll
                    for (int e = 0; e < 4; ++e) { const int i = i4 + e; const float v = acc[4 * g + e];
                        ff[e] = i > j ? betaf[i] * v * __expf(gcf[i] - gfj) : 0.f; fb[e] = i < j ? betab[i] * v * __expf(gcb[i] - gbj) : 0.f; }
                    *(LAS f32x4*)(ATf + j * 64 + i4) = (f32x4){ff[0], ff[1], ff[2], ff[3]};
                    *(LAS f32x4*)(ATb + (63 - j) * 64 + (60 - i4)) = (f32x4){fb[3], fb[2], fb[1], fb[0]}; }
            } else {
                const int i = col; const float gfi = gcf[i], gbi = gcb[i]; bf16_t* QKo = (bf16_t*)(F.ws + WS_QK);
#pragma unroll
                for (int g = 0; g < 4; ++g) { const int j4 = 32 * ti + 8 * g + 4 * hh; float ff[4], fb[4];
#pragma unroll
                    for (int e = 0; e < 4; ++e) { const int j = j4 + e; const float v = acc[4 * g + e];
                        ff[e] = i >= j ? v * __expf(gfi - gcf[j]) : 0.f; fb[e] = i <= j ? v * __expf(gbi - gcb[j]) : 0.f; }
                    const int pj = kpos32(j4);
                    *(u32x2*)(QKo + offF + (size_t)i * 64 + pj) = (u32x2){pk2(ff[0], ff[1]), pk2(ff[2], ff[3])};
                    *(u32x2*)(QKo + offB + (size_t)i * 64 + pj) = (u32x2){pk2(fb[0], fb[1]), pk2(fb[2], fb[3])}; }
            }
        }
    }
    { const int d = lt >> 2, cg = lt & 3; bf16_t* kt = (bf16_t*)(F.ws + WS_KN) + ((size_t)h * 192 + cl) * 4096 + d * 64;
#pragma unroll
      for (int g = 0; g < 4; ++g) { const int c = 16 * cg + 4 * g;
          const unsigned w0 = (unsigned)kb[(c + 0) * 72 + d] | ((unsigned)kb[(c + 1) * 72 + d] << 16), w1 = (unsigned)kb[(c + 2) * 72 + d] | ((unsigned)kb[(c + 3) * 72 + d] << 16);
          *(u32x2*)(kt + kpos32(c)) = (u32x2){w0, w1}; } }
    __syncthreads();
    PROF_END(41); PROF_BEGIN(42);
#pragma unroll 1
    for (int srep = 0; srep < NREP(16); ++srep) {
        const int c = lane;
        int dmask = (lw >> 1) * 63, isw = lw & 1;
        asm volatile("" : "+v"(dmask), "+v"(isw));
        const bool bdir = dmask != 0, bw = isw != 0;
        int vzero; asm volatile("v_mov_b32 %0, 0" : "=v"(vzero));
        const LAS float* AT = ATf + (bdir ? 4096 : 0) + vzero;
        const LAS float* bet = betaf + (bdir ? 64 : 0); const LAS float* gcc = gcf + (bdir ? 64 : 0);
        const LAS bf16_t* srcm = (bw ? kb : vb) + c;
        float x[64];
#pragma unroll
        for (int p = 0; p < 64; ++p) { const int t = p ^ dmask; const float be = bet[t]; const float eg = __expf(gcc[t]);
            x[p] = bf2f(srcm[t * 72]) * (bw ? be * eg : be);
            if ((p & 7) == 7) __builtin_amdgcn_sched_barrier(0); }
#define SOLVE_LD(R, j) do { _Pragma("unroll") for (int i4_ = ((j) + 1) & ~3; i4_ < 64; i4_ += 4) R[i4_ >> 2] = *(const LAS f32x4*)(AT + (j) * 64 + i4_); } while (0)
#define SOLVE_FM(R, j) do { const float xj_ = x[j]; _Pragma("unroll") for (int i_ = (j) + 1; i_ < 64; ++i_) x[i_] -= R[i_ >> 2][i_ & 3] * xj_; } while (0)
        {
#pragma unroll
          for (int j = 0; j < 32; ++j) { const float xj = x[j]; f32x4 rh[8];
              __builtin_amdgcn_sched_barrier(0);
#pragma unroll
              for (int i4 = (j + 1) & ~3; i4 < 32; i4 += 4) rh[i4 >> 2] = *(const LAS f32x4*)(AT + j * 64 + i4);
#pragma unroll
              for (int i = j + 1; i < 32; ++i) x[i] -= rh[i >> 2][i & 3] * xj;
              __builtin_amdgcn_sched_barrier(0);
#pragma unroll
              for (int i4 = 32; i4 < 64; i4 += 4) rh[(i4 - 32) >> 2] = *(const LAS f32x4*)(AT + j * 64 + i4);
#pragma unroll
              for (int i = 32; i < 64; ++i) x[i] -= rh[(i - 32) >> 2][i & 3] * xj; } }
        { f32x4 ra[16], rb[16];
          SOLVE_LD(ra, 32);
#pragma unroll
          for (int j = 32; j < 56; j += 2) {
            __builtin_amdgcn_sched_barrier(0); SOLVE_LD(rb, j + 1); __builtin_amdgcn_sched_barrier(0); SOLVE_FM(ra, j);
            __builtin_amdgcn_sched_barrier(0); if (j + 2 < 56) SOLVE_LD(ra, j + 2); __builtin_amdgcn_sched_barrier(0); SOLVE_FM(rb, j + 1); } }
        { f32x4 rt[7][2];
#pragma unroll
          for (int j = 56; j < 63; ++j)
#pragma unroll
              for (int i4 = (j + 1) & ~3; i4 < 64; i4 += 4) rt[j - 56][(i4 - 56) >> 2] = *(const LAS f32x4*)(AT + j * 64 + i4);
          __builtin_amdgcn_sched_barrier(0);
#pragma unroll
          for (int j = 56; j < 63; ++j) { const float xj = x[j];
#pragma unroll
              for (int i = j + 1; i < 64; ++i) x[i] -= rt[j - 56][(i - 56) >> 2][i & 3] * xj; } }
#undef SOLVE_LD
#undef SOLVE_FM
        __builtin_amdgcn_sched_barrier(0);
        int dmask2 = dmask; asm volatile("" : "+v"(dmask2), "+v"(x[63]));
        const size_t offD = bdir ? offB : offF;
        if (!bw) {
            bf16_t* dst = (bf16_t*)(F.ws + WS_U) + offD + (size_t)c * 64;
#pragma unroll
            for (int g = 0; g < 8; ++g) { unsigned w[4];
#pragma unroll
                for (int k = 0; k < 4; ++k) { const float a = x[8 * g + 2 * k], b = x[8 * g + 2 * k + 1]; w[k] = pk2(bdir ? b : a, bdir ? a : b); }
                const u32x4 o = bdir ? (u32x4){w[3], w[2], w[1], w[0]} : (u32x4){w[0], w[1], w[2], w[3]};
                *(u32x4*)(dst + (bdir ? 56 - 8 * g : 8 * g)) = o; }
        } else {
            bf16_t* dst = (bf16_t*)(F.ws + WS_WW) + offD + kpos32(c);
#pragma unroll
            for (int p = 0; p < 64; ++p) dst[(p ^ dmask2) * 64] = (bf16_t)f2bf(-x[p]);
        }
    }
    PROF_END(42); PROF_FLUSH();
}

__device__ __forceinline__ bf16x8 pack8(const f32x4 a, const f32x4 b) {
    u32x4 w; w.x = pg8::cvt_pk_bf16(a[0], a[1]); w.y = pg8::cvt_pk_bf16(a[2], a[3]); w.z = pg8::cvt_pk_bf16(b[0], b[1]); w.w = pg8::cvt_pk_bf16(b[2], b[3]);
    return __builtin_bit_cast(bf16x8, w);
}
__device__ __forceinline__ void d2_wave_task(Frame& F, int l, int s, int h, int dir, int sl) {
    PROF_DECL; PROF_BEGIN(50);
    int lane_ = F.lane; asm volatile("" : "+v"(lane_));
    const int lane = lane_, r16 = lane & 15, q = lane >> 4, e0 = sl * 16;
    const int nch = s < 32 ? 4 : 32;
    LAS float* lo = (LAS float*)(F.lds + F.wave * 4608);
    f32x4 S[4];
#pragma unroll
    for (int t = 0; t < 4; ++t)
#pragma unroll
        for (int rg = 0; rg < 4; ++rg) { const int d = 16 * t + 4 * q + rg;
            S[t][rg] = s >= 32 ? F.in[I_STATE][((((size_t)(s - 32) * 2 + l) * 2 + dir) * 8 + h) * 4096 + d * 64 + e0 + r16] : 0.f; }
    const bf16_t* Wg = (const bf16_t*)(F.ws + WS_WW); const bf16_t* QKg = (const bf16_t*)(F.ws + WS_QK); const bf16_t* Ug = (const bf16_t*)(F.ws + WS_U);
    const bf16_t* QNg = (const bf16_t*)(F.ws + WS_QN); const bf16_t* KTg = (const bf16_t*)(F.ws + WS_KN); const float* GCg = (const float*)(F.ws + WS_GC);
    bf16_t* Og = (bf16_t*)(F.ws + (dir == 0 ? WS_OF : WS_OB));
    const int fo = r16 * 64 + 8 * q;
#pragma unroll 1
    for (int step = 0; step < nch; ++step) {
        const int n = dir == 0 ? step : nch - 1 - step; const size_t cl = chunk_lin(s, n);
        const size_t off = ((size_t)(dir * 8 + h) * 192 + cl) * 4096; const int tok0 = seq_start(s) + n * 64;
        const bf16_t* Wp = Wg + off + fo; const bf16_t* QKp = QKg + off + fo; const bf16_t* KTp = KTg + ((size_t)h * 192 + cl) * 4096 + fo;
        const bf16_t* Qp = QNg + (size_t)(tok0 + r16) * 512 + h * 64 + 8 * q; const bf16_t* Up = Ug + off + (size_t)(e0 + r16) * 64 + 4 * q;
        const float* gcp = GCg + ((size_t)(dir * 8 + h) * 192 + cl) * 64;
        bf16x8 Wf[4][2], Qf[4][2], QKf[4][2], KTf[4][2]; u32x2 Uv[4]; f32x4 gcv[4];
#pragma unroll
        for (int t = 0; t < 4; ++t) { Uv[t] = *(const u32x2*)(Up + 16 * t); gcv[t] = *(const f32x4*)(gcp + 16 * t + 4 * q);
#pragma unroll
            for (int ks = 0; ks < 2; ++ks) { Wf[t][ks] = *(const bf16x8*)(Wp + t * 1024 + 32 * ks); Qf[t][ks] = *(const bf16x8*)(Qp + (size_t)t * 16 * 512 + 32 * ks);
                QKf[t][ks] = *(const bf16x8*)(QKp + t * 1024 + 32 * ks); KTf[t][ks] = *(const bf16x8*)(KTp + t * 1024 + 32 * ks); } }
        const float gl = gcp[dir == 0 ? 63 : 0];
        bf16x8 Sb[2] = {pack8(S[0], S[1]), pack8(S[2], S[3])};
        f32x4 VN[4], O[4];
#pragma unroll
        for (int t = 0; t < 4; ++t) { VN[t] = (f32x4){bflo(Uv[t].x), bfhi(Uv[t].x), bflo(Uv[t].y), bfhi(Uv[t].y)}; O[t] = (f32x4){0.f, 0.f, 0.f, 0.f};
#pragma unroll
            for (int ks = 0; ks < 2; ++ks) { VN[t] = __builtin_amdgcn_mfma_f32_16x16x32_bf16(Wf[t][ks], Sb[ks], VN[t], 0, 0, 0); O[t] = __builtin_amdgcn_mfma_f32_16x16x32_bf16(Qf[t][ks], Sb[ks], O[t], 0, 0, 0); } }
        f32x4 VS[4];
#pragma unroll
        for (int t = 0; t < 4; ++t)
#pragma unroll
            for (int rg = 0; rg < 4; ++rg) { O[t][rg] *= __expf(gcv[t][rg]); VS[t][rg] = VN[t][rg] * __expf(gl - gcv[t][rg]); }
        const bf16x8 VNb[2] = {pack8(VN[0], VN[1]), pack8(VN[2], VN[3])}, VSb[2] = {pack8(VS[0], VS[1]), pack8(VS[2], VS[3])};
        const float egl = __expf(gl);
#pragma unroll
        for (int t = 0; t < 4; ++t) { S[t] = S[t] * egl;
#pragma unroll
            for (int ks = 0; ks < 2; ++ks) { O[t] = __builtin_amdgcn_mfma_f32_16x16x32_bf16(QKf[t][ks], VNb[ks], O[t], 0, 0, 0); S[t] = __builtin_amdgcn_mfma_f32_16x16x32_bf16(KTf[t][ks], VSb[ks], S[t], 0, 0, 0); } }
#pragma unroll
        for (int t = 0; t < 4; ++t)
#pragma unroll
            for (int rg = 0; rg < 4; ++rg) lo[(16 * t + 4 * q + rg) * 17 + r16] = O[t][rg];
        asm volatile("s_waitcnt lgkmcnt(0)" ::: "memory");
        { float ov[16];
#pragma unroll
          for (int e = 0; e < 16; ++e) ov[e] = lo[lane * 17 + e];
          bf16_t* op = Og + (size_t)(tok0 + lane) * 512 + h * 64 + e0;
          *(u32x4*)op = (u32x4){pk2(ov[0], ov[1]), pk2(ov[2], ov[3]), pk2(ov[4], ov[5]), pk2(ov[6], ov[7])};
          *(u32x4*)(op + 8) = (u32x4){pk2(ov[8], ov[9]), pk2(ov[10], ov[11]), pk2(ov[12], ov[13]), pk2(ov[14], ov[15])}; }
        asm volatile("s_waitcnt lgkmcnt(0)" ::: "memory");
    }
    if (s < 32) { float* so = F.out + (size_t)NTOK * DM + ((((size_t)s * 2 + l) * 2 + dir) * 8 + h) * 4096;
#pragma unroll
        for (int t = 0; t < 4; ++t)
#pragma unroll
            for (int rg = 0; rg < 4; ++rg) so[(16 * t + 4 * q + rg) * 64 + e0 + r16] = S[t][rg]; }
    PROF_END(50); PROF_FLUSH();
}

__device__ __forceinline__ void phase_combine(Frame& F, int l) {
    const bf16_t* of = (const bf16_t*)(F.ws + WS_OF); const bf16_t* ob = (const bf16_t*)(F.ws + WS_OB); const bf16_t* z = (const bf16_t*)(F.ws + WS_Z);
    bf16_t* ya = (bf16_t*)(F.ws + WS_YA); const float* na = F.in[I_NORMA] + l * 64;
    for (int i = F.bid * NTHR + F.tid; i < NTOK * 64; i += F.G * NTHR) {
        const size_t off = (size_t)i * 8; const int e0 = (i & 7) * 8;
        const u32x4 a = *(const u32x4*)(of + off), b = *(const u32x4*)(ob + off), zz = *(const u32x4*)(z + off);
        float o[8]; const unsigned aw[4] = {a.x, a.y, a.z, a.w}, bw[4] = {b.x, b.y, b.z, b.w}, zw[4] = {zz.x, zz.y, zz.z, zz.w};
        float ss = 0.f;
#pragma unroll
        for (int j = 0; j < 4; ++j) { o[2 * j] = bflo(aw[j]) + bflo(bw[j]); o[2 * j + 1] = bfhi(aw[j]) + bfhi(bw[j]); ss += o[2 * j] * o[2 * j] + o[2 * j + 1] * o[2 * j + 1]; }
        ss += __shfl_xor(ss, 1); ss += __shfl_xor(ss, 2); ss += __shfl_xor(ss, 4);
        const float rs = 1.0f / sqrtf(ss * (1.f / 64.f) + EPS);
        unsigned w[4];
#pragma unroll
        for (int j = 0; j < 4; ++j) { const float z0 = bflo(zw[j]), z1 = bfhi(zw[j]);
            w[j] = pk2(o[2 * j] * rs * na[e0 + 2 * j] * siluf_(z0), o[2 * j + 1] * rs * na[e0 + 2 * j + 1] * siluf_(z1)); }
        *(u32x4*)(ya + off) = (u32x4){w[0], w[1], w[2], w[3]};
    }
}

constexpr int N_PHASES = 26;
__global__ void __launch_bounds__(NTHR, 2) mk_fwd(Args args) {
    extern __shared__ __attribute__((aligned(16))) unsigned char lds_raw[];
    Frame F;
    F.lds = (LAS unsigned char*)lds_raw; F.in = args.in; F.out = args.out; F.ws = args.ws; F.ctl = (unsigned*)(args.ws + WS_CTL);
    F.tid = threadIdx.x; F.lane = F.tid & 63; F.wave = __builtin_amdgcn_readfirstlane(F.tid >> 6); F.G = gridDim.x; F.bid = blockIdx.x;
    for (int u = F.tid; u < (LDS_BYTES - LDSCTL_OFF) / 4; u += NTHR) ((LAS unsigned*)(F.lds + LDSCTL_OFF))[u] = 0u;
    __syncthreads();
    XcdBarrier bar; bar.bar = F.ctl + CW_BAR; bar.x = 0; bar.st = nullptr;
    if (!MK_PER_PHASE) bar = xcd_barrier_post(F.ctl + CW_BAR, (volatile LAS unsigned*)(F.lds + MISC_OFF) + 8);
    const int lo = args.ph_lo, hi = args.ph_hi;
    PROF_DECL;
    using namespace pg8;
#define IN(k) (lo <= (k) && (k) < hi)
#define SEAM(k) do { if (IN(k) && IN((k) + 1)) { if (!MK_PER_PHASE) xcd_barrier(bar); } } while (0)
#define PHASE_FRAME() Frame P = F; P.ws = opq(P.ws); P.out = opq(P.out); P.ctl = opq(P.ctl); asm volatile("" : "+v"(P.tid)); P.lane = P.tid & 63; P.wave = __builtin_amdgcn_readfirstlane(P.tid >> 6); \
    unsigned char* ws = P.ws; LAS unsigned char* ring = P.lds; (void)ws; (void)ring

    PROF_BEGIN(100);
    if (IN(0)) for (int rep = 0; rep < NREP(13); ++rep) { PHASE_FRAME(); PROF_BEGIN(120); prep_x_tables(P); __syncthreads(); PROF_END(120); PROF_BEGIN(121); prep_mod(P); __syncthreads(); PROF_END(121); PROF_BEGIN(122); prep_weights(P, 0, 63); __syncthreads(); PROF_END(122); PROF_BEGIN(124); prep_filters(P, 0); __syncthreads(); PROF_END(124); }
    SEAM(0);
    PROF_END(100);
#pragma unroll 1
    for (int l = 0; l < 2; ++l) {
        const int pb = 1 + 12 * l;
#define MODL ((const float*)(ws + WS_MOD) + (size_t)l * 3 * 6144)
        PROF_BEGIN(101);
        if (IN(pb + 0)) { PHASE_FRAME(); if (l == 1) { prep_weights(P, 1, P.G > 192 ? 32 : 63); if (P.G <= 192) prep_filters(P, 1); }
            for (int rep = 0; rep < NREP(0); ++rep) phase_norm(P, P.in[I_N1G] + l * DM, MODL, 0, 1024, (bf16_t*)(ws + WS_H)); }
        SEAM(pb + 0);
        PROF_END(101);
        PROF_BEGIN(102);
        if (IN(pb + 1)) for (int rep = 0; rep < NREP(1); ++rep) { PHASE_FRAME();
            { Gemm g{1024, 2048, 2048}; Sched2D S{(const char*)(ws + WS_H), (const char*)(ws + W_N), (size_t)256 * 2048, (size_t)256 * 2048, 48, 9, P.G, P.bid, 0, 0};
              EpiInN E{(bf16_t*)(ws + WS_QKV), (bf16_t*)(ws + WS_Z), (float*)(ws + WS_BA)};
              gemm_phase<EpiInN, Sched2D, true, true>(ring, g, S, E); }
            { Gemm g{1024, 2048, 2048}; Sched2D S{(const char*)(ws + W_S), (const char*)(ws + WS_H), (size_t)256 * 2048, (size_t)256 * 2048, 10, 48, P.G, P.bid, 0, 0};
              EpiInS E{(bf16_t*)(ws + WS_HYT), (bf16_t*)(ws + WS_XCSL), (bf16_t*)(ws + WS_XCSC)};
              gemm_phase<EpiInS, Sched2D, true, true>(ring, g, S, E); }
        }
        SEAM(pb + 1);
        PROF_END(102);
        PROF_BEGIN(103);
        if (IN(pb + 2)) {
            { PHASE_FRAME(); Gemm g{2048, 8192, 8192}; SchedFourL S{(const char*)(ws + WS_TABL), (const char*)(ws + WS_XCSL), P.bid};
              EpiScaleBf16 E{(bf16_t*)(ws + WS_YF), 512, 1.0f};
              gemm_phase<EpiScaleBf16, SchedFourL, true, true>(ring, g, S, E); }
            { PHASE_FRAME(); Gemm g{512, 1024, 1024}; SchedFourC S{(const char*)(ws + WS_TABC), (const char*)(ws + WS_XCSC), P.bid - 64};
              EpiScaleBf16 E{(bf16_t*)(ws + WS_YC), 512, 1.0f / sqrtf(64.0f * 256.0f)};
              gemm_phase<EpiScaleBf16, SchedFourC, true, true>(ring, g, S, E); }
            for (int rep = 0; rep < NREP(2); ++rep) { PHASE_FRAME(); __syncthreads();
              const int xq = P.bid & 7, qid = 16 + (2 * l + rep) * 8 + xq;
              for (int t = q_next(P, qid); t < 192; t = q_next(P, qid)) {
                if (t < 64) hyena_task(P, l, 64 * xq + t, 0);
                else { const int tt = t - 64; hyena_task(P, l, 64 * xq + (tt >> 1), 1 + (tt & 1)); }
              } }
        }
        SEAM(pb + 2);
        PROF_END(103);
        PROF_BEGIN(104);
        if (IN(pb + 3)) for (int rep = 0; rep < NREP(3); ++rep) { PHASE_FRAME();
            for (int t0 = 2 * P.bid; t0 < 1536; t0 += 2 * P.G) { const int t = t0 + (P.wave >> 2);
                int s, h, n;
                if (t < 1024) { s = t >> 5; h = (t >> 2) & 7; n = t & 3; } else { const int tt = t - 1024; s = 32 + (tt >> 8); h = (tt >> 5) & 7; n = tt & 31; }
                d1_task(P, l, s, h, n);
            }
        }
        SEAM(pb + 3);
        PROF_END(104);
        PROF_BEGIN(105);
        if (IN(pb + 4)) for (int rep = 0; rep < NREP(4); ++rep) { PHASE_FRAME();
            const int gw = P.wave * P.G + P.bid, NW = NWAVES * P.G;
            if (gw < 128) { d2_wave_task(P, l, 32 + (gw >> 6), (gw >> 3) & 7, (gw >> 2) & 1, gw & 3); }
            else for (int tt = gw - 128; tt < 2048; tt += NW - 128) d2_wave_task(P, l, tt >> 6, (tt >> 3) & 7, (tt >> 2) & 1, tt & 3);
        }
        SEAM(pb + 4);
        PROF_END(105);
        PROF_BEGIN(106);
        if (IN(pb + 5)) { PHASE_FRAME();
            { const u32x4* p0 = (const u32x4*)(ws + WS_YF); const u32x4* p1 = p0 + 4096 * 512 / 8; bf16_t* yc = (bf16_t*)(ws + WS_YC) + (size_t)NCTX * 512; const float sc = 1.0f / sqrtf(64.0f * 2048.0f);
              for (int i = P.bid * NTHR + P.tid; i < 4096 * 512 / 8; i += P.G * NTHR) { const u32x4 a = p0[i], b = p1[i];
                  *(u32x4*)(yc + (size_t)i * 8) = (u32x4){pk2((bflo(a.x) + bflo(b.x)) * sc, (bfhi(a.x) + bfhi(b.x)) * sc), pk2((bflo(a.y) + bflo(b.y)) * sc, (bfhi(a.y) + bfhi(b.y)) * sc),
                                                          pk2((bflo(a.z) + bflo(b.z)) * sc, (bfhi(a.z) + bfhi(b.z)) * sc), pk2((bflo(a.w) + bflo(b.w)) * sc, (bfhi(a.w) + bfhi(b.w)) * sc)}; } }
            phase_combine(P, l); phase_norm(P, P.in[I_N1G] + l * DM, MODL, 0, 1024, (bf16_t*)(ws + WS_H)); }
        SEAM(pb + 5);
        PROF_END(106);
        PROF_BEGIN(107);
        if (IN(pb + 6)) for (int rep = 0; rep < NREP(6); ++rep) { PHASE_FRAME(); Gemm g{1024, 2048, 2048}; Sched2D S{(const char*)(ws + WS_H), (const char*)(ws + W_G), (size_t)256 * 2048, (size_t)256 * 2048, 48, 12, P.G, P.bid, 0, 0};
            EpiGate E{(bf16_t*)(ws + WS_GATE)};
            gemm_phase<EpiGate, Sched2D, true, true>(ring, g, S, E); }
        SEAM(pb + 6);
        PROF_END(107);
        PROF_BEGIN(108);
        if (IN(pb + 7) && l == 0 && blockIdx.x >= 192) { PHASE_FRAME(); Frame Q = P; Q.bid = P.bid - 192; Q.G = P.G - 192; prep_weights(Q, 1, 1); }
        if (IN(pb + 7)) {
            static_assert(WS_YB == WS_YA + 12 * MiB && WS_YC == WS_YB + 12 * MiB, "y buffers 12 MiB apart");
#pragma unroll 1
            for (int br = 0; br < 3; ++br) { PHASE_FRAME(); Gemm g{512, 1024, 1024};
                Sched2D S{(const char*)(ws + WS_YA + (size_t)br * 12 * MiB), (const char*)(ws + W_P + (size_t)br * MiB), (size_t)256 * 1024, (size_t)256 * 1024, 48, 4, P.G, P.bid, 0, 0};
                EpiMergeAcc E{(bf16_t*)(ws + WS_MRG), (const bf16_t*)(ws + WS_GATE), br * 1024, br == 0 ? 1 : 0};
                gemm_phase<EpiMergeAcc, Sched2D, true, true>(ring, g, S, E); }
        }
        SEAM(pb + 7);
        PROF_END(108);
        PROF_BEGIN(109);
        if (IN(pb + 8) && l == 0 && blockIdx.x >= 192) { PHASE_FRAME(); Frame Q = P; Q.bid = P.bid - 192; Q.G = P.G - 192; prep_weights(Q, 1, 2 | 4); }
        if (IN(pb + 8)) { PHASE_FRAME(); Gemm g{1024, 2048, 6144}; Sched2D S{(const char*)(ws + WS_MRG), (const char*)(ws + W_O3), (size_t)256 * 2048, (size_t)256 * 6144, 48, 4, P.G, P.bid, 0, 0};
            EpiResid E{P.out, MODL + 2048};
            gemm_phase<EpiResid, Sched2D, false, true>(ring, g, S, E); }
        SEAM(pb + 8);
        PROF_END(109);
        PROF_BEGIN(110);
        if (IN(pb + 9)) { PHASE_FRAME(); phase_norm(P, P.in[I_N2G] + l * DM, MODL, 3072, 4096, (bf16_t*)(ws + WS_H)); }
        SEAM(pb + 9);
        PROF_END(110);
        PROF_BEGIN(111);
        if (IN(pb + 10)) for (int rep = 0; rep < NREP(10); ++rep) { PHASE_FRAME(); Gemm g{1024, 2048, 2048}; Sched2D S{(const char*)(ws + WS_H), (const char*)(ws + W_GU), (size_t)256 * 2048, (size_t)256 * 2048, 48, 22, P.G, P.bid, 0, 0};
            EpiGU E{(bf16_t*)(ws + WS_ACT)};
            gemm_phase<EpiGU, Sched2D, true, true>(ring, g, S, E);
            if (l == 0 && P.G > 192 && P.bid >= 32) { __syncthreads(); Frame Q = P; Q.bid = P.bid - 32; Q.G = P.G - 32; prep_filters(Q, 1); prep_weights(Q, 1, 8); } }
        SEAM(pb + 10);
        PROF_END(111);
        PROF_BEGIN(112);
        if (IN(pb + 11) && l == 0 && blockIdx.x >= 192) { PHASE_FRAME(); Frame Q = P; Q.bid = P.bid - 192; Q.G = P.G - 192; prep_weights(Q, 1, 16); }
        if (IN(pb + 11)) { PHASE_FRAME(); Gemm g{DFF, DFF * 2, DFF * 2}; Sched2D S{(const char*)(ws + WS_ACT), (const char*)(ws + W_DN), (size_t)256 * DFF * 2, (size_t)256 * DFF * 2, 48, 4, P.G, P.bid, 0, 0};
            EpiResid E{P.out, MODL + 5120};
            gemm_phase<EpiResid, Sched2D, false, true>(ring, g, S, E); }
        SEAM(pb + 11);
        PROF_END(112);
    }
    PROF_BEGIN(113);
    if (IN(25)) { PHASE_FRAME(); phase_final(P); }
    PROF_END(113); PROF_FLUSH();
    if (PROBE_ID != 0) { __syncthreads();
        if (blockIdx.x == PROBE_BLK && threadIdx.x == 0) { const unsigned tot = *(volatile LAS unsigned*)(F.lds + MISC_OFF + 96); unsigned long long want = (unsigned long long)tot * PROBE_AMP; if (want > 3000000ull) want = 3000000ull;
            const unsigned long long t0 = __builtin_amdgcn_s_memrealtime(); while (__builtin_amdgcn_s_memrealtime() - t0 < want) __builtin_amdgcn_s_sleep(16); }
        __syncthreads(); }
#undef IN
#undef SEAM
}

extern "C" void kernel_launch(void* const* d_in, const int* in_sizes, int n_in, void* d_out, int out_size, void* d_ws, size_t ws_size, hipStream_t stream) {
    static int grid = 0;
    if (grid == 0) {
        if (n_in != N_IN || out_size != NTOK * DM + 32 * 2 * 2 * 8 * 4096 || ws_size < WS_END) { fprintf(stderr, "kernel_launch: unexpected shapes (n_in %d out %d ws %zu); nothing launched\n", n_in, out_size, ws_size); grid = -1; return; }
        int dev = 0, cus = 0, per_cu = 0;
        if (hipGetDevice(&dev) != hipSuccess || hipDeviceGetAttribute(&cus, hipDeviceAttributeMultiprocessorCount, dev) != hipSuccess) { grid = -1; return; }
        if (hipFuncSetAttribute((const void*)mk_fwd, hipFuncAttributeMaxDynamicSharedMemorySize, LDS_BYTES) != hipSuccess) { fprintf(stderr, "kernel_launch: hipFuncSetAttribute failed\n"); grid = -1; return; }
        if (hipOccupancyMaxActiveBlocksPerMultiprocessor(&per_cu, (const void*)mk_fwd, NTHR, LDS_BYTES) != hipSuccess || per_cu < 1) { fprintf(stderr, "kernel_launch: occupancy query says %d blocks per CU; nothing launched\n", per_cu); (void)hipGetLastError(); grid = -1; return; }
        grid = cus;
    }
    if (grid < 0) return;
    if (hipMemsetAsync((char*)d_ws + WS_CTL, 0, CTL_ZERO_BYTES, stream) != hipSuccess) return;
    Args a{};
    for (int i = 0; i < N_IN; ++i) a.in[i] = (const float*)d_in[i];
    a.out = (float*)d_out; a.ws = (unsigned char*)d_ws;
#if MK_PER_PHASE
    for (int p = 0; p < N_PHASES; ++p) { a.ph_lo = p; a.ph_hi = p + 1; a.li = 0; hipLaunchKernelGGL(mk_fwd, dim3(grid), dim3(NTHR), LDS_BYTES, stream, a); }
#else
    a.ph_lo = 0; a.ph_hi = N_PHASES; a.li = 0;
    hipLaunchKernelGGL(mk_fwd, dim3(grid), dim3(NTHR), LDS_BYTES, stream, a);
#endif
}
```

```cpp
#include <hip/hip_runtime.h>
#include <cstdio>
#include <cstdint>

#ifndef MK_PER_PHASE
#define MK_PER_PHASE 0
#endif

#ifndef REPMASK
#define REPMASK 0
#endif
#define NREP(k) (((REPMASK >> (k)) & 1) ? 2 : 1)
#ifndef PROBE_ID
#define PROBE_ID 0
#endif
#define PROBE_AMP 10
#ifndef PROBE_BLK
#define PROBE_BLK 150
#endif
#ifndef PROBE_BLK
#define PROBE_BLK 200
#endif
#define PROF_COUNT(id) do { if (PROBE_ID == (id) && blockIdx.x == PROBE_BLK && threadIdx.x == 0) { *PROF_WORD(0) = *PROF_WORD(0) + 1000u; } } while (0)
#ifndef PROBE_BLK
#define PROBE_BLK 200
#endif
#define PROF_COUNT(id) do { if (PROBE_ID == (id) && blockIdx.x == PROBE_BLK && threadIdx.x == 0) { *PROF_WORD(0) = *PROF_WORD(0) + 1000u; } } while (0)
#define PROF_WORD(i) ((volatile __attribute__((address_space(3))) unsigned*)(F.lds + MISC_OFF + 96 + 4 * (i)))
#define PROF_BEGIN(id) do { if (PROBE_ID == (id) && blockIdx.x == PROBE_BLK && threadIdx.x == 0) { *PROF_WORD(1) = (unsigned)__builtin_amdgcn_s_memrealtime(); } } while (0)
#define PROF_END(id) do { if (PROBE_ID == (id) && blockIdx.x == PROBE_BLK && threadIdx.x == 0) { asm volatile("s_waitcnt vmcnt(0) lgkmcnt(0)" ::: "memory"); *PROF_WORD(0) = *PROF_WORD(0) + ((unsigned)__builtin_amdgcn_s_memrealtime() - *PROF_WORD(1)); } } while (0)
#define LAS __attribute__((address_space(3)))
#define GAS __attribute__((address_space(1)))
typedef unsigned short bf16_t;
typedef short bf16x8 __attribute__((ext_vector_type(8)));
typedef float f32x4 __attribute__((ext_vector_type(4)));
typedef float f32x2 __attribute__((ext_vector_type(2)));
typedef unsigned u32x4 __attribute__((ext_vector_type(4)));
typedef unsigned u32x2 __attribute__((ext_vector_type(2)));

constexpr int DM = 1024, NTOK = 12288, NCTX = 8192, LCTX = 256, LLAT = 2048, BCTX = 32, BLAT = 2;
constexpr int HA = 8, QKVW = 1536, DFF = 2816, DIN = 7200;
constexpr int OFF_Z = 1536, OFF_B = 2048, OFF_HY = 2080, OFF_FN = 3616, OFF_GATE = 4128;
constexpr float EPS = 1e-6f;
enum { I_XP = 0, I_XS, I_STATE, I_C, I_CCTX, I_WMOD, I_BMOD, I_N1G, I_N2G, I_WIN, I_CONVQKV, I_ALOG, I_DTB, I_NORMA, I_CONVHY,
       I_HW1, I_HB1, I_HFREQ, I_HW2, I_HB2, I_HW3, I_HBIAS, I_WPA, I_WPB, I_WPC, I_WO, I_WGU, I_WDOWN, I_NORMF, N_IN };

constexpr size_t MiB = 1u << 20;
constexpr size_t WS_CTL = 0, CTL_ZERO_BYTES = 256 * 1024;
constexpr size_t WS_MOD = 1 * MiB;
constexpr size_t WS_B0 = 1 * MiB + 512 * 1024;
constexpr size_t WS_CB = WS_B0;
constexpr size_t WS_SS = WS_CTL + 256 * 1024;
constexpr size_t WS_SS1 = 2 * MiB + 256 * 1024;
constexpr size_t WS_CB1 = 1 * MiB + 256 * 1024;
constexpr size_t WS_TABC = 2 * MiB;
constexpr size_t WS_FILC = 3 * MiB;
constexpr size_t WS_FILL = 5 * MiB;
constexpr size_t WS_YF = 13 * MiB;
constexpr size_t WS_TABL = 21 * MiB;
constexpr size_t WS_W = 37 * MiB;
constexpr size_t W_N = WS_W;
constexpr size_t W_S = W_N + 2304 * 1024 * 2;
constexpr size_t W_G = W_S + 2560 * 1024 * 2;
constexpr size_t W_P = W_G + 3072 * 1024 * 2;
constexpr size_t W_O3 = W_P + 3 * 1024 * 512 * 2;
constexpr size_t W_GU = W_O3 + 1024 * 3072 * 2;
constexpr size_t W_DN = W_GU + 5632 * 1024 * 2;
constexpr size_t W_END = W_DN + 1024 * 2816 * 2;
static_assert(W_END <= 78 * MiB, "weights region");
constexpr size_t WS_A0 = 78 * MiB;
constexpr size_t WS_QKV = WS_A0, WS_OF = WS_A0, WS_OB = WS_A0 + 12 * MiB, WS_MRG = WS_A0;
constexpr size_t WS_Z = 116 * MiB, WS_YA = WS_Z;
constexpr size_t WS_BA = 114 * MiB;
constexpr size_t WS_YB = 128 * MiB, WS_YC = 140 * MiB;
constexpr size_t WS_A5 = 152 * MiB;
constexpr size_t WS_H = WS_A5;
constexpr size_t WS_HYT = WS_A5 + 24 * MiB;
constexpr size_t WS_XCS = WS_A5 + 60 * MiB;
constexpr size_t WS_XCSL = WS_XCS, WS_XCSC = WS_XCS + 8 * MiB;
constexpr size_t WS_QN = WS_A5, WS_KN = WS_A5 + 12 * MiB;
constexpr size_t WS_U = WS_A5 + 24 * MiB;
constexpr size_t WS_WW = WS_A5 + 48 * MiB;
constexpr size_t WS_QK = WS_A5 + 72 * MiB;
constexpr size_t WS_GC = WS_A5 + 96 * MiB;
constexpr size_t WS_GATE = WS_A5 + 24 * MiB;
constexpr size_t WS_ACT = WS_A5 + 24 * MiB;
constexpr size_t WS_END = 256 * MiB;
static_assert(WS_GC + 2 * 8 * 192 * 64 * 4 <= WS_END && WS_GATE + (size_t)NTOK * 3072 * 2 <= WS_END, "ws map");
constexpr int CW_BAR = 4096;
constexpr int CW_Q = 16384;
constexpr int CW_PROG = 8192;

constexpr int RING_BYTES = 131072, LDSCTL_OFF = RING_BYTES, MISC_OFF = LDSCTL_OFF + 320, LDS_BYTES = 147456;
constexpr int NWAVES = 8, NTHR = 512;

#define RLX_AGENT __ATOMIC_RELAXED, __HIP_MEMORY_SCOPE_AGENT
#define LDS_WAIT() asm volatile("s_waitcnt lgkmcnt(0)" ::: "memory")
typedef __bf16 bf16n2 __attribute__((ext_vector_type(2)));
typedef float f32n2 __attribute__((ext_vector_type(2)));
__device__ __forceinline__ unsigned pk2(float lo, float hi) { const f32n2 f = {lo, hi}; return __builtin_bit_cast(unsigned, __builtin_convertvector(f, bf16n2)); }
__device__ __forceinline__ unsigned f2bf(float f) { return pk2(f, 0.f) & 0xffffu; }
__device__ __forceinline__ float bf2f(unsigned short b) { return __builtin_bit_cast(float, (unsigned)b << 16); }
__device__ __forceinline__ float bflo(unsigned w) { return __builtin_bit_cast(float, w << 16); }
__device__ __forceinline__ float bfhi(unsigned w) { return __builtin_bit_cast(float, w & 0xffff0000u); }
__device__ __forceinline__ float sin_rev(float r) { return __builtin_amdgcn_sinf(r - rintf(r)); }
__device__ __forceinline__ float cos_rev(float r) { return __builtin_amdgcn_cosf(r - rintf(r)); }
__device__ __forceinline__ float sin_rad(float x) { return sin_rev(x * 0.15915494309189535f); }
__device__ __forceinline__ float cos_rad(float x) { return cos_rev(x * 0.15915494309189535f); }
__device__ __forceinline__ float sigmoidf_(float x) { return __builtin_amdgcn_rcpf(1.f + __expf(-x)); }
__device__ __forceinline__ float siluf_(float x) { return x * __builtin_amdgcn_rcpf(1.f + __expf(-x)); }
__device__ __forceinline__ float rsqrtf_(float x) { return __builtin_amdgcn_rsqf(x); }
template <class T> __device__ __forceinline__ T* opq(T* p) {
    unsigned lo = (unsigned)(uintptr_t)p, hi = (unsigned)((uintptr_t)p >> 32); asm volatile("" : "+v"(lo), "+v"(hi));
    lo = __builtin_amdgcn_readfirstlane(lo); hi = __builtin_amdgcn_readfirstlane(hi);
    return (T*)(GAS T*)(((uintptr_t)hi << 32) | (uintptr_t)lo);
}
__device__ __forceinline__ float dpp_f(float x, int ctrl_tag) {
    const int v = __builtin_bit_cast(int, x); int r;
    if (ctrl_tag == 0) r = __builtin_amdgcn_update_dpp(0, v, 0xB1, 0xF, 0xF, true);
    else if (ctrl_tag == 1) r = __builtin_amdgcn_update_dpp(0, v, 0x4E, 0xF, 0xF, true);
    else r = __builtin_amdgcn_update_dpp(0, v, 0x141, 0xF, 0xF, true);
    return __builtin_bit_cast(float, r);
}
__device__ __forceinline__ float sum8(float s) { s += dpp_f(s, 0); s += dpp_f(s, 1); s += dpp_f(s, 2); return s; }
__device__ __forceinline__ float lane_read(float x, int srclane) { return __builtin_bit_cast(float, __builtin_amdgcn_ds_bpermute(srclane << 2, __builtin_bit_cast(int, x))); }
__device__ __forceinline__ float wave_sum(float v, int lane) {
    v = sum8(v);
#pragma unroll
    for (int o = 8; o < 64; o <<= 1) v += lane_read(v, lane ^ o);
    return v;
}
__device__ __forceinline__ int seq_start(int s) { return s < 32 ? s * 256 : NCTX + (s - 32) * 2048; }
__device__ __forceinline__ int seq_len(int s) { return s < 32 ? 256 : 2048; }
__device__ __forceinline__ int mod_idx(int row) { return row < NCTX ? 0 : 1 + ((row - NCTX) >> 11); }

namespace pg8 {
constexpr int BM = 256, BK = 64, HALF = 128, HTB = HALF * BK * 2, STAGE_BYTES = 8 * HTB, NXCD = 8, WGM = 8;
__host__ __device__ __forceinline__ int lds_byte(int r, int c) { const int st = (r >> 4) * 2 + (c >> 5), rr = r & 15, cc = c & 31, ob = rr * 64 + cc * 2; return st * 1024 + (ob ^ (((ob >> 9) & 1) << 5)); }
__host__ __device__ __forceinline__ void stage_rc(int b, int& R, int& C) { const int st = b / 1024, sb = b % 1024, swz = sb ^ (((sb >> 9) & 1) << 5); R = (st >> 1) * 16 + swz / 64; C = (st & 1) * 32 + (swz % 64) / 2; }
__host__ __device__ __forceinline__ int perm32(int rho) { const int n = rho >> 4, i = rho & 15; return 8 * (i >> 2) + 4 * n + (i & 3); }

struct Unit { const char* a; const char* b; int r0, c0; };
struct Gemm { int K, lda, ldb; };

__device__ __forceinline__ bool static_order(long L, int nM, int nN, int& pm, int& pn) {
    const int nwg = nM * nN; if (L >= nwg) return false;
    int wgid = (int)L; { const int q = nwg / NXCD, r = nwg % NXCD, xcd = wgid % NXCD, off = wgid / NXCD; wgid = (xcd < r ? xcd * (q + 1) : r * (q + 1) + (xcd - r) * q) + off; }
    const int nig = WGM * nN, gid = wgid / nig, fm = gid * WGM, gsz = (nM - fm) < WGM ? (nM - fm) : WGM;
    pm = fm + ((wgid % nig) % gsz); pn = (wgid % nig) / gsz; return true;
}
__device__ __forceinline__ unsigned cvt_pk_bf16(float lo, float hi) { return pk2(lo, hi); }

template <class Epi, class Sched, bool ALIGN_EPI, bool SP2, bool HN = false>
__device__ __forceinline__ void gemm_phase(LAS unsigned char* lds, const Gemm g, const Sched& S, Epi& E) {
    int tid_ = threadIdx.x; asm volatile("" : "+v"(tid_));
    const int tid = tid_, wid = __builtin_amdgcn_readfirstlane(tid >> 6), lane = tid & 63, wr = wid >> 2, wc = wid & 3, fr = lane & 15, fq = lane >> 4;
    const int K = g.K, nt = K / BK;
    unsigned voffA[2], voffB[2];
#pragma unroll
    for (int i = 0; i < 2; ++i) { int R, C; stage_rc(tid * 16 + i * 8192, R, C); const int Rb = Epi::PERM ? ((R & ~31) + perm32(R & 31)) : R;
        voffA[i] = (unsigned)(R * g.lda + C * 2); voffB[i] = (unsigned)(Rb * g.ldb + C * 2); }
    const size_t kstep = (size_t)(BK * 2);
    const size_t hstepA = (size_t)HALF * g.lda, hstepB = (size_t)HALF * g.ldb;
    const unsigned ldsw = (unsigned)wid * 1024u;
    const int aoff = lds_byte(wr * 64 + fr, fq * 8), boff = lds_byte(wc * 32 + fr, fq * 8);
#define PG8_SA(b, h) (((b) * 2 + (h)) * HTB)
#define PG8_SB(b, h) ((4 + (b) * 2 + (h)) * HTB)
#define PG8_STAGE(bufoff, gbase, voff) do { _Pragma("unroll") for (int _i = 0; _i < 2; ++_i) \
        __builtin_amdgcn_global_load_lds((const unsigned*)((const char*)(gbase) + (voff)[_i]), (LAS unsigned*)(lds + (bufoff) + ldsw + _i * 8192), 16, 0, 0); } while (0)
#define PG8_LDA(dst, b, h) do { _Pragma("unroll") for (int m = 0; m < 4; ++m) _Pragma("unroll") for (int k = 0; k < 2; ++k) dst[m][k] = *(const LAS bf16x8*)(lds + PG8_SA(b, h) + aoff + m * 2048 + k * 1024); } while (0)
#define PG8_LDB(dst, b, h) do { _Pragma("unroll") for (int n = 0; n < 2; ++n) _Pragma("unroll") for (int k = 0; k < 2; ++k) dst[n][k] = *(const LAS bf16x8*)(lds + PG8_SB(b, h) + boff + n * 2048 + k * 1024); } while (0)
#define PG8_MMA(ai, bj, At, Bt) do { __builtin_amdgcn_s_setprio(1); _Pragma("unroll") for (int m = 0; m < 4; ++m) _Pragma("unroll") for (int n = 0; n < 2; ++n) _Pragma("unroll") for (int k = 0; k < 2; ++k) \
        acc[ai][bj][m][n] = __builtin_amdgcn_mfma_f32_16x16x32_bf16(Bt[n][k], At[m][k], acc[ai][bj][m][n], 0, 0, 0); __builtin_amdgcn_s_setprio(0); } while (0)
#define PG8_WAIT_V(n) asm volatile("s_waitcnt vmcnt(" #n ")" ::: "memory")
#define PG8_WAIT_L(n) asm volatile("s_waitcnt lgkmcnt(" #n ")" ::: "memory")
#define PG8_BAR __builtin_amdgcn_s_barrier()
#define PG8_SCHED __builtin_amdgcn_sched_barrier(0)
    Unit cur, nxt; int ui = 0;
    if (!S.next(0, cur)) return;
    E.pre(0);
    constexpr int NBJ = HN ? 1 : 2;
    f32x4 acc[2][NBJ][4][2];
#pragma unroll
    for (int a = 0; a < 2; ++a)
#pragma unroll
        for (int b = 0; b < NBJ; ++b)
#pragma unroll
            for (int m = 0; m < 4; ++m)
#pragma unroll
                for (int n = 0; n < 2; ++n) acc[a][b][m][n] = (f32x4){0.f, 0.f, 0.f, 0.f};
    bf16x8 At[4][2], B0[2][2], B1[2][2];
    const char* cA = cur.a; const char* cB = cur.b;
    if constexpr (HN) {
        PG8_STAGE(PG8_SB(0, 0), cB, voffB); PG8_STAGE(PG8_SA(0, 0), cA, voffA); PG8_STAGE(PG8_SA(0, 1), cA + hstepA, voffA);
        if (wr == 1) PG8_BAR;
        PG8_WAIT_V(2); PG8_BAR;
        PG8_STAGE(PG8_SB(1, 0), cB + kstep, voffB); PG8_STAGE(PG8_SA(1, 0), cA + kstep, voffA);
        PG8_WAIT_V(4); PG8_BAR;
    } else if constexpr (SP2) {
        PG8_STAGE(PG8_SB(0, 0), cB, voffB); PG8_STAGE(PG8_SB(0, 1), cB + hstepB, voffB); PG8_STAGE(PG8_SA(0, 0), cA, voffA); PG8_STAGE(PG8_SA(0, 1), cA + hstepA, voffA);
        if (wr == 1) PG8_BAR;
        PG8_WAIT_V(2); PG8_BAR;
        PG8_STAGE(PG8_SB(1, 0), cB + kstep, voffB); PG8_STAGE(PG8_SA(1, 0), cA + kstep, voffA); PG8_STAGE(PG8_SB(1, 1), cB + hstepB + kstep, voffB);
        PG8_WAIT_V(6); PG8_BAR;
    } else {
        PG8_STAGE(PG8_SB(0, 0), cB, voffB); PG8_STAGE(PG8_SA(0, 0), cA, voffA); PG8_STAGE(PG8_SB(0, 1), cB + hstepB, voffB); PG8_STAGE(PG8_SA(0, 1), cA + hstepA, voffA);
        if (wr == 1) PG8_BAR;
        PG8_WAIT_V(4); PG8_BAR;
        PG8_STAGE(PG8_SB(1, 0), cB + kstep, voffB); PG8_STAGE(PG8_SA(1, 0), cA + kstep, voffA); PG8_STAGE(PG8_SB(1, 1), cB + hstepB + kstep, voffB);
        PG8_WAIT_V(6); PG8_BAR;
    }
    for (;;) {
        const bool has_next = S.next(ui + 1, nxt);
        const char* nA = has_next ? nxt.a : cA; const char* nB = has_next ? nxt.b : cB;
        for (int t = 0; t < nt; t += 2) {
            const bool last = (t == nt - 2);
            const char* a1 = cA + (size_t)(t + 1) * kstep;
            const char* a2 = last ? nA : cA + (size_t)(t + 2) * kstep; const char* b2 = last ? nB : cB + (size_t)(t + 2) * kstep;
            const char* a3 = a2 + kstep; const char* b3 = b2 + kstep;
            if constexpr (HN) {
            PG8_LDB(B0, 0, 0); PG8_SCHED; PG8_LDA(At, 0, 0); PG8_STAGE(PG8_SA(1, 1), a1 + hstepA, voffA);
            PG8_WAIT_V(6); PG8_WAIT_L(0); PG8_BAR; PG8_MMA(0, 0, At, B0); PG8_BAR; PG8_SCHED;
            PG8_LDA(At, 0, 1); PG8_STAGE(PG8_SB(0, 0), b2, voffB); PG8_STAGE(PG8_SA(0, 0), a2, voffA);
            PG8_WAIT_V(6); PG8_WAIT_L(0); PG8_BAR; PG8_MMA(1, 0, At, B0); PG8_BAR; PG8_SCHED;
            PG8_LDB(B0, 1, 0); PG8_SCHED; PG8_LDA(At, 1, 0); PG8_STAGE(PG8_SA(0, 1), a2 + hstepA, voffA);
            PG8_WAIT_V(6); PG8_WAIT_L(0); PG8_BAR; PG8_MMA(0, 0, At, B0); PG8_BAR; PG8_SCHED;
            PG8_LDA(At, 1, 1); PG8_STAGE(PG8_SB(1, 0), b3, voffB); PG8_STAGE(PG8_SA(1, 0), a3, voffA);
            PG8_WAIT_V(6); PG8_WAIT_L(0); PG8_BAR; PG8_MMA(1, 0, At, B0); PG8_BAR; PG8_SCHED;
            } else if constexpr (SP2) {
            PG8_LDB(B0, 0, 0); PG8_LDB(B1, 0, 1); PG8_SCHED; PG8_LDA(At, 0, 0); PG8_STAGE(PG8_SA(1, 1), a1 + hstepA, voffA);
            PG8_WAIT_V(8); PG8_WAIT_L(0); PG8_BAR; PG8_MMA(0, 0, At, B0); PG8_MMA(0, 1, At, B1); PG8_BAR; PG8_SCHED;
            PG8_LDA(At, 0, 1); PG8_STAGE(PG8_SB(0, 0), b2, voffB); PG8_STAGE(PG8_SB(0, 1), b2 + hstepB, voffB); PG8_STAGE(PG8_SA(0, 0), a2, voffA);
            PG8_WAIT_V(8); PG8_WAIT_L(0); PG8_BAR; PG8_MMA(1, 0, At, B0); PG8_MMA(1, 1, At, B1); PG8_BAR; PG8_SCHED;
            PG8_LDB(B0, 1, 0); PG8_LDB(B1, 1, 1); PG8_SCHED; PG8_LDA(At, 1, 0); PG8_STAGE(PG8_SA(0, 1), a2 + hstepA, voffA);
            PG8_WAIT_V(8); PG8_WAIT_L(0); PG8_BAR; PG8_MMA(0, 0, At, B0); PG8_MMA(0, 1, At, B1); PG8_BAR; PG8_SCHED;
            PG8_LDA(At, 1, 1); PG8_STAGE(PG8_SB(1, 0), b3, voffB); PG8_STAGE(PG8_SB(1, 1), b3 + hstepB, voffB); PG8_STAGE(PG8_SA(1, 0), a3, voffA);
            PG8_WAIT_V(8); PG8_WAIT_L(0); PG8_BAR; PG8_MMA(1, 0, At, B0); PG8_MMA(1, 1, At, B1); PG8_BAR; PG8_SCHED;
            } else {
            PG8_LDB(B0, 0, 0); PG8_SCHED; PG8_LDA(At, 0, 0); PG8_STAGE(PG8_SA(1, 1), a1 + hstepA, voffA);
            PG8_WAIT_L(8); PG8_BAR; PG8_WAIT_L(0); PG8_MMA(0, 0, At, B0); PG8_BAR; PG8_SCHED;
            PG8_LDB(B1, 0, 1); PG8_STAGE(PG8_SB(0, 0), b2, voffB);
            PG8_BAR; PG8_WAIT_L(0); PG8_MMA(0, 1, At, B1); PG8_BAR;
            PG8_LDA(At, 0, 1); PG8_STAGE(PG8_SA(0, 0), a2, voffA);
            PG8_BAR; PG8_WAIT_L(0); PG8_MMA(1, 0, At, B0); PG8_BAR; PG8_SCHED;
            PG8_STAGE(PG8_SB(0, 1), b2 + hstepB, voffB);
            PG8_WAIT_V(6); PG8_BAR; PG8_MMA(1, 1, At, B1); PG8_BAR;
            PG8_LDB(B0, 1, 0); PG8_SCHED; PG8_LDA(At, 1, 0); PG8_STAGE(PG8_SA(0, 1), a2 + hstepA, voffA);
            PG8_WAIT_L(8); PG8_BAR; PG8_WAIT_L(0); PG8_MMA(0, 0, At, B0); PG8_BAR; PG8_SCHED;
            PG8_LDB(B1, 1, 1); PG8_STAGE(PG8_SB(1, 0), b3, voffB);
            PG8_BAR; PG8_WAIT_L(0); PG8_MMA(0, 1, At, B1); PG8_BAR;
            PG8_LDA(At, 1, 1); PG8_STAGE(PG8_SA(1, 0), a3, voffA);
            PG8_BAR; PG8_WAIT_L(0); PG8_MMA(1, 0, At, B0); PG8_BAR; PG8_SCHED;
            PG8_STAGE(PG8_SB(1, 1), b3 + hstepB, voffB);
            PG8_WAIT_V(6); PG8_BAR; PG8_MMA(1, 1, At, B1); PG8_BAR;
            }
        }
        if constexpr (ALIGN_EPI) { if (wr == 0) PG8_BAR; }
        E(acc, cur, wr, wc, fr, fq);
        if (!has_next) break;
#pragma unroll
        for (int a = 0; a < 2; ++a)
#pragma unroll
            for (int b = 0; b < NBJ; ++b)
#pragma unroll
                for (int m = 0; m < 4; ++m)
#pragma unroll
                    for (int n = 0; n < 2; ++n) acc[a][b][m][n] = (f32x4){0.f, 0.f, 0.f, 0.f};
        cur = nxt; cA = nA; cB = nB; ++ui;
        E.pre(ui);
        if constexpr (ALIGN_EPI) { if (wr == 1) PG8_BAR; }
    }
    PG8_WAIT_V(0);
    if constexpr (!ALIGN_EPI) { if (wr == 0) PG8_BAR; }
    PG8_BAR;
#undef PG8_SA
#undef PG8_SB
#undef PG8_STAGE
#undef PG8_LDA
#undef PG8_LDB
#undef PG8_MMA
#undef PG8_WAIT_V
#undef PG8_WAIT_L
#undef PG8_BAR
#undef PG8_SCHED
}

struct Sched2D {
    const char* A; const char* B; size_t atile, btile; int nM, nN, G, c, r_base, c_base;
    __device__ __forceinline__ bool next(int i, Unit& u) const {
        if (c < 0) return false;
        int pm, pn; if (!static_order((long)i * G + c, nM, nN, pm, pn)) return false;
        u.a = A + (size_t)pm * atile; u.b = B + (size_t)pn * btile; u.r0 = r_base + pm * 256; u.c0 = c_base + pn * 256; return true;
    }
};
struct SchedSplitA {
    const char* A0; const char* A1; const char* B; size_t atile, btile; int nM, nN, msplit, G, c;
    __device__ __forceinline__ bool next(int i, Unit& u) const {
        int pm, pn; if (!static_order((long)i * G + c, nM, nN, pm, pn)) return false;
        u.a = pm < msplit ? A0 + (size_t)pm * atile : A1 + (size_t)(pm - msplit) * atile; u.b = B + (size_t)pn * btile; u.r0 = pm * 256; u.c0 = pn * 256; return true;
    }
};
struct SchedMerge {
    const char *y0, *w0; int G, c;
    __device__ __forceinline__ bool next(int i, Unit& u) const {
        const int ti = i / 3, br = i - 3 * ti; int pm, pn; if (!static_order((long)ti * G + c, 48, 4, pm, pn)) return false;
        u.a = y0 + (size_t)br * (12u << 20) + (size_t)pm * 256 * 512 * 2; u.b = w0 + (size_t)br * (1u << 20) + (size_t)pn * 256 * 512 * 2; u.r0 = pm * 256; u.c0 = br * 1024 + pn * 256; return true;
    }
};
struct SchedFourL {
    const char* tab; const char* xcs; int c;
    __device__ __forceinline__ bool next(int i, Unit& u) const {
        if (i > 0 || c < 0 || c >= 64) return false;
        const int ks = c >> 5, b = (c >> 4) & 1, pm = (c & 15) >> 1, pn = c & 1;
        u.a = tab + (size_t)pm * 256 * 4096 * 2 + (size_t)ks * 2048 * 2; u.b = xcs + ((size_t)b * 512 + pn * 256) * 4096 * 2 + (size_t)ks * 2048 * 2; u.r0 = ks * 4096 + b * 2048 + pm * 256; u.c0 = pn * 256; return true;
    }
};
struct SchedFourC {
    const char* tab; const char* xcs; int c;
    __device__ __forceinline__ bool next(int i, Unit& u) const {
        if (i > 0 || c < 0 || c >= 64) return false;
        const int b = c >> 1, pn = c & 1;
        u.a = tab; u.b = xcs + ((size_t)b * 512 + pn * 256) * 512 * 2; u.r0 = b * 256; u.c0 = pn * 256; return true;
    }
};

struct SchedMergeHN {
    const char *y0, *w0; int G, c;
    __device__ __forceinline__ bool next(int i, Unit& u) const {
        const int ti = i / 3, br = i - 3 * ti; int pm, pn; if (!static_order((long)ti * G + c, 48, 8, pm, pn)) return false;
        u.a = y0 + (size_t)br * (12u << 20) + (size_t)pm * 256 * 512 * 2; u.b = w0 + (size_t)br * (1u << 20) + (size_t)pn * 128 * 512 * 2; u.r0 = pm * 256; u.c0 = br * 1024 + pn * 128; return true;
    }
};
typedef f32x4 Acc[2][2][4][2];
__device__ __forceinline__ float rstd16(const float* sp) {
    const f32x4 a = ((const f32x4*)sp)[0], b = ((const f32x4*)sp)[1], c = ((const f32x4*)sp)[2], d = ((const f32x4*)sp)[3];
    return rsqrtf_(((((a[0] + a[1]) + (a[2] + a[3])) + ((b[0] + b[1]) + (b[2] + b[3]))) + (((c[0] + c[1]) + (c[2] + c[3])) + ((d[0] + d[1]) + (d[2] + d[3])))) * (1.f / DM) + EPS);
}
constexpr int RSTD_LDS_OFF = LDSCTL_OFF + 4096, RSTD_MAX_UNITS = 8;
template <class Sched> __device__ __forceinline__ void rstd_prepass(const Sched& S, const float* ss, LAS unsigned char* lds, bool use_c0) {
    LAS float* tab = (LAS float*)(lds + RSTD_LDS_OFF); const int tid = threadIdx.x;
    if (tid < 256) {
#pragma unroll 1
        for (int i = 0; i < RSTD_MAX_UNITS; ++i) { Unit u; if (!S.next(i, u)) break; tab[i * 256 + tid] = rstd16(ss + (size_t)((use_c0 ? u.c0 : u.r0) + tid) * 16); } }
    __syncthreads();
}
struct EpiInN {
    static constexpr bool PERM = true;
    __device__ __forceinline__ void pre(int ui) { rtab = (const LAS float*)(ldsb + RSTD_LDS_OFF) + ui * 256; }
    bf16_t* qkv; bf16_t* z; float* ba; const float* ss; const float* cb; LAS unsigned char* ldsb; const LAS float* rtab;
    __device__ __forceinline__ void operator()(const Acc& acc, const Unit& u, int wr, int wc, int fr, int fq) {
        const int colt = u.c0, lane = fr + 16 * fq;
        const float* cbp = cb + (size_t)mod_idx(u.r0) * 7936 + colt + wc * 32 + 8 * fq;
        const f32x4 cb00 = *(const f32x4*)cbp, cb01 = *(const f32x4*)(cbp + 4), cb10 = *(const f32x4*)(cbp + HALF), cb11 = *(const f32x4*)(cbp + HALF + 4);
#pragma unroll
        for (int ai = 0; ai < 2; ++ai)
#pragma unroll
            for (int m = 0; m < 4; ++m) { const int row = u.r0 + ai * HALF + wr * 64 + m * 16 + fr; const float rs = rtab[ai * HALF + wr * 64 + m * 16 + fr];
#pragma unroll
                for (int bj = 0; bj < 2; ++bj) { const int col = colt + bj * HALF + wc * 32 + 8 * fq; const f32x4 v0 = acc[ai][bj][m][0] * rs + (bj ? cb10 : cb00), v1 = acc[ai][bj][m][1] * rs + (bj ? cb11 : cb01);
                    if (colt < 2048) { u32x4 w; w.x = cvt_pk_bf16(v0[0], v0[1]); w.y = cvt_pk_bf16(v0[2], v0[3]); w.z = cvt_pk_bf16(v1[0], v1[1]); w.w = cvt_pk_bf16(v1[2], v1[3]);
                        bf16_t* p = colt < 1536 ? qkv + (size_t)row * 1536 + col : z + (size_t)row * 512 + (col - 1536);
                        *(u32x4*)p = w; }
                    else if (col - 2048 < 32) { float* p = ba + (size_t)row * 32 + (col - 2048); *(f32x4*)p = v0; *(f32x4*)(p + 4) = v1; } } }
    }
};
struct EpiInS {
    static constexpr bool PERM = true;
    __device__ __forceinline__ void pre(int ui) { rtab = (const LAS float*)(ldsb + RSTD_LDS_OFF) + ui * 256; }
    bf16_t* hyt; bf16_t* xcsl; bf16_t* xcsc; const float* ss; const float* cb; LAS unsigned char* ldsb; const LAS float* rtab;
    __device__ __forceinline__ void operator()(const Acc& acc, const Unit& u, int wr, int wc, int fr, int fq) {
        const int lane = fr + 16 * fq;
        const float* cbp = cb + (size_t)mod_idx(u.c0) * 7936 + 2304 + u.r0 + wr * 64 + fr;
        f32x4 r[2][2];
#pragma unroll
        for (int bj = 0; bj < 2; ++bj) { r[bj][0] = *(const LAS f32x4*)(rtab + bj * HALF + wc * 32 + 8 * fq); r[bj][1] = *(const LAS f32x4*)(rtab + bj * HALF + wc * 32 + 8 * fq + 4); }
#pragma unroll
        for (int ai = 0; ai < 2; ++ai)
#pragma unroll
            for (int m = 0; m < 4; ++m) { const int ch = u.r0 + ai * HALF + wr * 64 + m * 16 + fr; const float cv = cbp[ai * HALF + m * 16];
#pragma unroll
                for (int bj = 0; bj < 2; ++bj) { const int tok = u.c0 + bj * HALF + wc * 32 + 8 * fq; const f32x4 v0 = acc[ai][bj][m][0] * r[bj][0] + cv, v1 = acc[ai][bj][m][1] * r[bj][1] + cv;
                    u32x4 w; w.x = cvt_pk_bf16(v0[0], v0[1]); w.y = cvt_pk_bf16(v0[2], v0[3]); w.z = cvt_pk_bf16(v1[0], v1[1]); w.w = cvt_pk_bf16(v1[2], v1[3]);
                    bf16_t* p;
                    if (ch < 1536) p = hyt + (size_t)ch * NTOK + tok;
                    else { const int cc = ch - 1536, which = cc >> 9, n = cc & 511;
                        if (tok < NCTX) { const int b = tok >> 8, t = tok & 255; p = xcsc + ((size_t)(b * 512 + n) * 512 + which * 256 + t); }
                        else { const int tt = tok - NCTX, b = tt >> 11, t = tt & 2047; p = xcsl + ((size_t)(b * 512 + n) * 4096 + which * 2048 + t); } }
                    *(u32x4*)p = w; } }
    }
};
struct EpiScaleBf16 {
    static constexpr bool PERM = true;
    __device__ __forceinline__ void pre(int) {}
    bf16_t* O; int ldc; float scale;
    __device__ __forceinline__ void operator()(const Acc& acc, const Unit& u, int wr, int wc, int fr, int fq) const {
#pragma unroll
        for (int ai = 0; ai < 2; ++ai)
#pragma unroll
            for (int m = 0; m < 4; ++m) { const int row = u.r0 + ai * HALF + wr * 64 + m * 16 + fr;
#pragma unroll
                for (int bj = 0; bj < 2; ++bj) { const int col = u.c0 + bj * HALF + wc * 32 + 8 * fq; const f32x4 v0 = acc[ai][bj][m][0] * scale, v1 = acc[ai][bj][m][1] * scale;
                    u32x4 w; w.x = cvt_pk_bf16(v0[0], v0[1]); w.y = cvt_pk_bf16(v0[2], v0[3]); w.z = cvt_pk_bf16(v1[0], v1[1]); w.w = cvt_pk_bf16(v1[2], v1[3]);
                    *(u32x4*)(O + (size_t)row * ldc + col) = w; } }
    }
};
struct EpiAtomicF32 {
    static constexpr bool PERM = false;
    __device__ __forceinline__ void pre(int) {}
    float* C; int ldc;
    __device__ __forceinline__ void operator()(const Acc& acc, const Unit& u, int wr, int wc, int fr, int fq) const {
#pragma unroll
        for (int ai = 0; ai < 2; ++ai)
#pragma unroll
            for (int m = 0; m < 4; ++m) { float* rowp = C + (size_t)(u.r0 + ai * HALF + wr * 64 + m * 16 + fr) * ldc + u.c0 + wc * 32 + 4 * fq;
#pragma unroll
                for (int bj = 0; bj < 2; ++bj)
#pragma unroll
                    for (int n = 0; n < 2; ++n)
#pragma unroll
                        for (int e = 0; e < 4; ++e) unsafeAtomicAdd(rowp + bj * HALF + n * 16 + e, acc[ai][bj][m][n][e]); }
    }
};
struct EpiGate {
    static constexpr bool PERM = true;
    __device__ __forceinline__ void pre(int ui) { rtab = (const LAS float*)(ldsb + RSTD_LDS_OFF) + ui * 256; }
    bf16_t* O; const float* ss; const float* cb; LAS unsigned char* ldsb; const LAS float* rtab;
    __device__ __forceinline__ void operator()(const Acc& acc, const Unit& u, int wr, int wc, int fr, int fq) {
        const int lane = fr + 16 * fq;
        const float* cbp = cb + (size_t)mod_idx(u.r0) * 7936 + 4864 + u.c0 + wc * 32 + 8 * fq;
        const f32x4 cb00 = *(const f32x4*)cbp, cb01 = *(const f32x4*)(cbp + 4), cb10 = *(const f32x4*)(cbp + HALF), cb11 = *(const f32x4*)(cbp + HALF + 4);
#pragma unroll
        for (int ai = 0; ai < 2; ++ai)
#pragma unroll
            for (int m = 0; m < 4; ++m) { const int row = u.r0 + ai * HALF + wr * 64 + m * 16 + fr; const float rs = rtab[ai * HALF + wr * 64 + m * 16 + fr];
#pragma unroll
                for (int bj = 0; bj < 2; ++bj) { const int col = u.c0 + bj * HALF + wc * 32 + 8 * fq; const f32x4 v0 = acc[ai][bj][m][0] * rs + (bj ? cb10 : cb00), v1 = acc[ai][bj][m][1] * rs + (bj ? cb11 : cb01);
                    u32x4 w; w.x = cvt_pk_bf16(sigmoidf_(v0[0]), sigmoidf_(v0[1])); w.y = cvt_pk_bf16(sigmoidf_(v0[2]), sigmoidf_(v0[3]));
                    w.z = cvt_pk_bf16(sigmoidf_(v1[0]), sigmoidf_(v1[1])); w.w = cvt_pk_bf16(sigmoidf_(v1[2]), sigmoidf_(v1[3]));
                    *(u32x4*)(O + (size_t)row * 3072 + col) = w; } }
    }
};
struct EpiMerge {
    static constexpr bool PERM = true;
    __device__ __forceinline__ void pre(int) {}
    bf16_t* O;
    __device__ __forceinline__ void operator()(const Acc& acc, const Unit& u, int wr, int wc, int fr, int fq) const {
#pragma unroll
        for (int ai = 0; ai < 2; ++ai)
#pragma unroll
            for (int m = 0; m < 4; ++m) { const int row = u.r0 + ai * HALF + wr * 64 + m * 16 + fr;
#pragma unroll
                for (int bj = 0; bj < 2; ++bj) { const int col = u.c0 + bj * HALF + wc * 32 + 8 * fq; const f32x4 v0 = acc[ai][bj][m][0], v1 = acc[ai][bj][m][1];
                    bf16_t* p = O + (size_t)row * 3072 + col; const u32x4 gg = *(const u32x4*)p;
                    u32x4 w; w.x = cvt_pk_bf16(v0[0] * bflo(gg.x), v0[1] * bfhi(gg.x)); w.y = cvt_pk_bf16(v0[2] * bflo(gg.y), v0[3] * bfhi(gg.y));
                    w.z = cvt_pk_bf16(v1[0] * bflo(gg.z), v1[1] * bfhi(gg.z)); w.w = cvt_pk_bf16(v1[2] * bflo(gg.w), v1[3] * bfhi(gg.w));
                    *(u32x4*)p = w; } }
    }
};
struct EpiMergeAcc {
    static constexpr bool PERM = true;
    __device__ __forceinline__ void pre(int) {}
    bf16_t* M; const bf16_t* G;
    __device__ __forceinline__ void operator()(const Acc& acc, const Unit& u, int wr, int wc, int fr, int fq) const {
        const bool first = u.c0 < 1024;
#pragma unroll
        for (int ai = 0; ai < 2; ++ai) {
#pragma unroll
          for (int mh = 0; mh < 4; mh += 2) {
            u32x4 gg[4][2], mm[4][2];
#pragma unroll
            for (int m = mh; m < mh + 2; ++m) { const int row = u.r0 + ai * HALF + wr * 64 + m * 16 + fr;
#pragma unroll
                for (int bj = 0; bj < 2; ++bj) { const int col = u.c0 + bj * HALF + wc * 32 + 8 * fq;
                    gg[m][bj] = *(const u32x4*)(G + (size_t)row * 3072 + col);
                    mm[m][bj] = first ? (u32x4){0u, 0u, 0u, 0u} : *(const u32x4*)(M + (size_t)row * 1024 + (col & 1023)); } }
#pragma unroll
            for (int m = mh; m < mh + 2; ++m) { const int row = u.r0 + ai * HALF + wr * 64 + m * 16 + fr;
#pragma unroll
                for (int bj = 0; bj < 2; ++bj) { const int col = u.c0 + bj * HALF + wc * 32 + 8 * fq; const f32x4 v0 = acc[ai][bj][m][0], v1 = acc[ai][bj][m][1];
                    const u32x4 g4 = gg[m][bj], m4 = mm[m][bj];
                    u32x4 w; w.x = cvt_pk_bf16(v0[0] * bflo(g4.x) + bflo(m4.x), v0[1] * bfhi(g4.x) + bfhi(m4.x)); w.y = cvt_pk_bf16(v0[2] * bflo(g4.y) + bflo(m4.y), v0[3] * bfhi(g4.y) + bfhi(m4.y));
                    w.z = cvt_pk_bf16(v1[0] * bflo(g4.z) + bflo(m4.z), v1[1] * bfhi(g4.z) + bfhi(m4.z)); w.w = cvt_pk_bf16(v1[2] * bflo(g4.w) + bflo(m4.w), v1[3] * bfhi(g4.w) + bfhi(m4.w));
                    *(u32x4*)(M + (size_t)row * 1024 + (col & 1023)) = w; } } } }
    }
};
struct EpiMergeHN {
    static constexpr bool PERM = true;
    __device__ __forceinline__ void pre(int) {}
    bf16_t* M; const bf16_t* G; f32x4 tot[2][4][2];
    __device__ __forceinline__ void operator()(const f32x4 (&acc)[2][1][4][2], const Unit& u, int wr, int wc, int fr, int fq) {
        const int br = u.c0 >> 10, col = u.c0 + wc * 32 + 8 * fq;
        u32x4 gg[2][4];
#pragma unroll
        for (int ai = 0; ai < 2; ++ai)
#pragma unroll
            for (int m = 0; m < 4; ++m) gg[ai][m] = *(const u32x4*)(G + (size_t)(u.r0 + ai * HALF + wr * 64 + m * 16 + fr) * 3072 + col);
#pragma unroll
        for (int ai = 0; ai < 2; ++ai)
#pragma unroll
            for (int m = 0; m < 4; ++m) { const u32x4 g4 = gg[ai][m]; const f32x4 v0 = acc[ai][0][m][0], v1 = acc[ai][0][m][1];
                const f32x4 p0 = {v0[0] * bflo(g4.x), v0[1] * bfhi(g4.x), v0[2] * bflo(g4.y), v0[3] * bfhi(g4.y)}, p1 = {v1[0] * bflo(g4.z), v1[1] * bfhi(g4.z), v1[2] * bflo(g4.w), v1[3] * bfhi(g4.w)};
                tot[ai][m][0] += p0; tot[ai][m][1] += p1; }
        if (br == 2) {
#pragma unroll
            for (int ai = 0; ai < 2; ++ai)
#pragma unroll
                for (int m = 0; m < 4; ++m) { const f32x4 t0 = tot[ai][m][0], t1 = tot[ai][m][1];
                    u32x4 w; w.x = cvt_pk_bf16(t0[0], t0[1]); w.y = cvt_pk_bf16(t0[2], t0[3]); w.z = cvt_pk_bf16(t1[0], t1[1]); w.w = cvt_pk_bf16(t1[2], t1[3]);
                    *(u32x4*)(M + (size_t)(u.r0 + ai * HALF + wr * 64 + m * 16 + fr) * 1024 + (col & 1023)) = w;
                    tot[ai][m][0] = (f32x4){0.f, 0.f, 0.f, 0.f}; tot[ai][m][1] = (f32x4){0.f, 0.f, 0.f, 0.f}; } }
    }
};
struct EpiResid {
    static constexpr bool PERM = true;
    __device__ __forceinline__ void pre(int) {}
    bf16_t* X; const float* gate;
    __device__ __forceinline__ void operator()(const Acc& acc, const Unit& u, int wr, int wc, int fr, int fq) const {
        const float* gp = gate + (size_t)mod_idx(u.r0) * 6144;
#pragma unroll
        for (int bj = 0; bj < 2; ++bj) { const int col = u.c0 + bj * HALF + wc * 32 + 8 * fq;
            const f32x4 gv0 = *(const f32x4*)(gp + col), gv1 = *(const f32x4*)(gp + col + 4);
#pragma unroll
            for (int ai = 0; ai < 2; ++ai) {
                u32x4 xv[4];
#pragma unroll
                for (int m = 0; m < 4; ++m) xv[m] = *(const u32x4*)(X + (size_t)(u.r0 + ai * HALF + wr * 64 + m * 16 + fr) * DM + col);
#pragma unroll
                for (int m = 0; m < 4; ++m) { const u32x4 a = xv[m];
                    const f32x4 y0 = (f32x4){bflo(a.x), bfhi(a.x), bflo(a.y), bfhi(a.y)} + gv0 * acc[ai][bj][m][0], y1 = (f32x4){bflo(a.z), bfhi(a.z), bflo(a.w), bfhi(a.w)} + gv1 * acc[ai][bj][m][1];
                    *(u32x4*)(X + (size_t)(u.r0 + ai * HALF + wr * 64 + m * 16 + fr) * DM + col) = (u32x4){cvt_pk_bf16(y0[0], y0[1]), cvt_pk_bf16(y0[2], y0[3]), cvt_pk_bf16(y1[0], y1[1]), cvt_pk_bf16(y1[2], y1[3])}; } } }
    }
};
struct EpiResidN {
    static constexpr bool PERM = true;
    __device__ __forceinline__ void pre(int) {}
    bf16_t* X; const float* gate; bf16_t* Hn; float* ss; const float* g; const float* sc;
    __device__ __forceinline__ void operator()(const Acc& acc, const Unit& u, int wr, int wc, int fr, int fq) const {
        const int mi = mod_idx(u.r0); const float* gp = gate + (size_t)mi * 6144; const float* scp = sc + (size_t)mi * 6144;
        const int lane = fr + 16 * fq;
#pragma unroll
        for (int ai = 0; ai < 2; ++ai) {
            float rs[4] = {0.f, 0.f, 0.f, 0.f};
#pragma unroll
            for (int bj = 0; bj < 2; ++bj) { const int col = u.c0 + bj * HALF + wc * 32 + 8 * fq;
                const f32x4 gv0 = *(const f32x4*)(gp + col), gv1 = *(const f32x4*)(gp + col + 4);
                const f32x4 gn0 = *(const f32x4*)(g + col), gn1 = *(const f32x4*)(g + col + 4), gs0 = *(const f32x4*)(scp + col), gs1 = *(const f32x4*)(scp + col + 4);
                const f32x4 gm0 = gn0 + gn0 * gs0, gm1 = gn1 + gn1 * gs1;
                u32x4 xv[4];
#pragma unroll
                for (int m = 0; m < 4; ++m) xv[m] = *(const u32x4*)(X + (size_t)(u.r0 + ai * HALF + wr * 64 + m * 16 + fr) * DM + col);
#pragma unroll
                for (int m = 0; m < 4; ++m) { const int row = u.r0 + ai * HALF + wr * 64 + m * 16 + fr; const u32x4 a = xv[m];
                    const f32x4 y0 = (f32x4){bflo(a.x), bfhi(a.x), bflo(a.y), bfhi(a.y)} + gv0 * acc[ai][bj][m][0], y1 = (f32x4){bflo(a.z), bfhi(a.z), bflo(a.w), bfhi(a.w)} + gv1 * acc[ai][bj][m][1];
                    *(u32x4*)(X + (size_t)row * DM + col) = (u32x4){cvt_pk_bf16(y0[0], y0[1]), cvt_pk_bf16(y0[2], y0[3]), cvt_pk_bf16(y1[0], y1[1]), cvt_pk_bf16(y1[2], y1[3])};
                    rs[m] += (y0[0] * y0[0] + y0[1] * y0[1]) + (y0[2] * y0[2] + y0[3] * y0[3]) + (y1[0] * y1[0] + y1[1] * y1[1]) + (y1[2] * y1[2] + y1[3] * y1[3]);
                    const f32x4 h0 = y0 * gm0, h1 = y1 * gm1;
                    *(u32x4*)(Hn + (size_t)row * DM + col) = (u32x4){cvt_pk_bf16(h0[0], h0[1]), cvt_pk_bf16(h0[2], h0[3]), cvt_pk_bf16(h1[0], h1[1]), cvt_pk_bf16(h1[2], h1[3])}; } }
#pragma unroll
            for (int m = 0; m < 4; ++m) { float v = rs[m]; v += lane_read(v, lane ^ 16); v += lane_read(v, lane ^ 32);
                if (fq == 0) ss[(size_t)(u.r0 + ai * HALF + wr * 64 + m * 16 + fr) * 16 + (u.c0 >> 8) * 4 + wc] = v; } }
    }
};
struct EpiGU2 {
    static constexpr bool PERM = true;
    __device__ __forceinline__ void pre(int ui) { rtab = (const LAS float*)(ldsb + RSTD_LDS_OFF) + ui * 256; }
    bf16_t* O; const float* ss; const float* cb; LAS unsigned char* ldsb; const LAS float* rtab;
    __device__ __forceinline__ void operator()(const Acc& acc, const Unit& u, int wr, int wc, int fr, int fq) {
        const int col = (u.c0 >> 1) + wc * 32 + 8 * fq, lane = fr + 16 * fq;
        const float* cbp = cb + (size_t)mod_idx(u.r0) * 5632 + u.c0 + wc * 32 + 8 * fq;
        const f32x4 cg0 = *(const f32x4*)cbp, cg1 = *(const f32x4*)(cbp + 4), cu0 = *(const f32x4*)(cbp + HALF), cu1 = *(const f32x4*)(cbp + HALF + 4);
#pragma unroll
        for (int ai = 0; ai < 2; ++ai)
#pragma unroll
            for (int m = 0; m < 4; ++m) { const int row = u.r0 + ai * HALF + wr * 64 + m * 16 + fr;
                const float rs = rtab[ai * HALF + wr * 64 + m * 16 + fr];
                const f32x4 g0 = acc[ai][0][m][0] * rs + cg0, g1 = acc[ai][0][m][1] * rs + cg1, u0 = acc[ai][1][m][0] * rs + cu0, u1 = acc[ai][1][m][1] * rs + cu1;
                u32x4 w; w.x = cvt_pk_bf16(siluf_(g0[0]) * u0[0], siluf_(g0[1]) * u0[1]); w.y = cvt_pk_bf16(siluf_(g0[2]) * u0[2], siluf_(g0[3]) * u0[3]);
                w.z = cvt_pk_bf16(siluf_(g1[0]) * u1[0], siluf_(g1[1]) * u1[1]); w.w = cvt_pk_bf16(siluf_(g1[2]) * u1[2], siluf_(g1[3]) * u1[3]);
                *(u32x4*)(O + (size_t)row * DFF + col) = w; }
    }
};
struct EpiGU {
    static constexpr bool PERM = true;
    __device__ __forceinline__ void pre(int) {}
    bf16_t* O;
    __device__ __forceinline__ void operator()(const Acc& acc, const Unit& u, int wr, int wc, int fr, int fq) const {
        const int col = (u.c0 >> 1) + wc * 32 + 8 * fq;
#pragma unroll
        for (int ai = 0; ai < 2; ++ai)
#pragma unroll
            for (int m = 0; m < 4; ++m) { const int row = u.r0 + ai * HALF + wr * 64 + m * 16 + fr;
                const f32x4 g0 = acc[ai][0][m][0], g1 = acc[ai][0][m][1], u0 = acc[ai][1][m][0], u1 = acc[ai][1][m][1];
                u32x4 w; w.x = cvt_pk_bf16(siluf_(g0[0]) * u0[0], siluf_(g0[1]) * u0[1]); w.y = cvt_pk_bf16(siluf_(g0[2]) * u0[2], siluf_(g0[3]) * u0[3]);
                w.z = cvt_pk_bf16(siluf_(g1[0]) * u1[0], siluf_(g1[1]) * u1[1]); w.w = cvt_pk_bf16(siluf_(g1[2]) * u1[2], siluf_(g1[3]) * u1[3]);
                *(u32x4*)(O + (size_t)row * DFF + col) = w; }
    }
};
}

#define XB_TMO      128
#define XB_XCNT(j)  (256  + 64 * (j))
#define XB_XSUB(j)  (1280 + 64 * (j))
#define XB_XGEN(j)  (2304 + 64 * (j))
#define XB_TOP      3328
#define XB_TOPGEN   3392
#define XCD_BAR_WORDS 3456
#define XB_SPIN_CAP (1u << 18)
__device__ __forceinline__ unsigned xb_ld(unsigned* p)              { return __hip_atomic_load(p, __ATOMIC_RELAXED, __HIP_MEMORY_SCOPE_AGENT); }
__device__ __forceinline__ unsigned xb_add(unsigned* p, unsigned v) { return __hip_atomic_fetch_add(p, v, __ATOMIC_RELAXED, __HIP_MEMORY_SCOPE_AGENT); }
__device__ __forceinline__ unsigned xb_xcc_id() { return (unsigned)__builtin_amdgcn_s_getreg((3 << 11) | 20) & 0xFu; }
#define XB_SPIN(cond, bar) do { unsigned _sp = 0; while (cond) { __builtin_amdgcn_s_sleep(1); \
    if ((++_sp & 255u) == 0u) { if (xb_ld(&(bar)[XB_TMO])) break; if (_sp > XB_SPIN_CAP) { atomicAdd(&(bar)[XB_TMO], 1u); break; } } } } while (0)
struct XcdBarrier { unsigned* bar; unsigned x; volatile LAS unsigned* st; };
__device__ __forceinline__ XcdBarrier xcd_barrier_post(unsigned* bar, volatile LAS unsigned* st) {
    XcdBarrier b; b.bar = bar; b.x = xb_xcc_id(); b.st = st;
    if (threadIdx.x == 0) (void)xb_add(&bar[XB_XCNT(b.x)], 1u);
    return b;
}
__device__ __forceinline__ void xcd_barrier_complete(unsigned* bar, unsigned x, unsigned& nloc, unsigned& nx) {
    const unsigned G = gridDim.x * gridDim.y * gridDim.z;
    unsigned sum, cnt, mine, sp = 0u;
    for (;;) {
        sum = 0u; cnt = 0u; mine = 0u;
#pragma unroll 1
        for (unsigned j = 0; j < 16; ++j) { const unsigned c = xb_ld(&bar[XB_XCNT(j)]); sum += c; cnt += (c > 0u) ? 1u : 0u; mine = (j == x) ? c : mine; }
        if (sum == G) break;
        __builtin_amdgcn_s_sleep(1);
        if ((++sp & 255u) == 0u) { if (xb_ld(&bar[XB_TMO])) break; if (sp > XB_SPIN_CAP) { atomicAdd(&bar[XB_TMO], 1u); break; } }
    }
    nloc = mine > 0u ? mine : 1u; nx = cnt > 0u ? cnt : 1u;
}
__device__ __forceinline__ void xcd_barrier(const XcdBarrier& b) {
    asm volatile("s_waitcnt vmcnt(0)" ::: "memory");
    __syncthreads();
    if (threadIdx.x == 0) {
        unsigned* bar = opq(b.bar);
        __builtin_amdgcn_s_waitcnt(0);
        unsigned nloc = b.st[0], nx = b.st[1];
        if (nloc == 0u) { xcd_barrier_complete(bar, b.x, nloc, nx); b.st[0] = nloc; b.st[1] = nx; }
        const unsigned old = xb_add(&bar[XB_XSUB(b.x)], 1u);
        const unsigned gen = old / nloc;
        if (old + 1u == (gen + 1u) * nloc) {
            __builtin_amdgcn_fence(__ATOMIC_RELEASE, "agent");
            asm volatile("s_waitcnt vmcnt(0)" ::: "memory");
            const unsigned og = xb_add(&bar[XB_TOP], 1u);
            const unsigned tg = og / nx;
            if (og + 1u == (tg + 1u) * nx) xb_add(&bar[XB_TOPGEN], 1u);
            else XB_SPIN(xb_ld(&bar[XB_TOPGEN]) == tg, bar);
            __builtin_amdgcn_fence(__ATOMIC_ACQUIRE, "agent");
            xb_add(&bar[XB_XGEN(b.x)], 1u);
            asm volatile("s_waitcnt vmcnt(0)" ::: "memory");
        } else {
            XB_SPIN(xb_ld(&bar[XB_XGEN(b.x)]) == gen, bar);
            __builtin_amdgcn_fence(__ATOMIC_ACQUIRE, "agent");
            asm volatile("s_waitcnt vmcnt(0)" ::: "memory");
        }
    }
    __syncthreads();
}

struct Args { const float* in[N_IN]; float* out; unsigned char* ws; int ph_lo, ph_hi, li, pad; };
struct Frame {
    LAS unsigned char* lds; const float* const* in; float* out; unsigned char* ws; unsigned* ctl;
    int tid, lane, wave, G, bid;
};
#define PROF_DECL do {} while (0)
#define PROF_FLUSH() do {} while (0)
__device__ __forceinline__ int q_next(Frame& F, int qid) {
    volatile LAS int* slot = (volatile LAS int*)(F.lds + MISC_OFF + 64);
    __syncthreads();
    if (F.tid == 0) *slot = (int)__hip_atomic_fetch_add(F.ctl + CW_Q + 64 * qid, 1u, RLX_AGENT);
    __syncthreads();
    return *slot;
}

__device__ __forceinline__ void transpose_item(const float* W, int ld_src, int col0, bf16_t* WT, int ld_dst, int dst_k0, int row0, int k0, LAS float* scr, int lane) {
    float tv[32];
#pragma unroll
    for (int i = 0; i < 32; ++i) tv[i] = W[(size_t)(k0 + 2 * i + (lane >> 5)) * ld_src + col0 + (lane & 31)];
#pragma unroll
    for (int i = 0; i < 32; ++i) scr[(2 * i + (lane >> 5)) * 33 + (lane & 31)] = tv[i];
    LDS_WAIT(); asm volatile("" ::: "memory");
    const int c = lane & 7;
#pragma unroll
    for (int j = 0; j < 4; ++j) { const int n = (lane >> 3) + 8 * j; const LAS float* s = scr + (8 * c) * 33 + n;
        u32x4 o; o.x = pk2(s[0 * 33], s[1 * 33]); o.y = pk2(s[2 * 33], s[3 * 33]); o.z = pk2(s[4 * 33], s[5 * 33]); o.w = pk2(s[6 * 33], s[7 * 33]);
        *(u32x4*)(WT + (size_t)(row0 + n) * ld_dst + dst_k0 + k0 + 8 * c) = o; }
    LDS_WAIT(); asm volatile("" ::: "memory");
}
struct TrItem { const float* src; bf16_t* dst; int ld_src, ld_dst; };
__device__ __forceinline__ int tr_part(int r) {
    constexpr int NI_QKVZBA = 16 * (2080 / 32), NI_HY = 16 * 48, NI_G = 16 * 96, NI_P = 8 * 32, NI_O = 16 * 32, NI_GU = 16 * 176;
    return r < NI_QKVZBA + NI_HY ? 0 : (r < NI_QKVZBA + NI_HY + NI_G ? 1 : (r < NI_QKVZBA + NI_HY + NI_G + 3 * NI_P ? 2 : (r < NI_QKVZBA + NI_HY + NI_G + 3 * NI_P + 3 * NI_O ? 3 : (r < NI_QKVZBA + NI_HY + NI_G + 3 * NI_P + 3 * NI_O + NI_GU ? 4 : 5))));
}
__device__ __forceinline__ TrItem tr_decode(Frame& F, int l, int r) {
    constexpr int NI_QKVZBA = 16 * (2080 / 32), NI_HY = 16 * 48, NI_G = 16 * 96, NI_P = 8 * 32, NI_O = 16 * 32, NI_GU = 16 * 176;
    const float* w_in = F.in[I_WIN] + (size_t)l * DM * DIN; unsigned char* ws = F.ws;
    const float* src; int ld_src, col0, ld_dst, dst_k0, row0, k0; bf16_t* dst;
    if (r < NI_QKVZBA) { const int nb = r % 65, kb = r / 65; src = w_in; ld_src = DIN; col0 = nb * 32; dst = (bf16_t*)(ws + W_N); ld_dst = 1024; dst_k0 = 0; row0 = nb * 32; k0 = kb * 64; }
    else if ((r -= NI_QKVZBA) < NI_HY) { const int nb = r % 48, kb = r / 48; src = w_in; ld_src = DIN; col0 = OFF_HY + nb * 32; dst = (bf16_t*)(ws + W_S); ld_dst = 1024; dst_k0 = 0; row0 = nb * 32; k0 = kb * 64; }
    else if ((r -= NI_HY) < NI_G) { const int nb = r % 96, kb = r / 96; src = w_in; ld_src = DIN; col0 = OFF_GATE + nb * 32; dst = (bf16_t*)(ws + W_G); ld_dst = 1024; dst_k0 = 0; row0 = nb * 32; k0 = kb * 64; }
    else if ((r -= NI_G) < 3 * NI_P) { const int j = r / NI_P, q = r % NI_P, nb = q % 32, kb = q / 32; src = (j == 0 ? F.in[I_WPA] : (j == 1 ? F.in[I_WPB] : F.in[I_WPC])) + (size_t)l * 512 * 1024;
        ld_src = 1024; col0 = nb * 32; dst = (bf16_t*)(ws + W_P) + (size_t)j * 1024 * 512; ld_dst = 512; dst_k0 = 0; row0 = nb * 32; k0 = kb * 64; }
    else if ((r -= 3 * NI_P) < 3 * NI_O) { const int j = r / NI_O, q = r % NI_O, nb = q % 32, kb = q / 32; src = F.in[I_WO] + (size_t)l * 1024 * 1024;
        ld_src = 1024; col0 = nb * 32; dst = (bf16_t*)(ws + W_O3); ld_dst = 3072; dst_k0 = j * 1024; row0 = nb * 32; k0 = kb * 64; }
    else if ((r -= 3 * NI_O) < NI_GU) { const int nb = r % 176, kb = r / 176; const int n0 = nb * 32, up = n0 >= DFF ? 1 : 0, nn = n0 - up * DFF;
        src = F.in[I_WGU] + (size_t)l * 1024 * 5632; ld_src = 5632; col0 = n0; dst = (bf16_t*)(ws + W_GU); ld_dst = 1024; dst_k0 = 0; row0 = 256 * (nn / 128) + 128 * up + (nn % 128); k0 = kb * 64; }
    else { r -= NI_GU; const int nb = r % 32, kb = r / 32; src = F.in[I_WDOWN] + (size_t)l * DFF * 1024; ld_src = 1024; col0 = nb * 32; dst = (bf16_t*)(ws + W_DN); ld_dst = DFF; dst_k0 = 0; row0 = nb * 32; k0 = kb * 64; }
    TrItem t; t.src = src + (size_t)k0 * ld_src + col0; t.dst = dst + (size_t)row0 * ld_dst + dst_k0 + k0; t.ld_src = ld_src; t.ld_dst = ld_dst; return t;
}
__device__ __forceinline__ void prep_weights(Frame& F, int l, int mask) {
    LAS float* scr = (LAS float*)(F.lds + F.wave * 16384);
    const int gw = F.bid * NWAVES + F.wave, NGW = F.G * NWAVES, lane = F.lane;
    unsigned char* ws = F.ws; const float* w_in = F.in[I_WIN] + (size_t)l * DM * DIN;
    constexpr int NITEMS = 16 * 65 + 16 * 48 + 16 * 96 + 3 * 8 * 32 + 3 * 16 * 32 + 16 * 176 + 44 * 32;
    int it = gw;
    while (it < NITEMS && !((mask >> tr_part(it)) & 1)) it += NGW;
    float tv[32]; TrItem cur{};
    if (it < NITEMS) { cur = tr_decode(F, l, it);
#pragma unroll
        for (int i = 0; i < 32; ++i) tv[i] = cur.src[(size_t)(2 * i + (lane >> 5)) * cur.ld_src + (lane & 31)]; }
#pragma unroll 1
    while (it < NITEMS) {
        int nx = it + NGW;
        while (nx < NITEMS && !((mask >> tr_part(nx)) & 1)) nx += NGW;
        float tn[32]; TrItem nxt = cur;
        if (nx < NITEMS) { nxt = tr_decode(F, l, nx);
#pragma unroll
            for (int i = 0; i < 32; ++i) tn[i] = nxt.src[(size_t)(2 * i + (lane >> 5)) * nxt.ld_src + (lane & 31)]; }
        else {
#pragma unroll
            for (int i = 0; i < 32; ++i) tn[i] = 0.f; }
#pragma unroll
        for (int i = 0; i < 32; ++i) scr[(2 * i + (lane >> 5)) * 33 + (lane & 31)] = tv[i];
        LDS_WAIT(); asm volatile("" ::: "memory");
        { const int c = lane & 7;
#pragma unroll
          for (int j = 0; j < 4; ++j) { const int n = (lane >> 3) + 8 * j; const LAS float* s = scr + (8 * c) * 33 + n;
              u32x4 o; o.x = pk2(s[0 * 33], s[1 * 33]); o.y = pk2(s[2 * 33], s[3 * 33]); o.z = pk2(s[4 * 33], s[5 * 33]); o.w = pk2(s[6 * 33], s[7 * 33]);
              *(u32x4*)(cur.dst + (size_t)n * cur.ld_dst + 8 * c) = o; } }
        LDS_WAIT(); asm volatile("" ::: "memory");
#pragma unroll
        for (int i = 0; i < 32; ++i) tv[i] = tn[i];
        cur = nxt; it = nx;
    }
    if (!(mask & 1)) return;
    { u32x4* z = (u32x4*)(ws + W_N + (size_t)2080 * 1024 * 2); const int n16 = 224 * 1024 * 2 / 16;
      for (int i = F.bid * NTHR + F.tid; i < n16; i += F.G * NTHR) z[i] = (u32x4){0u, 0u, 0u, 0u}; }
    __syncthreads();
    {
        LAS float* tile = (LAS float*)F.lds;
        LAS float* ctab = tile + 64 * 65;
        if (F.tid < 64) { ctab[F.tid] = cos_rev((float)F.tid / 64.0f); ctab[64 + F.tid] = sin_rev((float)F.tid / 64.0f); }
        const bool pro = F.G == 256;
        for (int task = pro ? (F.bid < 112 ? 111 - F.bid : 128) : F.bid; task < 128; task += pro ? 112 : F.G) {
            const int kb = task >> 3, g = task & 7;
            __syncthreads();
            for (int i = F.tid; i < 4096; i += NTHR) { const int kk = i >> 6, cc = i & 63; tile[kk * 65 + cc] = w_in[(size_t)(kb * 64 + kk) * DIN + OFF_FN + g * 64 + cc]; }
            __syncthreads();
            const int kk = F.tid & 63, cq = F.tid >> 6;
#pragma unroll 1
            for (int j = 0; j < 8; ++j) { const int c = cq * 8 + j; float ac = 0.f, as = 0.f;
#pragma unroll 4
                for (int cp = 0; cp < 64; ++cp) { const float w = tile[kk * 65 + cp]; const int idx = (c * cp) & 63; ac += w * ctab[idx]; as += w * ctab[64 + idx]; }
                bf16_t* d = (bf16_t*)(ws + W_S);
                d[(size_t)(1536 + g * 64 + c) * 1024 + kb * 64 + kk] = (bf16_t)f2bf(ac);
                d[(size_t)(2048 + g * 64 + c) * 1024 + kb * 64 + kk] = (bf16_t)f2bf(as); }
        }
        __syncthreads();
    }
}
typedef float f32x16 __attribute__((ext_vector_type(16)));
__device__ __forceinline__ void prep_filters(Frame& F, int l) {
    LAS bf16_t* h2b = (LAS bf16_t*)F.lds;
    LAS bf16_t* w3t = h2b + 64 * 72;
    LAS float* zp = (LAS float*)w3t;
    LAS float* h1 = zp + 64 * 33;
    LAS float* w1s = h1 + 64 * 64;
    LAS float* w2s = w1s + 33 * 64;
    const float* w1 = F.in[I_HW1] + l * 33 * 64; const float* b1 = F.in[I_HB1] + l * 64; const float* fq = F.in[I_HFREQ] + l * 64;
    const float* w2 = F.in[I_HW2] + l * 64 * 64; const float* b2 = F.in[I_HB2] + l * 64; const float* w3 = F.in[I_HW3] + (size_t)l * 64 * 2048;
    for (int task4 = F.G - 1 - F.bid; task4 < 144; task4 += F.G) {
        const int task = task4 >> 2, qsel = task4 & 3;
        const int L = task < 32 ? LLAT : LCTX, t0 = (task < 32 ? task : task - 32) * 64;
        bf16_t* fil = (bf16_t*)(F.ws + (task < 32 ? WS_FILL : WS_FILC));
        float wcol[64];
#pragma unroll
        for (int k = 0; k < 64; ++k) wcol[k] = w3[(size_t)k * 2048 + qsel * 512 + F.tid];
        unsigned wpk[32];
#pragma unroll
        for (int k = 0; k < 32; ++k) wpk[k] = pk2(wcol[2 * k], wcol[2 * k + 1]);
        __syncthreads();
        for (int i = F.tid; i < 33 * 64; i += NTHR) w1s[i] = w1[i];
        for (int i = F.tid; i < 64 * 64; i += NTHR) w2s[i] = w2[i];
        for (int i = F.tid; i < 64 * 33; i += NTHR) { const int tt = i / 33, e = i % 33; const int ti = t0 + tt;
            float v;
            if (e == 0) v = (float)ti / (float)(L - 1);
            else { const int b = (e - 1) & 15; const float fr = 1e-4f + (15.0f - 1e-4f) * (float)b / 15.0f; const float rv = fr * ((float)ti / (float)L);
                   v = e <= 16 ? cos_rev(rv) : -sin_rev(rv); }
            zp[i] = v; }
        __syncthreads();
        for (int i = F.tid; i < 4096; i += NTHR) { const int tt = i >> 6, j = i & 63; float a = b1[j];
            for (int e = 0; e < 33; ++e) a += zp[tt * 33 + e] * w1s[e * 64 + j];
            h1[i] = sin_rad(fq[j] * a); }
        __syncthreads();
        for (int i = F.tid; i < 4096; i += NTHR) { const int tt = i >> 6, j = i & 63; float a = b2[j];
            for (int k = 0; k < 64; ++k) a += h1[tt * 64 + k] * w2s[k * 64 + j];
            h2b[tt * 72 + j] = (bf16_t)f2bf(sin_rad(fq[j] * a)); }
        __syncthreads();
#pragma unroll
        for (int m = 0; m < 8; ++m) *(LAS u32x4*)(w3t + F.tid * 72 + 8 * m) = (u32x4){wpk[4 * m], wpk[4 * m + 1], wpk[4 * m + 2], wpk[4 * m + 3]};
        __syncthreads();
        const int r = F.lane & 31, hh = F.lane >> 5;
        const float dmin = 4.605170185988091f / 1.5f, dmax = 4.605170185988091f / 0.3f;
#pragma unroll 1
        for (int tile = 0; tile < 4; ++tile) { const int ct = 2 * F.wave + (tile & 1), rt = tile >> 1;
            const LAS bf16_t* Am = h2b + (32 * rt + r) * 72 + 8 * hh; const LAS bf16_t* Bm = w3t + (32 * ct + r) * 72 + 8 * hh;
            f32x16 acc;
#pragma unroll
            for (int e = 0; e < 16; ++e) acc[e] = 0.f;
#pragma unroll
            for (int ks = 0; ks < 4; ++ks) acc = __builtin_amdgcn_mfma_f32_32x32x16_bf16(*(const LAS bf16x8*)(Am + 16 * ks), *(const LAS bf16x8*)(Bm + 16 * ks), acc, 0, 0, 0);
            const int c = 32 * ct + r, n = qsel * 512 + c; const float delta = dmin + (dmax - dmin) * (float)c / 511.0f;
            bf16_t* dst = fil + (size_t)n * L + t0;
#pragma unroll
            for (int g = 0; g < 4; ++g) { const int tt4 = 32 * rt + 8 * g + 4 * hh; float v[4];
#pragma unroll
                for (int e = 0; e < 4; ++e) { const float tl = (float)(t0 + tt4 + e) / (float)(L - 1); v[e] = acc[4 * g + e] * expf(-tl * delta); }
                *(u32x2*)(dst + tt4) = (u32x2){pk2(v[0], v[1]), pk2(v[2], v[3])}; } }
    }
    __syncthreads();
}
__device__ __forceinline__ void prep_mod(Frame& F) {
    LAS float* sc = (LAS float*)F.lds;
    LAS float* red = sc + 3 * 1024;
    __syncthreads();
    for (int i = F.tid; i < 3 * 1024; i += NTHR) { const int mi = i >> 10, k = i & 1023; const float v = mi == 0 ? F.in[I_CCTX][k] : F.in[I_C][(mi - 1) * 1024 + k]; sc[i] = v / (1.f + expf(-v)); }
    __syncthreads();
    float* mod = (float*)(F.ws + WS_MOD);
    const int modG = F.G == 256 ? 96 : F.G;
    for (int task = F.bid < modG ? F.bid : 192; task < 192; task += modG) {
        const int l = task / 96, j = task % 96, n = j * 64 + F.lane;
        const float* w = F.in[I_WMOD] + (size_t)l * 1024 * 6144 + n;
        float a0 = 0.f, a1 = 0.f, a2 = 0.f;
        const int kb = F.wave * 128;
        float wv[128];
#pragma unroll
        for (int k = 0; k < 128; ++k) wv[k] = w[(size_t)(kb + k) * 6144];
#pragma unroll
        for (int k = 0; k < 128; ++k) { a0 += sc[kb + k] * wv[k]; a1 += sc[1024 + kb + k] * wv[k]; a2 += sc[2048 + kb + k] * wv[k]; }
        red[(F.wave * 3 + 0) * 64 + F.lane] = a0; red[(F.wave * 3 + 1) * 64 + F.lane] = a1; red[(F.wave * 3 + 2) * 64 + F.lane] = a2;
        __syncthreads();
        if (F.tid < 192) { const int mi = F.tid >> 6, ln = F.tid & 63; float s = F.in[I_BMOD][l * 6144 + j * 64 + ln];
            for (int w8 = 0; w8 < 8; ++w8) s += red[(w8 * 3 + mi) * 64 + ln];
            mod[((size_t)l * 3 + mi) * 6144 + j * 64 + ln] = s; }
        __syncthreads();
    }
}
__device__ __forceinline__ void prep_bias(Frame& F, const float* sh_, const bf16_t* W_, float* cb, int nrows) {
    const float* sh = sh_ + 16 * F.lane; const bf16_t* W = W_ + 16 * F.lane;
    const int gw = F.bid * NWAVES + F.wave, NGW = F.G * NWAVES;
    for (int n = gw; n < nrows; n += NGW) { const u32x4 a = *(const u32x4*)(W + (size_t)n * 1024), b = *(const u32x4*)(W + (size_t)n * 1024 + 8);
        const unsigned ww[8] = {a.x, a.y, a.z, a.w, b.x, b.y, b.z, b.w};
#pragma unroll
        for (int mi = 0; mi < 3; ++mi) { float s = 0.f;
#pragma unroll
            for (int j = 0; j < 8; ++j) s += bflo(ww[j]) * sh[mi * 6144 + 2 * j] + bfhi(ww[j]) * sh[mi * 6144 + 2 * j + 1];
            s = wave_sum(s, F.lane);
            if (F.lane == 0) cb[mi * nrows + n] = s; } }
}
__device__ __forceinline__ void prep_bias_gu(Frame& F, int l) {
    prep_bias(F, (const float*)(F.ws + WS_MOD) + (size_t)l * 3 * 6144 + 3072, (const bf16_t*)(F.ws + W_GU), (float*)(F.ws + WS_CB) + (size_t)l * 3 * 5632, 5632);
}
__device__ __forceinline__ void prep_bias_in(Frame& F, int l) {
    prep_bias(F, (const float*)(F.ws + WS_MOD) + (size_t)l * 3 * 6144, (const bf16_t*)(F.ws + W_N), (float*)(F.ws + WS_CB1) + (size_t)l * 3 * 7936, 7936);
}
__device__ __forceinline__ void prep_tabl(Frame& F) {
    const int gt = F.bid * NTHR + F.tid, NG = F.G * NTHR;
    for (int i = gt; i < 2048 * 4096 / 8; i += NG) { const int tp = i >> 9, k0 = (i & 511) * 8; unsigned w[4];
#pragma unroll
        for (int u = 0; u < 4; ++u) { float v[2];
#pragma unroll
            for (int e = 0; e < 2; ++e) { const int k = k0 + 2 * u + e; const int m = (tp * (k & 2047)) & 2047; const float x = (float)m / 2048.0f; v[e] = k < 2048 ? cos_rev(x) : -sin_rev(x); }
            w[u] = pk2(v[0], v[1]); }
        *(u32x4*)((bf16_t*)(F.ws + WS_TABL) + (size_t)tp * 4096 + k0) = (u32x4){w[0], w[1], w[2], w[3]}; }
}
__device__ __forceinline__ void prep_x_tables(Frame& F) {
    const int gt = F.bid * NTHR + F.tid, NG = F.G * NTHR;
    prep_tabl(F);
    for (int i = gt; i < 256 * 512 / 8; i += NG) { const int tp = i >> 6, k0 = (i & 63) * 8; unsigned w[4];
#pragma unroll
        for (int u = 0; u < 4; ++u) { float v[2];
#pragma unroll
            for (int e = 0; e < 2; ++e) { const int k = k0 + 2 * u + e; const int m = (tp * (k & 255)) & 255; const float x = (float)m / 256.0f; v[e] = k < 256 ? cos_rev(x) : -sin_rev(x); }
            w[u] = pk2(v[0], v[1]); }
        *(u32x4*)((bf16_t*)(F.ws + WS_TABC) + (size_t)tp * 512 + k0) = (u32x4){w[0], w[1], w[2], w[3]}; }
}

template <bool FROM_IN>
__device__ __forceinline__ void phase_norm(Frame& F, const float* g, const float* modl, int sc_off, bf16_t* H, bf16_t* Hhi, int split, float* ss) {
    const int gw = F.bid * NWAVES + F.wave, NGW = F.G * NWAVES;
    for (int row0 = gw; row0 < NTOK; row0 += 2 * NGW) {
        const int row1 = row0 + NGW < NTOK ? row0 + NGW : row0;
        const u32x2* xr0 = (const u32x2*)((const bf16_t*)F.out + (size_t)row0 * DM) + F.lane; const u32x2* xr1 = (const u32x2*)((const bf16_t*)F.out + (size_t)row1 * DM) + F.lane;
        f32x4 v0[4], v1[4];
        if constexpr (FROM_IN) {
            const f32x4* i0 = (const f32x4*)(row0 < NCTX ? F.in[I_XP] + (size_t)row0 * DM : F.in[I_XS] + (size_t)(row0 - NCTX) * DM) + F.lane; const f32x4* i1 = (const f32x4*)(row1 < NCTX ? F.in[I_XP] + (size_t)row1 * DM : F.in[I_XS] + (size_t)(row1 - NCTX) * DM) + F.lane;
#pragma unroll
            for (int j = 0; j < 4; ++j) { v0[j] = i0[64 * j]; v1[j] = i1[64 * j]; }
            if (row1 >= NCTX) {
                const int t0 = (row0 - NCTX) & 2047, t1 = (row1 - NCTX) & 2047; const bool s0 = row0 >= NCTX;
#pragma unroll
                for (int u = 0; u < 4; ++u) { const float om = expf(-9.210340371976184f * (float)(4 * F.lane + u) / 256.0f);
#pragma unroll
                    for (int j = 0; j < 4; ++j) { const float p0 = (j < 2) ? (float)(t0 >> 6) : (float)(t0 & 63), p1 = (j < 2) ? (float)(t1 >> 6) : (float)(t1 & 63);
                        if (s0) v0[j][u] += (j & 1) ? cos_rad(p0 * om) : sin_rad(p0 * om);
                        v1[j][u] += (j & 1) ? cos_rad(p1 * om) : sin_rad(p1 * om); } } }
            u32x2* w0 = (u32x2*)((bf16_t*)F.out + (size_t)row0 * DM) + F.lane; u32x2* w1 = (u32x2*)((bf16_t*)F.out + (size_t)row1 * DM) + F.lane;
#pragma unroll
            for (int j = 0; j < 4; ++j) { w0[64 * j] = (u32x2){pk2(v0[j].x, v0[j].y), pk2(v0[j].z, v0[j].w)}; if (row1 != row0) w1[64 * j] = (u32x2){pk2(v1[j].x, v1[j].y), pk2(v1[j].z, v1[j].w)}; }
        } else {
#pragma unroll
            for (int j = 0; j < 4; ++j) { const u32x2 a = xr0[64 * j], b = xr1[64 * j]; v0[j] = (f32x4){bflo(a.x), bfhi(a.x), bflo(a.y), bfhi(a.y)}; v1[j] = (f32x4){bflo(b.x), bfhi(b.x), bflo(b.y), bfhi(b.y)}; }
        }
        if (ss != nullptr) { float s0 = 0.f, s1 = 0.f;
#pragma unroll
            for (int j = 0; j < 4; ++j) { s0 += (v0[j].x * v0[j].x + v0[j].y * v0[j].y) + (v0[j].z * v0[j].z + v0[j].w * v0[j].w); s1 += (v1[j].x * v1[j].x + v1[j].y * v1[j].y) + (v1[j].z * v1[j].z + v1[j].w * v1[j].w); }
            s0 = wave_sum(s0, F.lane); s1 = wave_sum(s1, F.lane);
            if (F.lane < 16) { ss[(size_t)row0 * 16 + F.lane] = F.lane == 0 ? s0 : 0.f; if (row1 != row0) ss[(size_t)row1 * 16 + F.lane] = F.lane == 0 ? s1 : 0.f; } }
        const float* mp0 = modl + (size_t)mod_idx(row0) * 6144; const float* mp1 = modl + (size_t)mod_idx(row1) * 6144;
        u32x2* o0 = (u32x2*)(row0 < split ? H + (size_t)row0 * DM : Hhi + (size_t)(row0 - split) * DM) + F.lane; u32x2* o1 = (u32x2*)(row1 < split ? H + (size_t)row1 * DM : Hhi + (size_t)(row1 - split) * DM) + F.lane;
#pragma unroll
        for (int j = 0; j < 4; ++j) { const int c = 4 * F.lane + 256 * j; const f32x4 gg = *(const f32x4*)(g + c);
            const f32x4 y0 = v0[j] * (gg + gg * *(const f32x4*)(mp0 + sc_off + c));
            const f32x4 y1 = v1[j] * (gg + gg * *(const f32x4*)(mp1 + sc_off + c));
            o0[64 * j] = (u32x2){pk2(y0.x, y0.y), pk2(y0.z, y0.w)};
            if (row1 != row0) o1[64 * j] = (u32x2){pk2(y1.x, y1.y), pk2(y1.z, y1.w)}; }
    }
}
template <class Bar> __device__ __forceinline__ void phase_final(Frame& F, const Bar& bar) {
    const int gw = F.bid * NWAVES + F.wave, NGW = F.G * NWAVES; const float* g = F.in[I_NORMF];
    constexpr int MAXR = 12;
    u32x2 xv[MAXR][4]; float rs[MAXR];
#pragma unroll
    for (int i = 0; i < MAXR; ++i) { const int row = gw + i * NGW; rs[i] = 0.f;
#pragma unroll
        for (int j = 0; j < 4; ++j) xv[i][j] = (u32x2){0u, 0u};
        if (row < NTOK) { const u32x2* xr = (const u32x2*)((const bf16_t*)F.out + (size_t)row * DM) + F.lane; float s = 0.f;
#pragma unroll
            for (int j = 0; j < 4; ++j) { const u32x2 a = xr[64 * j]; xv[i][j] = a; const float x0 = bflo(a.x), x1 = bfhi(a.x), x2 = bflo(a.y), x3 = bfhi(a.y); s += (x0 * x0 + x1 * x1) + (x2 * x2 + x3 * x3); }
            rs[i] = rsqrtf_(wave_sum(s, F.lane) * (1.f / DM) + EPS); } }
    if (!MK_PER_PHASE) xcd_barrier(bar);
#pragma unroll
    for (int i = 0; i < MAXR; ++i) { const int row = gw + i * NGW;
        if (row < NTOK) { f32x4* yr = (f32x4*)(F.out + (size_t)row * DM) + F.lane;
#pragma unroll
            for (int j = 0; j < 4; ++j) { const int c = 4 * F.lane + 256 * j; const f32x4 gg = *(const f32x4*)(g + c); const u32x2 a = xv[i][j];
                yr[64 * j] = ((f32x4){bflo(a.x), bfhi(a.x), bflo(a.y), bfhi(a.y)} * rs[i]) * gg; } } }
}

constexpr int HY_X1 = 0, HY_X2 = 8192, HY_ZP1 = 16384, HY_ZP2 = 47104, HY_TR = 77824, HY_TRCOPY = 8256, HY_RED = 110848, HY_TRSTG = LDSCTL_OFF + 4096;
static_assert(HY_TR + 4 * HY_TRCOPY <= HY_RED && HY_TRSTG + HY_TRCOPY <= LDS_BYTES, "hyena filter images");
static_assert(HY_RED + 16384 <= RING_BYTES, "hyena LDS map");
__device__ __forceinline__ void hyena_task(Frame& F, int l, int c, int grp) {
    int tid_ = F.tid; asm volatile("" : "+v"(tid_));
    const int tid = tid_, lane = tid & 63, wave = __builtin_amdgcn_readfirstlane(tid >> 6);
    const int lg = grp == 0 ? 11 : 8, L = 1 << lg, nb = L >> 5, ZSEQ = (3 * nb) * 40, row0 = grp == 0 ? NCTX : (grp - 1) * 4096;
    LAS unsigned char* lds = F.lds;
    const bf16_t* hyt = (const bf16_t*)(F.ws + WS_HYT);
    const float* cw = F.in[I_CONVHY] + (size_t)l * 3 * 1536;
    const float* fil = (const float*)(F.ws + (grp == 0 ? WS_FILL : WS_FILC));
    const float* hb = F.in[I_HBIAS] + (size_t)l * 2 * 512;
    PROF_DECL;
    const int npc = L >> 3; u32x4 fpc[2];
#pragma unroll
    for (int u = 0; u < 2; ++u) { const int i2 = tid + u * NTHR; const int jd = i2 < 4 * npc ? i2 >> (lg - 3) : 0, k = i2 < 4 * npc ? i2 & (npc - 1) : 0;
        fpc[u] = *(const u32x4*)((const bf16_t*)fil + ((size_t)jd * 512 + c) * L + 8 * k); }
    __syncthreads();
    if (grp == 0) PROF_COUNT(4); else PROF_COUNT(5);
    PROF_BEGIN(1);
    {
        const int p = 8 * tid, t = p & (L - 1), qs = p >> lg;
#pragma unroll
        for (int st = 0; st < 3; ++st) { const int ch = st * 512 + c; const bf16_t* src = hyt + (size_t)ch * NTOK + row0 + p;
            const u32x4 rv = *(const u32x4*)src; const float xm_ = bf2f(src[t > 0 ? -1 : 0]), xp_ = bf2f(src[t + 8 < L ? 8 : 0]); const float xm = t > 0 ? xm_ : 0.f, xp = t + 8 < L ? xp_ : 0.f;
            const float w0 = cw[ch], w1 = cw[1536 + ch], w2 = cw[2 * 1536 + ch];
            const float x[10] = {xm, bflo(rv.x), bfhi(rv.x), bflo(rv.y), bfhi(rv.y), bflo(rv.z), bfhi(rv.z), bflo(rv.w), bfhi(rv.w), xp};
            float o[8];
#pragma unroll
            for (int e = 0; e < 8; ++e) o[e] = w0 * x[e] + w1 * x[e + 1] + w2 * x[e + 2];
            const u32x4 pk = (u32x4){pk2(o[0], o[1]), pk2(o[2], o[3]), pk2(o[4], o[5]), pk2(o[6], o[7])};
            if (st < 2) *(LAS u32x4*)(lds + (st == 0 ? HY_X1 : HY_X2) + p * 2) = pk;
            else *(LAS u32x4*)(lds + HY_ZP1 + (qs * ZSEQ + (nb + (t >> 5)) * 40 + (t & 31)) * 2) = pk; }
        constexpr int npad = 256;
        for (int i2 = tid; i2 < 2 * npad * 5; i2 += NTHR) { const int img = i2 / (npad * 5), rem = i2 % (npad * 5), pbk = rem / 5, piece = rem % 5;
            const int qs2 = pbk >> (lg - 4), bb = pbk & (2 * nb - 1), blk = bb < nb ? bb : bb + nb;
            *(LAS u32x4*)(lds + (img == 0 ? HY_ZP1 : HY_ZP2) + (qs2 * ZSEQ + blk * 40) * 2 + piece * 16) = (u32x4){0u, 0u, 0u, 0u}; }
    }
    PROF_END(1); PROF_BEGIN(2);
    {
#pragma unroll
      for (int u = 0; u < 2; ++u) { const int i2 = tid + u * NTHR; if (i2 >= 4 * npc) continue; const int jd = i2 >> (lg - 3), k = i2 & (npc - 1), o = jd >> 1, dirn = jd & 1;
          const u32x4 v = fpc[u];
          LAS unsigned char* c0 = lds + (o == 0 ? HY_TR : HY_TRSTG);
          const unsigned e0 = v.x & 0xffffu, e1 = v.x >> 16, e2 = v.y & 0xffffu, e3 = v.y >> 16, e4 = v.z & 0xffffu, e5 = v.z >> 16, e6 = v.w & 0xffffu, e7 = v.w >> 16;
          if (dirn == 0) {
              const int p0 = L - 8 * k - 7;
              *(LAS unsigned short*)(c0 + p0 * 2) = (unsigned short)e7;
              *(LAS unsigned*)(c0 + (p0 + 1) * 2) = e6 | (e5 << 16); *(LAS unsigned*)(c0 + (p0 + 3) * 2) = e4 | (e3 << 16); *(LAS unsigned*)(c0 + (p0 + 5) * 2) = e2 | (e1 << 16);
              *(LAS unsigned short*)(c0 + (p0 + 7) * 2) = (unsigned short)e0;
          } else {
              const int q0 = L + 8 * k;
              if (k > 0) *(LAS u32x4*)(c0 + q0 * 2) = v;
              else { *(LAS unsigned short*)(c0 + (q0 + 1) * 2) = (unsigned short)e1; *(LAS unsigned*)(c0 + (q0 + 2) * 2) = v.y; *(LAS unsigned*)(c0 + (q0 + 4) * 2) = v.z; *(LAS unsigned*)(c0 + (q0 + 6) * 2) = v.w; }
          } } }
    __syncthreads();
#define HY_DERIVE(SRC, WRITE0) do { for (int s4_ = tid; s4_ < (L >> 1); s4_ += NTHR) { const LAS u32x2* sp_ = (const LAS u32x2*)((SRC) + s4_ * 8); const u32x2 a_ = sp_[0], b_ = sp_[1]; \
            LAS unsigned char* dp_ = lds + HY_TR + s4_ * 8;        \
            if (WRITE0) *(LAS u32x2*)dp_ = a_; \
            *(LAS u32x2*)(dp_ + HY_TRCOPY) = (u32x2){(a_.x >> 16) | (a_.y << 16), (a_.y >> 16) | (b_.x << 16)}; \
            *(LAS u32x2*)(dp_ + 2 * HY_TRCOPY) = (u32x2){a_.y, b_.x}; \
            *(LAS u32x2*)(dp_ + 3 * HY_TRCOPY) = (u32x2){(a_.y >> 16) | (b_.x << 16), (b_.x >> 16) | (b_.y << 16)}; } __syncthreads(); } while (0)
    PROF_END(2); PROF_BEGIN(3);
    const int tile = wave & 3, half = wave >> 2, r = lane & 31, hh = lane >> 5, colg = 32 * tile + r;
    int qs, ib, imin, imax;
    if (grp == 0) { qs = colg >> 6; ib = colg & 63; imin = 32 * (tile & 1); imax = imin + 31; } else { qs = colg >> 3; ib = colg & 7; imin = 0; imax = 7; }
    const int dlo = imin - nb + 1, cnt = imax - imin + nb, mid = dlo + (cnt >> 1);
    const int d0 = half == 0 ? dlo : mid, d1 = half == 0 ? mid : dlo + cnt;
    const int sq = (4 - (r & 3)) & 3;
    const int aoff = sq * HY_TRCOPY + (L + 8 * hh - r - 32 * d0 - sq) * 2;
    const int boff = (qs * ZSEQ + (nb + ib - d0) * 40 + 8 * hh) * 2;
    const float bias0 = hb[c] + bf2f(((const bf16_t*)fil)[((size_t)1 * 512 + c) * L]), bias1 = hb[512 + c] + bf2f(((const bf16_t*)fil)[((size_t)3 * 512 + c) * L]);
    bf16_t* yb = (bf16_t*)(F.ws + WS_YB);
#pragma unroll 1
    for (int o = 0; o < 2; ++o) {
        if (o == 0) HY_DERIVE(lds + HY_TR, false); else HY_DERIVE(lds + HY_TRSTG, true);
        if (grp == 0) PROF_BEGIN(6);
        f32x16 acc;
#pragma unroll
        for (int e = 0; e < 16; ++e) acc[e] = 0.f;
        const LAS unsigned char* Ap = lds + HY_TR + aoff; const LAS unsigned char* Bp = lds + (o == 0 ? HY_ZP1 : HY_ZP2) + boff;
        f32x16 acc2;
#pragma unroll
        for (int e = 0; e < 16; ++e) acc2[e] = 0.f;
        u32x4 xa[4][2], ya[4][2]; bf16x8 xb[4][2], yb2[4][2];
#define HY_LD4(A, B) do { _Pragma("unroll") for (int u_ = 0; u_ < 4; ++u_) { const volatile LAS u32x2* ap_ = (const volatile LAS u32x2*)(Ap - 64 * u_); const u32x2 a0_ = ap_[0], a1_ = ap_[1], a2_ = ap_[4], a3_ = ap_[5];        \
            A[u_][0] = (u32x4){a0_.x, a0_.y, a1_.x, a1_.y}; A[u_][1] = (u32x4){a2_.x, a2_.y, a3_.x, a3_.y}; \
            B[u_][0] = *(const LAS bf16x8*)(Bp - 80 * u_); B[u_][1] = *(const LAS bf16x8*)(Bp - 80 * u_ + 32); } Ap -= 256; Bp -= 320; } while (0)
#define HY_MM4(A, B) do { _Pragma("unroll") for (int u_ = 0; u_ < 4; ++u_) { acc = __builtin_amdgcn_mfma_f32_32x32x16_bf16(__builtin_bit_cast(bf16x8, A[u_][0]), B[u_][0], acc, 0, 0, 0); \
            acc2 = __builtin_amdgcn_mfma_f32_32x32x16_bf16(__builtin_bit_cast(bf16x8, A[u_][1]), B[u_][1], acc2, 0, 0, 0); } } while (0)
        const int ng = (d1 - d0) >> 2, nrem = (d1 - d0) & 3;
        HY_LD4(xa, xb);
#pragma unroll 1
        for (int g = 0;;) {
            __builtin_amdgcn_sched_barrier(0); if (g + 1 < ng) HY_LD4(ya, yb2); __builtin_amdgcn_sched_barrier(0); HY_MM4(xa, xb);
            if (++g >= ng) break;
            __builtin_amdgcn_sched_barrier(0); if (g + 1 < ng) HY_LD4(xa, xb); __builtin_amdgcn_sched_barrier(0); HY_MM4(ya, yb2);
            if (++g >= ng) break;
        }
#pragma unroll 1
        for (int rr = 0; rr < nrem; ++rr) { const volatile LAS u32x2* ap_ = (const volatile LAS u32x2*)Ap; const u32x2 a0_ = ap_[0], a1_ = ap_[1], a2_ = ap_[4], a3_ = ap_[5];
            const u32x4 q0 = (u32x4){a0_.x, a0_.y, a1_.x, a1_.y}, q1 = (u32x4){a2_.x, a2_.y, a3_.x, a3_.y};
            acc = __builtin_amdgcn_mfma_f32_32x32x16_bf16(__builtin_bit_cast(bf16x8, q0), *(const LAS bf16x8*)Bp, acc, 0, 0, 0);
            acc2 = __builtin_amdgcn_mfma_f32_32x32x16_bf16(__builtin_bit_cast(bf16x8, q1), *(const LAS bf16x8*)(Bp + 32), acc2, 0, 0, 0);
            Ap -= 64; Bp -= 80; }
#undef HY_LD4
#undef HY_MM4
#pragma unroll
        for (int e = 0; e < 16; ++e) acc[e] += acc2[e];
        if (grp == 0) { PROF_END(6); PROF_BEGIN(7); }
        LAS float* red = (LAS float*)(lds + HY_RED);
        if (half == 1) {
#pragma unroll
            for (int e = 0; e < 16; ++e) red[(tile * 16 + e) * 64 + lane] = acc[e]; }
        __syncthreads();
        if (half == 0) {
#pragma unroll
            for (int e = 0; e < 16; ++e) acc[e] += red[(tile * 16 + e) * 64 + lane];
#pragma unroll
            for (int g = 0; g < 4; ++g) { const int a4 = 8 * g + 4 * hh, p = qs * L + 32 * ib + a4, zo = (qs * ZSEQ + (nb + ib) * 40 + a4) * 2;
                const u32x2 gx = *(const LAS u32x2*)(lds + (o == 0 ? HY_X1 : HY_X2) + p * 2), zz = *(const LAS u32x2*)(lds + (o == 0 ? HY_ZP1 : HY_ZP2) + zo);
                const float gv[4] = {bflo(gx.x), bfhi(gx.x), bflo(gx.y), bfhi(gx.y)}, zv[4] = {bflo(zz.x), bfhi(zz.x), bflo(zz.y), bfhi(zz.y)};
                float y[4];
#pragma unroll
                for (int e = 0; e < 4; ++e) y[e] = gv[e] * (acc[4 * g + e] + (o == 0 ? bias0 : bias1) * zv[e]);
                if (o == 0) *(LAS u32x2*)(lds + HY_ZP2 + zo) = (u32x2){pk2(y[0], y[1]), pk2(y[2], y[3])};
                else {
#pragma unroll
                    for (int e = 0; e < 4; ++e) yb[(size_t)(row0 + p + e) * 512 + c] = (bf16_t)f2bf(y[e]); } }
        }
        __syncthreads();
        if (grp == 0) PROF_END(7);
    }
#undef HY_DERIVE
    PROF_END(3); PROF_FLUSH();
}

__device__ __forceinline__ int kpos32(int k) { return (k & ~31) | (((k >> 2) & 3) << 3) | (((k >> 4) & 1) << 2) | (k & 3); }
__device__ __forceinline__ int frag_off(int row, int colpos) { return (((row >> 4) * 2 + (colpos >> 5)) * 64 + ((colpos >> 3) & 3) * 16 + (row & 15)) * 8 + (colpos & 7); }
__device__ __forceinline__ size_t chunk_lin(int s, int n) { return (size_t)(s < 32 ? s * 4 + n : 128 + (s - 32) * 32 + n); }
constexpr int D1_GRP_BYTES = 61952;
__device__ __forceinline__ void d1_task(Frame& F, int l, int s, int h, int n) {
    int tid_ = F.tid; asm volatile("" : "+v"(tid_));
    const int tid = tid_, lane = tid & 63, wave = __builtin_amdgcn_readfirstlane(tid >> 6), lw = wave & 3, lt = tid & 255;
    LAS unsigned char* base = F.lds + (wave >> 2) * D1_GRP_BYTES;
    LAS bf16_t* qb = (LAS bf16_t*)base;
    LAS bf16_t* kb = qb + 64 * 72;
    LAS bf16_t* vb = kb + 64 * 72;
    LAS float* ATf = (LAS float*)(vb + 64 * 72);
    LAS float* ATb = ATf + 4096;
    LAS float* sm = ATb + 4096;
    LAS float* betaf = sm, *betab = sm + 64, *gcf = sm + 128, *gcb = sm + 192, *bwf = sm + 256, *bwb = sm + 320;
    const int L = seq_len(s), row0 = seq_start(s) + n * 64, tpos0 = n * 64;
    const bf16_t* qkv = (const bf16_t*)(F.ws + WS_QKV);
    const float* cw = F.in[I_CONVQKV] + (size_t)l * 3 * QKVW;
    const size_t cl = chunk_lin(s, n);
    PROF_DECL; PROF_BEGIN(40);
    float braw = 0.f, araw = 0.f, al = 0.f, dtb = 0.f;
    if (lw < 2) { const float* ba = (const float*)(F.ws + WS_BA) + (size_t)(row0 + lane) * 32; braw = ba[lw * 8 + h]; araw = ba[16 + lw * 8 + h];
        al = F.in[I_ALOG][l * 16 + lw * 8 + h]; dtb = F.in[I_DTB][l * 16 + lw * 8 + h]; }
    __syncthreads();
    {
        const int sub = lt & 7;
        u32x4 rr[2][3][3]; f32x4 ww[3][3][2];
#pragma unroll
        for (int part = 0; part < 3; ++part) { const int ch = part * 512 + h * 64 + sub * 8;
#pragma unroll
            for (int i = 0; i < 3; ++i) { ww[part][i][0] = *(const f32x4*)(cw + i * QKVW + ch); ww[part][i][1] = *(const f32x4*)(cw + i * QKVW + ch + 4); }
#pragma unroll
            for (int th = 0; th < 2; ++th) { const int t = (lt >> 3) + 32 * th, tp = tpos0 + t; const bf16_t* src = qkv + (size_t)(row0 + t) * QKVW + ch;
                rr[th][part][1] = *(const u32x4*)src; rr[th][part][0] = *(const u32x4*)(tp > 0 ? src - QKVW : src); rr[th][part][2] = *(const u32x4*)(tp < L - 1 ? src + QKVW : src); } }
#pragma unroll
        for (int th2 = 0; th2 < 2 * NREP(14); ++th2) { const int th = th2 & 1;
            const int t = (lt >> 3) + 32 * th, tp = tpos0 + t;
            const float m0 = tp > 0 ? 1.f : 0.f, m2 = tp < L - 1 ? 1.f : 0.f;
#pragma unroll
            for (int part = 0; part < 3; ++part) {
                const u32x4 r0 = rr[th][part][0], r1 = rr[th][part][1], r2 = rr[th][part][2];
                const unsigned a0[4] = {r0.x, r0.y, r0.z, r0.w}, a1[4] = {r1.x, r1.y, r1.z, r1.w}, a2[4] = {r2.x, r2.y, r2.z, r2.w};
                float v[8]; float ss = 0.f;
#pragma unroll
                for (int e = 0; e < 8; ++e) { const float x0 = (e & 1) ? bfhi(a0[e >> 1]) : bflo(a0[e >> 1]), x1 = (e & 1) ? bfhi(a1[e >> 1]) : bflo(a1[e >> 1]), x2 = (e & 1) ? bfhi(a2[e >> 1]) : bflo(a2[e >> 1]);
                    float a = x1 * ww[part][1][e >> 2][e & 3] + m0 * x0 * ww[part][0][e >> 2][e & 3] + m2 * x2 * ww[part][2][e >> 2][e & 3]; a = siluf_(a); v[e] = a; ss += a * a; }
                if (part < 2) { ss = sum8(ss);
                    const float rs = (part == 0 ? 0.125f : 1.0f) * rsqrtf_(ss + EPS);
#pragma unroll
                    for (int e = 0; e < 8; ++e) v[e] *= rs; }
                const u32x4 pk = (u32x4){pk2(v[0], v[1]), pk2(v[2], v[3]), pk2(v[4], v[5]), pk2(v[6], v[7])};
                *(LAS u32x4*)((part == 0 ? qb : (part == 1 ? kb : vb)) + t * 72 + sub * 8) = pk;
                if (part == 0) { bf16_t* qo = (bf16_t*)(F.ws + WS_QN) + ((size_t)h * 192 + cl) * 4096;
                    *(u32x2*)(qo + frag_off(t, kpos32(sub * 8))) = (u32x2){pk.x, pk.y}; *(u32x2*)(qo + frag_off(t, kpos32(sub * 8 + 4))) = (u32x2){pk.z, pk.w}; }
            }
        }
    }
    if (lw < 2) { const int dir = lw, t = lane;
        const float xx = araw + dtb; const float sp = xx > 20.f ? xx : __logf(1.0f + __expf(xx));
        float a = -expf(al) * sp;
#pragma unroll
        for (int o = 1; o < 64; o <<= 1) { const float y = lane_read(a, dir == 0 ? ((lane - o) & 63) : ((lane + o) & 63)); if (dir == 0 ? (lane >= o) : (lane + o < 64)) a += y; }
        const float be = 1.f / (1.f + expf(-braw));
        (dir == 0 ? betaf : betab)[t] = be; (dir == 0 ? gcf : gcb)[t] = a; (dir == 0 ? bwf : bwb)[t] = be * __expf(a);
        ((float*)(F.ws + WS_GC))[((size_t)(dir * 8 + h) * 192 + cl) * 64 + t] = a; }
    __syncthreads();
    PROF_END(40); PROF_BEGIN(41);
    const size_t offF = ((size_t)(0 * 8 + h) * 192 + cl) * 4096, offB = ((size_t)(1 * 8 + h) * 192 + cl) * 4096;
    {
        const int ti = lw >> 1, tj = lw & 1, r = lane & 31, hh = lane >> 5, col = 32 * tj + r;
#pragma unroll 1
        for (int prod2 = 0; prod2 < 2 * NREP(15); ++prod2) { const int prod = prod2 & 1;
            const LAS bf16_t* Am = kb + (32 * ti + r) * 72 + 8 * hh; const LAS bf16_t* Bm = (prod == 0 ? kb : qb) + (32 * tj + r) * 72 + 8 * hh;
            f32x16 acc;
#pragma unroll
            for (int e = 0; e < 16; ++e) acc[e] = 0.f;
#pragma unroll
            for (int ks = 0; ks < 4; ++ks) acc = __builtin_amdgcn_mfma_f32_32x32x16_bf16(*(const LAS bf16x8*)(Am + 16 * ks), *(const LAS bf16x8*)(Bm + 16 * ks), acc, 0, 0, 0);
            if (prod == 0) {
                const int j = col; const float gfj = gcf[j], gbj = gcb[j];
#pragma unroll
                for (int g = 0; g < 4; ++g) { const int i4 = 32 * ti + 8 * g + 4 * hh; float ff[4], fb[4];
#pragma unroll
                    for (int e = 0; e < 4; ++e) { const int i = i4 + e; const float v = acc[4 * g + e];
                        ff[e] = i > j ? betaf[i] * v * __expf(gcf[i] - gfj) : 0.f; fb[e] = i < j ? betab[i] * v * __expf(gcb[i] - gbj) : 0.f; }
                    *(LAS f32x4*)(ATf + j * 64 + i4) = (f32x4){ff[0], ff[1], ff[2], ff[3]};
                    *(LAS f32x4*)(ATb + (63 - j) * 64 + (60 - i4)) = (f32x4){fb[3], fb[2], fb[1], fb[0]}; }
            } else {
                const int i = col; const float gfi = gcf[i], gbi = gcb[i]; bf16_t* QKo = (bf16_t*)(F.ws + WS_QK);
#pragma unroll
                for (int g = 0; g < 4; ++g) { const int j4 = 32 * ti + 8 * g + 4 * hh; float ff[4], fb[4];
#pragma unroll
                    for (int e = 0; e < 4; ++e) { const int j = j4 + e; const float v = acc[4 * g + e];
                        ff[e] = i >= j ? v * __expf(gfi - gcf[j]) : 0.f; fb[e] = i <= j ? v * __expf(gbi - gcb[j]) : 0.f; }
                    const int pj = kpos32(j4);
                    const int fo_ = frag_off(i, pj);
                    *(u32x2*)(QKo + offF + fo_) = (u32x2){pk2(ff[0], ff[1]), pk2(ff[2], ff[3])};
                    *(u32x2*)(QKo + offB + fo_) = (u32x2){pk2(fb[0], fb[1]), pk2(fb[2], fb[3])}; }
            }
        }
    }
    { const int d = lt >> 2, cg = lt & 3; bf16_t* kt = (bf16_t*)(F.ws + WS_KN) + ((size_t)h * 192 + cl) * 4096;
#pragma unroll
      for (int g = 0; g < 4; ++g) { const int c = 16 * cg + 4 * g;
          const unsigned w0 = (unsigned)kb[(c + 0) * 72 + d] | ((unsigned)kb[(c + 1) * 72 + d] << 16), w1 = (unsigned)kb[(c + 2) * 72 + d] | ((unsigned)kb[(c + 3) * 72 + d] << 16);
          *(u32x2*)(kt + frag_off(d, kpos32(c))) = (u32x2){w0, w1}; } }
    __syncthreads();
    PROF_END(41); PROF_BEGIN(42);
#pragma unroll 1
    for (int srep = 0; srep < NREP(16); ++srep) {
        const int c = lane;
        int dmask = (lw >> 1) * 63, isw = lw & 1;
        asm volatile("" : "+v"(dmask), "+v"(isw));
        const bool bdir = dmask != 0, bw = isw != 0;
        int vzero; asm volatile("v_mov_b32 %0, 0" : "=v"(vzero));
        const LAS float* AT = ATf + (bdir ? 4096 : 0) + vzero;
        const LAS float* cf = (bw ? bwf : betaf) + (bdir ? 64 : 0);
        const LAS bf16_t* srcm = (bw ? kb : vb) + c;
        f32x4 xq[16];
#define XS(i) xq[(i) >> 2][(i) & 3]
#pragma unroll
        for (int p = 0; p < 64; ++p) { const int t = p ^ dmask; XS(p) = bf2f(srcm[t * 72]) * cf[t];
            if ((p & 7) == 7) __builtin_amdgcn_sched_barrier(0); }
#define SOLVE_UPD(lo, hi, RV, xj) do { \
            _Pragma("unroll") for (int i_ = (lo); i_ < (((lo) + 3) & ~3) && i_ < (hi); ++i_) XS(i_) -= RV(i_ >> 2)[i_ & 3] * (xj); \
            _Pragma("unroll") for (int g_ = ((lo) + 3) >> 2; g_ < ((hi) >> 2); ++g_) xq[g_] -= RV(g_) * (xj); } while (0)
#define SOLVE_LD(R, j) do { _Pragma("unroll") for (int i4_ = ((j) + 1) & ~3; i4_ < 64; i4_ += 4) R[i4_ >> 2] = *(const LAS f32x4*)(AT + (j) * 64 + i4_); } while (0)
#define RV_RA(g) ra[g]
#define RV_RB(g) rb[g]
#define RV_LO(g) rh[g]
#define RV_HI(g) rh[(g) - 8]
#define RV_RT(g) rt[jt_][(g) - 14]
        {
#pragma unroll
          for (int j = 0; j < 32; ++j) { const float xj = XS(j); f32x4 rh[8];
              __builtin_amdgcn_sched_barrier(0);
#pragma unroll
              for (int i4 = (j + 1) & ~3; i4 < 32; i4 += 4) rh[i4 >> 2] = *(const LAS f32x4*)(AT + j * 64 + i4);
              SOLVE_UPD(j + 1, 32, RV_LO, xj);
              __builtin_amdgcn_sched_barrier(0);
#pragma unroll
              for (int i4 = 32; i4 < 64; i4 += 4) rh[(i4 - 32) >> 2] = *(const LAS f32x4*)(AT + j * 64 + i4);
              SOLVE_UPD(32, 64, RV_HI, xj); } }
        { f32x4 ra[16], rb[16];
          SOLVE_LD(ra, 32);
#pragma unroll
          for (int j = 32; j < 56; j += 2) {
            __builtin_amdgcn_sched_barrier(0); SOLVE_LD(rb, j + 1); __builtin_amdgcn_sched_barrier(0); { const float xj = XS(j); SOLVE_UPD(j + 1, 64, RV_RA, xj); }
            __builtin_amdgcn_sched_barrier(0); if (j + 2 < 56) SOLVE_LD(ra, j + 2); __builtin_amdgcn_sched_barrier(0); { const float xj = XS(j + 1); SOLVE_UPD(j + 2, 64, RV_RB, xj); } } }
        { f32x4 rt[7][2];
#pragma unroll
          for (int j = 56; j < 63; ++j)
#pragma unroll
              for (int i4 = (j + 1) & ~3; i4 < 64; i4 += 4) rt[j - 56][(i4 - 56) >> 2] = *(const LAS f32x4*)(AT + j * 64 + i4);
          __builtin_amdgcn_sched_barrier(0);
#pragma unroll
          for (int j = 56; j < 63; ++j) { const float xj = XS(j); const int jt_ = j - 56; SOLVE_UPD(j + 1, 64, RV_RT, xj); } }
#undef SOLVE_LD
#undef SOLVE_UPD
#undef RV_RA
#undef RV_RB
#undef RV_LO
#undef RV_HI
#undef RV_RT
        __builtin_amdgcn_sched_barrier(0);
        int dmask2 = dmask; { float x63 = XS(63); asm volatile("" : "+v"(dmask2), "+v"(x63)); XS(63) = x63; }
        const size_t offD = bdir ? offB : offF;
        if (!bw) {
            bf16_t* dst = (bf16_t*)(F.ws + WS_U) + offD + (size_t)c * 64;
#pragma unroll
            for (int g = 0; g < 8; ++g) { unsigned w[4];
#pragma unroll
                for (int k = 0; k < 4; ++k) { const float a = XS(8 * g + 2 * k), b = XS(8 * g + 2 * k + 1); w[k] = pk2(bdir ? b : a, bdir ? a : b); }
                const u32x4 o = bdir ? (u32x4){w[3], w[2], w[1], w[0]} : (u32x4){w[0], w[1], w[2], w[3]};
                *(u32x4*)(dst + (bdir ? 56 - 8 * g : 8 * g)) = o; }
        } else {
            bf16_t* dst = (bf16_t*)(F.ws + WS_WW) + offD + kpos32(c);
#pragma unroll
            for (int p = 0; p < 64; ++p) dst[(p ^ dmask2) * 64] = (bf16_t)f2bf(-XS(p));
        }
    }
#undef XS
    PROF_END(42); PROF_FLUSH();
}

__device__ __forceinline__ bf16x8 pack8(const f32x4 a, const f32x4 b) {
    u32x4 w; w.x = pg8::cvt_pk_bf16(a[0], a[1]); w.y = pg8::cvt_pk_bf16(a[2], a[3]); w.z = pg8::cvt_pk_bf16(b[0], b[1]); w.w = pg8::cvt_pk_bf16(b[2], b[3]);
    return __builtin_bit_cast(bf16x8, w);
}
__device__ __forceinline__ void d2_wave_task(Frame& F, int l, int s, int h, int dir, int sl, unsigned* prog = nullptr) {
    int lane_ = F.lane; asm volatile("" : "+v"(lane_));
    const int lane = lane_, r16 = lane & 15, q = lane >> 4, e0 = sl * 16;
    const int nch = s < 32 ? 4 : 32;
    LAS float* lo = (LAS float*)(F.lds + F.wave * 4608);
    LAS float* lgc = lo + 64 * 17;
    f32x4 S[4];
#pragma unroll
    for (int t = 0; t < 4; ++t)
#pragma unroll
        for (int rg = 0; rg < 4; ++rg) { const int d = 16 * t + 4 * q + rg;
            S[t][rg] = s >= 32 ? F.in[I_STATE][((((size_t)(s - 32) * 2 + l) * 2 + dir) * 8 + h) * 4096 + d * 64 + e0 + r16] : 0.f; }
    const bf16_t* Wg = (const bf16_t*)(F.ws + WS_WW); const bf16_t* QKg = (const bf16_t*)(F.ws + WS_QK); const bf16_t* Ug = (const bf16_t*)(F.ws + WS_U);
    const bf16_t* QNg = (const bf16_t*)(F.ws + WS_QN); const bf16_t* KTg = (const bf16_t*)(F.ws + WS_KN); const float* GCg = (const float*)(F.ws + WS_GC);
    bf16_t* Og = (bf16_t*)(F.ws + (dir == 0 ? WS_OF : WS_OB));
    const int fo = r16 * 64 + 8 * q;
    bf16x8 Wf[4][2], Qf[4][2], QKf[4][2], KTf[4][2]; u32x2 Uv[4]; float gcl;
#define D2_ADDR(stp) const int n_ = dir == 0 ? (stp) : nch - 1 - (stp); const size_t cl_ = chunk_lin(s, n_); \
        const size_t off_ = ((size_t)(dir * 8 + h) * 192 + cl_) * 4096; const int tok0_ = seq_start(s) + n_ * 64
#define D2_LOAD_A(stp) do { D2_ADDR(stp); const bf16_t* Wp = Wg + off_ + fo; const bf16_t* Qp = QNg + ((size_t)h * 192 + cl_) * 4096 + 8 * lane; (void)tok0_; \
        const bf16_t* Up = Ug + off_ + (size_t)(e0 + r16) * 64 + 4 * q; \
        _Pragma("unroll") for (int t = 0; t < 4; ++t) { Uv[t] = *(const u32x2*)(Up + 16 * t); \
            _Pragma("unroll") for (int ks = 0; ks < 2; ++ks) { Wf[t][ks] = *(const bf16x8*)(Wp + t * 1024 + 32 * ks); Qf[t][ks] = *(const bf16x8*)(Qp + (2 * t + ks) * 512); } } } while (0)
#define D2_LOAD_B(stp) do { D2_ADDR(stp); (void)tok0_; const bf16_t* QKp = QKg + off_ + 8 * lane; const bf16_t* KTp = KTg + ((size_t)h * 192 + cl_) * 4096 + 8 * lane; \
        gcl = GCg[((size_t)(dir * 8 + h) * 192 + cl_) * 64 + lane]; \
        _Pragma("unroll") for (int t = 0; t < 4; ++t) _Pragma("unroll") for (int ks = 0; ks < 2; ++ks) { QKf[t][ks] = *(const bf16x8*)(QKp + (2 * t + ks) * 512); KTf[t][ks] = *(const bf16x8*)(KTp + (2 * t + ks) * 512); } } while (0)
    D2_LOAD_A(0); D2_LOAD_B(0);
#pragma unroll 1
    for (int step = 0; step < nch; ++step) {
        const int nstep = step + 1 < nch ? step + 1 : step;
        const int n = dir == 0 ? step : nch - 1 - step; const int tok0 = seq_start(s) + n * 64;
        if (prog != nullptr && lane == 0) __hip_atomic_store(prog, (unsigned)(step + 1), RLX_AGENT);
        lgc[lane] = gcl;
        bf16x8 Sb[2] = {pack8(S[0], S[1]), pack8(S[2], S[3])};
        f32x4 VN[4], O[4];
#pragma unroll
        for (int t = 0; t < 4; ++t) { VN[t] = (f32x4){bflo(Uv[t].x), bfhi(Uv[t].x), bflo(Uv[t].y), bfhi(Uv[t].y)};
            VN[t] = __builtin_amdgcn_mfma_f32_16x16x32_bf16(Wf[t][0], Sb[0], VN[t], 0, 0, 0); VN[t] = __builtin_amdgcn_mfma_f32_16x16x32_bf16(Wf[t][1], Sb[1], VN[t], 0, 0, 0);
            O[t] = __builtin_amdgcn_mfma_f32_16x16x32_bf16(Qf[t][0], Sb[0], (f32x4){0.f, 0.f, 0.f, 0.f}, 0, 0, 0); O[t] = __builtin_amdgcn_mfma_f32_16x16x32_bf16(Qf[t][1], Sb[1], O[t], 0, 0, 0); }
        __builtin_amdgcn_sched_barrier(0);
        D2_LOAD_A(nstep);
        __builtin_amdgcn_sched_barrier(0);
        const float gl = lgc[dir == 0 ? 63 : 0];
        f32x4 VS[4];
#pragma unroll
        for (int t = 0; t < 4; ++t) { const f32x4 gv = *(const LAS f32x4*)(lgc + 16 * t + 4 * q);
#pragma unroll
            for (int rg = 0; rg < 4; ++rg) { O[t][rg] *= __expf(gv[rg]); VS[t][rg] = VN[t][rg] * __expf(gl - gv[rg]); } }
        const bf16x8 VNb[2] = {pack8(VN[0], VN[1]), pack8(VN[2], VN[3])}, VSb[2] = {pack8(VS[0], VS[1]), pack8(VS[2], VS[3])};
        const float egl = __expf(gl);
#pragma unroll
        for (int t = 0; t < 4; ++t) { S[t] = S[t] * egl;
#pragma unroll
            for (int ks = 0; ks < 2; ++ks) { O[t] = __builtin_amdgcn_mfma_f32_16x16x32_bf16(QKf[t][ks], VNb[ks], O[t], 0, 0, 0); S[t] = __builtin_amdgcn_mfma_f32_16x16x32_bf16(KTf[t][ks], VSb[ks], S[t], 0, 0, 0); } }
        __builtin_amdgcn_sched_barrier(0);
        D2_LOAD_B(nstep);
        __builtin_amdgcn_sched_barrier(0);
#pragma unroll
        for (int t = 0; t < 4; ++t)
#pragma unroll
            for (int rg = 0; rg < 4; ++rg) lo[(16 * t + 4 * q + rg) * 17 + r16] = O[t][rg];
        asm volatile("s_waitcnt lgkmcnt(0)" ::: "memory");
        { float ov[16];
#pragma unroll
          for (int e = 0; e < 16; ++e) ov[e] = lo[lane * 17 + e];
          bf16_t* op = Og + (size_t)(tok0 + lane) * 512 + h * 64 + e0;
          *(u32x4*)op = (u32x4){pk2(ov[0], ov[1]), pk2(ov[2], ov[3]), pk2(ov[4], ov[5]), pk2(ov[6], ov[7])};
          *(u32x4*)(op + 8) = (u32x4){pk2(ov[8], ov[9]), pk2(ov[10], ov[11]), pk2(ov[12], ov[13]), pk2(ov[14], ov[15])}; }
        asm volatile("s_waitcnt lgkmcnt(0)" ::: "memory");
    }
#undef D2_ADDR
#undef D2_LOAD_A
#undef D2_LOAD_B
    if (s < 32) { float* so = F.out + (size_t)NTOK * DM + ((((size_t)s * 2 + l) * 2 + dir) * 8 + h) * 4096;
#pragma unroll
        for (int t = 0; t < 4; ++t)
#pragma unroll
            for (int rg = 0; rg < 4; ++rg) so[(16 * t + 4 * q + rg) * 64 + e0 + r16] = S[t][rg]; }
}

__device__ __forceinline__ void d2_helper(Frame& F, int l, int kk, int jq, const unsigned* prog) {
    const int lane = F.lane, s = 32 + (kk >> 4), h = (kk >> 1) & 7, dir = kk & 1, nch = 32;
    const bf16_t* base = jq == 0 ? (const bf16_t*)(F.ws + WS_WW) : jq == 1 ? (const bf16_t*)(F.ws + WS_QK) : jq == 2 ? (const bf16_t*)(F.ws + WS_KN) : (const bf16_t*)(F.ws + WS_QN);
    const bf16_t* Ug = (const bf16_t*)(F.ws + WS_U);
    int done = 0; unsigned sink = 0;
#pragma unroll 1
    for (int spin = 0; spin < (1 << 20); ++spin) {
        const int p = (int)__hip_atomic_load(prog, RLX_AGENT);
        if (p >= nch) break;
        if (done < p + 2) done = p + 2;
        const int tgt = p + 6 < nch ? p + 6 : nch;
        if (done >= tgt) { __builtin_amdgcn_s_sleep(8); continue; }
#pragma unroll 1
        for (int st = done; st < tgt; ++st) { const int n_ = dir == 0 ? st : nch - 1 - st; const size_t cl_ = chunk_lin(s, n_);
            const size_t off_ = ((size_t)(dir * 8 + h) * 192 + cl_) * 4096, offh = ((size_t)h * 192 + cl_) * 4096;
            const bf16_t* p0 = base + (jq < 2 ? off_ : offh) + (size_t)lane * 64; const bf16_t* p1 = Ug + off_ + (size_t)(jq * 16 + (lane & 15)) * 64;
            asm volatile("global_load_dword %0, %1, off\n\tglobal_load_dword %0, %2, off" : "+v"(sink) : "v"(p0), "v"(p1) : "memory"); }
        done = tgt;
        asm volatile("s_waitcnt vmcnt(0)" : "+v"(sink) :: "memory");
    }
    asm volatile("s_waitcnt vmcnt(0)" : "+v"(sink) :: "memory");
}

__device__ __forceinline__ void phase_combine(Frame& F, int l) {
    const bf16_t* of = (const bf16_t*)(F.ws + WS_OF); const bf16_t* ob = (const bf16_t*)(F.ws + WS_OB); const bf16_t* z = (const bf16_t*)(F.ws + WS_Z);
    bf16_t* ya = (bf16_t*)(F.ws + WS_YA); const float* na = F.in[I_NORMA] + l * 64;
    for (int i = F.bid * NTHR + F.tid; i < NTOK * 64; i += F.G * NTHR) {
        const size_t off = (size_t)i * 8; const int e0 = (i & 7) * 8;
        const u32x4 a = *(const u32x4*)(of + off), b = *(const u32x4*)(ob + off), zz = *(const u32x4*)(z + off);
        float o[8]; const unsigned aw[4] = {a.x, a.y, a.z, a.w}, bw[4] = {b.x, b.y, b.z, b.w}, zw[4] = {zz.x, zz.y, zz.z, zz.w};
        float ss = 0.f;
#pragma unroll
        for (int j = 0; j < 4; ++j) { o[2 * j] = bflo(aw[j]) + bflo(bw[j]); o[2 * j + 1] = bfhi(aw[j]) + bfhi(bw[j]); ss += o[2 * j] * o[2 * j] + o[2 * j + 1] * o[2 * j + 1]; }
        ss = sum8(ss);
        const float rs = rsqrtf_(ss * (1.f / 64.f) + EPS);
        unsigned w[4];
#pragma unroll
        for (int j = 0; j < 4; ++j) { const float z0 = bflo(zw[j]), z1 = bfhi(zw[j]);
            w[j] = pk2(o[2 * j] * rs * na[e0 + 2 * j] * siluf_(z0), o[2 * j + 1] * rs * na[e0 + 2 * j + 1] * siluf_(z1)); }
        *(u32x4*)(ya + off) = (u32x4){w[0], w[1], w[2], w[3]};
    }
}

constexpr int N_PHASES = 26;
__global__ void __launch_bounds__(NTHR, 2) mk_fwd(Args args) {
    extern __shared__ __attribute__((aligned(16))) unsigned char lds_raw[];
    Frame F;
    F.lds = (LAS unsigned char*)lds_raw; F.in = args.in; F.out = args.out; F.ws = args.ws; F.ctl = (unsigned*)(args.ws + WS_CTL);
    F.tid = threadIdx.x; F.lane = F.tid & 63; F.wave = __builtin_amdgcn_readfirstlane(F.tid >> 6); F.G = gridDim.x; F.bid = blockIdx.x;
    for (int u = F.tid; u < (LDS_BYTES - LDSCTL_OFF) / 4; u += NTHR) ((LAS unsigned*)(F.lds + LDSCTL_OFF))[u] = 0u;
    __syncthreads();
    XcdBarrier bar; bar.bar = F.ctl + CW_BAR; bar.x = 0; bar.st = nullptr;
    if (!MK_PER_PHASE) bar = xcd_barrier_post(F.ctl + CW_BAR, (volatile LAS unsigned*)(F.lds + MISC_OFF) + 8);
    const int lo = args.ph_lo, hi = args.ph_hi;
    PROF_DECL;
    using namespace pg8;
#define IN(k) (lo <= (k) && (k) < hi)
#define SEAM(k) do { if (IN(k) && IN((k) + 1)) { if (!MK_PER_PHASE) xcd_barrier(bar); } } while (0)
#define PHASE_FRAME() Frame P = F; P.ws = opq(P.ws); P.out = opq(P.out); P.ctl = opq(P.ctl); asm volatile("" : "+v"(P.tid)); asm volatile("" : "+s"(P.bid)); P.lane = P.tid & 63; P.wave = __builtin_amdgcn_readfirstlane(P.tid >> 6); \
    unsigned char* ws = P.ws; LAS unsigned char* ring = P.lds; (void)ws; (void)ring

    PROF_BEGIN(100);
    if (IN(0)) for (int rep = 0; rep < NREP(13); ++rep) { PHASE_FRAME(); PROF_BEGIN(124); prep_filters(P, 0); __syncthreads(); PROF_END(124); PROF_BEGIN(121); prep_mod(P); __syncthreads(); PROF_END(121); PROF_BEGIN(120); prep_x_tables(P); __syncthreads(); PROF_END(120); PROF_BEGIN(122); prep_weights(P, 0, 63); __syncthreads(); PROF_END(122); }
    SEAM(0);
    PROF_END(100);
#pragma unroll 1
    for (int l = 0; l < 2; ++l) {
        const int pb = 1 + 12 * l;
#define MODL ((const float*)(ws + WS_MOD) + (size_t)l * 3 * 6144)
        PROF_BEGIN(101);
        if (IN(pb + 0) && l == 0) { PHASE_FRAME();
            for (int rep = 0; rep < NREP(0); ++rep) phase_norm<true>(P, P.in[I_N1G], MODL, 1024, (bf16_t*)(ws + WS_H), (bf16_t*)(ws + WS_H), NTOK, (float*)(ws + WS_SS1));
            prep_bias_in(P, 0); }
        if (IN(pb + 0) && l == 1 && gridDim.x <= 192) { PHASE_FRAME(); prep_weights(P, 1, 63); prep_filters(P, 1); if (!MK_PER_PHASE) xcd_barrier(bar); prep_bias_in(P, 1); }
        if (l == 0 || gridDim.x <= 192) SEAM(pb + 0);
        PROF_END(101);
        PROF_BEGIN(102);
        if (IN(pb + 1)) for (int rep = 0; rep < NREP(1); ++rep) { PHASE_FRAME();
            { Gemm g{1024, 2048, 2048}; Sched2D S{(const char*)(ws + WS_H), (const char*)(ws + W_N), (size_t)256 * 2048, (size_t)256 * 2048, 48, 9, P.G, P.bid, 0, 0};
              EpiInN E{(bf16_t*)(ws + WS_QKV), (bf16_t*)(ws + WS_Z), (float*)(ws + WS_BA), (const float*)(ws + WS_SS1), (const float*)(ws + WS_CB1) + (size_t)l * 3 * 7936, ring, nullptr};
              rstd_prepass(S, E.ss, ring, false);
              gemm_phase<EpiInN, Sched2D, true, true>(ring, g, S, E); }
            { Gemm g{1024, 2048, 2048}; Sched2D S{(const char*)(ws + W_S), (const char*)(ws + WS_H), (size_t)256 * 2048, (size_t)256 * 2048, 10, 48, P.G, P.bid, 0, 0};
              EpiInS E{(bf16_t*)(ws + WS_HYT), (bf16_t*)(ws + WS_XCSL), (bf16_t*)(ws + WS_XCSC), (const float*)(ws + WS_SS1), (const float*)(ws + WS_CB1) + (size_t)l * 3 * 7936, ring, nullptr};
              rstd_prepass(S, E.ss, ring, true);
              gemm_phase<EpiInS, Sched2D, true, true>(ring, g, S, E); }
        }
        SEAM(pb + 1);
        PROF_END(102);
        PROF_BEGIN(103);
        if (IN(pb + 2)) {
            { PHASE_FRAME(); Gemm g{2048, 8192, 8192}; SchedFourL S{(const char*)(ws + WS_TABL), (const char*)(ws + WS_XCSL), P.bid};
              EpiScaleBf16 E{(bf16_t*)(ws + WS_YF), 512, 1.0f};
              gemm_phase<EpiScaleBf16, SchedFourL, true, true>(ring, g, S, E); }
            { PHASE_FRAME(); Gemm g{512, 1024, 1024}; SchedFourC S{(const char*)(ws + WS_TABC), (const char*)(ws + WS_XCSC), P.bid - 64};
              EpiScaleBf16 E{(bf16_t*)(ws + WS_YC), 512, 1.0f / sqrtf(64.0f * 256.0f)};
              gemm_phase<EpiScaleBf16, SchedFourC, true, true>(ring, g, S, E); }
            for (int rep = 0; rep < NREP(2); ++rep) { PHASE_FRAME(); __syncthreads();
              const int xq = P.bid & 7, qid = 16 + (2 * l + rep) * 8 + xq;
              for (int t = q_next(P, qid); t < 192; t = q_next(P, qid)) {
                if (t < 64) hyena_task(P, l, 64 * xq + t, 0);
                else { const int tt = t - 64; hyena_task(P, l, 64 * xq + (tt >> 1), 1 + (tt & 1)); }
              } }
        }
        SEAM(pb + 2);
        PROF_END(103);
        PROF_BEGIN(104);
        if (IN(pb + 3)) for (int rep = 0; rep < NREP(3); ++rep) { PHASE_FRAME();
            for (int t0 = 2 * P.bid; t0 < 1536; t0 += 2 * P.G) { const int t = t0 + (P.wave >> 2);
                int s, h, n;
                if (t < 1024) { s = t >> 5; h = (t >> 2) & 7; n = t & 3; } else { const int tt = t - 1024; s = 32 + (tt >> 8); h = (tt >> 5) & 7; n = tt & 31; }
                d1_task(P, l, s, h, n);
            }
        }
        SEAM(pb + 3);
        PROF_END(104);
        PROF_BEGIN(105);
        if (IN(pb + 4)) for (int rep = 0; rep < NREP(4); ++rep) { PHASE_FRAME();
            const int gw = P.wave * P.G + P.bid, NW = NWAVES * P.G;
            const bool xl = P.G == 256; const int xm = P.bid >> 3, xkk = (P.bid & 7) + 8 * ((xm & 15) >> 2), xsl = xm & 3;
            unsigned* prog = P.ctl + CW_PROG + (l * 32 + xkk) * 16;
            if (xl) {
                if (P.wave == 0 && P.bid < 128) d2_wave_task(P, l, 32 + (xkk >> 4), (xkk >> 1) & 7, xkk & 1, xsl, xsl == 0 ? prog : nullptr);
                const int hf = P.wave >> 2, slc = P.wave & 3, b1 = P.bid - 128;
                if (P.bid >= 128) { const int c0 = 2 * b1 + hf; d2_wave_task(P, l, c0 >> 4, (c0 >> 1) & 7, c0 & 1, slc); }
                else if (hf == 1) { const int c0 = 256 + P.bid, c1 = 384 + P.bid; d2_wave_task(P, l, c0 >> 4, (c0 >> 1) & 7, c0 & 1, slc); d2_wave_task(P, l, c1 >> 4, (c1 >> 1) & 7, c1 & 1, slc); }
                if (rep == 0 && P.bid >= 128) { Frame Q = P; Q.bid = b1; Q.G = P.G - 128;
                    phase_norm<false>(Q, P.in[I_N1G] + l * DM, MODL, 1024, (bf16_t*)(ws + WS_TABL), (bf16_t*)(ws + WS_FILL), 8192, nullptr);
                    if (P.wave == 0) d2_helper(P, l, xkk, xsl, prog); }
            } else if (gw < 128) { d2_wave_task(P, l, 32 + (gw >> 6), (gw >> 3) & 7, (gw >> 2) & 1, gw & 3); }
            else { for (int tt = gw - 128; tt < 2048; tt += NW - 128) d2_wave_task(P, l, tt >> 6, (tt >> 3) & 7, (tt >> 2) & 1, tt & 3);
                if (rep == 0 && P.G > 128 && P.bid >= 128) { Frame Q = P; Q.bid = P.bid - 128; Q.G = P.G - 128;
                    phase_norm<false>(Q, P.in[I_N1G] + l * DM, MODL, 1024, (bf16_t*)(ws + WS_TABL), (bf16_t*)(ws + WS_FILL), 8192, nullptr); } }
        }
        SEAM(pb + 4);
        PROF_END(105);
        PROF_BEGIN(106);
        const bool mergeFG = gridDim.x == 256;
#define PHASE_F_BODY(Q) do { \
            { const u32x4* p0 = (const u32x4*)(ws + WS_YF); const u32x4* p1 = p0 + 4096 * 512 / 8; bf16_t* yc = (bf16_t*)(ws + WS_YC) + (size_t)NCTX * 512; const float sc = 1.0f / sqrtf(64.0f * 2048.0f); \
              for (int i = (Q).bid * NTHR + (Q).tid; i < 4096 * 512 / 8; i += (Q).G * NTHR) { const u32x4 a = p0[i], b = p1[i]; \
                  *(u32x4*)(yc + (size_t)i * 8) = (u32x4){pk2((bflo(a.x) + bflo(b.x)) * sc, (bfhi(a.x) + bfhi(b.x)) * sc), pk2((bflo(a.y) + bflo(b.y)) * sc, (bfhi(a.y) + bfhi(b.y)) * sc), \
                                                          pk2((bflo(a.z) + bflo(b.z)) * sc, (bfhi(a.z) + bfhi(b.z)) * sc), pk2((bflo(a.w) + bflo(b.w)) * sc, (bfhi(a.w) + bfhi(b.w)) * sc)}; } } \
            phase_combine(Q, l); } while (0)
        if (IN(pb + 5) && !mergeFG) { PHASE_FRAME(); PHASE_F_BODY(P); if (P.G <= 128) phase_norm<false>(P, P.in[I_N1G] + l * DM, MODL, 1024, (bf16_t*)(ws + WS_TABL), (bf16_t*)(ws + WS_FILL), 8192, nullptr); }
        if (!mergeFG) SEAM(pb + 5);
        PROF_END(106);
        PROF_BEGIN(107);
        if (IN(pb + 6) && mergeFG && blockIdx.x >= 64) { PHASE_FRAME(); Frame Q = P; Q.bid = P.bid - 64; Q.G = P.G - 64; PHASE_F_BODY(Q); __syncthreads(); }
        if (IN(pb + 6)) for (int rep = 0; rep < NREP(6); ++rep) { PHASE_FRAME(); Gemm g{1024, 2048, 2048}; SchedSplitA S{(const char*)(ws + WS_TABL), (const char*)(ws + WS_FILL), (const char*)(ws + W_G), (size_t)256 * 2048, (size_t)256 * 2048, 48, 12, 32, P.G, P.bid};
            EpiGate E{(bf16_t*)(ws + WS_GATE), (const float*)(ws + WS_SS1), (const float*)(ws + WS_CB1) + (size_t)l * 3 * 7936, ring, nullptr};
            rstd_prepass(S, E.ss, ring, false);
            gemm_phase<EpiGate, SchedSplitA, true, true>(ring, g, S, E); }
#undef PHASE_F_BODY
        SEAM(pb + 6);
        PROF_END(107);
        PROF_BEGIN(108);
        if (IN(pb + 7)) {
            static_assert(WS_YB == WS_YA + 12 * MiB && WS_YC == WS_YB + 12 * MiB, "y buffers 12 MiB apart");
            { PHASE_FRAME(); Gemm g{512, 1024, 1024};
              SchedMergeHN S{(const char*)(ws + WS_YA), (const char*)(ws + W_P), P.G, P.bid};
              EpiMergeHN E; E.M = (bf16_t*)(ws + WS_MRG); E.G = (const bf16_t*)(ws + WS_GATE);
#pragma unroll
              for (int i8 = 0; i8 < 8; ++i8) { E.tot[i8 >> 2][i8 & 3][0] = (f32x4){0.f, 0.f, 0.f, 0.f}; E.tot[i8 >> 2][i8 & 3][1] = (f32x4){0.f, 0.f, 0.f, 0.f}; }
              gemm_phase<EpiMergeHN, SchedMergeHN, true, true, true>(ring, g, S, E); }
            if (gridDim.x > 128 ? blockIdx.x >= 128 : true) { PHASE_FRAME(); __syncthreads(); Frame Q = P; if (P.G > 128) { Q.bid = P.bid - 128; Q.G = P.G - 128; }
                prep_bias_gu(Q, l); if (l == 0 && P.G > 192) prep_weights(Q, 1, 1); }
        }
        SEAM(pb + 7);
        PROF_END(108);
        PROF_BEGIN(109);
        if (IN(pb + 8) && blockIdx.x >= 192) { PHASE_FRAME(); Frame Q = P; Q.bid = P.bid - 192; Q.G = P.G - 192; prep_weights(Q, 1, l == 0 ? (2 | 4) : 32); }
        if (IN(pb + 8)) { PHASE_FRAME(); Gemm g{1024, 2048, 6144}; Sched2D S{(const char*)(ws + WS_MRG), (const char*)(ws + W_O3), (size_t)256 * 2048, (size_t)256 * 6144, 48, 4, P.G, P.bid, 0, 0};
            EpiResidN E{(bf16_t*)P.out, MODL + 2048, (bf16_t*)(ws + WS_H), (float*)(ws + WS_SS), P.in[I_N2G] + l * DM, MODL + 4096};
            gemm_phase<EpiResidN, Sched2D, false, true>(ring, g, S, E); }
        SEAM(pb + 8);
        PROF_END(109);
        PROF_BEGIN(111);
        if (IN(pb + 10)) for (int rep = 0; rep < NREP(10); ++rep) { PHASE_FRAME(); Gemm g{1024, 2048, 2048}; Sched2D S{(const char*)(ws + WS_H), (const char*)(ws + W_GU), (size_t)256 * 2048, (size_t)256 * 2048, 48, 22, P.G, P.bid, 0, 0};
            EpiGU2 E{(bf16_t*)(ws + WS_ACT), (const float*)(ws + WS_SS), (const float*)(ws + WS_CB) + (size_t)l * 3 * 5632, ring, nullptr};
            rstd_prepass(S, E.ss, ring, false);
            gemm_phase<EpiGU2, Sched2D, true, true>(ring, g, S, E);
            if (l == 0 && P.G > 192 && P.bid >= 32) { __syncthreads(); Frame Q = P; Q.bid = P.bid - 32; Q.G = P.G - 32; prep_filters(Q, 1); prep_weights(Q, 1, 8); } }
        SEAM(pb + 10);
        PROF_END(111);
        PROF_BEGIN(112);
        if (IN(pb + 11) && l == 0 && blockIdx.x >= 192) { PHASE_FRAME(); Frame Q = P; Q.bid = P.bid - 192; Q.G = P.G - 192; prep_weights(Q, 1, 16); prep_tabl(Q); prep_bias_in(Q, 1); }
        if (IN(pb + 11)) { PHASE_FRAME(); Gemm g{DFF, DFF * 2, DFF * 2}; Sched2D S{(const char*)(ws + WS_ACT), (const char*)(ws + W_DN), (size_t)256 * DFF * 2, (size_t)256 * DFF * 2, 48, 4, P.G, P.bid, 0, 0};
            if (l == 0) { EpiResidN E{(bf16_t*)P.out, MODL + 5120, (bf16_t*)(ws + WS_H), (float*)(ws + WS_SS1), P.in[I_N1G] + DM, MODL + 3 * 6144 + 1024};
                gemm_phase<EpiResidN, Sched2D, false, true>(ring, g, S, E); }
            else { EpiResid E{(bf16_t*)P.out, MODL + 5120};
                gemm_phase<EpiResid, Sched2D, false, true>(ring, g, S, E); } }
        SEAM(pb + 11);
        PROF_END(112);
    }
    PROF_BEGIN(113);
    if (IN(25)) { PHASE_FRAME(); phase_final(P, bar); }
    PROF_END(113); PROF_FLUSH();
    if (PROBE_ID != 0) { __syncthreads();
        if (blockIdx.x == PROBE_BLK && threadIdx.x == 0) { const unsigned tot = *(volatile LAS unsigned*)(F.lds + MISC_OFF + 96); unsigned long long want = (unsigned long long)tot * PROBE_AMP; if (want > 3000000ull) want = 3000000ull;
            const unsigned long long t0 = __builtin_amdgcn_s_memrealtime(); while (__builtin_amdgcn_s_memrealtime() - t0 < want) __builtin_amdgcn_s_sleep(16); }
        __syncthreads(); }
#undef IN
#undef SEAM
}

extern "C" void kernel_launch(void* const* d_in, const int* in_sizes, int n_in, void* d_out, int out_size, void* d_ws, size_t ws_size, hipStream_t stream) {
    static int grid = 0;
    if (grid == 0) {
        if (n_in != N_IN || out_size != NTOK * DM + 32 * 2 * 2 * 8 * 4096 || ws_size < WS_END) { fprintf(stderr, "kernel_launch: unexpected shapes (n_in %d out %d ws %zu); nothing launched\n", n_in, out_size, ws_size); grid = -1; return; }
        int dev = 0, cus = 0, per_cu = 0;
        if (hipGetDevice(&dev) != hipSuccess || hipDeviceGetAttribute(&cus, hipDeviceAttributeMultiprocessorCount, dev) != hipSuccess) { grid = -1; return; }
        if (hipFuncSetAttribute((const void*)mk_fwd, hipFuncAttributeMaxDynamicSharedMemorySize, LDS_BYTES) != hipSuccess) { fprintf(stderr, "kernel_launch: hipFuncSetAttribute failed\n"); grid = -1; return; }
        if (hipOccupancyMaxActiveBlocksPerMultiprocessor(&per_cu, (const void*)mk_fwd, NTHR, LDS_BYTES) != hipSuccess || per_cu < 1) { fprintf(stderr, "kernel_launch: occupancy query says %d blocks per CU; nothing launched\n", per_cu); (void)hipGetLastError(); grid = -1; return; }
        if (cus < 132) { fprintf(stderr, "kernel_launch: %d CUs: the per-workgroup row-statistics table holds 8 GEMM units (needs >= 132 workgroups); nothing launched\n", cus); grid = -1; return; }
        grid = cus;
    }
    if (grid < 0) return;
    if (hipMemsetAsync((char*)d_ws + WS_CTL, 0, CTL_ZERO_BYTES, stream) != hipSuccess) return;
    Args a{};
    for (int i = 0; i < N_IN; ++i) a.in[i] = (const float*)d_in[i];
    a.out = (float*)d_out; a.ws = (unsigned char*)d_ws;
#if MK_PER_PHASE
    for (int p = 0; p < N_PHASES; ++p) { a.ph_lo = p; a.ph_hi = p + 1; a.li = 0; hipLaunchKernelGGL(mk_fwd, dim3(grid), dim3(NTHR), LDS_BYTES, stream, a); }
#else
    a.ph_lo = 0; a.ph_hi = N_PHASES; a.li = 0;
    hipLaunchKernelGGL(mk_fwd, dim3(grid), dim3(NTHR), LDS_BYTES, stream, a);
#endif
}
```
